# Optimizing an MI355X kernel written in HIP

```python
import math
import jax
import jax.numpy as jnp
from jax import lax
import numpy as np

D_MODEL = 4096
BATCH = 1
SEQ = 8192
DEPTH = 2

MIX_WIDTH = D_MODEL
ATTN_WIDTH = MIX_WIDTH // 2
ATTN_HEAD_DIM = 128
ATTN_HEADS = ATTN_WIDTH // ATTN_HEAD_DIM
DILATION_PATTERNS = ((128, 1), (512, 4), (2048, 16))
ATTN_Q_BLOCK = 64
REL_BUCKETS = 32
REL_MAX_EXACT = REL_BUCKETS // 2
REL_MAX_DISTANCE = 2048
MLSTM_WIDTH = MIX_WIDTH - ATTN_WIDTH
MLSTM_HEADS = 4
MLSTM_V_DIM = MLSTM_WIDTH // MLSTM_HEADS
MLSTM_QK_DIM = MLSTM_V_DIM // 2
MLSTM_QK_WIDTH = MLSTM_HEADS * MLSTM_QK_DIM
MLSTM_CHUNK = 64
CONV_WIDTH = 4
NORM_EPS = 1e-6
SPLIT_SIZES = (ATTN_WIDTH, ATTN_WIDTH, ATTN_WIDTH, ATTN_WIDTH,
               MLSTM_QK_WIDTH, MLSTM_QK_WIDTH, MLSTM_WIDTH, MLSTM_WIDTH, MLSTM_WIDTH,
               MLSTM_HEADS, MLSTM_HEADS)
IN_WIDTH = sum(SPLIT_SIZES)

kernel_name = 'hymba_dilated_attn_mlstm_hybrid'


def rmsnorm(x, g):
    xf = x.astype(jnp.float32)
    y = xf * lax.rsqrt(jnp.mean(xf * xf, axis=-1, keepdims=True) + NORM_EPS)
    return (y * g.astype(jnp.float32)).astype(x.dtype)


def rel_buckets(dist):
    n = dist.astype(np.float32)
    large = REL_MAX_EXACT + np.floor(
        np.log(np.maximum(n, 1.0) / REL_MAX_EXACT)
        / np.log(REL_MAX_DISTANCE / REL_MAX_EXACT) * (REL_BUCKETS - REL_MAX_EXACT))
    large = np.minimum(large, REL_BUCKETS - 1)
    return np.where(n < REL_MAX_EXACT, n, large).astype(np.int32)


def dilated_attention(q, k, v, rel_bias):
    B, S, H, Dh = q.shape
    q = q * (Dh ** -0.5)
    offs = [np.arange(w // d + 1, dtype=np.int32) * d for w, d in DILATION_PATTERNS]
    biases = [rel_bias[rel_buckets(o)].T.astype(jnp.float32) for o in offs]

    def block(bi):
        start = bi * ATTN_Q_BLOCK
        t = start + jnp.arange(ATTN_Q_BLOCK, dtype=jnp.int32)
        qb = lax.dynamic_slice_in_dim(q, start, ATTN_Q_BLOCK, axis=1)
        outs, lses = [], []
        for off, bias in zip(offs, biases):
            idx = t[:, None] - jnp.asarray(off)[None, :]
            valid = idx >= 0
            idx = jnp.maximum(idx, 0)
            kg = k[:, idx]
            vg = v[:, idx]
            s = jnp.einsum('bqhd,bqjhd->bhqj', qb, kg).astype(jnp.float32) + bias[None, :, None, :]
            s = jnp.where(valid[None, None], s, -jnp.inf)
            m = jnp.max(s, axis=-1, keepdims=True)
            p = jnp.exp(s - m)
            l = jnp.sum(p, axis=-1)
            o = jnp.einsum('bhqj,bqjhd->bhqd', p, vg.astype(jnp.float32)) / l[..., None]
            outs.append(o)
            lses.append(m[..., 0] + jnp.log(l))
        wts = jax.nn.softmax(jnp.stack(lses), axis=0)
        o = jnp.einsum('pbhq,pbhqd->bqhd', wts, jnp.stack(outs))
        return o.astype(q.dtype)

    ob = lax.map(block, jnp.arange(S // ATTN_Q_BLOCK, dtype=jnp.int32))
    return ob.transpose(1, 0, 2, 3, 4).reshape(B, S, H, Dh)


def causal_conv(x, w):
    S = x.shape[1]
    xp = jnp.pad(x, ((0, 0), (CONV_WIDTH - 1, 0), (0, 0)))
    return sum(xp[:, j:j + S] * w[j] for j in range(CONV_WIDTH))


def mlstm_chunkwise(q, k, v, ig, fg):
    B, S, H, Dk = q.shape
    Dv = v.shape[-1]
    L = MLSTM_CHUNK
    NC = S // L
    f32 = jnp.float32
    q = q.astype(f32)
    k = k.astype(f32) * (Dk ** -0.5)
    v = v.astype(f32)
    log_f = jax.nn.log_sigmoid(fg.astype(f32))
    log_i = ig.astype(f32)

    def chunks(a):
        return jnp.moveaxis(a.reshape((B, NC, L) + a.shape[2:]), 1, 0).swapaxes(2, 3)

    qc, kc, vc = chunks(q), chunks(k), chunks(v)
    lfc, lic = chunks(log_f), chunks(log_i)
    bc = jnp.cumsum(lfc, axis=-1)
    tri = jnp.tril(jnp.ones((L, L), dtype=bool))

    def step(carry, inp):
        C, n, m = carry
        qx, kx, vx, b, li = inp
        D = b[..., :, None] - b[..., None, :] + li[..., None, :]
        D = jnp.where(tri, D, -jnp.inf)
        m_inter = b + m[..., None]
        m_t = jnp.maximum(m_inter, jnp.max(D, axis=-1))
        w_inter = jnp.exp(m_inter - m_t)
        Sqk = jnp.einsum('bhld,bhsd->bhls', qx, kx) * jnp.exp(D - m_t[..., None])
        num = w_inter[..., None] * jnp.einsum('bhld,bhdv->bhlv', qx, C) + jnp.einsum('bhls,bhsv->bhlv', Sqk, vx)
        nq = w_inter * jnp.einsum('bhld,bhd->bhl', qx, n) + jnp.sum(Sqk, axis=-1)
        h = num / jnp.maximum(jnp.abs(nq), jnp.exp(-m_t))[..., None]
        bL = b[..., -1]
        g = bL[..., None] - b + li
        m_new = jnp.maximum(bL + m, jnp.max(g, axis=-1))
        a = jnp.exp(bL + m - m_new)
        ws = jnp.exp(g - m_new[..., None])
        C_new = a[..., None, None] * C + jnp.einsum('bhs,bhsd,bhsv->bhdv', ws, kx, vx)
        n_new = a[..., None] * n + jnp.einsum('bhs,bhsd->bhd', ws, kx)
        return (C_new, n_new, m_new), h

    init = (jnp.zeros((B, H, Dk, Dv), f32), jnp.zeros((B, H, Dk), f32), jnp.zeros((B, H), f32))
    _, hs = lax.scan(step, init, (qc, kc, vc, bc, lic))
    return hs.transpose(1, 0, 3, 2, 4).reshape(B, S, H, Dv)


def setup_inputs(seed: int = 0) -> dict:
    key = jax.random.key(seed)
    ks = jax.random.split(key, 10)
    f32 = jnp.float32
    x = jax.random.normal(ks[0], (BATCH, SEQ, D_MODEL), f32)
    norm_g = 1.0 + 0.05 * jax.random.normal(ks[1], (DEPTH, D_MODEL), f32)
    w_in = jax.random.normal(ks[2], (DEPTH, D_MODEL, IN_WIDTH), f32) * D_MODEL ** -0.5
    b_i = 0.1 * jax.random.normal(ks[3], (DEPTH, MLSTM_HEADS), f32)
    b_f = jnp.linspace(3.0, 6.0, MLSTM_HEADS, dtype=f32)[None, :] + 0.1 * jax.random.normal(ks[4], (DEPTH, MLSTM_HEADS), f32)
    b_gate = jnp.concatenate([b_i, b_f], axis=-1)
    conv_w = jax.random.normal(ks[5], (DEPTH, CONV_WIDTH, 2 * MLSTM_QK_WIDTH), f32) * CONV_WIDTH ** -0.5
    mlstm_norm_g = 1.0 + 0.05 * jax.random.normal(ks[6], (DEPTH, MLSTM_WIDTH), f32)
    w_out = jax.random.normal(ks[7], (DEPTH, MIX_WIDTH, D_MODEL), f32) * (0.5 * MIX_WIDTH ** -0.5)
    rel_bias = 0.5 * jax.random.normal(ks[8], (REL_BUCKETS, ATTN_HEADS), f32)
    final_g = 1.0 + 0.05 * jax.random.normal(ks[9], (D_MODEL,), f32)
    return {'x': x, 'norm_g': norm_g, 'w_in': w_in, 'b_gate': b_gate, 'conv_w': conv_w,
            'mlstm_norm_g': mlstm_norm_g, 'w_out': w_out, 'rel_bias': rel_bias, 'final_g': final_g}


def reference(x, norm_g, w_in, b_gate, conv_w, mlstm_norm_g, w_out, rel_bias, final_g):
    B, S, _ = x.shape
    split_points = tuple(int(p) for p in np.cumsum(SPLIT_SIZES)[:-1])
    for l in range(DEPTH):
        h = rmsnorm(x, norm_g[l])
        u = jnp.einsum('bsd,de->bse', h, w_in[l])
        qa, ka, va, za, qm, km, vm, om, zm, ig, fg = jnp.split(u, split_points, axis=-1)
        hd = (B, S, ATTN_HEADS, ATTN_HEAD_DIM)
        ya = dilated_attention(qa.reshape(hd), ka.reshape(hd), va.reshape(hd), rel_bias)
        ya = ya.reshape(B, S, ATTN_WIDTH) * jax.nn.silu(za)
        qk = jax.nn.silu(causal_conv(jnp.concatenate([qm, km], axis=-1), conv_w[l]))
        qm, km = jnp.split(qk, 2, axis=-1)
        ig = ig.astype(jnp.float32) + b_gate[l, :MLSTM_HEADS].astype(jnp.float32)
        fg = fg.astype(jnp.float32) + b_gate[l, MLSTM_HEADS:].astype(jnp.float32)
        hm = mlstm_chunkwise(qm.reshape(B, S, MLSTM_HEADS, MLSTM_QK_DIM),
                             km.reshape(B, S, MLSTM_HEADS, MLSTM_QK_DIM),
                             vm.reshape(B, S, MLSTM_HEADS, MLSTM_V_DIM), ig, fg)
        hm = hm * lax.rsqrt(jnp.mean(hm * hm, axis=-1, keepdims=True) + NORM_EPS)
        hm = hm * mlstm_norm_g[l].astype(jnp.float32).reshape(MLSTM_HEADS, MLSTM_V_DIM)
        ym = hm.reshape(B, S, MLSTM_WIDTH).astype(x.dtype) * jax.nn.sigmoid(om) * jax.nn.silu(zm)
        y = jnp.concatenate([ya, ym], axis=-1)
        x = x + jnp.einsum('bse,ed->bsd', y, w_out[l]).astype(x.dtype)
    return rmsnorm(x, final_g)
```

```cpp
#include <hip/hip_runtime.h>
#include <hip/hip_cooperative_groups.h>
#include <cstdio>
#include <cstdint>
namespace cg = cooperative_groups;
namespace pg8 {
#define PG8_LAS __attribute__((address_space(3)))
typedef unsigned short bf16_t;
typedef short bf16x8 __attribute__((ext_vector_type(8)));
typedef float f32x4 __attribute__((ext_vector_type(4)));
typedef unsigned u32x4 __attribute__((ext_vector_type(4)));
constexpr int BM = 256, BK = 64, HALF = 128, HTB = HALF * BK * 2  , STAGE_BYTES = 8 * HTB, NXCD = 8, WGM = 8;

__host__ __device__ __forceinline__ int lds_byte(int r, int c) { const int st = (r >> 4) * 2 + (c >> 5), rr = r & 15, cc = c & 31, ob = rr * 64 + cc * 2; return st * 1024 + (ob ^ (((ob >> 9) & 1) << 5)); }
__host__ __device__ __forceinline__ void stage_rc(int b, int& R, int& C) { const int st = b / 1024, sb = b % 1024, swz = sb ^ (((sb >> 9) & 1) << 5); R = (st >> 1) * 16 + swz / 64; C = (st & 1) * 32 + (swz % 64) / 2; }
__host__ __device__ __forceinline__ int perm32(int rho) { const int n = rho >> 4, i = rho & 15; return 8 * (i >> 2) + 4 * n + (i & 3); }

struct Unit { int pm, pn; };
struct Gemm { const bf16_t* A; const bf16_t* Bt; int M, N, K; };

struct StaticOrder {
    int nM, nN, nwg, G, c;
    __host__ __device__ void init(int M, int N, int G_, int c_) { nM = M / BM; nN = N / BM; nwg = nM * nN; G = G_; c = c_; }
    __host__ __device__ bool next(int i, Unit& u) const {
        const long L = (long)i * G + c; if (L >= nwg) return false;
        int wgid = (int)L; { const int q = nwg / NXCD, r = nwg % NXCD, xcd = wgid % NXCD, off = wgid / NXCD; wgid = (xcd < r ? xcd * (q + 1) : r * (q + 1) + (xcd - r) * q) + off; }
        const int nig = WGM * nN, gid = wgid / nig, fm = gid * WGM, gsz = (nM - fm) < WGM ? (nM - fm) : WGM;
        u.pm = fm + ((wgid % nig) % gsz); u.pn = (wgid % nig) / gsz; return true;
    }
    __device__ __forceinline__ void a_ready(const Unit&) const {}
    __device__ __forceinline__ void done(const Unit&) const {}
};

__device__ __forceinline__ unsigned cvt_pk_bf16(float lo, float hi) { unsigned r; asm volatile("v_cvt_pk_bf16_f32 %0, %1, %2" : "=v"(r) : "v"(lo), "v"(hi)); return r; }
struct EpiBf16Plain {
    static constexpr bool PERM = true, AFTER_DRAIN = false;
    bf16_t* O; int ldc;
    __device__ __forceinline__ void operator()(const f32x4 (&acc)[2][2][4][2], const Unit& u, int wr, int wc, int fr, int fq) const {
        const int row0 = u.pm * BM + wr * 64 + fr; const int col0 = u.pn * BM + wc * 32 + 8 * fq;
#pragma unroll
        for (int ai = 0; ai < 2; ++ai)
#pragma unroll
            for (int m = 0; m < 4; ++m) { bf16_t* rowp = O + (size_t)(row0 + ai * HALF + m * 16) * ldc + col0;
#pragma unroll
                for (int bj = 0; bj < 2; ++bj) { const f32x4 v0 = acc[ai][bj][m][0], v1 = acc[ai][bj][m][1];
                    u32x4 w; w.x = cvt_pk_bf16(v0[0], v0[1]); w.y = cvt_pk_bf16(v0[2], v0[3]); w.z = cvt_pk_bf16(v1[0], v1[1]); w.w = cvt_pk_bf16(v1[2], v1[3]);
                    *(u32x4*)(rowp + bj * HALF) = w; } }
    }
};
struct EpiResF32 {
    static constexpr bool PERM = true, AFTER_DRAIN = false;
    const float* base; float* out; int ld;
    __device__ __forceinline__ void operator()(const f32x4 (&acc)[2][2][4][2], const Unit& u, int wr, int wc, int fr, int fq) const {
        const int row0 = u.pm * BM + wr * 64 + fr; const int col0 = u.pn * BM + wc * 32 + 8 * fq;
#pragma unroll
        for (int ai = 0; ai < 2; ++ai)
#pragma unroll
            for (int m = 0; m < 4; ++m) { const size_t ro = (size_t)(row0 + ai * HALF + m * 16) * ld + col0;
#pragma unroll
                for (int bj = 0; bj < 2; ++bj) {
                    const f32x4 b0 = *(const f32x4*)(base + ro + bj * HALF), b1 = *(const f32x4*)(base + ro + bj * HALF + 4);
                    *(f32x4*)(out + ro + bj * HALF) = acc[ai][bj][m][0] + b0;
                    *(f32x4*)(out + ro + bj * HALF + 4) = acc[ai][bj][m][1] + b1; } }
    }
};
template <class Epi, class Sched, bool ALIGN_EPI = false, bool SP2 = false>
__device__ __forceinline__ void gemm_phase(PG8_LAS unsigned char* lds, const Gemm g, const Sched& S, const Epi& E) {
    const int tid = threadIdx.x, wid = __builtin_amdgcn_readfirstlane(tid >> 6), lane = tid & 63, wr = wid >> 2, wc = wid & 3, fr = lane & 15, fq = lane >> 4;
    const int K = g.K, nt = K / BK;
    unsigned voffA[2], voffB[2];
#pragma unroll
    for (int i = 0; i < 2; ++i) { int R, C; stage_rc(tid * 16 + i * 8192, R, C); const int Rb = Epi::PERM ? ((R & ~31) + perm32(R & 31)) : R;
        voffA[i] = (unsigned)(R * K + C) * 2u; voffB[i] = (unsigned)(Rb * K + C) * 2u; }
    const size_t kstep = (size_t)(BK * 2);
    const size_t hstep = (size_t)HALF * K * 2;
    const size_t tstep = 2 * hstep;
    const unsigned ldsw = (unsigned)wid * 1024u;
    const int aoff = lds_byte(wr * 64 + fr, fq * 8), boff = lds_byte(wc * 32 + fr, fq * 8);
#define PG8_SA(b, h) (((b) * 2 + (h)) * HTB)
#define PG8_SB(b, h) ((4 + (b) * 2 + (h)) * HTB)
#define PG8_STAGE(bufoff, gbase, voff) do { _Pragma("unroll") for (int _i = 0; _i < 2; ++_i) \
        __builtin_amdgcn_global_load_lds((const unsigned*)((const char*)(gbase) + (voff)[_i]), (PG8_LAS unsigned*)(lds + (bufoff) + ldsw + _i * 8192), 16, 0, 0); } while (0)
#define PG8_LDA(dst, b, h) do { _Pragma("unroll") for (int m = 0; m < 4; ++m) _Pragma("unroll") for (int k = 0; k < 2; ++k) dst[m][k] = *(const PG8_LAS bf16x8*)(lds + PG8_SA(b, h) + aoff + m * 2048 + k * 1024); } while (0)
#define PG8_LDB(dst, b, h) do { _Pragma("unroll") for (int n = 0; n < 2; ++n) _Pragma("unroll") for (int k = 0; k < 2; ++k) dst[n][k] = *(const PG8_LAS bf16x8*)(lds + PG8_SB(b, h) + boff + n * 2048 + k * 1024); } while (0)
#define PG8_MMA(ai, bj, At, Bt) do { __builtin_amdgcn_s_setprio(1); _Pragma("unroll") for (int m = 0; m < 4; ++m) _Pragma("unroll") for (int n = 0; n < 2; ++n) _Pragma("unroll") for (int k = 0; k < 2; ++k) \
        acc[ai][bj][m][n] = __builtin_amdgcn_mfma_f32_16x16x32_bf16(Bt[n][k], At[m][k], acc[ai][bj][m][n], 0, 0, 0); __builtin_amdgcn_s_setprio(0); } while (0)
#define PG8_WAIT_V(n) asm volatile("s_waitcnt vmcnt(" #n ")" ::: "memory")
#define PG8_WAIT_L(n) asm volatile("s_waitcnt lgkmcnt(" #n ")" ::: "memory")
#define PG8_BAR __builtin_amdgcn_s_barrier()
#define PG8_SCHED __builtin_amdgcn_sched_barrier(0)
    Unit cur, nxt; int ui = 0;
    if (!S.next(0, cur)) return;
    f32x4 acc[2][2][4][2];
#pragma unroll
    for (int a = 0; a < 2; ++a)
#pragma unroll
        for (int b = 0; b < 2; ++b)
#pragma unroll
            for (int m = 0; m < 4; ++m)
#pragma unroll
                for (int n = 0; n < 2; ++n) acc[a][b][m][n] = (f32x4){0.f, 0.f, 0.f, 0.f};
    bf16x8 At[4][2], B0[2][2], B1[2][2];
    const char* cA = (const char*)g.A + (size_t)cur.pm * tstep; const char* cB = (const char*)g.Bt + (size_t)cur.pn * tstep;
    S.a_ready(cur);
    if constexpr (SP2) {
        PG8_STAGE(PG8_SB(0, 0), cB, voffB); PG8_STAGE(PG8_SB(0, 1), cB + hstep, voffB); PG8_STAGE(PG8_SA(0, 0), cA, voffA); PG8_STAGE(PG8_SA(0, 1), cA + hstep, voffA);
        if (wr == 1) PG8_BAR;
        PG8_WAIT_V(2); PG8_BAR;
        PG8_STAGE(PG8_SB(1, 0), cB + kstep, voffB); PG8_STAGE(PG8_SA(1, 0), cA + kstep, voffA); PG8_STAGE(PG8_SB(1, 1), cB + hstep + kstep, voffB);
        PG8_WAIT_V(6); PG8_BAR;
    } else {
        PG8_STAGE(PG8_SB(0, 0), cB, voffB); PG8_STAGE(PG8_SA(0, 0), cA, voffA); PG8_STAGE(PG8_SB(0, 1), cB + hstep, voffB); PG8_STAGE(PG8_SA(0, 1), cA + hstep, voffA);
        if (wr == 1) PG8_BAR;
        PG8_WAIT_V(4); PG8_BAR;
        PG8_STAGE(PG8_SB(1, 0), cB + kstep, voffB); PG8_STAGE(PG8_SA(1, 0), cA + kstep, voffA); PG8_STAGE(PG8_SB(1, 1), cB + hstep + kstep, voffB);
        PG8_WAIT_V(6); PG8_BAR;
    }
    for (;;) {
        const bool has_next = S.next(ui + 1, nxt);
        const char* nA = has_next ? (const char*)g.A + (size_t)nxt.pm * tstep : cA; const char* nB = has_next ? (const char*)g.Bt + (size_t)nxt.pn * tstep : cB;
        for (int t = 0; t < nt; t += 2) {
            const bool last = (t == nt - 2);
            const char* a1 = cA + (size_t)(t + 1) * kstep;
            const char* a2 = last ? nA : cA + (size_t)(t + 2) * kstep; const char* b2 = last ? nB : cB + (size_t)(t + 2) * kstep;
            const char* a3 = a2 + kstep; const char* b3 = b2 + kstep;
            if (last && has_next) S.a_ready(nxt);
            if constexpr (SP2) {
            PG8_LDB(B0, 0, 0); PG8_LDB(B1, 0, 1); PG8_SCHED; PG8_LDA(At, 0, 0); PG8_STAGE(PG8_SA(1, 1), a1 + hstep, voffA);
            PG8_WAIT_V(8); PG8_WAIT_L(0); PG8_BAR; PG8_MMA(0, 0, At, B0); PG8_MMA(0, 1, At, B1); PG8_BAR; PG8_SCHED;
            PG8_LDA(At, 0, 1); PG8_STAGE(PG8_SB(0, 0), b2, voffB); PG8_STAGE(PG8_SB(0, 1), b2 + hstep, voffB); PG8_STAGE(PG8_SA(0, 0), a2, voffA);
            PG8_WAIT_V(8); PG8_WAIT_L(0); PG8_BAR; PG8_MMA(1, 0, At, B0); PG8_MMA(1, 1, At, B1); PG8_BAR; PG8_SCHED;
            PG8_LDB(B0, 1, 0); PG8_LDB(B1, 1, 1); PG8_SCHED; PG8_LDA(At, 1, 0); PG8_STAGE(PG8_SA(0, 1), a2 + hstep, voffA);
            PG8_WAIT_V(8); PG8_WAIT_L(0); PG8_BAR; PG8_MMA(0, 0, At, B0); PG8_MMA(0, 1, At, B1); PG8_BAR; PG8_SCHED;
            PG8_LDA(At, 1, 1); PG8_STAGE(PG8_SB(1, 0), b3, voffB); PG8_STAGE(PG8_SB(1, 1), b3 + hstep, voffB); PG8_STAGE(PG8_SA(1, 0), a3, voffA);
            PG8_WAIT_V(8); PG8_WAIT_L(0); PG8_BAR; PG8_MMA(1, 0, At, B0); PG8_MMA(1, 1, At, B1); PG8_BAR; PG8_SCHED;
            } else {
            PG8_LDB(B0, 0, 0); PG8_SCHED; PG8_LDA(At, 0, 0); PG8_STAGE(PG8_SA(1, 1), a1 + hstep, voffA);
            PG8_WAIT_L(8); PG8_BAR; PG8_WAIT_L(0); PG8_MMA(0, 0, At, B0); PG8_BAR; PG8_SCHED;
            PG8_LDB(B1, 0, 1); PG8_STAGE(PG8_SB(0, 0), b2, voffB);
            PG8_BAR; PG8_WAIT_L(0); PG8_MMA(0, 1, At, B1); PG8_BAR;
            PG8_LDA(At, 0, 1); PG8_STAGE(PG8_SA(0, 0), a2, voffA);
            PG8_BAR; PG8_WAIT_L(0); PG8_MMA(1, 0, At, B0); PG8_BAR; PG8_SCHED;
            PG8_STAGE(PG8_SB(0, 1), b2 + hstep, voffB);
            PG8_WAIT_V(6); PG8_BAR; PG8_MMA(1, 1, At, B1); PG8_BAR;
            PG8_LDB(B0, 1, 0); PG8_SCHED; PG8_LDA(At, 1, 0); PG8_STAGE(PG8_SA(0, 1), a2 + hstep, voffA);
            PG8_WAIT_L(8); PG8_BAR; PG8_WAIT_L(0); PG8_MMA(0, 0, At, B0); PG8_BAR; PG8_SCHED;
            PG8_LDB(B1, 1, 1); PG8_STAGE(PG8_SB(1, 0), b3, voffB);
            PG8_BAR; PG8_WAIT_L(0); PG8_MMA(0, 1, At, B1); PG8_BAR;
            PG8_LDA(At, 1, 1); PG8_STAGE(PG8_SA(1, 0), a3, voffA);
            PG8_BAR; PG8_WAIT_L(0); PG8_MMA(1, 0, At, B0); PG8_BAR; PG8_SCHED;
            PG8_STAGE(PG8_SB(1, 1), b3 + hstep, voffB);
            PG8_WAIT_V(6); PG8_BAR; PG8_MMA(1, 1, At, B1); PG8_BAR;
            }
        }
        if constexpr (ALIGN_EPI) { if (wr == 0) PG8_BAR; }
        if constexpr (!Epi::AFTER_DRAIN) { E(acc, cur, wr, wc, fr, fq); S.done(cur); }
        if (!has_next) break;
#pragma unroll
        for (int a = 0; a < 2; ++a)
#pragma unroll
            for (int b = 0; b < 2; ++b)
#pragma unroll
                for (int m = 0; m < 4; ++m)
#pragma unroll
                    for (int n = 0; n < 2; ++n) acc[a][b][m][n] = (f32x4){0.f, 0.f, 0.f, 0.f};
        cur = nxt; cA = nA; cB = nB; ++ui;
        if constexpr (ALIGN_EPI) { if (wr == 1) PG8_BAR; }
    }
    PG8_WAIT_V(0);
    if constexpr (!ALIGN_EPI) { if (wr == 0) PG8_BAR; }
    PG8_BAR;
    if constexpr (Epi::AFTER_DRAIN) { E.fused(acc, cur, wr, wc, fr, fq, lds, wid, lane); S.done(cur); }
#undef PG8_SA
#undef PG8_SB
#undef PG8_STAGE
#undef PG8_LDA
#undef PG8_LDB
#undef PG8_MMA
#undef PG8_WAIT_V
#undef PG8_WAIT_L
#undef PG8_BAR
#undef PG8_SCHED
}
}

#ifndef MULTI_LAUNCH
#define MULTI_LAUNCH 0
#endif
#ifndef USE_TR
#define USE_TR 1
#endif
#ifndef REPEAT_MASK
#define REPEAT_MASK 0
#endif
#define LAS __attribute__((address_space(3)))
#define DI __device__ __forceinline__
typedef unsigned short bf16;
typedef short bf16x8 __attribute__((ext_vector_type(8)));
typedef float f32x4 __attribute__((ext_vector_type(4)));
typedef unsigned u32x4 __attribute__((ext_vector_type(4)));
typedef unsigned u32x2 __attribute__((ext_vector_type(2)));

constexpr int SEQ = 8192, DM = 4096, INW = 16392, NU = 16384;
constexpr int C_QA = 0, C_KA = 2048, C_VA = 4096, C_ZA = 6144, C_QM = 8192, C_KM = 9216, C_VM = 10240, C_OM = 12288, C_ZM = 14336;
constexpr float NORM_EPS = 1e-6f;
constexpr int NTHR = 512, NWAVE = 8;
constexpr int LDS_BYTES = 147456;

constexpr size_t MiB = (size_t)1 << 20;
constexpr size_t WS_WIN = 0, WS_WOUT = 256 * MiB, WS_XN = 320 * MiB, WS_U = 384 * MiB, WS_OP = 640 * MiB, WS_Y = 736 * MiB, WS_X1 = 800 * MiB,
                 WS_DC = 928 * MiB, WS_CS = 992 * MiB, WS_LSE = 1024 * MiB, WS_GATES = 1026 * MiB, WS_DN = 1027 * MiB, WS_NS = 1028 * MiB, WS_BL = 1029 * MiB,
                 WS_CTL = 1030 * MiB, WS_END = 1031 * MiB;
constexpr int LDS_BARST = LDS_BYTES - 64;

struct Params { const float *x, *norm_g, *w_in, *b_gate, *conv_w, *mnorm_g, *w_out, *rel_bias, *final_g; float* out; unsigned char* ws; int ph_lo, ph_hi; };

DI float bf_lo(unsigned u) { return __uint_as_float(u << 16); }
DI float bf_hi(unsigned u) { return __uint_as_float(u & 0xffff0000u); }
DI float bf2f(unsigned short u) { return __uint_as_float((unsigned)u << 16); }
DI unsigned pk2(float lo, float hi) { return pg8::cvt_pk_bf16(lo, hi); }
DI float wave_sum(float v) {
#pragma unroll
    for (int o = 1; o < 64; o <<= 1) v += __shfl_xor(v, o);
    return v;
}
DI float quad_sum(float v) { v += __shfl_xor(v, 16); v += __shfl_xor(v, 32); return v; }
DI float quad_max(float v) { v = fmaxf(v, __shfl_xor(v, 16)); v = fmaxf(v, __shfl_xor(v, 32)); return v; }
DI float silu_f(float x) { return x / (1.f + __expf(-x)); }
DI float sigm_f(float x) { return 1.f / (1.f + __expf(-x)); }
DI bf16x8 gatherT(const LAS unsigned short* p, int stride) {
    bf16x8 r;
#pragma unroll
    for (int j = 0; j < 8; ++j) r[j] = (short)p[j * stride];
    return r;
}
typedef short s16x4 __attribute__((ext_vector_type(4)));
DI bf16x8 trfrag(const LAS unsigned short* blk, int stride, int ql) {
#if USE_TR
    const LAS unsigned short* a = blk + (ql >> 2) * stride + 4 * (ql & 3);
    const s16x4 lo = __builtin_amdgcn_ds_read_tr16_b64_v4i16((LAS s16x4*)a);
    const s16x4 hi = __builtin_amdgcn_ds_read_tr16_b64_v4i16((LAS s16x4*)(a + 4 * stride));
    return (bf16x8){lo[0], lo[1], lo[2], lo[3], hi[0], hi[1], hi[2], hi[3]};
#else
    return gatherT(blk + ql, stride);
#endif
}
DI f32x4 mfma16(bf16x8 a, bf16x8 b, f32x4 c) { return __builtin_amdgcn_mfma_f32_16x16x32_bf16(a, b, c, 0, 0, 0); }
#define LDS_WAIT() asm volatile("s_waitcnt lgkmcnt(0)" ::: "memory")

struct TrTile { const float* src; bf16* dst; };
DI TrTile tr_tile_addr(const Params& p, int it, int lane) {
    constexpr int T_IN = 64 * 256, T_OUT = 64 * 64;
    const float* W; bf16* WT; int ldw, nb, kb;
    int r = it;
    if (r < T_IN) { W = p.w_in; WT = (bf16*)(p.ws + WS_WIN); ldw = INW; kb = r >> 8; nb = r & 255; }
    else if ((r -= T_IN) < T_OUT) { W = p.w_out; WT = (bf16*)(p.ws + WS_WOUT); ldw = DM; kb = r >> 6; nb = r & 63; }
    else if ((r -= T_OUT) < T_IN) { W = p.w_in + (size_t)DM * INW; WT = (bf16*)(p.ws + WS_WIN + 128 * MiB); ldw = INW; kb = r >> 8; nb = r & 255; }
    else { r -= T_IN; W = p.w_out + (size_t)DM * DM; WT = (bf16*)(p.ws + WS_WOUT + 32 * MiB); ldw = DM; kb = r >> 6; nb = r & 63; }
    TrTile t;
    t.src = W + (size_t)(kb * 64 + 16 * (lane >> 4)) * ldw + nb * 64 + 4 * (lane & 15);
    t.dst = WT + (size_t)(nb * 64 + (lane >> 3)) * DM + kb * 64 + 8 * (lane & 7);
    return t;
}
DI int tr_ldw(int it) { constexpr int T_IN = 64 * 256, T_OUT = 64 * 64; const int r = it % (T_IN + T_OUT); return r < T_IN ? INW : DM; }
DI void tr_load(const float* src, int ldw, f32x4 (&v)[16]) {
#pragma unroll
    for (int i = 0; i < 16; ++i) v[i] = *(const f32x4*)(src + (size_t)i * ldw);
}
DI void tr_store(const f32x4 (&v)[16], bf16* dst, LAS unsigned short* T, int lane) {
    const int kr = lane >> 4, nc = 4 * (lane & 15);
#pragma unroll
    for (int e = 0; e < 4; ++e)
#pragma unroll
        for (int hf = 0; hf < 2; ++hf) { u32x4 w;
            w.x = pk2(v[8 * hf + 0][e], v[8 * hf + 1][e]); w.y = pk2(v[8 * hf + 2][e], v[8 * hf + 3][e]); w.z = pk2(v[8 * hf + 4][e], v[8 * hf + 5][e]); w.w = pk2(v[8 * hf + 6][e], v[8 * hf + 7][e]);
            *(LAS u32x4*)(T + (nc + e) * 72 + 16 * kr + 8 * hf) = w; }
    LDS_WAIT(); asm volatile("" ::: "memory");
#pragma unroll
    for (int j = 0; j < 8; ++j) { const u32x4 w = *(const LAS u32x4*)(T + ((lane >> 3) + 8 * j) * 72 + 8 * (lane & 7)); *(u32x4*)(dst + (size_t)(8 * j) * DM) = w; }
    LDS_WAIT(); asm volatile("" ::: "memory");
}
DI void prologue_transposes(const Params& p, LAS unsigned char* lds, int wave, int lane) {
    LAS unsigned short* T = (LAS unsigned short*)(lds + wave * 16384);
    const int gw = blockIdx.x * NWAVE + wave, ngw = gridDim.x * NWAVE;
    constexpr int NIT = 2 * (64 * 256 + 64 * 64);
    f32x4 va[16], vb[16];
    int it = gw;
    if (it >= NIT) return;
    TrTile ta = tr_tile_addr(p, it, lane), tb;
    tr_load(ta.src, tr_ldw(it), va);
    for (;;) {
        const int it1 = it + ngw; const bool h1 = it1 < NIT;
        if (h1) { tb = tr_tile_addr(p, it1, lane); tr_load(tb.src, tr_ldw(it1), vb); }
        tr_store(va, ta.dst, T, lane);
        if (!h1) break;
        const int it2 = it1 + ngw; const bool h2 = it2 < NIT;
        if (h2) { ta = tr_tile_addr(p, it2, lane); tr_load(ta.src, tr_ldw(it2), va); }
        tr_store(vb, tb.dst, T, lane);
        if (!h2) break;
        it = it2;
    }
}

DI void norm_gates_phase(const Params& p, LAS unsigned char* lds, const float* X, int l, int tid, int wave, int lane) {
    LAS f32x4* G4 = (LAS f32x4*)lds;
    const float* wg = p.w_in + (size_t)l * DM * INW + NU;
#pragma unroll 4
    for (int i = 0; i < 16; ++i) { const int idx = tid + NTHR * i, k = idx >> 1, half = idx & 1;
        G4[((k & 3) * 2 + half) * 1024 + (k >> 2)] = *(const f32x4*)(wg + (size_t)k * INW + half * 4); }
    __syncthreads();
    const float* g = p.norm_g + l * DM;
    bf16* XN = (bf16*)(p.ws + WS_XN);
    float* gates = (float*)(p.ws + WS_GATES);
    for (int row = blockIdx.x * NWAVE + wave; row < SEQ; row += gridDim.x * NWAVE) {
        const f32x4* xr = (const f32x4*)(X + (size_t)row * DM) + lane;
        f32x4 v[16]; float ss = 0.f;
#pragma unroll
        for (int j = 0; j < 16; ++j) { v[j] = xr[64 * j]; ss += (v[j].x * v[j].x + v[j].y * v[j].y) + (v[j].z * v[j].z + v[j].w * v[j].w); }
        const float rstd = rsqrtf(wave_sum(ss) * (1.f / DM) + NORM_EPS);
        u32x2* o8 = (u32x2*)(XN + (size_t)row * DM) + lane;
        f32x4 a0 = {0.f, 0.f, 0.f, 0.f}, a1 = {0.f, 0.f, 0.f, 0.f};
#pragma unroll
        for (int j = 0; j < 16; ++j) {
            const f32x4 gv = ((const f32x4*)g)[lane + 64 * j];
            const f32x4 h = v[j] * rstd * gv;
            u32x2 w; w.x = pk2(h.x, h.y); w.y = pk2(h.z, h.w); o8[64 * j] = w;
            const int kq = lane + 64 * j;
            a0 += h.x * G4[0 * 1024 + kq]; a1 += h.x * G4[1 * 1024 + kq];
            a0 += h.y * G4[2 * 1024 + kq]; a1 += h.y * G4[3 * 1024 + kq];
            a0 += h.z * G4[4 * 1024 + kq]; a1 += h.z * G4[5 * 1024 + kq];
            a0 += h.w * G4[6 * 1024 + kq]; a1 += h.w * G4[7 * 1024 + kq];
        }
        const float s0 = wave_sum(a0.x), s1 = wave_sum(a0.y), s2 = wave_sum(a0.z), s3 = wave_sum(a0.w);
        const float s4 = wave_sum(a1.x), s5 = wave_sum(a1.y), s6 = wave_sum(a1.z), s7 = wave_sum(a1.w);
        float ov = s0; ov = lane == 1 ? s1 : ov; ov = lane == 2 ? s2 : ov; ov = lane == 3 ? s3 : ov;
        ov = lane == 4 ? s4 : ov; ov = lane == 5 ? s5 : ov; ov = lane == 6 ? s6 : ov; ov = lane == 7 ? s7 : ov;
        if (lane < 8) gates[(size_t)row * 8 + lane] = ov + p.b_gate[l * 8 + lane];
    }
    __syncthreads();
}
DI void final_norm_phase(const Params& p, int wave, int lane) {
    for (int row = blockIdx.x * NWAVE + wave; row < SEQ; row += gridDim.x * NWAVE) {
        f32x4* xr = (f32x4*)(p.out + (size_t)row * DM) + lane;
        f32x4 v[16]; float ss = 0.f;
#pragma unroll
        for (int j = 0; j < 16; ++j) { v[j] = xr[64 * j]; ss += (v[j].x * v[j].x + v[j].y * v[j].y) + (v[j].z * v[j].z + v[j].w * v[j].w); }
        const float rstd = rsqrtf(wave_sum(ss) * (1.f / DM) + NORM_EPS);
#pragma unroll
        for (int j = 0; j < 16; ++j) xr[64 * j] = v[j] * rstd * ((const f32x4*)p.final_g)[lane + 64 * j];
    }
}

constexpr int AT_KS = 136;
DI void attn_item(const Params& p, LAS unsigned char* lds, int item, int tid, int wave, int lane) {
    const bf16* U = (const bf16*)(p.ws + WS_U);
    LAS unsigned short* Ks = (LAS unsigned short*)lds;
    LAS unsigned short* Vs = Ks + 256 * AT_KS;
    LAS float* biasS = (LAS float*)(Vs + 256 * AT_KS);
    const int pat = item >> 10, rem = item & 1023, h = rem >> 6, rb = rem & 63;
    const int dsh = pat * 2;
    const int r = rb >> (6 - dsh), bq = rb & ((64 >> dsh) - 1);
    const int sub0 = 128 * bq - 128;
    const int ql = lane & 15, quad = lane >> 4, q0 = wave * 16;
    u32x4 kv[8], vv[8];
#pragma unroll
    for (int i = 0; i < 8; ++i) { const int c = tid + NTHR * i, row = c >> 4, ch = c & 15; int sub = sub0 + row; sub = sub < 0 ? 0 : sub;
        const bf16* src = U + (size_t)((sub << dsh) + r) * NU + h * 128 + ch * 8;
        kv[i] = *(const u32x4*)(src + C_KA); vv[i] = *(const u32x4*)(src + C_VA); }
    const int tq = ((128 * bq + q0 + ql) << dsh) + r;
    bf16x8 qf[4];
#pragma unroll
    for (int ks = 0; ks < 4; ++ks) qf[ks] = *(const bf16x8*)(U + (size_t)tq * NU + C_QA + h * 128 + ks * 32 + quad * 8);
    if (tid < 129) { const int n = tid << dsh; int b = n;
        if (n >= 16) { b = 16 + (int)floorf(log2f((float)n * 0.0625f) * (16.f / 7.f)); b = b > 31 ? 31 : b; }
        biasS[tid] = p.rel_bias[b * 16 + h]; }
#pragma unroll
    for (int i = 0; i < 8; ++i) { const int c = tid + NTHR * i, row = c >> 4, ch = c & 15;
        *(LAS u32x4*)(Ks + row * AT_KS + ch * 8) = kv[i]; *(LAS u32x4*)(Vs + row * AT_KS + ch * 8) = vv[i]; }
    __syncthreads();
    f32x4 sacc[10];
#pragma unroll
    for (int t = 0; t < 10; ++t) sacc[t] = (f32x4){0.f, 0.f, 0.f, 0.f};
#pragma unroll
    for (int s = 0; s < 5; ++s)
#pragma unroll
        for (int u = 0; u < 2; ++u) { int kk = q0 + 32 * s + (ql >> 2) * 8 + u * 4 + (ql & 3); kk = kk > 255 ? 255 : kk;
            const LAS unsigned short* kp = Ks + kk * AT_KS + quad * 8;
#pragma unroll
            for (int ks = 0; ks < 4; ++ks) sacc[2 * s + u] = mfma16(*(const LAS bf16x8*)(kp + ks * 32), qf[ks], sacc[2 * s + u]); }
    const float scale = 0.08838834764831845f;
    float mx = -1e30f;
    int ql2 = ql, quad2 = quad; asm volatile("" : "+v"(ql2), "+v"(quad2));
#pragma unroll
    for (int s = 0; s < 5; ++s)
#pragma unroll
        for (int u = 0; u < 2; ++u)
#pragma unroll
            for (int j = 0; j < 4; ++j) { const int koff = 32 * s + quad2 * 8 + u * 4 + j, rel = koff - ql2;
                const bool valid = (rel >= 0) && (rel <= 128) && (sub0 + q0 + koff >= 0);
                int jo = 128 - rel; jo = jo < 0 ? 0 : (jo > 128 ? 128 : jo);
                const float v = valid ? sacc[2 * s + u][j] * scale + biasS[jo] : -1e30f;
                sacc[2 * s + u][j] = v; mx = fmaxf(mx, v); }
    mx = quad_max(mx);
    float l = 0.f;
#pragma unroll
    for (int t = 0; t < 10; ++t)
#pragma unroll
        for (int j = 0; j < 4; ++j) { const float e = __expf(sacc[t][j] - mx); sacc[t][j] = e; l += e; }
    l = quad_sum(l);
    f32x4 oacc[8];
#pragma unroll
    for (int nt = 0; nt < 8; ++nt) oacc[nt] = (f32x4){0.f, 0.f, 0.f, 0.f};
#pragma unroll
    for (int s = 0; s < 5; ++s) {
        u32x4 pw; pw.x = pk2(sacc[2 * s][0], sacc[2 * s][1]); pw.y = pk2(sacc[2 * s][2], sacc[2 * s][3]); pw.z = pk2(sacc[2 * s + 1][0], sacc[2 * s + 1][1]); pw.w = pk2(sacc[2 * s + 1][2], sacc[2 * s + 1][3]);
        const bf16x8 pf = __builtin_bit_cast(bf16x8, pw);
        int key0 = q0 + 32 * s + quad * 8; key0 = key0 > 248 ? 248 : key0;
        const LAS unsigned short* vp = Vs + key0 * AT_KS;
#pragma unroll
        for (int nt = 0; nt < 8; ++nt) oacc[nt] = mfma16(trfrag(vp + nt * 16, AT_KS, ql), pf, oacc[nt]);
    }
    const float inv = 1.f / l;
    bf16* OP = (bf16*)(p.ws + WS_OP) + (size_t)pat * SEQ * 2048 + (size_t)tq * 2048 + h * 128 + quad * 4;
#pragma unroll
    for (int nt = 0; nt < 8; ++nt) { u32x2 w; w.x = pk2(oacc[nt][0] * inv, oacc[nt][1] * inv); w.y = pk2(oacc[nt][2] * inv, oacc[nt][3] * inv); *(u32x2*)(OP + nt * 16) = w; }
    if (quad == 0) ((float*)(p.ws + WS_LSE))[((size_t)pat * SEQ + tq) * 16 + h] = mx + __logf(l);
    __syncthreads();
}
DI void merge_phase(const Params& p, int tid) {
    const bf16* U = (const bf16*)(p.ws + WS_U);
    const bf16* OP = (const bf16*)(p.ws + WS_OP);
    const float* LSE = (const float*)(p.ws + WS_LSE);
    bf16* Y = (bf16*)(p.ws + WS_Y);
    const int gthreads = gridDim.x * NTHR;
    for (int idx = blockIdx.x * NTHR + tid; idx < SEQ * 256; idx += gthreads) {
        const int t = idx >> 8, c8 = idx & 255, h = c8 >> 4;
        const float l0 = LSE[(size_t)t * 16 + h], l1 = LSE[((size_t)SEQ + t) * 16 + h], l2 = LSE[((size_t)2 * SEQ + t) * 16 + h];
        const float M = fmaxf(l0, fmaxf(l1, l2));
        float w0 = __expf(l0 - M), w1 = __expf(l1 - M), w2 = __expf(l2 - M);
        const float inv = 1.f / (w0 + w1 + w2); w0 *= inv; w1 *= inv; w2 *= inv;
        const size_t o = (size_t)t * 2048 + c8 * 8;
        const u32x4 o0 = *(const u32x4*)(OP + o), o1 = *(const u32x4*)(OP + (size_t)SEQ * 2048 + o), o2 = *(const u32x4*)(OP + (size_t)2 * SEQ * 2048 + o);
        const u32x4 z = *(const u32x4*)(U + (size_t)t * NU + C_ZA + c8 * 8);
        u32x4 y;
#pragma unroll
        for (int e = 0; e < 4; ++e) {
            const float lo = (w0 * bf_lo(o0[e]) + w1 * bf_lo(o1[e]) + w2 * bf_lo(o2[e])) * silu_f(bf_lo(z[e]));
            const float hi = (w0 * bf_hi(o0[e]) + w1 * bf_hi(o1[e]) + w2 * bf_hi(o2[e])) * silu_f(bf_hi(z[e]));
            y[e] = pk2(lo, hi);
        }
        *(u32x4*)(Y + (size_t)t * DM + c8 * 8) = y;
    }
}

constexpr int M_KS = 264, M_VS3 = 520;
DI void conv8(const bf16* U, const float* cw, int t, int rawcol, int cch, float (&f)[8]) {
#pragma unroll
    for (int e = 0; e < 8; ++e) f[e] = 0.f;
#pragma unroll
    for (int j = 0; j < 4; ++j) { const int tt = t - 3 + j;
        if (tt >= 0) { const u32x4 raw = *(const u32x4*)(U + (size_t)tt * NU + rawcol);
            const f32x4 w0 = *(const f32x4*)(cw + j * 2048 + cch), w1 = *(const f32x4*)(cw + j * 2048 + cch + 4);
            f[0] += w0[0] * bf_lo(raw.x); f[1] += w0[1] * bf_hi(raw.x); f[2] += w0[2] * bf_lo(raw.y); f[3] += w0[3] * bf_hi(raw.y);
            f[4] += w1[0] * bf_lo(raw.z); f[5] += w1[1] * bf_hi(raw.z); f[6] += w1[2] * bf_lo(raw.w); f[7] += w1[3] * bf_hi(raw.w); } }
#pragma unroll
    for (int e = 0; e < 8; ++e) f[e] = silu_f(f[e]);
}
template <int NI, int MODE, int NB>
DI void conv_tile(const bf16* U, const float* cw, int t0, int rawcol0, int cch0, float sc, LAS unsigned short* dst, int tid, float bL, const LAS float* bS, const LAS float* liS, int roff) {
    const int ch = tid & 31, r0 = tid >> 5;
    f32x4 w[4][2];
#pragma unroll
    for (int j = 0; j < 4; ++j) { w[j][0] = *(const f32x4*)(cw + j * 2048 + cch0 + ch * 8); w[j][1] = *(const f32x4*)(cw + j * 2048 + cch0 + ch * 8 + 4); }
    const bf16* src = U + rawcol0 + ch * 8;
#pragma unroll
    for (int ib = 0; ib < NI; ib += NB) {
        u32x4 raw[NB][4];
#pragma unroll
        for (int i = 0; i < NB; ++i)
#pragma unroll
            for (int j = 0; j < 4; ++j) { const int tt = t0 + r0 + 16 * (ib + i) - 3 + j; const int tc = tt < 0 ? 0 : tt;
                raw[i][j] = *(const u32x4*)(src + (size_t)tc * NU); if (tt < 0) raw[i][j] = (u32x4){0u, 0u, 0u, 0u}; }
#pragma unroll
        for (int i = 0; i < NB; ++i) { const int row = r0 + 16 * (ib + i);
            float f[8];
#pragma unroll
            for (int e = 0; e < 8; ++e) f[e] = 0.f;
#pragma unroll
            for (int j = 0; j < 4; ++j) { const u32x4 rw = raw[i][j];
                f[0] += w[j][0][0] * bf_lo(rw.x); f[1] += w[j][0][1] * bf_hi(rw.x); f[2] += w[j][0][2] * bf_lo(rw.y); f[3] += w[j][0][3] * bf_hi(rw.y);
                f[4] += w[j][1][0] * bf_lo(rw.z); f[5] += w[j][1][1] * bf_hi(rw.z); f[6] += w[j][1][2] * bf_lo(rw.w); f[7] += w[j][1][3] * bf_hi(rw.w); }
            float m = sc;
            if (MODE == 1) m *= __expf(bL - bS[roff + row] + liS[roff + row]);
#pragma unroll
            for (int e = 0; e < 8; ++e) f[e] = silu_f(f[e]) * m;
            u32x4 o; o.x = pk2(f[0], f[1]); o.y = pk2(f[2], f[3]); o.z = pk2(f[4], f[5]); o.w = pk2(f[6], f[7]);
            *(LAS u32x4*)(dst + row * M_KS + ch * 8) = o; }
    }
}
DI void chunk_gates(const float* gates, int c, int hh, LAS float* bS, LAS float* liS, LAS float* wtot, int tid, int wave, int lane) {
    float v = 0.f;
    if (tid < 256) { const float* gp = gates + (size_t)(c * 256 + tid) * 8; const float fgv = gp[4 + hh]; liS[tid] = gp[hh];
        v = fminf(fgv, 0.f) - log1pf(__expf(-fabsf(fgv)));
#pragma unroll
        for (int o = 1; o < 64; o <<= 1) { const float t = __shfl_up(v, o); if (lane >= o) v += t; }
        if (lane == 63) wtot[wave] = v; }
    __syncthreads();
    if (tid < 256) { float pre = 0.f; for (int w = 0; w < wave; ++w) pre += wtot[w]; bS[tid] = v + pre; }
    __syncthreads();
}
DI void m1_item(const Params& p, LAS unsigned char* lds, int l, int item, int tid, int wave, int lane) {
    const bf16* U = (const bf16*)(p.ws + WS_U);
    const float* cw = p.conv_w + (size_t)l * 4 * 2048;
    LAS unsigned short* Kp = (LAS unsigned short*)lds;
    LAS unsigned short* Vs = Kp + 128 * M_KS;
    LAS float* bS = (LAS float*)(Vs + 128 * AT_KS); LAS float* liS = bS + 256; LAS float* wtot = liS + 256;
    const int hh = item >> 7, c = (item >> 2) & 31, sl = item & 3;
    const int ql = lane & 15, quad = lane >> 4;
    chunk_gates((const float*)(p.ws + WS_GATES), c, hh, bS, liS, wtot, tid, wave, lane);
    const float bL = bS[255];
    f32x4 acc[4][4];
#pragma unroll
    for (int a = 0; a < 4; ++a)
#pragma unroll
        for (int b = 0; b < 4; ++b) acc[a][b] = (f32x4){0.f, 0.f, 0.f, 0.f};
    float nsum = 0.f;
    const int dvt0 = (wave & 1) * 4, dkt0 = (wave >> 1) * 4;
    for (int half = 0; half < 2; ++half) {
        conv_tile<8, 1, 4>(U, cw, c * 256 + half * 128, C_KM + hh * 256, 1024 + hh * 256, 0.0625f, Kp, tid, bL, bS, liS, half * 128);
#pragma unroll
        for (int i = 0; i < 4; ++i) { const int cc = tid + NTHR * i, row = cc >> 4, ch = cc & 15;
            *(LAS u32x4*)(Vs + row * AT_KS + ch * 8) = *(const u32x4*)(U + (size_t)(c * 256 + half * 128 + row) * NU + C_VM + hh * 512 + sl * 128 + ch * 8); }
        __syncthreads();
#pragma unroll 1
        for (int ks = 0; ks < 4; ++ks) {
            bf16x8 af[4], bfr[4];
#pragma unroll
            for (int a = 0; a < 4; ++a) af[a] = trfrag(Vs + (ks * 32 + quad * 8) * AT_KS + (dvt0 + a) * 16, AT_KS, ql);
#pragma unroll
            for (int b = 0; b < 4; ++b) bfr[b] = trfrag(Kp + (ks * 32 + quad * 8) * M_KS + (dkt0 + b) * 16, M_KS, ql);
#pragma unroll
            for (int a = 0; a < 4; ++a)
#pragma unroll
                for (int b = 0; b < 4; ++b) acc[a][b] = mfma16(af[a], bfr[b], acc[a][b]);
        }
        if (sl == 0 && tid < 256) { for (int row = 0; row < 128; ++row) nsum += bf2f(Kp[row * M_KS + tid]); }
        __syncthreads();
    }
    float* DC = (float*)(p.ws + WS_DC) + ((size_t)(hh * 32 + c) * 512 + sl * 128) * 256;
#pragma unroll
    for (int a = 0; a < 4; ++a)
#pragma unroll
        for (int b = 0; b < 4; ++b)
#pragma unroll
            for (int j = 0; j < 4; ++j) DC[(size_t)((dvt0 + a) * 16 + quad * 4 + j) * 256 + (dkt0 + b) * 16 + ql] = acc[a][b][j];
    if (sl == 0 && tid < 256) ((float*)(p.ws + WS_DN))[(hh * 32 + c) * 256 + tid] = nsum;
    if (sl == 0 && tid == 0) ((float*)(p.ws + WS_BL))[hh * 32 + c] = bL;
}
DI void m2_phase(const Params& p, int tid) {
    const float* DC = (const float*)(p.ws + WS_DC); const float* BL = (const float*)(p.ws + WS_BL);
    bf16* CS = (bf16*)(p.ws + WS_CS);
    const int gthreads = gridDim.x * NTHR, gid = blockIdx.x * NTHR + tid;
    for (int e4 = gid; e4 < 4 * 32768; e4 += gthreads) {
        const int hh = e4 >> 15, e = e4 & 32767;
        f32x4 st = {0.f, 0.f, 0.f, 0.f};
#pragma unroll 8
        for (int c = 0; c < 32; ++c) {
            const size_t o = ((size_t)(hh * 32 + c) * 32768 + e) * 4;
            u32x2 w; w.x = pk2(st.x, st.y); w.y = pk2(st.z, st.w); *(u32x2*)(CS + o) = w;
            const f32x4 d = *(const f32x4*)(DC + o);
            st = st * __expf(BL[hh * 32 + c]) + d;
        }
    }
    if (gid < 1024) { const int hh = gid >> 8, dk = gid & 255; const float* DN = (const float*)(p.ws + WS_DN); float* NS = (float*)(p.ws + WS_NS);
        float st = 0.f;
        for (int c = 0; c < 32; ++c) { NS[(hh * 32 + c) * 256 + dk] = st; st = st * __expf(BL[hh * 32 + c]) + DN[(hh * 32 + c) * 256 + dk]; } }
}
DI void m3_item(const Params& p, LAS unsigned char* lds, int l, int item, int tid, int wave, int lane) {
    const bf16* U = (const bf16*)(p.ws + WS_U);
    const float* cw = p.conv_w + (size_t)l * 4 * 2048;
    LAS unsigned short* Qs = (LAS unsigned short*)lds;
    LAS unsigned short* Ks = Qs + 64 * M_KS;
    LAS unsigned short* Vs = Ks + 64 * M_KS;
    LAS float* bS = (LAS float*)(Vs + 64 * M_VS3); LAS float* liS = bS + 256; LAS float* nS = liS + 256; LAS float* wtot = nS + 256; LAS float* ssS = wtot + 8;
    const int hh = item >> 7; int qb = item & 127; if ((item >> 8) & 1) qb ^= 3;
    const int c = qb >> 2, jq = qb & 3;
    const int ql = lane & 15, quad = lane >> 4;
    if (tid < 256) nS[tid] = ((const float*)(p.ws + WS_NS))[(hh * 32 + c) * 256 + tid];
    chunk_gates((const float*)(p.ws + WS_GATES), c, hh, bS, liS, wtot, tid, wave, lane);
    conv_tile<4, 0, 2>(U, cw, qb * 64, C_QM + hh * 256, hh * 256, 1.f, Qs, tid, 0.f, bS, liS, 0);
    __syncthreads();
    const int qg = wave & 3, dvh = wave >> 2, q = qg * 16 + ql, iq = jq * 64 + q;
    bf16x8 qf[8];
#pragma unroll
    for (int ks = 0; ks < 8; ++ks) qf[ks] = *(const LAS bf16x8*)(Qs + q * M_KS + ks * 32 + quad * 8);
    const float b_q = bS[iq], eb = __expf(b_q);
    f32x4 acc[16];
#pragma unroll
    for (int nt = 0; nt < 16; ++nt) acc[nt] = (f32x4){0.f, 0.f, 0.f, 0.f};
    { const bf16* CT = (const bf16*)(p.ws + WS_CS) + ((size_t)(hh * 32 + c) * 512 + dvh * 256) * 256 + (size_t)ql * 256 + quad * 8;
#pragma unroll
      for (int nt = 0; nt < 16; ++nt)
#pragma unroll
          for (int ks = 0; ks < 8; ++ks) { acc[nt] = mfma16(*(const bf16x8*)(CT + (size_t)nt * 16 * 256 + ks * 32), qf[ks], acc[nt]); if (ks == 7 && (nt & 1)) __builtin_amdgcn_sched_barrier(0); }
    }
#pragma unroll
    for (int nt = 0; nt < 16; ++nt) acc[nt] = acc[nt] * eb;
    float nqp = 0.f;
#pragma unroll
    for (int ks = 0; ks < 8; ++ks)
#pragma unroll
        for (int j = 0; j < 8; ++j) nqp += bf2f((unsigned short)qf[ks][j]) * nS[ks * 32 + quad * 8 + j];
    float nq = quad_sum(nqp) * eb;
    float nqi = 0.f;
    for (int kt = 0; kt <= jq; ++kt) {
        __syncthreads();
        int tid2 = tid; asm volatile("" : "+v"(tid2));
        conv_tile<4, 0, 2>(U, cw, c * 256 + kt * 64, C_KM + hh * 256, 1024 + hh * 256, 0.0625f, Ks, tid2, 0.f, bS, liS, 0);
#pragma unroll
        for (int i = 0; i < 8; ++i) { const int cc = tid2 + NTHR * i, row = cc >> 6, ch = cc & 63;
            *(LAS u32x4*)(Vs + row * M_VS3 + ch * 8) = *(const u32x4*)(U + (size_t)(c * 256 + kt * 64 + row) * NU + C_VM + hh * 512 + ch * 8); }
        __syncthreads();
        f32x4 sacc[4];
#pragma unroll
        for (int t = 0; t < 4; ++t) sacc[t] = (f32x4){0.f, 0.f, 0.f, 0.f};
#pragma unroll
        for (int s = 0; s < 2; ++s)
#pragma unroll
            for (int u = 0; u < 2; ++u) { const int krow = 32 * s + (ql >> 2) * 8 + u * 4 + (ql & 3);
                const LAS unsigned short* kp = Ks + krow * M_KS + quad * 8;
#pragma unroll
                for (int ks = 0; ks < 8; ++ks) sacc[2 * s + u] = mfma16(*(const LAS bf16x8*)(kp + ks * 32), qf[ks], sacc[2 * s + u]); }
#pragma unroll
        for (int s = 0; s < 2; ++s)
#pragma unroll
            for (int u = 0; u < 2; ++u)
#pragma unroll
                for (int j = 0; j < 4; ++j) { const int sk = kt * 64 + 32 * s + quad * 8 + u * 4 + j;
                    const float w = (sk <= iq) ? __expf(b_q - bS[sk] + liS[sk]) : 0.f;
                    const float pv = sacc[2 * s + u][j] * w; sacc[2 * s + u][j] = pv; nqi += pv; }
#pragma unroll
        for (int s = 0; s < 2; ++s) {
            u32x4 pw; pw.x = pk2(sacc[2 * s][0], sacc[2 * s][1]); pw.y = pk2(sacc[2 * s][2], sacc[2 * s][3]); pw.z = pk2(sacc[2 * s + 1][0], sacc[2 * s + 1][1]); pw.w = pk2(sacc[2 * s + 1][2], sacc[2 * s + 1][3]);
            const bf16x8 pf = __builtin_bit_cast(bf16x8, pw);
            const LAS unsigned short* vp = Vs + (32 * s + quad * 8) * M_VS3 + dvh * 256;
#pragma unroll
            for (int nt = 0; nt < 16; ++nt) acc[nt] = mfma16(trfrag(vp + nt * 16, M_VS3, ql), pf, acc[nt]);
        }
    }
    nq += quad_sum(nqi);
    const float inv = 1.f / fmaxf(fabsf(nq), 1.f);
    float ss = 0.f;
#pragma unroll
    for (int nt = 0; nt < 16; ++nt) { acc[nt] = acc[nt] * inv; ss += (acc[nt][0] * acc[nt][0] + acc[nt][1] * acc[nt][1]) + (acc[nt][2] * acc[nt][2] + acc[nt][3] * acc[nt][3]); }
    ss = quad_sum(ss);
    if (quad == 0) ssS[dvh * 64 + q] = ss;
    __syncthreads();
    const float rstd = rsqrtf((ssS[q] + ssS[64 + q]) * (1.f / 512.f) + NORM_EPS);
    const int t = qb * 64 + q;
    const float* ng = p.mnorm_g + l * 2048;
    bf16* Y = (bf16*)(p.ws + WS_Y);
#pragma unroll
    for (int nt = 0; nt < 16; ++nt) { const int col = hh * 512 + dvh * 256 + nt * 16 + quad * 4;
        const f32x4 g4 = *(const f32x4*)(ng + col);
        const u32x2 om = *(const u32x2*)(U + (size_t)t * NU + C_OM + col), zm = *(const u32x2*)(U + (size_t)t * NU + C_ZM + col);
        const float y0 = acc[nt][0] * rstd * g4[0] * sigm_f(bf_lo(om.x)) * silu_f(bf_lo(zm.x));
        const float y1 = acc[nt][1] * rstd * g4[1] * sigm_f(bf_hi(om.x)) * silu_f(bf_hi(zm.x));
        const float y2 = acc[nt][2] * rstd * g4[2] * sigm_f(bf_lo(om.y)) * silu_f(bf_lo(zm.y));
        const float y3 = acc[nt][3] * rstd * g4[3] * sigm_f(bf_hi(om.y)) * silu_f(bf_hi(zm.y));
        u32x2 w; w.x = pk2(y0, y1); w.y = pk2(y2, y3);
        *(u32x2*)(Y + (size_t)t * DM + 2048 + col) = w; }
    __syncthreads();
}

#define RLX_AGENT __ATOMIC_RELAXED, __HIP_MEMORY_SCOPE_AGENT
#define XB_TMO      128
#define XB_XCNT(j)  (256  + 64 * (j))
#define XB_XSUB(j)  (1280 + 64 * (j))
#define XB_XGEN(j)  (2304 + 64 * (j))
#define XB_TOP      3328
#define XB_TOPGEN   3392
#define XCD_BAR_WORDS 3456
#define XB_SPIN_CAP (1u << 18)

__device__ __forceinline__ unsigned xb_ld(unsigned* p)              { return __hip_atomic_load(p, __ATOMIC_RELAXED, __HIP_MEMORY_SCOPE_AGENT); }
__device__ __forceinline__ unsigned xb_add(unsigned* p, unsigned v) { return __hip_atomic_fetch_add(p, v, __ATOMIC_RELAXED, __HIP_MEMORY_SCOPE_AGENT); }
__device__ __forceinline__ unsigned xb_xcc_id() { return (unsigned)__builtin_amdgcn_s_getreg((3 << 11) | 20) & 0xFu; }
#define XB_SPIN(cond, bar) do { unsigned _sp = 0; while (cond) { __builtin_amdgcn_s_sleep(1); \
    if ((++_sp & 255u) == 0u) { if (xb_ld(&(bar)[XB_TMO])) break; if (_sp > XB_SPIN_CAP) { atomicAdd(&(bar)[XB_TMO], 1u); break; } } } } while (0)

struct XcdBarrier {
    unsigned* bar; unsigned x;
    volatile LAS unsigned* st;
};

__device__ __forceinline__ XcdBarrier xcd_barrier_post(unsigned* bar, volatile LAS unsigned* st) {
    XcdBarrier b; b.bar = bar; b.x = xb_xcc_id(); b.st = st;
    if (threadIdx.x == 0) (void)xb_add(&bar[XB_XCNT(b.x)], 1u);
    return b;
}
__device__ __forceinline__ void xcd_barrier_complete(unsigned* bar, unsigned x, unsigned& nloc, unsigned& nx) {
    const unsigned G = gridDim.x * gridDim.y * gridDim.z;
    unsigned sum, cnt, mine, sp = 0u;
    for (;;) {
        sum = 0u; cnt = 0u; mine = 0u;
#pragma unroll
        for (unsigned j = 0; j < 16; ++j) { const unsigned c = xb_ld(&bar[XB_XCNT(j)]); sum += c; cnt += (c > 0u) ? 1u : 0u; mine = (j == x) ? c : mine; }
        if (sum == G) break;
        __builtin_amdgcn_s_sleep(1);
        if ((++sp & 255u) == 0u) { if (xb_ld(&bar[XB_TMO])) break; if (sp > XB_SPIN_CAP) { atomicAdd(&bar[XB_TMO], 1u); break; } }
    }
    nloc = mine > 0u ? mine : 1u; nx = cnt > 0u ? cnt : 1u;
}

__device__ __forceinline__ void xcd_barrier(const XcdBarrier& b) {
    asm volatile("s_waitcnt vmcnt(0)" ::: "memory");
    __syncthreads();
    if (threadIdx.x == 0) {
        unsigned* bar = b.bar;
        __builtin_amdgcn_s_waitcnt(0);
        unsigned nloc = b.st[0], nx = b.st[1];
        if (nloc == 0u) { xcd_barrier_complete(bar, b.x, nloc, nx); b.st[0] = nloc; b.st[1] = nx; }
        const unsigned old = xb_add(&bar[XB_XSUB(b.x)], 1u);
        const unsigned gen = old / nloc;
        if (old + 1u == (gen + 1u) * nloc) {
            __builtin_amdgcn_fence(__ATOMIC_RELEASE, "agent");
            asm volatile("s_waitcnt vmcnt(0)" ::: "memory");
            const unsigned og = xb_add(&bar[XB_TOP], 1u);
            const unsigned tg = og / nx;
            if (og + 1u == (tg + 1u) * nx) xb_add(&bar[XB_TOPGEN], 1u);
            else XB_SPIN(xb_ld(&bar[XB_TOPGEN]) == tg, bar);
            __builtin_amdgcn_fence(__ATOMIC_ACQUIRE, "agent");
            xb_add(&bar[XB_XGEN(b.x)], 1u);
            asm volatile("s_waitcnt vmcnt(0)" ::: "memory");
        } else {
            XB_SPIN(xb_ld(&bar[XB_XGEN(b.x)]) == gen, bar);
            __builtin_amdgcn_fence(__ATOMIC_ACQUIRE, "agent");
            asm volatile("s_waitcnt vmcnt(0)" ::: "memory");
        }
    }
    __syncthreads();
}

constexpr int NPH = 13;
__global__ void __launch_bounds__(NTHR, 2) hymba_fwd(Params p0) {
    extern __shared__ __attribute__((aligned(16))) unsigned char lds_raw[];
    cg::grid_group grid = cg::this_grid();
    const int G = gridDim.x;
    if (threadIdx.x < 16) ((LAS unsigned*)((LAS unsigned char*)lds_raw + LDS_BARST))[threadIdx.x] = 0u;
    __syncthreads();
    XcdBarrier bar = xcd_barrier_post((unsigned*)(p0.ws + WS_CTL), (volatile LAS unsigned*)((LAS unsigned char*)lds_raw + LDS_BARST));
    for (int ph = p0.ph_lo; ph < p0.ph_hi; ++ph) {
        const int ptype = ph == 0 ? 0 : 1 + (ph - 1) % 6;
        const int nrep = (REPEAT_MASK) == 0 ? 1 : ((((REPEAT_MASK) >> ptype) & 1) ? 2 : 1);
        for (int rep = 0; rep < nrep; ++rep) {
        int tid = threadIdx.x; asm volatile("" : "+v"(tid));
        const int lane = tid & 63, wave = __builtin_amdgcn_readfirstlane(tid >> 6);
        LAS unsigned char* lds = (LAS unsigned char*)lds_raw; asm volatile("" : "+s"(lds));
        Params p = p0;
        asm volatile("" : "+s"(p.ws)); asm volatile("" : "+s"(p.x)); asm volatile("" : "+s"(p.out)); asm volatile("" : "+s"(p.w_in)); asm volatile("" : "+s"(p.w_out));
        asm volatile("" : "+s"(p.conv_w)); asm volatile("" : "+s"(p.norm_g)); asm volatile("" : "+s"(p.mnorm_g)); asm volatile("" : "+s"(p.b_gate)); asm volatile("" : "+s"(p.rel_bias)); asm volatile("" : "+s"(p.final_g));
        if (ph == 0) {
            prologue_transposes(p, lds, wave, lane);
            __syncthreads();
            norm_gates_phase(p, lds, p.x, 0, tid, wave, lane);
        } else {
            const int l = (ph - 1) / 6, k = (ph - 1) % 6;
            if (k == 0) {
                pg8::Gemm g{(const pg8::bf16_t*)(p.ws + WS_XN), (const pg8::bf16_t*)(p.ws + WS_WIN + (size_t)l * 128 * MiB), SEQ, NU, DM};
                pg8::StaticOrder S; S.init(SEQ, NU, G, (int)blockIdx.x);
                pg8::EpiBf16Plain E{(pg8::bf16_t*)(p.ws + WS_U), NU};
                pg8::gemm_phase<pg8::EpiBf16Plain, pg8::StaticOrder, true, true>(lds, g, S, E);
            } else if (k == 1) {
                for (int it = blockIdx.x; it < 3072; it += G) attn_item(p, lds, it, tid, wave, lane);
                int tid3 = tid; asm volatile("" : "+v"(tid3));
                for (int it = blockIdx.x; it < 512; it += G) { m1_item(p, lds, l, it, tid3, __builtin_amdgcn_readfirstlane(tid3 >> 6), tid3 & 63); __syncthreads(); }
            } else if (k == 2) {
                m2_phase(p, tid);
                merge_phase(p, tid);
            } else if (k == 3) {
                for (int it = blockIdx.x; it < 512; it += G) m3_item(p, lds, l, it, tid, wave, lane);
            } else if (k == 4) {
                pg8::Gemm g{(const pg8::bf16_t*)(p.ws + WS_Y), (const pg8::bf16_t*)(p.ws + WS_WOUT + (size_t)l * 32 * MiB), SEQ, DM, DM};
                pg8::StaticOrder S; S.init(SEQ, DM, G, (int)blockIdx.x);
                pg8::EpiResF32 E{l == 0 ? p.x : (const float*)(p.ws + WS_X1), l == 0 ? (float*)(p.ws + WS_X1) : p.out, DM};
                pg8::gemm_phase<pg8::EpiResF32, pg8::StaticOrder, true, true>(lds, g, S, E);
            } else {
                if (l == 0) norm_gates_phase(p, lds, (const float*)(p.ws + WS_X1), 1, tid, wave, lane);
                else final_norm_phase(p, wave, lane);
            }
        }
        __syncthreads();
        }
        if (ph + 1 < p0.ph_hi) { if (ph == p0.ph_lo) grid.sync(); else xcd_barrier(bar); }
    }
}

extern "C" void kernel_launch(void* const* d_in, const int* in_sizes, int n_in, void* d_out, int out_size, void* d_ws, size_t ws_size, hipStream_t stream) {
    static int grid = 0;
    if (grid == 0) {
        if (n_in != 9 || in_sizes[0] != SEQ * DM || out_size != SEQ * DM || ws_size < WS_END) {
            fprintf(stderr, "kernel_launch: unexpected problem: n_in %d in0 %d out %d ws %zu (need %zu)\n", n_in, n_in > 0 ? in_sizes[0] : -1, out_size, ws_size, (size_t)WS_END); grid = -1; return; }
        int dev = 0, cus = 0, per_cu = 0;
        hipGetDevice(&dev);
        hipDeviceGetAttribute(&cus, hipDeviceAttributeMultiprocessorCount, dev);
        if (hipFuncSetAttribute((const void*)hymba_fwd, hipFuncAttributeMaxDynamicSharedMemorySize, LDS_BYTES) != hipSuccess) { fprintf(stderr, "kernel_launch: hipFuncSetAttribute failed\n"); grid = -1; return; }
        if (hipOccupancyMaxActiveBlocksPerMultiprocessor(&per_cu, (const void*)hymba_fwd, NTHR, LDS_BYTES) != hipSuccess || per_cu < 1) { fprintf(stderr, "kernel_launch: occupancy query gave %d\n", per_cu); per_cu = 1; }
        (void)hipGetLastError();
        grid = cus * per_cu;
        fprintf(stderr, "kernel_launch: %d CUs x %d = grid %d\n", cus, per_cu, grid);
    }
    if (grid < 0) return;
    if (hipMemsetAsync((char*)d_ws + WS_CTL, 0, 16384, stream) != hipSuccess) { fprintf(stderr, "kernel_launch: hipMemsetAsync failed\n"); return; }
    Params p{};
    p.x = (const float*)d_in[0]; p.norm_g = (const float*)d_in[1]; p.w_in = (const float*)d_in[2]; p.b_gate = (const float*)d_in[3]; p.conv_w = (const float*)d_in[4];
    p.mnorm_g = (const float*)d_in[5]; p.w_out = (const float*)d_in[6]; p.rel_bias = (const float*)d_in[7]; p.final_g = (const float*)d_in[8];
    p.out = (float*)d_out; p.ws = (unsigned char*)d_ws;
#if MULTI_LAUNCH
    for (int ph = 0; ph < NPH; ++ph) { p.ph_lo = ph; p.ph_hi = ph + 1; hipLaunchKernelGGL(hymba_fwd, dim3(grid), dim3(NTHR), LDS_BYTES, stream, p); }
#else
    p.ph_lo = 0; p.ph_hi = NPH;
    void* args[] = {&p};
    hipError_t e = hipLaunchCooperativeKernel((const void*)hymba_fwd, dim3(grid), dim3(NTHR), args, LDS_BYTES, stream);
    if (e != hipSuccess) fprintf(stderr, "kernel_launch: cooperative launch failed: %s (grid %d)\n", hipGetErrorString(e), grid);
#endif
}
```

```cpp
#include <hip/hip_runtime.h>
#include <hip/hip_cooperative_groups.h>
#include <cstdio>
#include <cstdint>
namespace cg = cooperative_groups;
namespace pg8 {
#define PG8_LAS __attribute__((address_space(3)))
typedef unsigned short bf16_t;
typedef short bf16x8 __attribute__((ext_vector_type(8)));
typedef float f32x4 __attribute__((ext_vector_type(4)));
typedef unsigned u32x4 __attribute__((ext_vector_type(4)));
constexpr int BM = 256, BK = 64, HALF = 128, HTB = HALF * BK * 2  , STAGE_BYTES = 8 * HTB, NXCD = 8, WGM = 8;

__host__ __device__ __forceinline__ int lds_byte(int r, int c) { const int st = (r >> 4) * 2 + (c >> 5), rr = r & 15, cc = c & 31, ob = rr * 64 + cc * 2; return st * 1024 + (ob ^ (((ob >> 9) & 1) << 5)); }
__host__ __device__ __forceinline__ void stage_rc(int b, int& R, int& C) { const int st = b / 1024, sb = b % 1024, swz = sb ^ (((sb >> 9) & 1) << 5); R = (st >> 1) * 16 + swz / 64; C = (st & 1) * 32 + (swz % 64) / 2; }
__host__ __device__ __forceinline__ int perm32(int rho) { const int n = rho >> 4, i = rho & 15; return 8 * (i >> 2) + 4 * n + (i & 3); }

struct Unit { int pm, pn; };
struct Gemm { const bf16_t* A; const bf16_t* Bt; int M, N, K; };

struct StaticOrder {
    int nM, nN, nwg, G, c;
    __host__ __device__ void init(int M, int N, int G_, int c_) { nM = M / BM; nN = N / BM; nwg = nM * nN; G = G_; c = c_; }
    __host__ __device__ bool next(int i, Unit& u) const {
        const long L = (long)i * G + c; if (L >= nwg) return false;
        int wgid = (int)L; { const int q = nwg / NXCD, r = nwg % NXCD, xcd = wgid % NXCD, off = wgid / NXCD; wgid = (xcd < r ? xcd * (q + 1) : r * (q + 1) + (xcd - r) * q) + off; }
        const int nig = WGM * nN, gid = wgid / nig, fm = gid * WGM, gsz = (nM - fm) < WGM ? (nM - fm) : WGM;
        u.pm = fm + ((wgid % nig) % gsz); u.pn = (wgid % nig) / gsz; return true;
    }
    __device__ __forceinline__ void a_ready(const Unit&) const {}
    __device__ __forceinline__ void done(const Unit&) const {}
};

__device__ __forceinline__ unsigned cvt_pk_bf16(float lo, float hi) { unsigned r; asm volatile("v_cvt_pk_bf16_f32 %0, %1, %2" : "=v"(r) : "v"(lo), "v"(hi)); return r; }
struct EpiBf16Plain {
    static constexpr bool PERM = true, AFTER_DRAIN = false;
    bf16_t* O; int ldc;
    __device__ __forceinline__ void operator()(const f32x4 (&acc)[2][2][4][2], const Unit& u, int wr, int wc, int fr, int fq) const {
        const int row0 = u.pm * BM + wr * 64 + fr; const int col0 = u.pn * BM + wc * 32 + 8 * fq;
#pragma unroll
        for (int ai = 0; ai < 2; ++ai)
#pragma unroll
            for (int m = 0; m < 4; ++m) { bf16_t* rowp = O + (size_t)(row0 + ai * HALF + m * 16) * ldc + col0;
#pragma unroll
                for (int bj = 0; bj < 2; ++bj) { const f32x4 v0 = acc[ai][bj][m][0], v1 = acc[ai][bj][m][1];
                    u32x4 w; w.x = cvt_pk_bf16(v0[0], v0[1]); w.y = cvt_pk_bf16(v0[2], v0[3]); w.z = cvt_pk_bf16(v1[0], v1[1]); w.w = cvt_pk_bf16(v1[2], v1[3]);
                    *(u32x4*)(rowp + bj * HALF) = w; } }
    }
};
struct EpiResF32 {
    static constexpr bool PERM = true, AFTER_DRAIN = false;
    const float* base; float* out; int ld;
    __device__ __forceinline__ void operator()(const f32x4 (&acc)[2][2][4][2], const Unit& u, int wr, int wc, int fr, int fq) const {
        const int row0 = u.pm * BM + wr * 64 + fr; const int col0 = u.pn * BM + wc * 32 + 8 * fq;
#pragma unroll
        for (int ai = 0; ai < 2; ++ai)
#pragma unroll
            for (int m = 0; m < 4; ++m) { const size_t ro = (size_t)(row0 + ai * HALF + m * 16) * ld + col0;
#pragma unroll
                for (int bj = 0; bj < 2; ++bj) {
                    const f32x4 b0 = *(const f32x4*)(base + ro + bj * HALF), b1 = *(const f32x4*)(base + ro + bj * HALF + 4);
                    *(f32x4*)(out + ro + bj * HALF) = acc[ai][bj][m][0] + b0;
                    *(f32x4*)(out + ro + bj * HALF + 4) = acc[ai][bj][m][1] + b1; } }
    }
};
template <class Epi, class Sched, bool ALIGN_EPI = false, bool SP2 = false>
__device__ __forceinline__ void gemm_phase(PG8_LAS unsigned char* lds, const Gemm g, const Sched& S, const Epi& E) {
    const int tid = threadIdx.x, wid = __builtin_amdgcn_readfirstlane(tid >> 6), lane = tid & 63, wr = wid >> 2, wc = wid & 3, fr = lane & 15, fq = lane >> 4;
    const int K = g.K, nt = K / BK;
    unsigned voffA[2], voffB[2];
#pragma unroll
    for (int i = 0; i < 2; ++i) { int R, C; stage_rc(tid * 16 + i * 8192, R, C); const int Rb = Epi::PERM ? ((R & ~31) + perm32(R & 31)) : R;
        voffA[i] = (unsigned)(R * K + C) * 2u; voffB[i] = (unsigned)(Rb * K + C) * 2u; }
    const size_t kstep = (size_t)(BK * 2);
    const size_t hstep = (size_t)HALF * K * 2;
    const size_t tstep = 2 * hstep;
    const unsigned ldsw = (unsigned)wid * 1024u;
    const int aoff = lds_byte(wr * 64 + fr, fq * 8), boff = lds_byte(wc * 32 + fr, fq * 8);
#define PG8_SA(b, h) (((b) * 2 + (h)) * HTB)
#define PG8_SB(b, h) ((4 + (b) * 2 + (h)) * HTB)
#define PG8_STAGE(bufoff, gbase, voff) do { _Pragma("unroll") for (int _i = 0; _i < 2; ++_i) \
        __builtin_amdgcn_global_load_lds((const unsigned*)((const char*)(gbase) + (voff)[_i]), (PG8_LAS unsigned*)(lds + (bufoff) + ldsw + _i * 8192), 16, 0, 0); } while (0)
#define PG8_LDA(dst, b, h) do { _Pragma("unroll") for (int m = 0; m < 4; ++m) _Pragma("unroll") for (int k = 0; k < 2; ++k) dst[m][k] = *(const PG8_LAS bf16x8*)(lds + PG8_SA(b, h) + aoff + m * 2048 + k * 1024); } while (0)
#define PG8_LDB(dst, b, h) do { _Pragma("unroll") for (int n = 0; n < 2; ++n) _Pragma("unroll") for (int k = 0; k < 2; ++k) dst[n][k] = *(const PG8_LAS bf16x8*)(lds + PG8_SB(b, h) + boff + n * 2048 + k * 1024); } while (0)
#define PG8_MMA(ai, bj, At, Bt) do { __builtin_amdgcn_s_setprio(1); _Pragma("unroll") for (int m = 0; m < 4; ++m) _Pragma("unroll") for (int n = 0; n < 2; ++n) _Pragma("unroll") for (int k = 0; k < 2; ++k) \
        acc[ai][bj][m][n] = __builtin_amdgcn_mfma_f32_16x16x32_bf16(Bt[n][k], At[m][k], acc[ai][bj][m][n], 0, 0, 0); __builtin_amdgcn_s_setprio(0); } while (0)
#define PG8_WAIT_V(n) asm volatile("s_waitcnt vmcnt(" #n ")" ::: "memory")
#define PG8_WAIT_L(n) asm volatile("s_waitcnt lgkmcnt(" #n ")" ::: "memory")
#define PG8_BAR __builtin_amdgcn_s_barrier()
#define PG8_SCHED __builtin_amdgcn_sched_barrier(0)
    Unit cur, nxt; int ui = 0;
    if (!S.next(0, cur)) return;
    f32x4 acc[2][2][4][2];
#pragma unroll
    for (int a = 0; a < 2; ++a)
#pragma unroll
        for (int b = 0; b < 2; ++b)
#pragma unroll
            for (int m = 0; m < 4; ++m)
#pragma unroll
                for (int n = 0; n < 2; ++n) acc[a][b][m][n] = (f32x4){0.f, 0.f, 0.f, 0.f};
    bf16x8 At[4][2], B0[2][2], B1[2][2];
    const char* cA = (const char*)g.A + (size_t)cur.pm * tstep; const char* cB = (const char*)g.Bt + (size_t)cur.pn * tstep;
    S.a_ready(cur);
    if constexpr (SP2) {
        PG8_STAGE(PG8_SB(0, 0), cB, voffB); PG8_STAGE(PG8_SB(0, 1), cB + hstep, voffB); PG8_STAGE(PG8_SA(0, 0), cA, voffA); PG8_STAGE(PG8_SA(0, 1), cA + hstep, voffA);
        if (wr == 1) PG8_BAR;
        PG8_WAIT_V(2); PG8_BAR;
        PG8_STAGE(PG8_SB(1, 0), cB + kstep, voffB); PG8_STAGE(PG8_SA(1, 0), cA + kstep, voffA); PG8_STAGE(PG8_SB(1, 1), cB + hstep + kstep, voffB);
        PG8_WAIT_V(6); PG8_BAR;
    } else {
        PG8_STAGE(PG8_SB(0, 0), cB, voffB); PG8_STAGE(PG8_SA(0, 0), cA, voffA); PG8_STAGE(PG8_SB(0, 1), cB + hstep, voffB); PG8_STAGE(PG8_SA(0, 1), cA + hstep, voffA);
        if (wr == 1) PG8_BAR;
        PG8_WAIT_V(4); PG8_BAR;
        PG8_STAGE(PG8_SB(1, 0), cB + kstep, voffB); PG8_STAGE(PG8_SA(1, 0), cA + kstep, voffA); PG8_STAGE(PG8_SB(1, 1), cB + hstep + kstep, voffB);
        PG8_WAIT_V(6); PG8_BAR;
    }
    for (;;) {
        const bool has_next = S.next(ui + 1, nxt);
        const char* nA = has_next ? (const char*)g.A + (size_t)nxt.pm * tstep : cA; const char* nB = has_next ? (const char*)g.Bt + (size_t)nxt.pn * tstep : cB;
        for (int t = 0; t < nt; t += 2) {
            const bool last = (t == nt - 2);
            const char* a1 = cA + (size_t)(t + 1) * kstep;
            const char* a2 = last ? nA : cA + (size_t)(t + 2) * kstep; const char* b2 = last ? nB : cB + (size_t)(t + 2) * kstep;
            const char* a3 = a2 + kstep; const char* b3 = b2 + kstep;
            if (last && has_next) S.a_ready(nxt);
            if constexpr (SP2) {
            PG8_LDB(B0, 0, 0); PG8_LDB(B1, 0, 1); PG8_SCHED; PG8_LDA(At, 0, 0); PG8_STAGE(PG8_SA(1, 1), a1 + hstep, voffA);
            PG8_WAIT_V(8); PG8_WAIT_L(0); PG8_BAR; PG8_MMA(0, 0, At, B0); PG8_MMA(0, 1, At, B1); PG8_BAR; PG8_SCHED;
            PG8_LDA(At, 0, 1); PG8_STAGE(PG8_SB(0, 0), b2, voffB); PG8_STAGE(PG8_SB(0, 1), b2 + hstep, voffB); PG8_STAGE(PG8_SA(0, 0), a2, voffA);
            PG8_WAIT_V(8); PG8_WAIT_L(0); PG8_BAR; PG8_MMA(1, 0, At, B0); PG8_MMA(1, 1, At, B1); PG8_BAR; PG8_SCHED;
            PG8_LDB(B0, 1, 0); PG8_LDB(B1, 1, 1); PG8_SCHED; PG8_LDA(At, 1, 0); PG8_STAGE(PG8_SA(0, 1), a2 + hstep, voffA);
            PG8_WAIT_V(8); PG8_WAIT_L(0); PG8_BAR; PG8_MMA(0, 0, At, B0); PG8_MMA(0, 1, At, B1); PG8_BAR; PG8_SCHED;
            PG8_LDA(At, 1, 1); PG8_STAGE(PG8_SB(1, 0), b3, voffB); PG8_STAGE(PG8_SB(1, 1), b3 + hstep, voffB); PG8_STAGE(PG8_SA(1, 0), a3, voffA);
            PG8_WAIT_V(8); PG8_WAIT_L(0); PG8_BAR; PG8_MMA(1, 0, At, B0); PG8_MMA(1, 1, At, B1); PG8_BAR; PG8_SCHED;
            } else {
            PG8_LDB(B0, 0, 0); PG8_SCHED; PG8_LDA(At, 0, 0); PG8_STAGE(PG8_SA(1, 1), a1 + hstep, voffA);
            PG8_WAIT_L(8); PG8_BAR; PG8_WAIT_L(0); PG8_MMA(0, 0, At, B0); PG8_BAR; PG8_SCHED;
            PG8_LDB(B1, 0, 1); PG8_STAGE(PG8_SB(0, 0), b2, voffB);
            PG8_BAR; PG8_WAIT_L(0); PG8_MMA(0, 1, At, B1); PG8_BAR;
            PG8_LDA(At, 0, 1); PG8_STAGE(PG8_SA(0, 0), a2, voffA);
            PG8_BAR; PG8_WAIT_L(0); PG8_MMA(1, 0, At, B0); PG8_BAR; PG8_SCHED;
            PG8_STAGE(PG8_SB(0, 1), b2 + hstep, voffB);
            PG8_WAIT_V(6); PG8_BAR; PG8_MMA(1, 1, At, B1); PG8_BAR;
            PG8_LDB(B0, 1, 0); PG8_SCHED; PG8_LDA(At, 1, 0); PG8_STAGE(PG8_SA(0, 1), a2 + hstep, voffA);
            PG8_WAIT_L(8); PG8_BAR; PG8_WAIT_L(0); PG8_MMA(0, 0, At, B0); PG8_BAR; PG8_SCHED;
            PG8_LDB(B1, 1, 1); PG8_STAGE(PG8_SB(1, 0), b3, voffB);
            PG8_BAR; PG8_WAIT_L(0); PG8_MMA(0, 1, At, B1); PG8_BAR;
            PG8_LDA(At, 1, 1); PG8_STAGE(PG8_SA(1, 0), a3, voffA);
            PG8_BAR; PG8_WAIT_L(0); PG8_MMA(1, 0, At, B0); PG8_BAR; PG8_SCHED;
            PG8_STAGE(PG8_SB(1, 1), b3 + hstep, voffB);
            PG8_WAIT_V(6); PG8_BAR; PG8_MMA(1, 1, At, B1); PG8_BAR;
            }
        }
        if constexpr (ALIGN_EPI) { if (wr == 0) PG8_BAR; }
        if constexpr (!Epi::AFTER_DRAIN) { E(acc, cur, wr, wc, fr, fq); S.done(cur); }
        if (!has_next) break;
#pragma unroll
        for (int a = 0; a < 2; ++a)
#pragma unroll
            for (int b = 0; b < 2; ++b)
#pragma unroll
                for (int m = 0; m < 4; ++m)
#pragma unroll
                    for (int n = 0; n < 2; ++n) acc[a][b][m][n] = (f32x4){0.f, 0.f, 0.f, 0.f};
        cur = nxt; cA = nA; cB = nB; ++ui;
        if constexpr (ALIGN_EPI) { if (wr == 1) PG8_BAR; }
    }
    PG8_WAIT_V(0);
    if constexpr (!ALIGN_EPI) { if (wr == 0) PG8_BAR; }
    PG8_BAR;
    if constexpr (Epi::AFTER_DRAIN) { E.fused(acc, cur, wr, wc, fr, fq, lds, wid, lane); S.done(cur); }
#undef PG8_SA
#undef PG8_SB
#undef PG8_STAGE
#undef PG8_LDA
#undef PG8_LDB
#undef PG8_MMA
#undef PG8_WAIT_V
#undef PG8_WAIT_L
#undef PG8_BAR
#undef PG8_SCHED
}
}

#ifndef MULTI_LAUNCH
#define MULTI_LAUNCH 0
#endif
#ifndef USE_TR
#define USE_TR 1
#endif
#ifndef REP_ATTN
#define REP_ATTN 0
#endif
#ifndef REP_M1
#define REP_M1 0
#endif
#ifndef REPEAT_MASK
#define REPEAT_MASK 0
#endif
#define LAS __attribute__((address_space(3)))
#define DI __device__ __forceinline__
typedef unsigned short bf16;
typedef short bf16x8 __attribute__((ext_vector_type(8)));
typedef float f32x4 __attribute__((ext_vector_type(4)));
typedef unsigned u32x4 __attribute__((ext_vector_type(4)));
typedef unsigned u32x2 __attribute__((ext_vector_type(2)));

constexpr int SEQ = 8192, DM = 4096, INW = 16392, NU = 16384;
constexpr int C_QA = 0, C_KA = 2048, C_VA = 4096, C_ZA = 6144, C_QM = 8192, C_KM = 9216, C_VM = 10240, C_OM = 12288, C_ZM = 14336;
constexpr float NORM_EPS = 1e-6f;
constexpr int NTHR = 512, NWAVE = 8;
constexpr int LDS_BYTES = 147456;

constexpr size_t MiB = (size_t)1 << 20;
constexpr size_t WS_WIN = 0, WS_WOUT = 256 * MiB, WS_XN = 320 * MiB, WS_U = 384 * MiB, WS_OP = 640 * MiB, WS_Y = 736 * MiB, WS_X1 = 800 * MiB,
                 WS_DC = 928 * MiB, WS_CS = 992 * MiB, WS_LSE = 1024 * MiB, WS_GATES = 1026 * MiB, WS_DN = 1027 * MiB, WS_NS = 1028 * MiB, WS_BL = 1029 * MiB,
                 WS_CTL = 1030 * MiB, WS_END = 1031 * MiB;
constexpr int LDS_BARST = LDS_BYTES - 64;

struct Params { const float *x, *norm_g, *w_in, *b_gate, *conv_w, *mnorm_g, *w_out, *rel_bias, *final_g; float* out; unsigned char* ws; int ph_lo, ph_hi; };

DI float bf_lo(unsigned u) { return __uint_as_float(u << 16); }
DI float bf_hi(unsigned u) { return __uint_as_float(u & 0xffff0000u); }
DI float bf2f(unsigned short u) { return __uint_as_float((unsigned)u << 16); }
DI unsigned pk2(float lo, float hi) { return pg8::cvt_pk_bf16(lo, hi); }
DI float wave_sum(float v) {
#pragma unroll
    for (int o = 1; o < 64; o <<= 1) v += __shfl_xor(v, o);
    return v;
}
DI float quad_sum(float v) { v += __shfl_xor(v, 16); v += __shfl_xor(v, 32); return v; }
DI float quad_max(float v) { v = fmaxf(v, __shfl_xor(v, 16)); v = fmaxf(v, __shfl_xor(v, 32)); return v; }
DI float silu_f(float x) { return x / (1.f + __expf(-x)); }
DI float sigm_f(float x) { return 1.f / (1.f + __expf(-x)); }
DI bf16x8 gatherT(const LAS unsigned short* p, int stride) {
    bf16x8 r;
#pragma unroll
    for (int j = 0; j < 8; ++j) r[j] = (short)p[j * stride];
    return r;
}
typedef short s16x4 __attribute__((ext_vector_type(4)));
DI bf16x8 trfrag(const LAS unsigned short* blk, int stride, int ql) {
#if USE_TR
    const LAS unsigned short* a = blk + (ql >> 2) * stride + 4 * (ql & 3);
    const s16x4 lo = __builtin_amdgcn_ds_read_tr16_b64_v4i16((LAS s16x4*)a);
    const s16x4 hi = __builtin_amdgcn_ds_read_tr16_b64_v4i16((LAS s16x4*)(a + 4 * stride));
    return (bf16x8){lo[0], lo[1], lo[2], lo[3], hi[0], hi[1], hi[2], hi[3]};
#else
    return gatherT(blk + ql, stride);
#endif
}
DI f32x4 mfma16(bf16x8 a, bf16x8 b, f32x4 c) { return __builtin_amdgcn_mfma_f32_16x16x32_bf16(a, b, c, 0, 0, 0); }
#define LDS_WAIT() asm volatile("s_waitcnt lgkmcnt(0)" ::: "memory")

struct TrTile { const float* src; bf16* dst; };
DI TrTile tr_tile_addr(const Params& p, int it, int lane) {
    constexpr int T_IN = 64 * 256, T_OUT = 64 * 64;
    const float* W; bf16* WT; int ldw, nb, kb;
    int r = it;
    if (r < T_IN) { W = p.w_in; WT = (bf16*)(p.ws + WS_WIN); ldw = INW; kb = r >> 8; nb = r & 255; }
    else if ((r -= T_IN) < T_OUT) { W = p.w_out; WT = (bf16*)(p.ws + WS_WOUT); ldw = DM; kb = r >> 6; nb = r & 63; }
    else if ((r -= T_OUT) < T_IN) { W = p.w_in + (size_t)DM * INW; WT = (bf16*)(p.ws + WS_WIN + 128 * MiB); ldw = INW; kb = r >> 8; nb = r & 255; }
    else { r -= T_IN; W = p.w_out + (size_t)DM * DM; WT = (bf16*)(p.ws + WS_WOUT + 32 * MiB); ldw = DM; kb = r >> 6; nb = r & 63; }
    TrTile t;
    t.src = W + (size_t)(kb * 64 + 16 * (lane >> 4)) * ldw + nb * 64 + 4 * (lane & 15);
    t.dst = WT + (size_t)(nb * 64 + (lane >> 3)) * DM + kb * 64 + 8 * (lane & 7);
    return t;
}
DI int tr_ldw(int it) { constexpr int T_IN = 64 * 256, T_OUT = 64 * 64; const int r = it % (T_IN + T_OUT); return r < T_IN ? INW : DM; }
DI void tr_load(const float* src, int ldw, f32x4 (&v)[16]) {
#pragma unroll
    for (int i = 0; i < 16; ++i) v[i] = *(const f32x4*)(src + (size_t)i * ldw);
}
DI void tr_store(const f32x4 (&v)[16], bf16* dst, LAS unsigned short* T, int lane) {
    const int kr = lane >> 4, nc = 4 * (lane & 15);
#pragma unroll
    for (int e = 0; e < 4; ++e)
#pragma unroll
        for (int hf = 0; hf < 2; ++hf) { u32x4 w;
            w.x = pk2(v[8 * hf + 0][e], v[8 * hf + 1][e]); w.y = pk2(v[8 * hf + 2][e], v[8 * hf + 3][e]); w.z = pk2(v[8 * hf + 4][e], v[8 * hf + 5][e]); w.w = pk2(v[8 * hf + 6][e], v[8 * hf + 7][e]);
            *(LAS u32x4*)(T + (nc + e) * 72 + 16 * kr + 8 * hf) = w; }
    LDS_WAIT(); asm volatile("" ::: "memory");
#pragma unroll
    for (int j = 0; j < 8; ++j) { const u32x4 w = *(const LAS u32x4*)(T + ((lane >> 3) + 8 * j) * 72 + 8 * (lane & 7)); *(u32x4*)(dst + (size_t)(8 * j) * DM) = w; }
    LDS_WAIT(); asm volatile("" ::: "memory");
}
DI void prologue_transposes(const Params& p, LAS unsigned char* lds, int wave, int lane) {
    LAS unsigned short* T = (LAS unsigned short*)(lds + wave * 16384);
    const int gw = blockIdx.x * NWAVE + wave, ngw = gridDim.x * NWAVE;
    constexpr int NIT = 2 * (64 * 256 + 64 * 64);
    f32x4 va[16], vb[16];
    int it = gw;
    if (it >= NIT) return;
    TrTile ta = tr_tile_addr(p, it, lane), tb;
    tr_load(ta.src, tr_ldw(it), va);
    for (;;) {
        const int it1 = it + ngw; const bool h1 = it1 < NIT;
        if (h1) { tb = tr_tile_addr(p, it1, lane); tr_load(tb.src, tr_ldw(it1), vb); }
        tr_store(va, ta.dst, T, lane);
        if (!h1) break;
        const int it2 = it1 + ngw; const bool h2 = it2 < NIT;
        if (h2) { ta = tr_tile_addr(p, it2, lane); tr_load(ta.src, tr_ldw(it2), va); }
        tr_store(vb, tb.dst, T, lane);
        if (!h2) break;
        it = it2;
    }
}

DI void norm_gates_phase(const Params& p, LAS unsigned char* lds, const float* X, int l, int tid, int wave, int lane) {
    LAS f32x4* G4 = (LAS f32x4*)lds;
    const float* wg = p.w_in + (size_t)l * DM * INW + NU;
#pragma unroll 4
    for (int i = 0; i < 16; ++i) { const int idx = tid + NTHR * i, k = idx >> 1, half = idx & 1;
        G4[((k & 3) * 2 + half) * 1024 + (k >> 2)] = *(const f32x4*)(wg + (size_t)k * INW + half * 4); }
    __syncthreads();
    const float* g = p.norm_g + l * DM;
    bf16* XN = (bf16*)(p.ws + WS_XN);
    float* gates = (float*)(p.ws + WS_GATES);
    for (int row = blockIdx.x * NWAVE + wave; row < SEQ; row += gridDim.x * NWAVE) {
        const f32x4* xr = (const f32x4*)(X + (size_t)row * DM) + lane;
        f32x4 v[16]; float ss = 0.f;
#pragma unroll
        for (int j = 0; j < 16; ++j) { v[j] = xr[64 * j]; ss += (v[j].x * v[j].x + v[j].y * v[j].y) + (v[j].z * v[j].z + v[j].w * v[j].w); }
        const float rstd = rsqrtf(wave_sum(ss) * (1.f / DM) + NORM_EPS);
        u32x2* o8 = (u32x2*)(XN + (size_t)row * DM) + lane;
        f32x4 a0 = {0.f, 0.f, 0.f, 0.f}, a1 = {0.f, 0.f, 0.f, 0.f};
#pragma unroll
        for (int j = 0; j < 16; ++j) {
            const f32x4 gv = ((const f32x4*)g)[lane + 64 * j];
            const f32x4 h = v[j] * rstd * gv;
            u32x2 w; w.x = pk2(h.x, h.y); w.y = pk2(h.z, h.w); o8[64 * j] = w;
            const int kq = lane + 64 * j;
            a0 += h.x * G4[0 * 1024 + kq]; a1 += h.x * G4[1 * 1024 + kq];
            a0 += h.y * G4[2 * 1024 + kq]; a1 += h.y * G4[3 * 1024 + kq];
            a0 += h.z * G4[4 * 1024 + kq]; a1 += h.z * G4[5 * 1024 + kq];
            a0 += h.w * G4[6 * 1024 + kq]; a1 += h.w * G4[7 * 1024 + kq];
        }
        const float s0 = wave_sum(a0.x), s1 = wave_sum(a0.y), s2 = wave_sum(a0.z), s3 = wave_sum(a0.w);
        const float s4 = wave_sum(a1.x), s5 = wave_sum(a1.y), s6 = wave_sum(a1.z), s7 = wave_sum(a1.w);
        float ov = s0; ov = lane == 1 ? s1 : ov; ov = lane == 2 ? s2 : ov; ov = lane == 3 ? s3 : ov;
        ov = lane == 4 ? s4 : ov; ov = lane == 5 ? s5 : ov; ov = lane == 6 ? s6 : ov; ov = lane == 7 ? s7 : ov;
        if (lane < 8) gates[(size_t)row * 8 + lane] = ov + p.b_gate[l * 8 + lane];
    }
    __syncthreads();
}
DI void final_norm_phase(const Params& p, int wave, int lane) {
    for (int row = blockIdx.x * NWAVE + wave; row < SEQ; row += gridDim.x * NWAVE) {
        f32x4* xr = (f32x4*)(p.out + (size_t)row * DM) + lane;
        f32x4 v[16]; float ss = 0.f;
#pragma unroll
        for (int j = 0; j < 16; ++j) { v[j] = xr[64 * j]; ss += (v[j].x * v[j].x + v[j].y * v[j].y) + (v[j].z * v[j].z + v[j].w * v[j].w); }
        const float rstd = rsqrtf(wave_sum(ss) * (1.f / DM) + NORM_EPS);
#pragma unroll
        for (int j = 0; j < 16; ++j) xr[64 * j] = v[j] * rstd * ((const f32x4*)p.final_g)[lane + 64 * j];
    }
}

constexpr int AT_KS = 136;
DI void attn_item(const Params& p, LAS unsigned char* lds, int item, int tid, int wave, int lane) {
    const bf16* U = (const bf16*)(p.ws + WS_U);
    LAS unsigned short* Ks = (LAS unsigned short*)lds;
    LAS unsigned short* Vs = Ks + 256 * AT_KS;
    LAS float* biasS = (LAS float*)(Vs + 256 * AT_KS);
    const int pat = item >> 10, rem = item & 1023, h = rem >> 6, rb = rem & 63;
    const int dsh = pat * 2;
    const int r = rb >> (6 - dsh), bq = rb & ((64 >> dsh) - 1);
    const int sub0 = 128 * bq - 128;
    const int ql = lane & 15, quad = lane >> 4, q0 = wave * 16;
    u32x4 kv[8], vv[8];
#pragma unroll
    for (int i = 0; i < 8; ++i) { const int c = tid + NTHR * i, row = c >> 4, ch = c & 15; int sub = sub0 + row; sub = sub < 0 ? 0 : sub;
        const bf16* src = U + (size_t)((sub << dsh) + r) * NU + h * 128 + ch * 8;
        kv[i] = *(const u32x4*)(src + C_KA); vv[i] = *(const u32x4*)(src + C_VA); }
    const int tq = ((128 * bq + q0 + ql) << dsh) + r;
    bf16x8 qf[4];
#pragma unroll
    for (int ks = 0; ks < 4; ++ks) qf[ks] = *(const bf16x8*)(U + (size_t)tq * NU + C_QA + h * 128 + ks * 32 + quad * 8);
    if (tid < 129) { const int n = tid << dsh; int b = n;
        if (n >= 16) { b = 16 + (int)floorf(log2f((float)n * 0.0625f) * (16.f / 7.f)); b = b > 31 ? 31 : b; }
        biasS[tid] = p.rel_bias[b * 16 + h]; }
#pragma unroll
    for (int i = 0; i < 8; ++i) { const int c = tid + NTHR * i, row = c >> 4, ch = c & 15;
        *(LAS u32x4*)(Ks + row * AT_KS + ch * 8) = kv[i]; *(LAS u32x4*)(Vs + row * AT_KS + ch * 8) = vv[i]; }
    __syncthreads();
    f32x4 sacc[10];
#pragma unroll
    for (int t = 0; t < 10; ++t) sacc[t] = (f32x4){0.f, 0.f, 0.f, 0.f};
#pragma unroll
    for (int s = 0; s < 5; ++s)
#pragma unroll
        for (int u = 0; u < 2; ++u) { int kk = q0 + 32 * s + (ql >> 2) * 8 + u * 4 + (ql & 3); kk = kk > 255 ? 255 : kk;
            const LAS unsigned short* kp = Ks + kk * AT_KS + quad * 8;
#pragma unroll
            for (int ks = 0; ks < 4; ++ks) sacc[2 * s + u] = mfma16(*(const LAS bf16x8*)(kp + ks * 32), qf[ks], sacc[2 * s + u]); }
    const float scale = 0.08838834764831845f;
    float mx = -1e30f;
    int ql2 = ql, quad2 = quad; asm volatile("" : "+v"(ql2), "+v"(quad2));
#pragma unroll
    for (int s = 0; s < 5; ++s)
#pragma unroll
        for (int u = 0; u < 2; ++u)
#pragma unroll
            for (int j = 0; j < 4; ++j) { const int koff = 32 * s + quad2 * 8 + u * 4 + j, rel = koff - ql2;
                const bool valid = (rel >= 0) && (rel <= 128) && (sub0 + q0 + koff >= 0);
                int jo = 128 - rel; jo = jo < 0 ? 0 : (jo > 128 ? 128 : jo);
                const float v = valid ? sacc[2 * s + u][j] * scale + biasS[jo] : -1e30f;
                sacc[2 * s + u][j] = v; mx = fmaxf(mx, v); }
    mx = quad_max(mx);
    float l = 0.f;
#pragma unroll
    for (int t = 0; t < 10; ++t)
#pragma unroll
        for (int j = 0; j < 4; ++j) { const float e = __expf(sacc[t][j] - mx); sacc[t][j] = e; l += e; }
    l = quad_sum(l);
    f32x4 oacc[8];
#pragma unroll
    for (int nt = 0; nt < 8; ++nt) oacc[nt] = (f32x4){0.f, 0.f, 0.f, 0.f};
#pragma unroll
    for (int s = 0; s < 5; ++s) {
        u32x4 pw; pw.x = pk2(sacc[2 * s][0], sacc[2 * s][1]); pw.y = pk2(sacc[2 * s][2], sacc[2 * s][3]); pw.z = pk2(sacc[2 * s + 1][0], sacc[2 * s + 1][1]); pw.w = pk2(sacc[2 * s + 1][2], sacc[2 * s + 1][3]);
        const bf16x8 pf = __builtin_bit_cast(bf16x8, pw);
        int key0 = q0 + 32 * s + quad * 8; key0 = key0 > 248 ? 248 : key0;
        const LAS unsigned short* vp = Vs + key0 * AT_KS;
#pragma unroll
        for (int nt = 0; nt < 8; ++nt) oacc[nt] = mfma16(trfrag(vp + nt * 16, AT_KS, ql), pf, oacc[nt]);
    }
    const float inv = 1.f / l;
    bf16* OP = (bf16*)(p.ws + WS_OP) + (size_t)pat * SEQ * 2048 + (size_t)tq * 2048 + h * 128 + quad * 4;
#pragma unroll
    for (int nt = 0; nt < 8; ++nt) { u32x2 w; w.x = pk2(oacc[nt][0] * inv, oacc[nt][1] * inv); w.y = pk2(oacc[nt][2] * inv, oacc[nt][3] * inv); *(u32x2*)(OP + nt * 16) = w; }
    if (quad == 0) ((float*)(p.ws + WS_LSE))[((size_t)pat * SEQ + tq) * 16 + h] = mx + __logf(l);
    __syncthreads();
}
DI void merge_phase(const Params& p, int tid) {
    const bf16* U = (const bf16*)(p.ws + WS_U);
    const bf16* OP = (const bf16*)(p.ws + WS_OP);
    const float* LSE = (const float*)(p.ws + WS_LSE);
    bf16* Y = (bf16*)(p.ws + WS_Y);
    const int gthreads = gridDim.x * NTHR;
    for (int idx = blockIdx.x * NTHR + tid; idx < SEQ * 256; idx += gthreads) {
        const int t = idx >> 8, c8 = idx & 255, h = c8 >> 4;
        const float l0 = LSE[(size_t)t * 16 + h], l1 = LSE[((size_t)SEQ + t) * 16 + h], l2 = LSE[((size_t)2 * SEQ + t) * 16 + h];
        const float M = fmaxf(l0, fmaxf(l1, l2));
        float w0 = __expf(l0 - M), w1 = __expf(l1 - M), w2 = __expf(l2 - M);
        const float inv = 1.f / (w0 + w1 + w2); w0 *= inv; w1 *= inv; w2 *= inv;
        const size_t o = (size_t)t * 2048 + c8 * 8;
        const u32x4 o0 = *(const u32x4*)(OP + o), o1 = *(const u32x4*)(OP + (size_t)SEQ * 2048 + o), o2 = *(const u32x4*)(OP + (size_t)2 * SEQ * 2048 + o);
        const u32x4 z = *(const u32x4*)(U + (size_t)t * NU + C_ZA + c8 * 8);
        u32x4 y;
#pragma unroll
        for (int e = 0; e < 4; ++e) {
            const float lo = (w0 * bf_lo(o0[e]) + w1 * bf_lo(o1[e]) + w2 * bf_lo(o2[e])) * silu_f(bf_lo(z[e]));
            const float hi = (w0 * bf_hi(o0[e]) + w1 * bf_hi(o1[e]) + w2 * bf_hi(o2[e])) * silu_f(bf_hi(z[e]));
            y[e] = pk2(lo, hi);
        }
        *(u32x4*)(Y + (size_t)t * DM + c8 * 8) = y;
    }
}

constexpr int M_KS = 264, M_VS3 = 520;
DI void conv8(const bf16* U, const float* cw, int t, int rawcol, int cch, float (&f)[8]) {
#pragma unroll
    for (int e = 0; e < 8; ++e) f[e] = 0.f;
#pragma unroll
    for (int j = 0; j < 4; ++j) { const int tt = t - 3 + j;
        if (tt >= 0) { const u32x4 raw = *(const u32x4*)(U + (size_t)tt * NU + rawcol);
            const f32x4 w0 = *(const f32x4*)(cw + j * 2048 + cch), w1 = *(const f32x4*)(cw + j * 2048 + cch + 4);
            f[0] += w0[0] * bf_lo(raw.x); f[1] += w0[1] * bf_hi(raw.x); f[2] += w0[2] * bf_lo(raw.y); f[3] += w0[3] * bf_hi(raw.y);
            f[4] += w1[0] * bf_lo(raw.z); f[5] += w1[1] * bf_hi(raw.z); f[6] += w1[2] * bf_lo(raw.w); f[7] += w1[3] * bf_hi(raw.w); } }
#pragma unroll
    for (int e = 0; e < 8; ++e) f[e] = silu_f(f[e]);
}
template <int NI, int MODE, int NB>
DI void conv_tile(const bf16* U, const float* cw, int t0, int rawcol0, int cch0, float sc, LAS unsigned short* dst, int tid, float bL, const LAS float* bS, const LAS float* liS, int roff) {
    const int ch = tid & 31, r0 = tid >> 5;
    f32x4 w[4][2];
#pragma unroll
    for (int j = 0; j < 4; ++j) { w[j][0] = *(const f32x4*)(cw + j * 2048 + cch0 + ch * 8); w[j][1] = *(const f32x4*)(cw + j * 2048 + cch0 + ch * 8 + 4); }
    const bf16* src = U + rawcol0 + ch * 8;
#pragma unroll
    for (int ib = 0; ib < NI; ib += NB) {
        u32x4 raw[NB][4];
#pragma unroll
        for (int i = 0; i < NB; ++i)
#pragma unroll
            for (int j = 0; j < 4; ++j) { const int tt = t0 + r0 + 16 * (ib + i) - 3 + j; const int tc = tt < 0 ? 0 : tt;
                raw[i][j] = *(const u32x4*)(src + (size_t)tc * NU); if (tt < 0) raw[i][j] = (u32x4){0u, 0u, 0u, 0u}; }
#pragma unroll
        for (int i = 0; i < NB; ++i) { const int row = r0 + 16 * (ib + i);
            float f[8];
#pragma unroll
            for (int e = 0; e < 8; ++e) f[e] = 0.f;
#pragma unroll
            for (int j = 0; j < 4; ++j) { const u32x4 rw = raw[i][j];
                f[0] += w[j][0][0] * bf_lo(rw.x); f[1] += w[j][0][1] * bf_hi(rw.x); f[2] += w[j][0][2] * bf_lo(rw.y); f[3] += w[j][0][3] * bf_hi(rw.y);
                f[4] += w[j][1][0] * bf_lo(rw.z); f[5] += w[j][1][1] * bf_hi(rw.z); f[6] += w[j][1][2] * bf_lo(rw.w); f[7] += w[j][1][3] * bf_hi(rw.w); }
            float m = sc;
            if (MODE == 1) m *= __expf(bL - bS[roff + row] + liS[roff + row]);
#pragma unroll
            for (int e = 0; e < 8; ++e) f[e] = silu_f(f[e]) * m;
            u32x4 o; o.x = pk2(f[0], f[1]); o.y = pk2(f[2], f[3]); o.z = pk2(f[4], f[5]); o.w = pk2(f[6], f[7]);
            *(LAS u32x4*)(dst + row * M_KS + ch * 8) = o; }
        __builtin_amdgcn_sched_barrier(0);
    }
}
DI void chunk_gates(const float* gates, int c, int hh, LAS float* bS, LAS float* liS, LAS float* wtot, int tid, int wave, int lane) {
    float v = 0.f;
    if (tid < 256) { const float* gp = gates + (size_t)(c * 256 + tid) * 8; const float fgv = gp[4 + hh]; liS[tid] = gp[hh];
        v = fminf(fgv, 0.f) - log1pf(__expf(-fabsf(fgv)));
#pragma unroll
        for (int o = 1; o < 64; o <<= 1) { const float t = __shfl_up(v, o); if (lane >= o) v += t; }
        if (lane == 63) wtot[wave] = v; }
    __syncthreads();
    if (tid < 256) { float pre = 0.f; for (int w = 0; w < wave; ++w) pre += wtot[w]; bS[tid] = v + pre; }
    __syncthreads();
}
DI void m1_item(const Params& p, LAS unsigned char* lds, int l, int item, int tid, int wave, int lane) {
    const bf16* U = (const bf16*)(p.ws + WS_U);
    const float* cw = p.conv_w + (size_t)l * 4 * 2048;
    LAS unsigned short* Kp = (LAS unsigned short*)lds;
    LAS unsigned short* Vs = Kp + 128 * M_KS;
    LAS float* bS = (LAS float*)(Vs + 128 * AT_KS); LAS float* liS = bS + 256; LAS float* wtot = liS + 256;
    const int hh = item >> 7, c = (item >> 2) & 31, sl = item & 3;
    const int ql = lane & 15, quad = lane >> 4;
    chunk_gates((const float*)(p.ws + WS_GATES), c, hh, bS, liS, wtot, tid, wave, lane);
    const float bL = bS[255];
    f32x4 acc[4][4];
#pragma unroll
    for (int a = 0; a < 4; ++a)
#pragma unroll
        for (int b = 0; b < 4; ++b) acc[a][b] = (f32x4){0.f, 0.f, 0.f, 0.f};
    float nsum = 0.f;
    const int dvt0 = (wave & 1) * 4, dkt0 = (wave >> 1) * 4;
    for (int half = 0; half < 2; ++half) {
        conv_tile<8, 1, 4>(U, cw, c * 256 + half * 128, C_KM + hh * 256, 1024 + hh * 256, 0.0625f, Kp, tid, bL, bS, liS, half * 128);
#pragma unroll
        for (int i = 0; i < 4; ++i) { const int cc = tid + NTHR * i, row = cc >> 4, ch = cc & 15;
            *(LAS u32x4*)(Vs + row * AT_KS + ch * 8) = *(const u32x4*)(U + (size_t)(c * 256 + half * 128 + row) * NU + C_VM + hh * 512 + sl * 128 + ch * 8); }
        __syncthreads();
#pragma unroll 1
        for (int ks = 0; ks < 4; ++ks) {
            bf16x8 af[4], bfr[4];
#pragma unroll
            for (int a = 0; a < 4; ++a) af[a] = trfrag(Vs + (ks * 32 + quad * 8) * AT_KS + (dvt0 + a) * 16, AT_KS, ql);
#pragma unroll
            for (int b = 0; b < 4; ++b) bfr[b] = trfrag(Kp + (ks * 32 + quad * 8) * M_KS + (dkt0 + b) * 16, M_KS, ql);
#pragma unroll
            for (int a = 0; a < 4; ++a)
#pragma unroll
                for (int b = 0; b < 4; ++b) acc[a][b] = mfma16(af[a], bfr[b], acc[a][b]);
        }
        if (sl == 0 && tid < 256) { for (int row = 0; row < 128; ++row) nsum += bf2f(Kp[row * M_KS + tid]); }
        __syncthreads();
    }
    float* DC = (float*)(p.ws + WS_DC) + ((size_t)(hh * 32 + c) * 512 + sl * 128) * 256;
#pragma unroll
    for (int a = 0; a < 4; ++a)
#pragma unroll
        for (int b = 0; b < 4; ++b)
#pragma unroll
            for (int j = 0; j < 4; ++j) DC[(size_t)((dvt0 + a) * 16 + quad * 4 + j) * 256 + (dkt0 + b) * 16 + ql] = acc[a][b][j];
    if (sl == 0 && tid < 256) ((float*)(p.ws + WS_DN))[(hh * 32 + c) * 256 + tid] = nsum;
    if (sl == 0 && tid == 0) ((float*)(p.ws + WS_BL))[hh * 32 + c] = bL;
}
DI void m2_phase(const Params& p, int tid) {
    const float* DC = (const float*)(p.ws + WS_DC); const float* BL = (const float*)(p.ws + WS_BL);
    bf16* CS = (bf16*)(p.ws + WS_CS);
    const int gthreads = gridDim.x * NTHR, gid = blockIdx.x * NTHR + tid;
    for (int e4 = gid; e4 < 4 * 32768; e4 += gthreads) {
        const int hh = e4 >> 15, e = e4 & 32767;
        f32x4 st = {0.f, 0.f, 0.f, 0.f};
#pragma unroll 8
        for (int c = 0; c < 32; ++c) {
            const size_t o = ((size_t)(hh * 32 + c) * 32768 + e) * 4;
            u32x2 w; w.x = pk2(st.x, st.y); w.y = pk2(st.z, st.w); *(u32x2*)(CS + o) = w;
            const f32x4 d = *(const f32x4*)(DC + o);
            st = st * __expf(BL[hh * 32 + c]) + d;
        }
    }
    if (gid < 1024) { const int hh = gid >> 8, dk = gid & 255; const float* DN = (const float*)(p.ws + WS_DN); float* NS = (float*)(p.ws + WS_NS);
        float st = 0.f;
        for (int c = 0; c < 32; ++c) { NS[(hh * 32 + c) * 256 + dk] = st; st = st * __expf(BL[hh * 32 + c]) + DN[(hh * 32 + c) * 256 + dk]; } }
}
DI void m3_item(const Params& p, LAS unsigned char* lds, int l, int item, int tid, int wave, int lane) {
    const bf16* U = (const bf16*)(p.ws + WS_U);
    const float* cw = p.conv_w + (size_t)l * 4 * 2048;
    LAS unsigned short* Qs = (LAS unsigned short*)lds;
    LAS unsigned short* Ks = Qs + 64 * M_KS;
    LAS unsigned short* Vs = Ks + 64 * M_KS;
    LAS float* bS = (LAS float*)(Vs + 64 * M_VS3); LAS float* liS = bS + 256; LAS float* nS = liS + 256; LAS float* wtot = nS + 256; LAS float* ssS = wtot + 8;
    const int hh = item >> 7; int qb = item & 127; if ((item >> 8) & 1) qb ^= 3;
    const int c = qb >> 2, jq = qb & 3;
    const int ql = lane & 15, quad = lane >> 4;
    if (tid < 256) nS[tid] = ((const float*)(p.ws + WS_NS))[(hh * 32 + c) * 256 + tid];
    chunk_gates((const float*)(p.ws + WS_GATES), c, hh, bS, liS, wtot, tid, wave, lane);
    conv_tile<4, 0, 2>(U, cw, qb * 64, C_QM + hh * 256, hh * 256, 1.f, Qs, tid, 0.f, bS, liS, 0);
    __syncthreads();
    const int qg = wave & 3, dvh = wave >> 2, q = qg * 16 + ql, iq = jq * 64 + q;
    bf16x8 qf[8];
#pragma unroll
    for (int ks = 0; ks < 8; ++ks) qf[ks] = *(const LAS bf16x8*)(Qs + q * M_KS + ks * 32 + quad * 8);
    const float b_q = bS[iq], eb = __expf(b_q);
    f32x4 acc[16];
#pragma unroll
    for (int nt = 0; nt < 16; ++nt) acc[nt] = (f32x4){0.f, 0.f, 0.f, 0.f};
    { const bf16* CT = (const bf16*)(p.ws + WS_CS) + (size_t)(hh * 32 + c) * 512 * 256;
      LAS unsigned short* Cs = Ks;
#pragma unroll 1
      for (int pc = 0; pc < 4; ++pc) {
          __syncthreads();
          u32x4 cv[8];
#pragma unroll
          for (int i = 0; i < 8; ++i) { const int cc = tid + NTHR * i, row = cc >> 5, ch = cc & 31;
              cv[i] = *(const u32x4*)(CT + (size_t)((row >> 6) * 256 + pc * 64 + (row & 63)) * 256 + ch * 8); }
#pragma unroll
          for (int i = 0; i < 8; ++i) { const int cc = tid + NTHR * i, row = cc >> 5, ch = cc & 31; *(LAS u32x4*)(Cs + row * M_KS + ch * 8) = cv[i]; }
          __syncthreads();
#pragma unroll
          for (int n4 = 0; n4 < 4; ++n4) { const LAS unsigned short* cp = Cs + (dvh * 64 + n4 * 16 + ql) * M_KS + quad * 8;
#pragma unroll
              for (int ks = 0; ks < 8; ++ks) acc[n4] = mfma16(*(const LAS bf16x8*)(cp + ks * 32), qf[ks], acc[n4]); }
          { const f32x4 t0 = acc[0], t1 = acc[1], t2 = acc[2], t3 = acc[3];
#pragma unroll
            for (int i = 0; i < 12; ++i) acc[i] = acc[i + 4];
            acc[12] = t0; acc[13] = t1; acc[14] = t2; acc[15] = t3; }
      }
    }
#pragma unroll
    for (int nt = 0; nt < 16; ++nt) acc[nt] = acc[nt] * eb;
    float nqp = 0.f;
#pragma unroll
    for (int ks = 0; ks < 8; ++ks)
#pragma unroll
        for (int j = 0; j < 8; ++j) nqp += bf2f((unsigned short)qf[ks][j]) * nS[ks * 32 + quad * 8 + j];
    float nq = quad_sum(nqp) * eb;
    float nqi = 0.f;
    for (int kt = 0; kt <= jq; ++kt) {
        __syncthreads();
        int tid2 = tid; asm volatile("" : "+v"(tid2));
#pragma unroll
        for (int ib = 0; ib < 8; ib += 4) { u32x4 vv[4];
#pragma unroll
            for (int i = 0; i < 4; ++i) { const int cc = tid2 + NTHR * (ib + i), row = cc >> 6, ch = cc & 63; vv[i] = *(const u32x4*)(U + (size_t)(c * 256 + kt * 64 + row) * NU + C_VM + hh * 512 + ch * 8); }
#pragma unroll
            for (int i = 0; i < 4; ++i) { const int cc = tid2 + NTHR * (ib + i), row = cc >> 6, ch = cc & 63; *(LAS u32x4*)(Vs + row * M_VS3 + ch * 8) = vv[i]; }
            __builtin_amdgcn_sched_barrier(0); }
        conv_tile<4, 0, 2>(U, cw, c * 256 + kt * 64, C_KM + hh * 256, 1024 + hh * 256, 0.0625f, Ks, tid2, 0.f, bS, liS, 0);
        __syncthreads();
        f32x4 sacc[4];
#pragma unroll
        for (int t = 0; t < 4; ++t) sacc[t] = (f32x4){0.f, 0.f, 0.f, 0.f};
#pragma unroll
        for (int s = 0; s < 2; ++s)
#pragma unroll
            for (int u = 0; u < 2; ++u) { const int krow = 32 * s + (ql >> 2) * 8 + u * 4 + (ql & 3);
                const LAS unsigned short* kp = Ks + krow * M_KS + quad * 8;
#pragma unroll
                for (int ks = 0; ks < 8; ++ks) sacc[2 * s + u] = mfma16(*(const LAS bf16x8*)(kp + ks * 32), qf[ks], sacc[2 * s + u]); }
#pragma unroll
        for (int s = 0; s < 2; ++s)
#pragma unroll
            for (int u = 0; u < 2; ++u)
#pragma unroll
                for (int j = 0; j < 4; ++j) { const int sk = kt * 64 + 32 * s + quad * 8 + u * 4 + j;
                    const float w = (sk <= iq) ? __expf(b_q - bS[sk] + liS[sk]) : 0.f;
                    const float pv = sacc[2 * s + u][j] * w; sacc[2 * s + u][j] = pv; nqi += pv; }
#pragma unroll
        for (int s = 0; s < 2; ++s) {
            u32x4 pw; pw.x = pk2(sacc[2 * s][0], sacc[2 * s][1]); pw.y = pk2(sacc[2 * s][2], sacc[2 * s][3]); pw.z = pk2(sacc[2 * s + 1][0], sacc[2 * s + 1][1]); pw.w = pk2(sacc[2 * s + 1][2], sacc[2 * s + 1][3]);
            const bf16x8 pf = __builtin_bit_cast(bf16x8, pw);
            const LAS unsigned short* vp = Vs + (32 * s + quad * 8) * M_VS3 + dvh * 256;
#pragma unroll
            for (int nt = 0; nt < 16; ++nt) acc[nt] = mfma16(trfrag(vp + nt * 16, M_VS3, ql), pf, acc[nt]);
        }
    }
    nq += quad_sum(nqi);
    const float inv = 1.f / fmaxf(fabsf(nq), 1.f);
    float ss = 0.f;
#pragma unroll
    for (int nt = 0; nt < 16; ++nt) { acc[nt] = acc[nt] * inv; ss += (acc[nt][0] * acc[nt][0] + acc[nt][1] * acc[nt][1]) + (acc[nt][2] * acc[nt][2] + acc[nt][3] * acc[nt][3]); }
    ss = quad_sum(ss);
    if (quad == 0) ssS[dvh * 64 + q] = ss;
    __syncthreads();
    const float rstd = rsqrtf((ssS[q] + ssS[64 + q]) * (1.f / 512.f) + NORM_EPS);
    const int t = qb * 64 + q;
    const float* ng = p.mnorm_g + l * 2048;
    bf16* Y = (bf16*)(p.ws + WS_Y);
#pragma unroll
    for (int nt = 0; nt < 16; ++nt) { const int col = hh * 512 + dvh * 256 + nt * 16 + quad * 4;
        const f32x4 g4 = *(const f32x4*)(ng + col);
        const u32x2 om = *(const u32x2*)(U + (size_t)t * NU + C_OM + col), zm = *(const u32x2*)(U + (size_t)t * NU + C_ZM + col);
        const float y0 = acc[nt][0] * rstd * g4[0] * sigm_f(bf_lo(om.x)) * silu_f(bf_lo(zm.x));
        const float y1 = acc[nt][1] * rstd * g4[1] * sigm_f(bf_hi(om.x)) * silu_f(bf_hi(zm.x));
        const float y2 = acc[nt][2] * rstd * g4[2] * sigm_f(bf_lo(om.y)) * silu_f(bf_lo(zm.y));
        const float y3 = acc[nt][3] * rstd * g4[3] * sigm_f(bf_hi(om.y)) * silu_f(bf_hi(zm.y));
        u32x2 w; w.x = pk2(y0, y1); w.y = pk2(y2, y3);
        *(u32x2*)(Y + (size_t)t * DM + 2048 + col) = w;
        if ((nt & 3) == 3) __builtin_amdgcn_sched_barrier(0); }
    __syncthreads();
}

#define RLX_AGENT __ATOMIC_RELAXED, __HIP_MEMORY_SCOPE_AGENT
#define XB_TMO      128
#define XB_XCNT(j)  (256  + 64 * (j))
#define XB_XSUB(j)  (1280 + 64 * (j))
#define XB_XGEN(j)  (2304 + 64 * (j))
#define XB_TOP      3328
#define XB_TOPGEN   3392
#define XCD_BAR_WORDS 3456
#define XB_SPIN_CAP (1u << 18)

__device__ __forceinline__ unsigned xb_ld(unsigned* p)              { return __hip_atomic_load(p, __ATOMIC_RELAXED, __HIP_MEMORY_SCOPE_AGENT); }
__device__ __forceinline__ unsigned xb_add(unsigned* p, unsigned v) { return __hip_atomic_fetch_add(p, v, __ATOMIC_RELAXED, __HIP_MEMORY_SCOPE_AGENT); }
__device__ __forceinline__ unsigned xb_xcc_id() { return (unsigned)__builtin_amdgcn_s_getreg((3 << 11) | 20) & 0xFu; }
#define XB_SPIN(cond, bar) do { unsigned _sp = 0; while (cond) { __builtin_amdgcn_s_sleep(1); \
    if ((++_sp & 255u) == 0u) { if (xb_ld(&(bar)[XB_TMO])) break; if (_sp > XB_SPIN_CAP) { atomicAdd(&(bar)[XB_TMO], 1u); break; } } } } while (0)

struct XcdBarrier {
    unsigned* bar; unsigned x;
    volatile LAS unsigned* st;
};

__device__ __forceinline__ XcdBarrier xcd_barrier_post(unsigned* bar, volatile LAS unsigned* st) {
    XcdBarrier b; b.bar = bar; b.x = xb_xcc_id(); b.st = st;
    if (threadIdx.x == 0) (void)xb_add(&bar[XB_XCNT(b.x)], 1u);
    return b;
}
__device__ __forceinline__ void xcd_barrier_complete(unsigned* bar, unsigned x, unsigned& nloc, unsigned& nx) {
    const unsigned G = gridDim.x * gridDim.y * gridDim.z;
    unsigned sum, cnt, mine, sp = 0u;
    for (;;) {
        sum = 0u; cnt = 0u; mine = 0u;
#pragma unroll
        for (unsigned j = 0; j < 16; ++j) { const unsigned c = xb_ld(&bar[XB_XCNT(j)]); sum += c; cnt += (c > 0u) ? 1u : 0u; mine = (j == x) ? c : mine; }
        if (sum == G) break;
        __builtin_amdgcn_s_sleep(1);
        if ((++sp & 255u) == 0u) { if (xb_ld(&bar[XB_TMO])) break; if (sp > XB_SPIN_CAP) { atomicAdd(&bar[XB_TMO], 1u); break; } }
    }
    nloc = mine > 0u ? mine : 1u; nx = cnt > 0u ? cnt : 1u;
}

__device__ __forceinline__ void xcd_barrier(const XcdBarrier& b) {
    asm volatile("s_waitcnt vmcnt(0)" ::: "memory");
    __syncthreads();
    if (threadIdx.x == 0) {
        unsigned* bar = b.bar;
        __builtin_amdgcn_s_waitcnt(0);
        unsigned nloc = b.st[0], nx = b.st[1];
        if (nloc == 0u) { xcd_barrier_complete(bar, b.x, nloc, nx); b.st[0] = nloc; b.st[1] = nx; }
        const unsigned old = xb_add(&bar[XB_XSUB(b.x)], 1u);
        const unsigned gen = old / nloc;
        if (old + 1u == (gen + 1u) * nloc) {
            __builtin_amdgcn_fence(__ATOMIC_RELEASE, "agent");
            asm volatile("s_waitcnt vmcnt(0)" ::: "memory");
            const unsigned og = xb_add(&bar[XB_TOP], 1u);
            const unsigned tg = og / nx;
            if (og + 1u == (tg + 1u) * nx) xb_add(&bar[XB_TOPGEN], 1u);
            else XB_SPIN(xb_ld(&bar[XB_TOPGEN]) == tg, bar);
            __builtin_amdgcn_fence(__ATOMIC_ACQUIRE, "agent");
            xb_add(&bar[XB_XGEN(b.x)], 1u);
            asm volatile("s_waitcnt vmcnt(0)" ::: "memory");
        } else {
            XB_SPIN(xb_ld(&bar[XB_XGEN(b.x)]) == gen, bar);
            __builtin_amdgcn_fence(__ATOMIC_ACQUIRE, "agent");
            asm volatile("s_waitcnt vmcnt(0)" ::: "memory");
        }
    }
    __syncthreads();
}

constexpr int NPH = 13;
__global__ void __launch_bounds__(NTHR, 2) hymba_fwd(Params p0) {
    extern __shared__ __attribute__((aligned(16))) unsigned char lds_raw[];
    cg::grid_group grid = cg::this_grid();
    const int G = gridDim.x;
    if (threadIdx.x < 16) ((LAS unsigned*)((LAS unsigned char*)lds_raw + LDS_BARST))[threadIdx.x] = 0u;
    __syncthreads();
    XcdBarrier bar = xcd_barrier_post((unsigned*)(p0.ws + WS_CTL), (volatile LAS unsigned*)((LAS unsigned char*)lds_raw + LDS_BARST));
    for (int ph = p0.ph_lo; ph < p0.ph_hi; ++ph) {
        const int ptype = ph == 0 ? 0 : 1 + (ph - 1) % 6;
        const int nrep = (REPEAT_MASK) == 0 ? 1 : ((((REPEAT_MASK) >> ptype) & 1) ? 2 : 1);
        for (int rep = 0; rep < nrep; ++rep) {
        int tid = threadIdx.x; asm volatile("" : "+v"(tid));
        const int lane = tid & 63, wave = __builtin_amdgcn_readfirstlane(tid >> 6);
        LAS unsigned char* lds = (LAS unsigned char*)lds_raw; asm volatile("" : "+s"(lds));
        Params p = p0;
        asm volatile("" : "+s"(p.ws)); asm volatile("" : "+s"(p.x)); asm volatile("" : "+s"(p.out)); asm volatile("" : "+s"(p.w_in)); asm volatile("" : "+s"(p.w_out));
        asm volatile("" : "+s"(p.conv_w)); asm volatile("" : "+s"(p.norm_g)); asm volatile("" : "+s"(p.mnorm_g)); asm volatile("" : "+s"(p.b_gate)); asm volatile("" : "+s"(p.rel_bias)); asm volatile("" : "+s"(p.final_g));
        if (ph == 0) {
            prologue_transposes(p, lds, wave, lane);
            __syncthreads();
            norm_gates_phase(p, lds, p.x, 0, tid, wave, lane);
        } else {
            const int l = (ph - 1) / 6, k = (ph - 1) % 6;
            if (k == 0) {
                pg8::Gemm g{(const pg8::bf16_t*)(p.ws + WS_XN), (const pg8::bf16_t*)(p.ws + WS_WIN + (size_t)l * 128 * MiB), SEQ, NU, DM};
                pg8::StaticOrder S; S.init(SEQ, NU, G, (int)blockIdx.x);
                pg8::EpiBf16Plain E{(pg8::bf16_t*)(p.ws + WS_U), NU};
                pg8::gemm_phase<pg8::EpiBf16Plain, pg8::StaticOrder, true, true>(lds, g, S, E);
            } else if (k == 1) {
                for (int rr = 0; rr < 1 + (REP_ATTN); ++rr)
                for (int it = blockIdx.x; it < 3072; it += G) attn_item(p, lds, it, tid, wave, lane);
                int tid3 = tid; asm volatile("" : "+v"(tid3));
                for (int rr = 0; rr < 1 + (REP_M1); ++rr)
                for (int it = blockIdx.x; it < 512; it += G) { m1_item(p, lds, l, it, tid3, __builtin_amdgcn_readfirstlane(tid3 >> 6), tid3 & 63); __syncthreads(); }
            } else if (k == 2) {
                m2_phase(p, tid);
                merge_phase(p, tid);
            } else if (k == 3) {
                for (int it = blockIdx.x; it < 512; it += G) m3_item(p, lds, l, it, tid, wave, lane);
            } else if (k == 4) {
                pg8::Gemm g{(const pg8::bf16_t*)(p.ws + WS_Y), (const pg8::bf16_t*)(p.ws + WS_WOUT + (size_t)l * 32 * MiB), SEQ, DM, DM};
                pg8::StaticOrder S; S.init(SEQ, DM, G, (int)blockIdx.x);
                pg8::EpiResF32 E{l == 0 ? p.x : (const float*)(p.ws + WS_X1), l == 0 ? (float*)(p.ws + WS_X1) : p.out, DM};
                pg8::gemm_phase<pg8::EpiResF32, pg8::StaticOrder, true, true>(lds, g, S, E);
            } else {
                if (l == 0) norm_gates_phase(p, lds, (const float*)(p.ws + WS_X1), 1, tid, wave, lane);
                else final_norm_phase(p, wave, lane);
            }
        }
        __syncthreads();
        }
        if (ph + 1 < p0.ph_hi) { if (p0.ph_hi > NPH) grid.sync(); else xcd_barrier(bar); }
    }
}

extern "C" void kernel_launch(void* const* d_in, const int* in_sizes, int n_in, void* d_out, int out_size, void* d_ws, size_t ws_size, hipStream_t stream) {
    static int grid = 0;
    if (grid == 0) {
        if (n_in != 9 || in_sizes[0] != SEQ * DM || out_size != SEQ * DM || ws_size < WS_END) {
            fprintf(stderr, "kernel_launch: unexpected problem: n_in %d in0 %d out %d ws %zu (need %zu)\n", n_in, n_in > 0 ? in_sizes[0] : -1, out_size, ws_size, (size_t)WS_END); grid = -1; return; }
        int dev = 0, cus = 0, per_cu = 0;
        hipGetDevice(&dev);
        hipDeviceGetAttribute(&cus, hipDeviceAttributeMultiprocessorCount, dev);
        if (hipFuncSetAttribute((const void*)hymba_fwd, hipFuncAttributeMaxDynamicSharedMemorySize, LDS_BYTES) != hipSuccess) { fprintf(stderr, "kernel_launch: hipFuncSetAttribute failed\n"); grid = -1; return; }
        if (hipOccupancyMaxActiveBlocksPerMultiprocessor(&per_cu, (const void*)hymba_fwd, NTHR, LDS_BYTES) != hipSuccess || per_cu < 1) { fprintf(stderr, "kernel_launch: occupancy query gave %d\n", per_cu); per_cu = 1; }
        (void)hipGetLastError();
        grid = cus * per_cu;
        fprintf(stderr, "kernel_launch: %d CUs x %d = grid %d\n", cus, per_cu, grid);
    }
    if (grid < 0) return;
    if (hipMemsetAsync((char*)d_ws + WS_CTL, 0, 16384, stream) != hipSuccess) { fprintf(stderr, "kernel_launch: hipMemsetAsync failed\n"); return; }
    Params p{};
    p.x = (const float*)d_in[0]; p.norm_g = (const float*)d_in[1]; p.w_in = (const float*)d_in[2]; p.b_gate = (const float*)d_in[3]; p.conv_w = (const float*)d_in[4];
    p.mnorm_g = (const float*)d_in[5]; p.w_out = (const float*)d_in[6]; p.rel_bias = (const float*)d_in[7]; p.final_g = (const float*)d_in[8];
    p.out = (float*)d_out; p.ws = (unsigned char*)d_ws;
#if MULTI_LAUNCH
    for (int ph = 0; ph < NPH; ++ph) { p.ph_lo = ph; p.ph_hi = ph + 1; hipLaunchKernelGGL(hymba_fwd, dim3(grid), dim3(NTHR), LDS_BYTES, stream, p); }
#else
    p.ph_lo = 0; p.ph_hi = NPH;
    void* args[] = {&p};
    hipError_t e = hipLaunchCooperativeKernel((const void*)hymba_fwd, dim3(grid), dim3(NTHR), args, LDS_BYTES, stream);
    if (e != hipSuccess) fprintf(stderr, "kernel_launch: cooperative launch failed: %s (grid %d)\n", hipGetErrorString(e), grid);
#endif
}
```

```cpp
#include <hip/hip_runtime.h>
#include <hip/hip_cooperative_groups.h>
#include <cstdio>
#include <cstdint>
namespace cg = cooperative_groups;
namespace pg8 {
#define PG8_LAS __attribute__((address_space(3)))
typedef unsigned short bf16_t;
typedef short bf16x8 __attribute__((ext_vector_type(8)));
typedef float f32x4 __attribute__((ext_vector_type(4)));
typedef unsigned u32x4 __attribute__((ext_vector_type(4)));
constexpr int BM = 256, BK = 64, HALF = 128, HTB = HALF * BK * 2  , STAGE_BYTES = 8 * HTB, NXCD = 8, WGM = 8;

__host__ __device__ __forceinline__ int lds_byte(int r, int c) { const int st = (r >> 4) * 2 + (c >> 5), rr = r & 15, cc = c & 31, ob = rr * 64 + cc * 2; return st * 1024 + (ob ^ (((ob >> 9) & 1) << 5)); }
__host__ __device__ __forceinline__ void stage_rc(int b, int& R, int& C) { const int st = b / 1024, sb = b % 1024, swz = sb ^ (((sb >> 9) & 1) << 5); R = (st >> 1) * 16 + swz / 64; C = (st & 1) * 32 + (swz % 64) / 2; }
__host__ __device__ __forceinline__ int perm32(int rho) { const int n = rho >> 4, i = rho & 15; return 8 * (i >> 2) + 4 * n + (i & 3); }

struct Unit { int pm, pn; };
struct Gemm { const bf16_t* A; const bf16_t* Bt; int M, N, K; };

struct StaticOrder {
    int nM, nN, nwg, G, c;
    __host__ __device__ void init(int M, int N, int G_, int c_) { nM = M / BM; nN = N / BM; nwg = nM * nN; G = G_; c = c_; }
    __host__ __device__ bool next(int i, Unit& u) const {
        const long L = (long)i * G + c; if (L >= nwg) return false;
        int wgid = (int)L; { const int q = nwg / NXCD, r = nwg % NXCD, xcd = wgid % NXCD, off = wgid / NXCD; wgid = (xcd < r ? xcd * (q + 1) : r * (q + 1) + (xcd - r) * q) + off; }
        const int nig = WGM * nN, gid = wgid / nig, fm = gid * WGM, gsz = (nM - fm) < WGM ? (nM - fm) : WGM;
        u.pm = fm + ((wgid % nig) % gsz); u.pn = (wgid % nig) / gsz; return true;
    }
    __device__ __forceinline__ void a_ready(const Unit&) const {}
    __device__ __forceinline__ void done(const Unit&) const {}
};

__device__ __forceinline__ unsigned cvt_pk_bf16(float lo, float hi) { unsigned r; asm volatile("v_cvt_pk_bf16_f32 %0, %1, %2" : "=v"(r) : "v"(lo), "v"(hi)); return r; }
struct EpiBf16Plain {
    static constexpr bool PERM = true, AFTER_DRAIN = false;
    bf16_t* O; int ldc;
    __device__ __forceinline__ void operator()(const f32x4 (&acc)[2][2][4][2], const Unit& u, int wr, int wc, int fr, int fq) const {
        const int row0 = u.pm * BM + wr * 64 + fr; const int col0 = u.pn * BM + wc * 32 + 8 * fq;
#pragma unroll
        for (int ai = 0; ai < 2; ++ai)
#pragma unroll
            for (int m = 0; m < 4; ++m) { bf16_t* rowp = O + (size_t)(row0 + ai * HALF + m * 16) * ldc + col0;
#pragma unroll
                for (int bj = 0; bj < 2; ++bj) { const f32x4 v0 = acc[ai][bj][m][0], v1 = acc[ai][bj][m][1];
                    u32x4 w; w.x = cvt_pk_bf16(v0[0], v0[1]); w.y = cvt_pk_bf16(v0[2], v0[3]); w.z = cvt_pk_bf16(v1[0], v1[1]); w.w = cvt_pk_bf16(v1[2], v1[3]);
                    *(u32x4*)(rowp + bj * HALF) = w; } }
    }
};
struct EpiResF32 {
    static constexpr bool PERM = true, AFTER_DRAIN = false;
    const float* base; float* out; int ld;
    __device__ __forceinline__ void operator()(const f32x4 (&acc)[2][2][4][2], const Unit& u, int wr, int wc, int fr, int fq) const {
        const int row0 = u.pm * BM + wr * 64 + fr; const int col0 = u.pn * BM + wc * 32 + 8 * fq;
#pragma unroll
        for (int ai = 0; ai < 2; ++ai)
#pragma unroll
            for (int m = 0; m < 4; ++m) { const size_t ro = (size_t)(row0 + ai * HALF + m * 16) * ld + col0;
#pragma unroll
                for (int bj = 0; bj < 2; ++bj) {
                    const f32x4 b0 = *(const f32x4*)(base + ro + bj * HALF), b1 = *(const f32x4*)(base + ro + bj * HALF + 4);
                    *(f32x4*)(out + ro + bj * HALF) = acc[ai][bj][m][0] + b0;
                    *(f32x4*)(out + ro + bj * HALF + 4) = acc[ai][bj][m][1] + b1; } }
    }
};
template <class Epi, class Sched, bool ALIGN_EPI = false, bool SP2 = false>
__device__ __forceinline__ void gemm_phase(PG8_LAS unsigned char* lds, const Gemm g, const Sched& S, const Epi& E) {
    const int tid = threadIdx.x, wid = __builtin_amdgcn_readfirstlane(tid >> 6), lane = tid & 63, wr = wid >> 2, wc = wid & 3, fr = lane & 15, fq = lane >> 4;
    const int K = g.K, nt = K / BK;
    unsigned voffA[2], voffB[2];
#pragma unroll
    for (int i = 0; i < 2; ++i) { int R, C; stage_rc(tid * 16 + i * 8192, R, C); const int Rb = Epi::PERM ? ((R & ~31) + perm32(R & 31)) : R;
        voffA[i] = (unsigned)(R * K + C) * 2u; voffB[i] = (unsigned)(Rb * K + C) * 2u; }
    const size_t kstep = (size_t)(BK * 2);
    const size_t hstep = (size_t)HALF * K * 2;
    const size_t tstep = 2 * hstep;
    const unsigned ldsw = (unsigned)wid * 1024u;
    const int aoff = lds_byte(wr * 64 + fr, fq * 8), boff = lds_byte(wc * 32 + fr, fq * 8);
#define PG8_SA(b, h) (((b) * 2 + (h)) * HTB)
#define PG8_SB(b, h) ((4 + (b) * 2 + (h)) * HTB)
#define PG8_STAGE(bufoff, gbase, voff) do { _Pragma("unroll") for (int _i = 0; _i < 2; ++_i) \
        __builtin_amdgcn_global_load_lds((const unsigned*)((const char*)(gbase) + (voff)[_i]), (PG8_LAS unsigned*)(lds + (bufoff) + ldsw + _i * 8192), 16, 0, 0); } while (0)
#define PG8_LDA(dst, b, h) do { _Pragma("unroll") for (int m = 0; m < 4; ++m) _Pragma("unroll") for (int k = 0; k < 2; ++k) dst[m][k] = *(const PG8_LAS bf16x8*)(lds + PG8_SA(b, h) + aoff + m * 2048 + k * 1024); } while (0)
#define PG8_LDB(dst, b, h) do { _Pragma("unroll") for (int n = 0; n < 2; ++n) _Pragma("unroll") for (int k = 0; k < 2; ++k) dst[n][k] = *(const PG8_LAS bf16x8*)(lds + PG8_SB(b, h) + boff + n * 2048 + k * 1024); } while (0)
#define PG8_MMA(ai, bj, At, Bt) do { __builtin_amdgcn_s_setprio(1); _Pragma("unroll") for (int m = 0; m < 4; ++m) _Pragma("unroll") for (int n = 0; n < 2; ++n) _Pragma("unroll") for (int k = 0; k < 2; ++k) \
        acc[ai][bj][m][n] = __builtin_amdgcn_mfma_f32_16x16x32_bf16(Bt[n][k], At[m][k], acc[ai][bj][m][n], 0, 0, 0); __builtin_amdgcn_s_setprio(0); } while (0)
#define PG8_WAIT_V(n) asm volatile("s_waitcnt vmcnt(" #n ")" ::: "memory")
#define PG8_WAIT_L(n) asm volatile("s_waitcnt lgkmcnt(" #n ")" ::: "memory")
#define PG8_BAR __builtin_amdgcn_s_barrier()
#define PG8_SCHED __builtin_amdgcn_sched_barrier(0)
    Unit cur, nxt; int ui = 0;
    if (!S.next(0, cur)) return;
    f32x4 acc[2][2][4][2];
#pragma unroll
    for (int a = 0; a < 2; ++a)
#pragma unroll
        for (int b = 0; b < 2; ++b)
#pragma unroll
            for (int m = 0; m < 4; ++m)
#pragma unroll
                for (int n = 0; n < 2; ++n) acc[a][b][m][n] = (f32x4){0.f, 0.f, 0.f, 0.f};
    bf16x8 At[4][2], B0[2][2], B1[2][2];
    const char* cA = (const char*)g.A + (size_t)cur.pm * tstep; const char* cB = (const char*)g.Bt + (size_t)cur.pn * tstep;
    S.a_ready(cur);
    if constexpr (SP2) {
        PG8_STAGE(PG8_SB(0, 0), cB, voffB); PG8_STAGE(PG8_SB(0, 1), cB + hstep, voffB); PG8_STAGE(PG8_SA(0, 0), cA, voffA); PG8_STAGE(PG8_SA(0, 1), cA + hstep, voffA);
        if (wr == 1) PG8_BAR;
        PG8_WAIT_V(2); PG8_BAR;
        PG8_STAGE(PG8_SB(1, 0), cB + kstep, voffB); PG8_STAGE(PG8_SA(1, 0), cA + kstep, voffA); PG8_STAGE(PG8_SB(1, 1), cB + hstep + kstep, voffB);
        PG8_WAIT_V(6); PG8_BAR;
    } else {
        PG8_STAGE(PG8_SB(0, 0), cB, voffB); PG8_STAGE(PG8_SA(0, 0), cA, voffA); PG8_STAGE(PG8_SB(0, 1), cB + hstep, voffB); PG8_STAGE(PG8_SA(0, 1), cA + hstep, voffA);
        if (wr == 1) PG8_BAR;
        PG8_WAIT_V(4); PG8_BAR;
        PG8_STAGE(PG8_SB(1, 0), cB + kstep, voffB); PG8_STAGE(PG8_SA(1, 0), cA + kstep, voffA); PG8_STAGE(PG8_SB(1, 1), cB + hstep + kstep, voffB);
        PG8_WAIT_V(6); PG8_BAR;
    }
    for (;;) {
        const bool has_next = S.next(ui + 1, nxt);
        const char* nA = has_next ? (const char*)g.A + (size_t)nxt.pm * tstep : cA; const char* nB = has_next ? (const char*)g.Bt + (size_t)nxt.pn * tstep : cB;
        for (int t = 0; t < nt; t += 2) {
            const bool last = (t == nt - 2);
            const char* a1 = cA + (size_t)(t + 1) * kstep;
            const char* a2 = last ? nA : cA + (size_t)(t + 2) * kstep; const char* b2 = last ? nB : cB + (size_t)(t + 2) * kstep;
            const char* a3 = a2 + kstep; const char* b3 = b2 + kstep;
            if (last && has_next) S.a_ready(nxt);
            if constexpr (SP2) {
            PG8_LDB(B0, 0, 0); PG8_LDB(B1, 0, 1); PG8_SCHED; PG8_LDA(At, 0, 0); PG8_STAGE(PG8_SA(1, 1), a1 + hstep, voffA);
            PG8_WAIT_V(8); PG8_WAIT_L(0); PG8_BAR; PG8_MMA(0, 0, At, B0); PG8_MMA(0, 1, At, B1); PG8_BAR; PG8_SCHED;
            PG8_LDA(At, 0, 1); PG8_STAGE(PG8_SB(0, 0), b2, voffB); PG8_STAGE(PG8_SB(0, 1), b2 + hstep, voffB); PG8_STAGE(PG8_SA(0, 0), a2, voffA);
            PG8_WAIT_V(8); PG8_WAIT_L(0); PG8_BAR; PG8_MMA(1, 0, At, B0); PG8_MMA(1, 1, At, B1); PG8_BAR; PG8_SCHED;
            PG8_LDB(B0, 1, 0); PG8_LDB(B1, 1, 1); PG8_SCHED; PG8_LDA(At, 1, 0); PG8_STAGE(PG8_SA(0, 1), a2 + hstep, voffA);
            PG8_WAIT_V(8); PG8_WAIT_L(0); PG8_BAR; PG8_MMA(0, 0, At, B0); PG8_MMA(0, 1, At, B1); PG8_BAR; PG8_SCHED;
            PG8_LDA(At, 1, 1); PG8_STAGE(PG8_SB(1, 0), b3, voffB); PG8_STAGE(PG8_SB(1, 1), b3 + hstep, voffB); PG8_STAGE(PG8_SA(1, 0), a3, voffA);
            PG8_WAIT_V(8); PG8_WAIT_L(0); PG8_BAR; PG8_MMA(1, 0, At, B0); PG8_MMA(1, 1, At, B1); PG8_BAR; PG8_SCHED;
            } else {
            PG8_LDB(B0, 0, 0); PG8_SCHED; PG8_LDA(At, 0, 0); PG8_STAGE(PG8_SA(1, 1), a1 + hstep, voffA);
            PG8_WAIT_L(8); PG8_BAR; PG8_WAIT_L(0); PG8_MMA(0, 0, At, B0); PG8_BAR; PG8_SCHED;
            PG8_LDB(B1, 0, 1); PG8_STAGE(PG8_SB(0, 0), b2, voffB);
            PG8_BAR; PG8_WAIT_L(0); PG8_MMA(0, 1, At, B1); PG8_BAR;
            PG8_LDA(At, 0, 1); PG8_STAGE(PG8_SA(0, 0), a2, voffA);
            PG8_BAR; PG8_WAIT_L(0); PG8_MMA(1, 0, At, B0); PG8_BAR; PG8_SCHED;
            PG8_STAGE(PG8_SB(0, 1), b2 + hstep, voffB);
            PG8_WAIT_V(6); PG8_BAR; PG8_MMA(1, 1, At, B1); PG8_BAR;
            PG8_LDB(B0, 1, 0); PG8_SCHED; PG8_LDA(At, 1, 0); PG8_STAGE(PG8_SA(0, 1), a2 + hstep, voffA);
            PG8_WAIT_L(8); PG8_BAR; PG8_WAIT_L(0); PG8_MMA(0, 0, At, B0); PG8_BAR; PG8_SCHED;
            PG8_LDB(B1, 1, 1); PG8_STAGE(PG8_SB(1, 0), b3, voffB);
            PG8_BAR; PG8_WAIT_L(0); PG8_MMA(0, 1, At, B1); PG8_BAR;
            PG8_LDA(At, 1, 1); PG8_STAGE(PG8_SA(1, 0), a3, voffA);
            PG8_BAR; PG8_WAIT_L(0); PG8_MMA(1, 0, At, B0); PG8_BAR; PG8_SCHED;
            PG8_STAGE(PG8_SB(1, 1), b3 + hstep, voffB);
            PG8_WAIT_V(6); PG8_BAR; PG8_MMA(1, 1, At, B1); PG8_BAR;
            }
        }
        if constexpr (ALIGN_EPI) { if (wr == 0) PG8_BAR; }
        if constexpr (!Epi::AFTER_DRAIN) { E(acc, cur, wr, wc, fr, fq); S.done(cur); }
        if (!has_next) break;
#pragma unroll
        for (int a = 0; a < 2; ++a)
#pragma unroll
            for (int b = 0; b < 2; ++b)
#pragma unroll
                for (int m = 0; m < 4; ++m)
#pragma unroll
                    for (int n = 0; n < 2; ++n) acc[a][b][m][n] = (f32x4){0.f, 0.f, 0.f, 0.f};
        cur = nxt; cA = nA; cB = nB; ++ui;
        if constexpr (ALIGN_EPI) { if (wr == 1) PG8_BAR; }
    }
    PG8_WAIT_V(0);
    if constexpr (!ALIGN_EPI) { if (wr == 0) PG8_BAR; }
    PG8_BAR;
    if constexpr (Epi::AFTER_DRAIN) { E.fused(acc, cur, wr, wc, fr, fq, lds, wid, lane); S.done(cur); }
#undef PG8_SA
#undef PG8_SB
#undef PG8_STAGE
#undef PG8_LDA
#undef PG8_LDB
#undef PG8_MMA
#undef PG8_WAIT_V
#undef PG8_WAIT_L
#undef PG8_BAR
#undef PG8_SCHED
}
}

#ifndef MULTI_LAUNCH
#define MULTI_LAUNCH 0
#endif
#ifndef USE_TR
#define USE_TR 1
#endif
#ifndef TSEL
#define TSEL (-1)
#endif
#ifndef REP_ATTN
#define REP_ATTN 0
#endif
#ifndef REP_M1
#define REP_M1 0
#endif
#ifndef REPEAT_MASK
#define REPEAT_MASK 0
#endif
#define LAS __attribute__((address_space(3)))
#define DI __device__ __forceinline__
typedef unsigned short bf16;
typedef short bf16x8 __attribute__((ext_vector_type(8)));
typedef float f32x4 __attribute__((ext_vector_type(4)));
typedef unsigned u32x4 __attribute__((ext_vector_type(4)));
typedef unsigned u32x2 __attribute__((ext_vector_type(2)));

constexpr int SEQ = 8192, DM = 4096, INW = 16392, NU = 16384;
constexpr int C_QA = 0, C_KA = 2048, C_VA = 4096, C_ZA = 6144, C_QM = 8192, C_KM = 9216, C_VM = 10240, C_OM = 12288, C_ZM = 14336;
constexpr float NORM_EPS = 1e-6f;
constexpr int NTHR = 512, NWAVE = 8;
constexpr int LDS_BYTES = 147456;

constexpr size_t MiB = (size_t)1 << 20;
constexpr size_t WS_WIN = 0, WS_WOUT = 256 * MiB, WS_XN = 320 * MiB, WS_U = 384 * MiB, WS_OP = 640 * MiB, WS_Y = 736 * MiB, WS_X1 = 800 * MiB,
                 WS_DC = 928 * MiB, WS_CS = 992 * MiB, WS_LSE = 1024 * MiB, WS_GATES = 1026 * MiB, WS_DN = 1027 * MiB, WS_NS = 1028 * MiB, WS_BL = 1029 * MiB,
                 WS_CTL = 1030 * MiB, WS_END = 1031 * MiB;
constexpr int LDS_BARST = LDS_BYTES - 64;

struct Params { const float *x, *norm_g, *w_in, *b_gate, *conv_w, *mnorm_g, *w_out, *rel_bias, *final_g; float* out; unsigned char* ws; int ph_lo, ph_hi; };

DI float bf_lo(unsigned u) { return __uint_as_float(u << 16); }
DI float bf_hi(unsigned u) { return __uint_as_float(u & 0xffff0000u); }
DI float bf2f(unsigned short u) { return __uint_as_float((unsigned)u << 16); }
DI unsigned pk2(float lo, float hi) { return pg8::cvt_pk_bf16(lo, hi); }
DI float wave_sum(float v) {
#pragma unroll
    for (int o = 1; o < 64; o <<= 1) v += __shfl_xor(v, o);
    return v;
}
DI float quad_sum(float v) { v += __shfl_xor(v, 16); v += __shfl_xor(v, 32); return v; }
DI float quad_max(float v) { v = fmaxf(v, __shfl_xor(v, 16)); v = fmaxf(v, __shfl_xor(v, 32)); return v; }
DI float silu_f(float x) { return x / (1.f + __expf(-x)); }
DI float sigm_f(float x) { return 1.f / (1.f + __expf(-x)); }
DI bf16x8 gatherT(const LAS unsigned short* p, int stride) {
    bf16x8 r;
#pragma unroll
    for (int j = 0; j < 8; ++j) r[j] = (short)p[j * stride];
    return r;
}
typedef short s16x4 __attribute__((ext_vector_type(4)));
DI bf16x8 trfrag(const LAS unsigned short* blk, int stride, int ql) {
#if USE_TR
    const LAS unsigned short* a = blk + (ql >> 2) * stride + 4 * (ql & 3);
    const s16x4 lo = __builtin_amdgcn_ds_read_tr16_b64_v4i16((LAS s16x4*)a);
    const s16x4 hi = __builtin_amdgcn_ds_read_tr16_b64_v4i16((LAS s16x4*)(a + 4 * stride));
    return (bf16x8){lo[0], lo[1], lo[2], lo[3], hi[0], hi[1], hi[2], hi[3]};
#else
    return gatherT(blk + ql, stride);
#endif
}
DI f32x4 mfma16(bf16x8 a, bf16x8 b, f32x4 c) { return __builtin_amdgcn_mfma_f32_16x16x32_bf16(a, b, c, 0, 0, 0); }
#define LDS_WAIT() asm volatile("s_waitcnt lgkmcnt(0)" ::: "memory")

struct TrTile { const float* src; bf16* dst; };
DI TrTile tr_tile_addr(const Params& p, int it, int lane) {
    constexpr int T_IN = 64 * 256, T_OUT = 64 * 64;
    const float* W; bf16* WT; int ldw, nb, kb;
    int r = it;
    if (r < T_IN) { W = p.w_in; WT = (bf16*)(p.ws + WS_WIN); ldw = INW; kb = r >> 8; nb = r & 255; }
    else if ((r -= T_IN) < T_OUT) { W = p.w_out; WT = (bf16*)(p.ws + WS_WOUT); ldw = DM; kb = r >> 6; nb = r & 63; }
    else if ((r -= T_OUT) < T_IN) { W = p.w_in + (size_t)DM * INW; WT = (bf16*)(p.ws + WS_WIN + 128 * MiB); ldw = INW; kb = r >> 8; nb = r & 255; }
    else { r -= T_IN; W = p.w_out + (size_t)DM * DM; WT = (bf16*)(p.ws + WS_WOUT + 32 * MiB); ldw = DM; kb = r >> 6; nb = r & 63; }
    TrTile t;
    t.src = W + (size_t)(kb * 64 + 16 * (lane >> 4)) * ldw + nb * 64 + 4 * (lane & 15);
    t.dst = WT + (size_t)(nb * 64 + (lane >> 3)) * DM + kb * 64 + 8 * (lane & 7);
    return t;
}
DI int tr_ldw(int it) { constexpr int T_IN = 64 * 256, T_OUT = 64 * 64; const int r = it % (T_IN + T_OUT); return r < T_IN ? INW : DM; }
DI void tr_load(const float* src, int ldw, f32x4 (&v)[16]) {
#pragma unroll
    for (int i = 0; i < 16; ++i) v[i] = *(const f32x4*)(src + (size_t)i * ldw);
}
DI void tr_store(const f32x4 (&v)[16], bf16* dst, LAS unsigned short* T, int lane) {
    const int kr = lane >> 4, nc = 4 * (lane & 15);
#pragma unroll
    for (int e = 0; e < 4; ++e)
#pragma unroll
        for (int hf = 0; hf < 2; ++hf) { u32x4 w;
            w.x = pk2(v[8 * hf + 0][e], v[8 * hf + 1][e]); w.y = pk2(v[8 * hf + 2][e], v[8 * hf + 3][e]); w.z = pk2(v[8 * hf + 4][e], v[8 * hf + 5][e]); w.w = pk2(v[8 * hf + 6][e], v[8 * hf + 7][e]);
            *(LAS u32x4*)(T + (nc + e) * 72 + 16 * kr + 8 * hf) = w; }
    LDS_WAIT(); asm volatile("" ::: "memory");
#pragma unroll
    for (int j = 0; j < 8; ++j) { const u32x4 w = *(const LAS u32x4*)(T + ((lane >> 3) + 8 * j) * 72 + 8 * (lane & 7)); *(u32x4*)(dst + (size_t)(8 * j) * DM) = w; }
    LDS_WAIT(); asm volatile("" ::: "memory");
}
DI void prologue_transposes(const Params& p, LAS unsigned char* lds, int wave, int lane) {
    LAS unsigned short* T = (LAS unsigned short*)(lds + wave * 16384);
    const int gw = blockIdx.x * NWAVE + wave, ngw = gridDim.x * NWAVE;
    constexpr int NIT = 2 * (64 * 256 + 64 * 64);
    f32x4 va[16], vb[16];
    int it = gw;
    if (it >= NIT) return;
    TrTile ta = tr_tile_addr(p, it, lane), tb;
    tr_load(ta.src, tr_ldw(it), va);
    for (;;) {
        const int it1 = it + ngw; const bool h1 = it1 < NIT;
        if (h1) { tb = tr_tile_addr(p, it1, lane); tr_load(tb.src, tr_ldw(it1), vb); }
        tr_store(va, ta.dst, T, lane);
        if (!h1) break;
        const int it2 = it1 + ngw; const bool h2 = it2 < NIT;
        if (h2) { ta = tr_tile_addr(p, it2, lane); tr_load(ta.src, tr_ldw(it2), va); }
        tr_store(vb, tb.dst, T, lane);
        if (!h2) break;
        it = it2;
    }
}

DI void norm_gates_phase(const Params& p, LAS unsigned char* lds, const float* X, int l, int tid, int wave, int lane) {
    LAS f32x4* G4 = (LAS f32x4*)lds;
    const float* wg = p.w_in + (size_t)l * DM * INW + NU;
#pragma unroll 4
    for (int i = 0; i < 16; ++i) { const int idx = tid + NTHR * i, k = idx >> 1, half = idx & 1;
        G4[((k & 3) * 2 + half) * 1024 + (k >> 2)] = *(const f32x4*)(wg + (size_t)k * INW + half * 4); }
    __syncthreads();
    const float* g = p.norm_g + l * DM;
    bf16* XN = (bf16*)(p.ws + WS_XN);
    float* gates = (float*)(p.ws + WS_GATES);
    for (int row = blockIdx.x * NWAVE + wave; row < SEQ; row += gridDim.x * NWAVE) {
        const f32x4* xr = (const f32x4*)(X + (size_t)row * DM) + lane;
        f32x4 v[16]; float ss = 0.f;
#pragma unroll
        for (int j = 0; j < 16; ++j) { v[j] = xr[64 * j]; ss += (v[j].x * v[j].x + v[j].y * v[j].y) + (v[j].z * v[j].z + v[j].w * v[j].w); }
        const float rstd = rsqrtf(wave_sum(ss) * (1.f / DM) + NORM_EPS);
        u32x2* o8 = (u32x2*)(XN + (size_t)row * DM) + lane;
        f32x4 a0 = {0.f, 0.f, 0.f, 0.f}, a1 = {0.f, 0.f, 0.f, 0.f};
#pragma unroll
        for (int j = 0; j < 16; ++j) {
            const f32x4 gv = ((const f32x4*)g)[lane + 64 * j];
            const f32x4 h = v[j] * rstd * gv;
            u32x2 w; w.x = pk2(h.x, h.y); w.y = pk2(h.z, h.w); o8[64 * j] = w;
            const int kq = lane + 64 * j;
            a0 += h.x * G4[0 * 1024 + kq]; a1 += h.x * G4[1 * 1024 + kq];
            a0 += h.y * G4[2 * 1024 + kq]; a1 += h.y * G4[3 * 1024 + kq];
            a0 += h.z * G4[4 * 1024 + kq]; a1 += h.z * G4[5 * 1024 + kq];
            a0 += h.w * G4[6 * 1024 + kq]; a1 += h.w * G4[7 * 1024 + kq];
        }
        const float s0 = wave_sum(a0.x), s1 = wave_sum(a0.y), s2 = wave_sum(a0.z), s3 = wave_sum(a0.w);
        const float s4 = wave_sum(a1.x), s5 = wave_sum(a1.y), s6 = wave_sum(a1.z), s7 = wave_sum(a1.w);
        float ov = s0; ov = lane == 1 ? s1 : ov; ov = lane == 2 ? s2 : ov; ov = lane == 3 ? s3 : ov;
        ov = lane == 4 ? s4 : ov; ov = lane == 5 ? s5 : ov; ov = lane == 6 ? s6 : ov; ov = lane == 7 ? s7 : ov;
        if (lane < 8) gates[(size_t)row * 8 + lane] = ov + p.b_gate[l * 8 + lane];
    }
    __syncthreads();
}
DI void final_norm_phase(const Params& p, LAS unsigned char* lds0, int wave, int lane) {
#if TSEL >= 0
    const int n2 = ((volatile LAS int*)(lds0 + LDS_BARST + 16))[8];
#endif
    for (int row = blockIdx.x * NWAVE + wave; row < SEQ; row += gridDim.x * NWAVE) {
        f32x4* xr = (f32x4*)(p.out + (size_t)row * DM) + lane;
        f32x4 v[16]; float ss = 0.f;
#pragma unroll
        for (int j = 0; j < 16; ++j) { v[j] = xr[64 * j]; ss += (v[j].x * v[j].x + v[j].y * v[j].y) + (v[j].z * v[j].z + v[j].w * v[j].w); }
        const float rstd = rsqrtf(wave_sum(ss) * (1.f / DM) + NORM_EPS);
#pragma unroll
        for (int j = 0; j < 16; ++j) { f32x4 o = v[j] * rstd * ((const f32x4*)p.final_g)[lane + 64 * j];
#if TSEL >= 0
            if (blockIdx.x == 0) { const int e0 = ((row >> 11) * 8 + (row & 7)) * 4096 + 4 * (lane + 64 * j);
                o.x += (e0 + 0 < n2) ? 0.02f : 0.f; o.y += (e0 + 1 < n2) ? 0.02f : 0.f; o.z += (e0 + 2 < n2) ? 0.02f : 0.f; o.w += (e0 + 3 < n2) ? 0.02f : 0.f; }
#endif
            xr[64 * j] = o; }
    }
}

constexpr int AT_KS = 136;
DI void attn_item(const Params& p, LAS unsigned char* lds, int item, int tid, int wave, int lane) {
    const bf16* U = (const bf16*)(p.ws + WS_U);
    LAS unsigned short* Ks = (LAS unsigned short*)lds;
    LAS unsigned short* Vs = Ks + 256 * AT_KS;
    LAS float* biasS = (LAS float*)(Vs + 256 * AT_KS);
    const int pat = item >> 10, rem = item & 1023, h = rem >> 6, rb = rem & 63;
    const int dsh = pat * 2;
    const int r = rb >> (6 - dsh), bq = rb & ((64 >> dsh) - 1);
    const int sub0 = 128 * bq - 128;
    const int ql = lane & 15, quad = lane >> 4, q0 = wave * 16;
    u32x4 kv[8], vv[8];
#pragma unroll
    for (int i = 0; i < 8; ++i) { const int c = tid + NTHR * i, row = c >> 4, ch = c & 15; int sub = sub0 + row; sub = sub < 0 ? 0 : sub;
        const bf16* src = U + (size_t)((sub << dsh) + r) * NU + h * 128 + ch * 8;
        kv[i] = *(const u32x4*)(src + C_KA); vv[i] = *(const u32x4*)(src + C_VA); }
    const int tq = ((128 * bq + q0 + ql) << dsh) + r;
    bf16x8 qf[4];
#pragma unroll
    for (int ks = 0; ks < 4; ++ks) qf[ks] = *(const bf16x8*)(U + (size_t)tq * NU + C_QA + h * 128 + ks * 32 + quad * 8);
    if (tid < 129) { const int n = tid << dsh; int b = n;
        if (n >= 16) { b = 16 + (int)floorf(log2f((float)n * 0.0625f) * (16.f / 7.f)); b = b > 31 ? 31 : b; }
        biasS[tid] = p.rel_bias[b * 16 + h]; }
#pragma unroll
    for (int i = 0; i < 8; ++i) { const int c = tid + NTHR * i, row = c >> 4, ch = c & 15;
        *(LAS u32x4*)(Ks + row * AT_KS + ch * 8) = kv[i]; *(LAS u32x4*)(Vs + row * AT_KS + ch * 8) = vv[i]; }
    __syncthreads();
    f32x4 sacc[10];
#pragma unroll
    for (int t = 0; t < 10; ++t) sacc[t] = (f32x4){0.f, 0.f, 0.f, 0.f};
#pragma unroll
    for (int s = 0; s < 5; ++s)
#pragma unroll
        for (int u = 0; u < 2; ++u) { int kk = q0 + 32 * s + (ql >> 2) * 8 + u * 4 + (ql & 3); kk = kk > 255 ? 255 : kk;
            const LAS unsigned short* kp = Ks + kk * AT_KS + quad * 8;
#pragma unroll
            for (int ks = 0; ks < 4; ++ks) sacc[2 * s + u] = mfma16(*(const LAS bf16x8*)(kp + ks * 32), qf[ks], sacc[2 * s + u]); }
    const float scale = 0.08838834764831845f;
    float mx = -1e30f;
    int ql2 = ql, quad2 = quad; asm volatile("" : "+v"(ql2), "+v"(quad2));
#pragma unroll
    for (int s = 0; s < 5; ++s)
#pragma unroll
        for (int u = 0; u < 2; ++u)
#pragma unroll
            for (int j = 0; j < 4; ++j) { const int koff = 32 * s + quad2 * 8 + u * 4 + j, rel = koff - ql2;
                const bool valid = (rel >= 0) && (rel <= 128) && (sub0 + q0 + koff >= 0);
                int jo = 128 - rel; jo = jo < 0 ? 0 : (jo > 128 ? 128 : jo);
                const float v = valid ? sacc[2 * s + u][j] * scale + biasS[jo] : -1e30f;
                sacc[2 * s + u][j] = v; mx = fmaxf(mx, v); }
    mx = quad_max(mx);
    float l = 0.f;
#pragma unroll
    for (int t = 0; t < 10; ++t)
#pragma unroll
        for (int j = 0; j < 4; ++j) { const float e = __expf(sacc[t][j] - mx); sacc[t][j] = e; l += e; }
    l = quad_sum(l);
    f32x4 oacc[8];
#pragma unroll
    for (int nt = 0; nt < 8; ++nt) oacc[nt] = (f32x4){0.f, 0.f, 0.f, 0.f};
#pragma unroll
    for (int s = 0; s < 5; ++s) {
        u32x4 pw; pw.x = pk2(sacc[2 * s][0], sacc[2 * s][1]); pw.y = pk2(sacc[2 * s][2], sacc[2 * s][3]); pw.z = pk2(sacc[2 * s + 1][0], sacc[2 * s + 1][1]); pw.w = pk2(sacc[2 * s + 1][2], sacc[2 * s + 1][3]);
        const bf16x8 pf = __builtin_bit_cast(bf16x8, pw);
        int key0 = q0 + 32 * s + quad * 8; key0 = key0 > 248 ? 248 : key0;
        const LAS unsigned short* vp = Vs + key0 * AT_KS;
#pragma unroll
        for (int nt = 0; nt < 8; ++nt) oacc[nt] = mfma16(trfrag(vp + nt * 16, AT_KS, ql), pf, oacc[nt]);
    }
    const float inv = 1.f / l;
    bf16* OP = (bf16*)(p.ws + WS_OP) + (size_t)pat * SEQ * 2048 + (size_t)tq * 2048 + h * 128 + quad * 4;
#pragma unroll
    for (int nt = 0; nt < 8; ++nt) { u32x2 w; w.x = pk2(oacc[nt][0] * inv, oacc[nt][1] * inv); w.y = pk2(oacc[nt][2] * inv, oacc[nt][3] * inv); *(u32x2*)(OP + nt * 16) = w; }
    if (quad == 0) ((float*)(p.ws + WS_LSE))[((size_t)pat * SEQ + tq) * 16 + h] = mx + __logf(l);
    __syncthreads();
}
DI void merge_phase(const Params& p, int tid) {
    const bf16* U = (const bf16*)(p.ws + WS_U);
    const bf16* OP = (const bf16*)(p.ws + WS_OP);
    const float* LSE = (const float*)(p.ws + WS_LSE);
    bf16* Y = (bf16*)(p.ws + WS_Y);
    const int gthreads = gridDim.x * NTHR;
    for (int idx = blockIdx.x * NTHR + tid; idx < SEQ * 256; idx += gthreads) {
        const int t = idx >> 8, c8 = idx & 255, h = c8 >> 4;
        const float l0 = LSE[(size_t)t * 16 + h], l1 = LSE[((size_t)SEQ + t) * 16 + h], l2 = LSE[((size_t)2 * SEQ + t) * 16 + h];
        const float M = fmaxf(l0, fmaxf(l1, l2));
        float w0 = __expf(l0 - M), w1 = __expf(l1 - M), w2 = __expf(l2 - M);
        const float inv = 1.f / (w0 + w1 + w2); w0 *= inv; w1 *= inv; w2 *= inv;
        const size_t o = (size_t)t * 2048 + c8 * 8;
        const u32x4 o0 = *(const u32x4*)(OP + o), o1 = *(const u32x4*)(OP + (size_t)SEQ * 2048 + o), o2 = *(const u32x4*)(OP + (size_t)2 * SEQ * 2048 + o);
        const u32x4 z = *(const u32x4*)(U + (size_t)t * NU + C_ZA + c8 * 8);
        u32x4 y;
#pragma unroll
        for (int e = 0; e < 4; ++e) {
            const float lo = (w0 * bf_lo(o0[e]) + w1 * bf_lo(o1[e]) + w2 * bf_lo(o2[e])) * silu_f(bf_lo(z[e]));
            const float hi = (w0 * bf_hi(o0[e]) + w1 * bf_hi(o1[e]) + w2 * bf_hi(o2[e])) * silu_f(bf_hi(z[e]));
            y[e] = pk2(lo, hi);
        }
        *(u32x4*)(Y + (size_t)t * DM + c8 * 8) = y;
    }
}

constexpr int M_KS = 264, M_VS3 = 520;
DI void conv8(const bf16* U, const float* cw, int t, int rawcol, int cch, float (&f)[8]) {
#pragma unroll
    for (int e = 0; e < 8; ++e) f[e] = 0.f;
#pragma unroll
    for (int j = 0; j < 4; ++j) { const int tt = t - 3 + j;
        if (tt >= 0) { const u32x4 raw = *(const u32x4*)(U + (size_t)tt * NU + rawcol);
            const f32x4 w0 = *(const f32x4*)(cw + j * 2048 + cch), w1 = *(const f32x4*)(cw + j * 2048 + cch + 4);
            f[0] += w0[0] * bf_lo(raw.x); f[1] += w0[1] * bf_hi(raw.x); f[2] += w0[2] * bf_lo(raw.y); f[3] += w0[3] * bf_hi(raw.y);
            f[4] += w1[0] * bf_lo(raw.z); f[5] += w1[1] * bf_hi(raw.z); f[6] += w1[2] * bf_lo(raw.w); f[7] += w1[3] * bf_hi(raw.w); } }
#pragma unroll
    for (int e = 0; e < 8; ++e) f[e] = silu_f(f[e]);
}
template <int NI, int MODE, int NB>
DI void conv_tile(const bf16* U, const float* cw, int t0, int rawcol0, int cch0, float sc, LAS unsigned short* dst, int tid, float bL, const LAS float* bS, const LAS float* liS, int roff) {
    const int ch = tid & 31, r0 = tid >> 5;
    f32x4 w[4][2];
#pragma unroll
    for (int j = 0; j < 4; ++j) { w[j][0] = *(const f32x4*)(cw + j * 2048 + cch0 + ch * 8); w[j][1] = *(const f32x4*)(cw + j * 2048 + cch0 + ch * 8 + 4); }
    const bf16* src = U + rawcol0 + ch * 8;
#pragma unroll
    for (int ib = 0; ib < NI; ib += NB) {
        u32x4 raw[NB][4];
#pragma unroll
        for (int i = 0; i < NB; ++i)
#pragma unroll
            for (int j = 0; j < 4; ++j) { const int tt = t0 + r0 + 16 * (ib + i) - 3 + j; const int tc = tt < 0 ? 0 : tt;
                raw[i][j] = *(const u32x4*)(src + (size_t)tc * NU); if (tt < 0) raw[i][j] = (u32x4){0u, 0u, 0u, 0u}; }
#pragma unroll
        for (int i = 0; i < NB; ++i) { const int row = r0 + 16 * (ib + i);
            float f[8];
#pragma unroll
            for (int e = 0; e < 8; ++e) f[e] = 0.f;
#pragma unroll
            for (int j = 0; j < 4; ++j) { const u32x4 rw = raw[i][j];
                f[0] += w[j][0][0] * bf_lo(rw.x); f[1] += w[j][0][1] * bf_hi(rw.x); f[2] += w[j][0][2] * bf_lo(rw.y); f[3] += w[j][0][3] * bf_hi(rw.y);
                f[4] += w[j][1][0] * bf_lo(rw.z); f[5] += w[j][1][1] * bf_hi(rw.z); f[6] += w[j][1][2] * bf_lo(rw.w); f[7] += w[j][1][3] * bf_hi(rw.w); }
            float m = sc;
            if (MODE == 1) m *= __expf(bL - bS[roff + row] + liS[roff + row]);
#pragma unroll
            for (int e = 0; e < 8; ++e) f[e] = silu_f(f[e]) * m;
            u32x4 o; o.x = pk2(f[0], f[1]); o.y = pk2(f[2], f[3]); o.z = pk2(f[4], f[5]); o.w = pk2(f[6], f[7]);
            *(LAS u32x4*)(dst + row * M_KS + ch * 8) = o; }
        __builtin_amdgcn_sched_barrier(0);
    }
}
DI void chunk_gates(const float* gates, int c, int hh, LAS float* bS, LAS float* liS, LAS float* wtot, int tid, int wave, int lane) {
    float v = 0.f;
    if (tid < 256) { const float* gp = gates + (size_t)(c * 256 + tid) * 8; const float fgv = gp[4 + hh]; liS[tid] = gp[hh];
        v = fminf(fgv, 0.f) - log1pf(__expf(-fabsf(fgv)));
#pragma unroll
        for (int o = 1; o < 64; o <<= 1) { const float t = __shfl_up(v, o); if (lane >= o) v += t; }
        if (lane == 63) wtot[wave] = v; }
    __syncthreads();
    if (tid < 256) { float pre = 0.f; for (int w = 0; w < wave; ++w) pre += wtot[w]; bS[tid] = v + pre; }
    __syncthreads();
}
DI void m1_item(const Params& p, LAS unsigned char* lds, int l, int item, int tid, int wave, int lane) {
    const bf16* U = (const bf16*)(p.ws + WS_U);
    const float* cw = p.conv_w + (size_t)l * 4 * 2048;
    LAS unsigned short* Kp = (LAS unsigned short*)lds;
    LAS unsigned short* Vs = Kp + 128 * M_KS;
    LAS float* bS = (LAS float*)(Vs + 128 * AT_KS); LAS float* liS = bS + 256; LAS float* wtot = liS + 256;
    const int hh = item >> 7, c = (item >> 2) & 31, sl = item & 3;
    const int ql = lane & 15, quad = lane >> 4;
    chunk_gates((const float*)(p.ws + WS_GATES), c, hh, bS, liS, wtot, tid, wave, lane);
    const float bL = bS[255];
    f32x4 acc[4][4];
#pragma unroll
    for (int a = 0; a < 4; ++a)
#pragma unroll
        for (int b = 0; b < 4; ++b) acc[a][b] = (f32x4){0.f, 0.f, 0.f, 0.f};
    float nsum = 0.f;
    const int dvt0 = (wave & 1) * 4, dkt0 = (wave >> 1) * 4;
    for (int half = 0; half < 2; ++half) {
        conv_tile<8, 1, 4>(U, cw, c * 256 + half * 128, C_KM + hh * 256, 1024 + hh * 256, 0.0625f, Kp, tid, bL, bS, liS, half * 128);
#pragma unroll
        for (int i = 0; i < 4; ++i) { const int cc = tid + NTHR * i, row = cc >> 4, ch = cc & 15;
            *(LAS u32x4*)(Vs + row * AT_KS + ch * 8) = *(const u32x4*)(U + (size_t)(c * 256 + half * 128 + row) * NU + C_VM + hh * 512 + sl * 128 + ch * 8); }
        __syncthreads();
#pragma unroll 1
        for (int ks = 0; ks < 4; ++ks) {
            bf16x8 af[4], bfr[4];
#pragma unroll
            for (int a = 0; a < 4; ++a) af[a] = trfrag(Vs + (ks * 32 + quad * 8) * AT_KS + (dvt0 + a) * 16, AT_KS, ql);
#pragma unroll
            for (int b = 0; b < 4; ++b) bfr[b] = trfrag(Kp + (ks * 32 + quad * 8) * M_KS + (dkt0 + b) * 16, M_KS, ql);
#pragma unroll
            for (int a = 0; a < 4; ++a)
#pragma unroll
                for (int b = 0; b < 4; ++b) acc[a][b] = mfma16(af[a], bfr[b], acc[a][b]);
        }
        if (sl == 0 && tid < 256) { for (int row = 0; row < 128; ++row) nsum += bf2f(Kp[row * M_KS + tid]); }
        __syncthreads();
    }
    float* DC = (float*)(p.ws + WS_DC) + ((size_t)(hh * 32 + c) * 512 + sl * 128) * 256;
#pragma unroll
    for (int a = 0; a < 4; ++a)
#pragma unroll
        for (int b = 0; b < 4; ++b)
#pragma unroll
            for (int j = 0; j < 4; ++j) DC[(size_t)((dvt0 + a) * 16 + quad * 4 + j) * 256 + (dkt0 + b) * 16 + ql] = acc[a][b][j];
    if (sl == 0 && tid < 256) ((float*)(p.ws + WS_DN))[(hh * 32 + c) * 256 + tid] = nsum;
    if (sl == 0 && tid == 0) ((float*)(p.ws + WS_BL))[hh * 32 + c] = bL;
}
DI void m2_phase(const Params& p, int tid) {
    const float* DC = (const float*)(p.ws + WS_DC); const float* BL = (const float*)(p.ws + WS_BL);
    bf16* CS = (bf16*)(p.ws + WS_CS);
    const int gthreads = gridDim.x * NTHR, gid = blockIdx.x * NTHR + tid;
    for (int e4 = gid; e4 < 4 * 32768; e4 += gthreads) {
        const int hh = e4 >> 15, e = e4 & 32767;
        f32x4 st = {0.f, 0.f, 0.f, 0.f};
#pragma unroll 8
        for (int c = 0; c < 32; ++c) {
            const size_t o = ((size_t)(hh * 32 + c) * 32768 + e) * 4;
            u32x2 w; w.x = pk2(st.x, st.y); w.y = pk2(st.z, st.w); *(u32x2*)(CS + o) = w;
            const f32x4 d = *(const f32x4*)(DC + o);
            st = st * __expf(BL[hh * 32 + c]) + d;
        }
    }
    if (gid < 1024) { const int hh = gid >> 8, dk = gid & 255; const float* DN = (const float*)(p.ws + WS_DN); float* NS = (float*)(p.ws + WS_NS);
        float st = 0.f;
        for (int c = 0; c < 32; ++c) { NS[(hh * 32 + c) * 256 + dk] = st; st = st * __expf(BL[hh * 32 + c]) + DN[(hh * 32 + c) * 256 + dk]; } }
}
DI void m3_item(const Params& p, LAS unsigned char* lds, int l, int hh, int qb, int tid, int wave, int lane) {
    const bf16* U = (const bf16*)(p.ws + WS_U);
    const float* cw = p.conv_w + (size_t)l * 4 * 2048;
    LAS unsigned short* Qs = (LAS unsigned short*)lds;
    LAS unsigned short* Ks = Qs + 64 * M_KS;
    LAS unsigned short* Vs = Ks + 64 * M_KS;
    LAS float* bS = (LAS float*)(Vs + 64 * M_VS3); LAS float* liS = bS + 256; LAS float* nS = liS + 256; LAS float* wtot = nS + 256; LAS float* ssS = wtot + 8;
    const int c = qb >> 2, jq = qb & 3;
    const int ql = lane & 15, quad = lane >> 4;
    if (tid < 256) nS[tid] = ((const float*)(p.ws + WS_NS))[(hh * 32 + c) * 256 + tid];
    chunk_gates((const float*)(p.ws + WS_GATES), c, hh, bS, liS, wtot, tid, wave, lane);
    conv_tile<4, 0, 2>(U, cw, qb * 64, C_QM + hh * 256, hh * 256, 1.f, Qs, tid, 0.f, bS, liS, 0);
    __syncthreads();
    const int qg = wave & 3, dvh = wave >> 2, q = qg * 16 + ql, iq = jq * 64 + q;
    bf16x8 qf[8];
#pragma unroll
    for (int ks = 0; ks < 8; ++ks) qf[ks] = *(const LAS bf16x8*)(Qs + q * M_KS + ks * 32 + quad * 8);
    const float b_q = bS[iq], eb = __expf(b_q);
    f32x4 acc[16];
#pragma unroll
    for (int nt = 0; nt < 16; ++nt) acc[nt] = (f32x4){0.f, 0.f, 0.f, 0.f};
    { const bf16* CT = (const bf16*)(p.ws + WS_CS) + (size_t)(hh * 32 + c) * 512 * 256;
      LAS unsigned short* Cs = Ks;
#pragma unroll 1
      for (int pc = 0; pc < 4; ++pc) {
          __syncthreads();
          u32x4 cv[8];
#pragma unroll
          for (int i = 0; i < 8; ++i) { const int cc = tid + NTHR * i, row = cc >> 5, ch = cc & 31;
              cv[i] = *(const u32x4*)(CT + (size_t)((row >> 6) * 256 + pc * 64 + (row & 63)) * 256 + ch * 8); }
#pragma unroll
          for (int i = 0; i < 8; ++i) { const int cc = tid + NTHR * i, row = cc >> 5, ch = cc & 31; *(LAS u32x4*)(Cs + row * M_KS + ch * 8) = cv[i]; }
          __syncthreads();
#pragma unroll
          for (int n4 = 0; n4 < 4; ++n4) { const LAS unsigned short* cp = Cs + (dvh * 64 + n4 * 16 + ql) * M_KS + quad * 8;
#pragma unroll
              for (int ks = 0; ks < 8; ++ks) acc[n4] = mfma16(*(const LAS bf16x8*)(cp + ks * 32), qf[ks], acc[n4]); }
          { const f32x4 t0 = acc[0], t1 = acc[1], t2 = acc[2], t3 = acc[3];
#pragma unroll
            for (int i = 0; i < 12; ++i) acc[i] = acc[i + 4];
            acc[12] = t0; acc[13] = t1; acc[14] = t2; acc[15] = t3; }
      }
    }
#pragma unroll
    for (int nt = 0; nt < 16; ++nt) acc[nt] = acc[nt] * eb;
    float nqp = 0.f;
#pragma unroll
    for (int ks = 0; ks < 8; ++ks)
#pragma unroll
        for (int j = 0; j < 8; ++j) nqp += bf2f((unsigned short)qf[ks][j]) * nS[ks * 32 + quad * 8 + j];
    float nq = quad_sum(nqp) * eb;
    float nqi = 0.f;
    for (int kt = 0; kt <= jq; ++kt) {
        __syncthreads();
        int tid2 = tid; asm volatile("" : "+v"(tid2));
#pragma unroll
        for (int ib = 0; ib < 8; ib += 4) { u32x4 vv[4];
#pragma unroll
            for (int i = 0; i < 4; ++i) { const int cc = tid2 + NTHR * (ib + i), row = cc >> 6, ch = cc & 63; vv[i] = *(const u32x4*)(U + (size_t)(c * 256 + kt * 64 + row) * NU + C_VM + hh * 512 + ch * 8); }
#pragma unroll
            for (int i = 0; i < 4; ++i) { const int cc = tid2 + NTHR * (ib + i), row = cc >> 6, ch = cc & 63; *(LAS u32x4*)(Vs + row * M_VS3 + ch * 8) = vv[i]; }
            __builtin_amdgcn_sched_barrier(0); }
        conv_tile<4, 0, 2>(U, cw, c * 256 + kt * 64, C_KM + hh * 256, 1024 + hh * 256, 0.0625f, Ks, tid2, 0.f, bS, liS, 0);
        __syncthreads();
        f32x4 sacc[4];
#pragma unroll
        for (int t = 0; t < 4; ++t) sacc[t] = (f32x4){0.f, 0.f, 0.f, 0.f};
#pragma unroll
        for (int s = 0; s < 2; ++s)
#pragma unroll
            for (int u = 0; u < 2; ++u) { const int krow = 32 * s + (ql >> 2) * 8 + u * 4 + (ql & 3);
                const LAS unsigned short* kp = Ks + krow * M_KS + quad * 8;
#pragma unroll
                for (int ks = 0; ks < 8; ++ks) sacc[2 * s + u] = mfma16(*(const LAS bf16x8*)(kp + ks * 32), qf[ks], sacc[2 * s + u]); }
#pragma unroll
        for (int s = 0; s < 2; ++s)
#pragma unroll
            for (int u = 0; u < 2; ++u)
#pragma unroll
                for (int j = 0; j < 4; ++j) { const int sk = kt * 64 + 32 * s + quad * 8 + u * 4 + j;
                    const float w = (sk <= iq) ? __expf(b_q - bS[sk] + liS[sk]) : 0.f;
                    const float pv = sacc[2 * s + u][j] * w; sacc[2 * s + u][j] = pv; nqi += pv; }
#pragma unroll
        for (int s = 0; s < 2; ++s) {
            u32x4 pw; pw.x = pk2(sacc[2 * s][0], sacc[2 * s][1]); pw.y = pk2(sacc[2 * s][2], sacc[2 * s][3]); pw.z = pk2(sacc[2 * s + 1][0], sacc[2 * s + 1][1]); pw.w = pk2(sacc[2 * s + 1][2], sacc[2 * s + 1][3]);
            const bf16x8 pf = __builtin_bit_cast(bf16x8, pw);
            const LAS unsigned short* vp = Vs + (32 * s + quad * 8) * M_VS3 + dvh * 256;
#pragma unroll
            for (int nt = 0; nt < 16; ++nt) acc[nt] = mfma16(trfrag(vp + nt * 16, M_VS3, ql), pf, acc[nt]);
        }
    }
    nq += quad_sum(nqi);
    const float inv = 1.f / fmaxf(fabsf(nq), 1.f);
    float ss = 0.f;
#pragma unroll
    for (int nt = 0; nt < 16; ++nt) { acc[nt] = acc[nt] * inv; ss += (acc[nt][0] * acc[nt][0] + acc[nt][1] * acc[nt][1]) + (acc[nt][2] * acc[nt][2] + acc[nt][3] * acc[nt][3]); }
    ss = quad_sum(ss);
    if (quad == 0) ssS[dvh * 64 + q] = ss;
    __syncthreads();
    const float rstd = rsqrtf((ssS[q] + ssS[64 + q]) * (1.f / 512.f) + NORM_EPS);
    const int t = qb * 64 + q;
    const float* ng = p.mnorm_g + l * 2048;
    bf16* Y = (bf16*)(p.ws + WS_Y);
#pragma unroll
    for (int nt = 0; nt < 16; ++nt) { const int col = hh * 512 + dvh * 256 + nt * 16 + quad * 4;
        const f32x4 g4 = *(const f32x4*)(ng + col);
        const u32x2 om = *(const u32x2*)(U + (size_t)t * NU + C_OM + col), zm = *(const u32x2*)(U + (size_t)t * NU + C_ZM + col);
        const float y0 = acc[nt][0] * rstd * g4[0] * sigm_f(bf_lo(om.x)) * silu_f(bf_lo(zm.x));
        const float y1 = acc[nt][1] * rstd * g4[1] * sigm_f(bf_hi(om.x)) * silu_f(bf_hi(zm.x));
        const float y2 = acc[nt][2] * rstd * g4[2] * sigm_f(bf_lo(om.y)) * silu_f(bf_lo(zm.y));
        const float y3 = acc[nt][3] * rstd * g4[3] * sigm_f(bf_hi(om.y)) * silu_f(bf_hi(zm.y));
        u32x2 w; w.x = pk2(y0, y1); w.y = pk2(y2, y3);
        *(u32x2*)(Y + (size_t)t * DM + 2048 + col) = w;
        if ((nt & 3) == 3) __builtin_amdgcn_sched_barrier(0); }
    __syncthreads();
}

#define RLX_AGENT __ATOMIC_RELAXED, __HIP_MEMORY_SCOPE_AGENT
#define XB_TMO      128
#define XB_XCNT(j)  (256  + 64 * (j))
#define XB_XSUB(j)  (1280 + 64 * (j))
#define XB_XGEN(j)  (2304 + 64 * (j))
#define XB_TOP      3328
#define XB_TOPGEN   3392
#define XCD_BAR_WORDS 3456
#define XB_SPIN_CAP (1u << 18)

__device__ __forceinline__ unsigned xb_ld(unsigned* p)              { return __hip_atomic_load(p, __ATOMIC_RELAXED, __HIP_MEMORY_SCOPE_AGENT); }
__device__ __forceinline__ unsigned xb_add(unsigned* p, unsigned v) { return __hip_atomic_fetch_add(p, v, __ATOMIC_RELAXED, __HIP_MEMORY_SCOPE_AGENT); }
__device__ __forceinline__ unsigned xb_xcc_id() { return (unsigned)__builtin_amdgcn_s_getreg((3 << 11) | 20) & 0xFu; }
#define XB_SPIN(cond, bar) do { unsigned _sp = 0; while (cond) { __builtin_amdgcn_s_sleep(1); \
    if ((++_sp & 255u) == 0u) { if (xb_ld(&(bar)[XB_TMO])) break; if (_sp > XB_SPIN_CAP) { atomicAdd(&(bar)[XB_TMO], 1u); break; } } } } while (0)

struct XcdBarrier {
    unsigned* bar; unsigned x;
    volatile LAS unsigned* st;
};

__device__ __forceinline__ XcdBarrier xcd_barrier_post(unsigned* bar, volatile LAS unsigned* st) {
    XcdBarrier b; b.bar = bar; b.x = xb_xcc_id(); b.st = st;
    if (threadIdx.x == 0) (void)xb_add(&bar[XB_XCNT(b.x)], 1u);
    return b;
}
__device__ __forceinline__ void xcd_barrier_complete(unsigned* bar, unsigned x, unsigned& nloc, unsigned& nx) {
    const unsigned G = gridDim.x * gridDim.y * gridDim.z;
    unsigned sum, cnt, mine, sp = 0u;
    for (;;) {
        sum = 0u; cnt = 0u; mine = 0u;
#pragma unroll
        for (unsigned j = 0; j < 16; ++j) { const unsigned c = xb_ld(&bar[XB_XCNT(j)]); sum += c; cnt += (c > 0u) ? 1u : 0u; mine = (j == x) ? c : mine; }
        if (sum == G) break;
        __builtin_amdgcn_s_sleep(1);
        if ((++sp & 255u) == 0u) { if (xb_ld(&bar[XB_TMO])) break; if (sp > XB_SPIN_CAP) { atomicAdd(&bar[XB_TMO], 1u); break; } }
    }
    nloc = mine > 0u ? mine : 1u; nx = cnt > 0u ? cnt : 1u;
}

__device__ __forceinline__ void xcd_barrier(const XcdBarrier& b) {
    asm volatile("s_waitcnt vmcnt(0)" ::: "memory");
    __syncthreads();
    if (threadIdx.x == 0) {
        unsigned* bar = b.bar;
        __builtin_amdgcn_s_waitcnt(0);
        unsigned nloc = b.st[0], nx = b.st[1];
        if (nloc == 0u) { xcd_barrier_complete(bar, b.x, nloc, nx); b.st[0] = nloc; b.st[1] = nx; }
        const unsigned old = xb_add(&bar[XB_XSUB(b.x)], 1u);
        const unsigned gen = old / nloc;
        if (old + 1u == (gen + 1u) * nloc) {
            __builtin_amdgcn_fence(__ATOMIC_RELEASE, "agent");
            asm volatile("s_waitcnt vmcnt(0)" ::: "memory");
            const unsigned og = xb_add(&bar[XB_TOP], 1u);
            const unsigned tg = og / nx;
            if (og + 1u == (tg + 1u) * nx) xb_add(&bar[XB_TOPGEN], 1u);
            else XB_SPIN(xb_ld(&bar[XB_TOPGEN]) == tg, bar);
            __builtin_amdgcn_fence(__ATOMIC_ACQUIRE, "agent");
            xb_add(&bar[XB_XGEN(b.x)], 1u);
            asm volatile("s_waitcnt vmcnt(0)" ::: "memory");
        } else {
            XB_SPIN(xb_ld(&bar[XB_XGEN(b.x)]) == gen, bar);
            __builtin_amdgcn_fence(__ATOMIC_ACQUIRE, "agent");
            asm volatile("s_waitcnt vmcnt(0)" ::: "memory");
        }
    }
    __syncthreads();
}

constexpr int NPH = 13;
__global__ void __launch_bounds__(NTHR, 2) hymba_fwd(Params p0) {
    extern __shared__ __attribute__((aligned(16))) unsigned char lds_raw[];
    cg::grid_group grid = cg::this_grid();
    const int G = gridDim.x;
    if (threadIdx.x < 16) ((LAS unsigned*)((LAS unsigned char*)lds_raw + LDS_BARST))[threadIdx.x] = 0u;
    __syncthreads();
    XcdBarrier bar = xcd_barrier_post((unsigned*)(p0.ws + WS_CTL), (volatile LAS unsigned*)((LAS unsigned char*)lds_raw + LDS_BARST));
#if TSEL >= 0
    volatile LAS unsigned long long* TW = (volatile LAS unsigned long long*)((LAS unsigned char*)lds_raw + LDS_BARST + 16);
    if (threadIdx.x == 0) { const unsigned long long t = __builtin_amdgcn_s_memrealtime(); TW[0] = t; TW[1] = t; TW[2] = 0; }
#endif
    for (int ph = p0.ph_lo; ph < p0.ph_hi; ++ph) {
        const int ptype = ph == 0 ? 0 : 1 + (ph - 1) % 6;
        const int nrep = (REPEAT_MASK) == 0 ? 1 : ((((REPEAT_MASK) >> ptype) & 1) ? 2 : 1);
        for (int rep = 0; rep < nrep; ++rep) {
        int tid = threadIdx.x; asm volatile("" : "+v"(tid));
        const int lane = tid & 63, wave = __builtin_amdgcn_readfirstlane(tid >> 6);
        LAS unsigned char* lds = (LAS unsigned char*)lds_raw; asm volatile("" : "+s"(lds));
        Params p = p0;
        asm volatile("" : "+s"(p.ws)); asm volatile("" : "+s"(p.x)); asm volatile("" : "+s"(p.out)); asm volatile("" : "+s"(p.w_in)); asm volatile("" : "+s"(p.w_out));
        asm volatile("" : "+s"(p.conv_w)); asm volatile("" : "+s"(p.norm_g)); asm volatile("" : "+s"(p.mnorm_g)); asm volatile("" : "+s"(p.b_gate)); asm volatile("" : "+s"(p.rel_bias)); asm volatile("" : "+s"(p.final_g));
        if (ph == 0) {
            prologue_transposes(p, lds, wave, lane);
            __syncthreads();
            norm_gates_phase(p, lds, p.x, 0, tid, wave, lane);
        } else {
            const int l = (ph - 1) / 6, k = (ph - 1) % 6;
            if (k == 0) {
                pg8::Gemm g{(const pg8::bf16_t*)(p.ws + WS_XN), (const pg8::bf16_t*)(p.ws + WS_WIN + (size_t)l * 128 * MiB), SEQ, NU, DM};
                pg8::StaticOrder S; S.init(SEQ, NU, G, (int)blockIdx.x);
                pg8::EpiBf16Plain E{(pg8::bf16_t*)(p.ws + WS_U), NU};
                pg8::gemm_phase<pg8::EpiBf16Plain, pg8::StaticOrder, true, true>(lds, g, S, E);
            } else if (k == 1) {
                const bool xmap = (G == 256); const int xcd = blockIdx.x & 7, xi = blockIdx.x >> 3;
                for (int rr = 0; rr < 1 + (REP_ATTN); ++rr)
                for (int it = blockIdx.x, rnd = 0; it < 3072; it += G, ++rnd) {
                    int item = it;
                    if (xmap) { const int h = 2 * xcd + rnd / 6, j = (rnd % 6) * 32 + xi; item = (j >> 6) * 1024 + h * 64 + (j & 63); }
                    attn_item(p, lds, item, tid, wave, lane); }
                int tid3 = tid; asm volatile("" : "+v"(tid3));
                for (int rr = 0; rr < 1 + (REP_M1); ++rr)
                for (int it = blockIdx.x, rnd = 0; it < 512; it += G, ++rnd) {
                    int item = it;
                    if (xmap) item = (xcd * 16 + rnd * 8 + (xi >> 2)) * 4 + (xi & 3);
                    m1_item(p, lds, l, item, tid3, __builtin_amdgcn_readfirstlane(tid3 >> 6), tid3 & 63); __syncthreads(); }
            } else if (k == 2) {
                m2_phase(p, tid);
                merge_phase(p, tid);
            } else if (k == 3) {
                const bool xmap = (G == 256); const int xcd = blockIdx.x & 7, xi = blockIdx.x >> 3;
                for (int it = blockIdx.x, rnd = 0; it < 512; it += G, ++rnd) {
                    int hh = it >> 7, qb = it & 127; if ((it >> 8) & 1) qb ^= 3;
                    if (xmap) { const int pair = xcd * 16 + rnd * 8 + (xi >> 2); hh = pair >> 5; qb = (pair & 31) * 4 + (rnd ? 3 - (xi & 3) : (xi & 3)); }
                    m3_item(p, lds, l, hh, qb, tid, wave, lane); }
            } else if (k == 4) {
                pg8::Gemm g{(const pg8::bf16_t*)(p.ws + WS_Y), (const pg8::bf16_t*)(p.ws + WS_WOUT + (size_t)l * 32 * MiB), SEQ, DM, DM};
                pg8::StaticOrder S; S.init(SEQ, DM, G, (int)blockIdx.x);
                pg8::EpiResF32 E{l == 0 ? p.x : (const float*)(p.ws + WS_X1), l == 0 ? (float*)(p.ws + WS_X1) : p.out, DM};
                pg8::gemm_phase<pg8::EpiResF32, pg8::StaticOrder, true, true>(lds, g, S, E);
            } else {
                if (l == 0) norm_gates_phase(p, lds, (const float*)(p.ws + WS_X1), 1, tid, wave, lane);
                else final_norm_phase(p, (LAS unsigned char*)lds_raw, wave, lane);
            }
        }
        __syncthreads();
        }
        if (ph + 1 < p0.ph_hi) { if (p0.ph_hi > NPH) grid.sync(); else xcd_barrier(bar); }
#if TSEL >= 0
        if (threadIdx.x == 0) { const unsigned long long now = __builtin_amdgcn_s_memrealtime(); if (ptype == (TSEL)) TW[2] += now - TW[1]; TW[1] = now;
          if (ph + 2 == p0.ph_hi) ((volatile LAS int*)TW)[8] = (int)((float)TW[2] / (float)(now - TW[0]) * 131072.f); }
        if (ph + 2 == p0.ph_hi) __syncthreads();
#endif
    }
}

extern "C" void kernel_launch(void* const* d_in, const int* in_sizes, int n_in, void* d_out, int out_size, void* d_ws, size_t ws_size, hipStream_t stream) {
    static int grid = 0;
    if (grid == 0) {
        if (n_in != 9 || in_sizes[0] != SEQ * DM || out_size != SEQ * DM || ws_size < WS_END) {
            fprintf(stderr, "kernel_launch: unexpected problem: n_in %d in0 %d out %d ws %zu (need %zu)\n", n_in, n_in > 0 ? in_sizes[0] : -1, out_size, ws_size, (size_t)WS_END); grid = -1; return; }
        int dev = 0, cus = 0, per_cu = 0;
        hipGetDevice(&dev);
        hipDeviceGetAttribute(&cus, hipDeviceAttributeMultiprocessorCount, dev);
        if (hipFuncSetAttribute((const void*)hymba_fwd, hipFuncAttributeMaxDynamicSharedMemorySize, LDS_BYTES) != hipSuccess) { fprintf(stderr, "kernel_launch: hipFuncSetAttribute failed\n"); grid = -1; return; }
        if (hipOccupancyMaxActiveBlocksPerMultiprocessor(&per_cu, (const void*)hymba_fwd, NTHR, LDS_BYTES) != hipSuccess || per_cu < 1) { fprintf(stderr, "kernel_launch: occupancy query gave %d\n", per_cu); per_cu = 1; }
        (void)hipGetLastError();
        grid = cus * per_cu;
        fprintf(stderr, "kernel_launch: %d CUs x %d = grid %d\n", cus, per_cu, grid);
    }
    if (grid < 0) return;
    if (hipMemsetAsync((char*)d_ws + WS_CTL, 0, 16384, stream) != hipSuccess) { fprintf(stderr, "kernel_launch: hipMemsetAsync failed\n"); return; }
    Params p{};
    p.x = (const float*)d_in[0]; p.norm_g = (const float*)d_in[1]; p.w_in = (const float*)d_in[2]; p.b_gate = (const float*)d_in[3]; p.conv_w = (const float*)d_in[4];
    p.mnorm_g = (const float*)d_in[5]; p.w_out = (const float*)d_in[6]; p.rel_bias = (const float*)d_in[7]; p.final_g = (const float*)d_in[8];
    p.out = (float*)d_out; p.ws = (unsigned char*)d_ws;
#if MULTI_LAUNCH
    for (int ph = 0; ph < NPH; ++ph) { p.ph_lo = ph; p.ph_hi = ph + 1; hipLaunchKernelGGL(hymba_fwd, dim3(grid), dim3(NTHR), LDS_BYTES, stream, p); }
#else
    p.ph_lo = 0; p.ph_hi = NPH;
    void* args[] = {&p};
    hipError_t e = hipLaunchCooperativeKernel((const void*)hymba_fwd, dim3(grid), dim3(NTHR), args, LDS_BYTES, stream);
    if (e != hipSuccess) fprintf(stderr, "kernel_launch: cooperative launch failed: %s (grid %d)\n", hipGetErrorString(e), grid);
#endif
}
```

```cpp
#include <hip/hip_runtime.h>
#include <hip/hip_cooperative_groups.h>
#include <cstdio>
#include <cstdint>
namespace cg = cooperative_groups;
namespace pg8 {
#define PG8_LAS __attribute__((address_space(3)))
typedef unsigned short bf16_t;
typedef short bf16x8 __attribute__((ext_vector_type(8)));
typedef float f32x4 __attribute__((ext_vector_type(4)));
typedef unsigned u32x4 __attribute__((ext_vector_type(4)));
constexpr int BM = 256, BK = 64, HALF = 128, HTB = HALF * BK * 2  , STAGE_BYTES = 8 * HTB, NXCD = 8, WGM = 8;

__host__ __device__ __forceinline__ int lds_byte(int r, int c) { const int st = (r >> 4) * 2 + (c >> 5), rr = r & 15, cc = c & 31, ob = rr * 64 + cc * 2; return st * 1024 + (ob ^ (((ob >> 9) & 1) << 5)); }
__host__ __device__ __forceinline__ void stage_rc(int b, int& R, int& C) { const int st = b / 1024, sb = b % 1024, swz = sb ^ (((sb >> 9) & 1) << 5); R = (st >> 1) * 16 + swz / 64; C = (st & 1) * 32 + (swz % 64) / 2; }
__host__ __device__ __forceinline__ int perm32(int rho) { const int n = rho >> 4, i = rho & 15; return 8 * (i >> 2) + 4 * n + (i & 3); }

struct Unit { int pm, pn; };
struct Gemm { const bf16_t* A; const bf16_t* Bt; int M, N, K; };

struct StaticOrder {
    int nM, nN, nwg, G, c;
    __host__ __device__ void init(int M, int N, int G_, int c_) { nM = M / BM; nN = N / BM; nwg = nM * nN; G = G_; c = c_; }
    __host__ __device__ bool next(int i, Unit& u) const {
        const long L = (long)i * G + c; if (L >= nwg) return false;
        int wgid = (int)L; { const int q = nwg / NXCD, r = nwg % NXCD, xcd = wgid % NXCD, off = wgid / NXCD; wgid = (xcd < r ? xcd * (q + 1) : r * (q + 1) + (xcd - r) * q) + off; }
        const int nig = WGM * nN, gid = wgid / nig, fm = gid * WGM, gsz = (nM - fm) < WGM ? (nM - fm) : WGM;
        u.pm = fm + ((wgid % nig) % gsz); u.pn = (wgid % nig) / gsz; return true;
    }
    __device__ __forceinline__ void a_ready(const Unit&) const {}
    __device__ __forceinline__ void done(const Unit&) const {}
};

__device__ __forceinline__ unsigned cvt_pk_bf16(float lo, float hi) { unsigned r; asm volatile("v_cvt_pk_bf16_f32 %0, %1, %2" : "=v"(r) : "v"(lo), "v"(hi)); return r; }
struct EpiBf16Plain {
    static constexpr bool PERM = true, AFTER_DRAIN = false;
    bf16_t* O; int ldc;
    __device__ __forceinline__ void operator()(const f32x4 (&acc)[2][2][4][2], const Unit& u, int wr, int wc, int fr, int fq) const {
        const int row0 = u.pm * BM + wr * 64 + fr; const int col0 = u.pn * BM + wc * 32 + 8 * fq;
#pragma unroll
        for (int ai = 0; ai < 2; ++ai)
#pragma unroll
            for (int m = 0; m < 4; ++m) { bf16_t* rowp = O + (size_t)(row0 + ai * HALF + m * 16) * ldc + col0;
#pragma unroll
                for (int bj = 0; bj < 2; ++bj) { const f32x4 v0 = acc[ai][bj][m][0], v1 = acc[ai][bj][m][1];
                    u32x4 w; w.x = cvt_pk_bf16(v0[0], v0[1]); w.y = cvt_pk_bf16(v0[2], v0[3]); w.z = cvt_pk_bf16(v1[0], v1[1]); w.w = cvt_pk_bf16(v1[2], v1[3]);
                    *(u32x4*)(rowp + bj * HALF) = w; } }
    }
};
struct EpiResF32 {
    static constexpr bool PERM = true, AFTER_DRAIN = false;
    const float* base; float* out; int ld;
    __device__ __forceinline__ void operator()(const f32x4 (&acc)[2][2][4][2], const Unit& u, int wr, int wc, int fr, int fq) const {
        const int row0 = u.pm * BM + wr * 64 + fr; const int col0 = u.pn * BM + wc * 32 + 8 * fq;
#pragma unroll
        for (int ai = 0; ai < 2; ++ai)
#pragma unroll
            for (int m = 0; m < 4; ++m) { const size_t ro = (size_t)(row0 + ai * HALF + m * 16) * ld + col0;
#pragma unroll
                for (int bj = 0; bj < 2; ++bj) {
                    const f32x4 b0 = *(const f32x4*)(base + ro + bj * HALF), b1 = *(const f32x4*)(base + ro + bj * HALF + 4);
                    *(f32x4*)(out + ro + bj * HALF) = acc[ai][bj][m][0] + b0;
                    *(f32x4*)(out + ro + bj * HALF + 4) = acc[ai][bj][m][1] + b1; } }
    }
};
template <class Epi, class Sched, bool ALIGN_EPI = false, bool SP2 = false>
__device__ __forceinline__ void gemm_phase(PG8_LAS unsigned char* lds, const Gemm g, const Sched& S, const Epi& E) {
    const int tid = threadIdx.x, wid = __builtin_amdgcn_readfirstlane(tid >> 6), lane = tid & 63, wr = wid >> 2, wc = wid & 3, fr = lane & 15, fq = lane >> 4;
    const int K = g.K, nt = K / BK;
    unsigned voffA[2], voffB[2];
#pragma unroll
    for (int i = 0; i < 2; ++i) { int R, C; stage_rc(tid * 16 + i * 8192, R, C); const int Rb = Epi::PERM ? ((R & ~31) + perm32(R & 31)) : R;
        voffA[i] = (unsigned)(R * K + C) * 2u; voffB[i] = (unsigned)(Rb * K + C) * 2u; }
    const size_t kstep = (size_t)(BK * 2);
    const size_t hstep = (size_t)HALF * K * 2;
    const size_t tstep = 2 * hstep;
    const unsigned ldsw = (unsigned)wid * 1024u;
    const int aoff = lds_byte(wr * 64 + fr, fq * 8), boff = lds_byte(wc * 32 + fr, fq * 8);
#define PG8_SA(b, h) (((b) * 2 + (h)) * HTB)
#define PG8_SB(b, h) ((4 + (b) * 2 + (h)) * HTB)
#define PG8_STAGE(bufoff, gbase, voff) do { _Pragma("unroll") for (int _i = 0; _i < 2; ++_i) \
        __builtin_amdgcn_global_load_lds((const unsigned*)((const char*)(gbase) + (voff)[_i]), (PG8_LAS unsigned*)(lds + (bufoff) + ldsw + _i * 8192), 16, 0, 0); } while (0)
#define PG8_LDA(dst, b, h) do { _Pragma("unroll") for (int m = 0; m < 4; ++m) _Pragma("unroll") for (int k = 0; k < 2; ++k) dst[m][k] = *(const PG8_LAS bf16x8*)(lds + PG8_SA(b, h) + aoff + m * 2048 + k * 1024); } while (0)
#define PG8_LDB(dst, b, h) do { _Pragma("unroll") for (int n = 0; n < 2; ++n) _Pragma("unroll") for (int k = 0; k < 2; ++k) dst[n][k] = *(const PG8_LAS bf16x8*)(lds + PG8_SB(b, h) + boff + n * 2048 + k * 1024); } while (0)
#define PG8_MMA(ai, bj, At, Bt) do { __builtin_amdgcn_s_setprio(1); _Pragma("unroll") for (int m = 0; m < 4; ++m) _Pragma("unroll") for (int n = 0; n < 2; ++n) _Pragma("unroll") for (int k = 0; k < 2; ++k) \
        acc[ai][bj][m][n] = __builtin_amdgcn_mfma_f32_16x16x32_bf16(Bt[n][k], At[m][k], acc[ai][bj][m][n], 0, 0, 0); __builtin_amdgcn_s_setprio(0); } while (0)
#define PG8_WAIT_V(n) asm volatile("s_waitcnt vmcnt(" #n ")" ::: "memory")
#define PG8_WAIT_L(n) asm volatile("s_waitcnt lgkmcnt(" #n ")" ::: "memory")
#define PG8_BAR __builtin_amdgcn_s_barrier()
#define PG8_SCHED __builtin_amdgcn_sched_barrier(0)
    Unit cur, nxt; int ui = 0;
    if (!S.next(0, cur)) return;
    f32x4 acc[2][2][4][2];
#pragma unroll
    for (int a = 0; a < 2; ++a)
#pragma unroll
        for (int b = 0; b < 2; ++b)
#pragma unroll
            for (int m = 0; m < 4; ++m)
#pragma unroll
                for (int n = 0; n < 2; ++n) acc[a][b][m][n] = (f32x4){0.f, 0.f, 0.f, 0.f};
    bf16x8 At[4][2], B0[2][2], B1[2][2];
    const char* cA = (const char*)g.A + (size_t)cur.pm * tstep; const char* cB = (const char*)g.Bt + (size_t)cur.pn * tstep;
    S.a_ready(cur);
    if constexpr (SP2) {
        PG8_STAGE(PG8_SB(0, 0), cB, voffB); PG8_STAGE(PG8_SB(0, 1), cB + hstep, voffB); PG8_STAGE(PG8_SA(0, 0), cA, voffA); PG8_STAGE(PG8_SA(0, 1), cA + hstep, voffA);
        if (wr == 1) PG8_BAR;
        PG8_WAIT_V(2); PG8_BAR;
        PG8_STAGE(PG8_SB(1, 0), cB + kstep, voffB); PG8_STAGE(PG8_SA(1, 0), cA + kstep, voffA); PG8_STAGE(PG8_SB(1, 1), cB + hstep + kstep, voffB);
        PG8_WAIT_V(6); PG8_BAR;
    } else {
        PG8_STAGE(PG8_SB(0, 0), cB, voffB); PG8_STAGE(PG8_SA(0, 0), cA, voffA); PG8_STAGE(PG8_SB(0, 1), cB + hstep, voffB); PG8_STAGE(PG8_SA(0, 1), cA + hstep, voffA);
        if (wr == 1) PG8_BAR;
        PG8_WAIT_V(4); PG8_BAR;
        PG8_STAGE(PG8_SB(1, 0), cB + kstep, voffB); PG8_STAGE(PG8_SA(1, 0), cA + kstep, voffA); PG8_STAGE(PG8_SB(1, 1), cB + hstep + kstep, voffB);
        PG8_WAIT_V(6); PG8_BAR;
    }
    for (;;) {
        const bool has_next = S.next(ui + 1, nxt);
        const char* nA = has_next ? (const char*)g.A + (size_t)nxt.pm * tstep : cA; const char* nB = has_next ? (const char*)g.Bt + (size_t)nxt.pn * tstep : cB;
        for (int t = 0; t < nt; t += 2) {
            const bool last = (t == nt - 2);
            const char* a1 = cA + (size_t)(t + 1) * kstep;
            const char* a2 = last ? nA : cA + (size_t)(t + 2) * kstep; const char* b2 = last ? nB : cB + (size_t)(t + 2) * kstep;
            const char* a3 = a2 + kstep; const char* b3 = b2 + kstep;
            if (last && has_next) S.a_ready(nxt);
            if constexpr (SP2) {
            PG8_LDB(B0, 0, 0); PG8_LDB(B1, 0, 1); PG8_SCHED; PG8_LDA(At, 0, 0); PG8_STAGE(PG8_SA(1, 1), a1 + hstep, voffA);
            PG8_WAIT_V(8); PG8_WAIT_L(0); PG8_BAR; PG8_MMA(0, 0, At, B0); PG8_MMA(0, 1, At, B1); PG8_BAR; PG8_SCHED;
            PG8_LDA(At, 0, 1); PG8_STAGE(PG8_SB(0, 0), b2, voffB); PG8_STAGE(PG8_SB(0, 1), b2 + hstep, voffB); PG8_STAGE(PG8_SA(0, 0), a2, voffA);
            PG8_WAIT_V(8); PG8_WAIT_L(0); PG8_BAR; PG8_MMA(1, 0, At, B0); PG8_MMA(1, 1, At, B1); PG8_BAR; PG8_SCHED;
            PG8_LDB(B0, 1, 0); PG8_LDB(B1, 1, 1); PG8_SCHED; PG8_LDA(At, 1, 0); PG8_STAGE(PG8_SA(0, 1), a2 + hstep, voffA);
            PG8_WAIT_V(8); PG8_WAIT_L(0); PG8_BAR; PG8_MMA(0, 0, At, B0); PG8_MMA(0, 1, At, B1); PG8_BAR; PG8_SCHED;
            PG8_LDA(At, 1, 1); PG8_STAGE(PG8_SB(1, 0), b3, voffB); PG8_STAGE(PG8_SB(1, 1), b3 + hstep, voffB); PG8_STAGE(PG8_SA(1, 0), a3, voffA);
            PG8_WAIT_V(8); PG8_WAIT_L(0); PG8_BAR; PG8_MMA(1, 0, At, B0); PG8_MMA(1, 1, At, B1); PG8_BAR; PG8_SCHED;
            } else {
            PG8_LDB(B0, 0, 0); PG8_SCHED; PG8_LDA(At, 0, 0); PG8_STAGE(PG8_SA(1, 1), a1 + hstep, voffA);
            PG8_WAIT_L(8); PG8_BAR; PG8_WAIT_L(0); PG8_MMA(0, 0, At, B0); PG8_BAR; PG8_SCHED;
            PG8_LDB(B1, 0, 1); PG8_STAGE(PG8_SB(0, 0), b2, voffB);
            PG8_BAR; PG8_WAIT_L(0); PG8_MMA(0, 1, At, B1); PG8_BAR;
            PG8_LDA(At, 0, 1); PG8_STAGE(PG8_SA(0, 0), a2, voffA);
            PG8_BAR; PG8_WAIT_L(0); PG8_MMA(1, 0, At, B0); PG8_BAR; PG8_SCHED;
            PG8_STAGE(PG8_SB(0, 1), b2 + hstep, voffB);
            PG8_WAIT_V(6); PG8_BAR; PG8_MMA(1, 1, At, B1); PG8_BAR;
            PG8_LDB(B0, 1, 0); PG8_SCHED; PG8_LDA(At, 1, 0); PG8_STAGE(PG8_SA(0, 1), a2 + hstep, voffA);
            PG8_WAIT_L(8); PG8_BAR; PG8_WAIT_L(0); PG8_MMA(0, 0, At, B0); PG8_BAR; PG8_SCHED;
            PG8_LDB(B1, 1, 1); PG8_STAGE(PG8_SB(1, 0), b3, voffB);
            PG8_BAR; PG8_WAIT_L(0); PG8_MMA(0, 1, At, B1); PG8_BAR;
            PG8_LDA(At, 1, 1); PG8_STAGE(PG8_SA(1, 0), a3, voffA);
            PG8_BAR; PG8_WAIT_L(0); PG8_MMA(1, 0, At, B0); PG8_BAR; PG8_SCHED;
            PG8_STAGE(PG8_SB(1, 1), b3 + hstep, voffB);
            PG8_WAIT_V(6); PG8_BAR; PG8_MMA(1, 1, At, B1); PG8_BAR;
            }
        }
        if constexpr (ALIGN_EPI) { if (wr == 0) PG8_BAR; }
        if constexpr (!Epi::AFTER_DRAIN) { E(acc, cur, wr, wc, fr, fq); S.done(cur); }
        if (!has_next) break;
#pragma unroll
        for (int a = 0; a < 2; ++a)
#pragma unroll
            for (int b = 0; b < 2; ++b)
#pragma unroll
                for (int m = 0; m < 4; ++m)
#pragma unroll
                    for (int n = 0; n < 2; ++n) acc[a][b][m][n] = (f32x4){0.f, 0.f, 0.f, 0.f};
        cur = nxt; cA = nA; cB = nB; ++ui;
        if constexpr (ALIGN_EPI) { if (wr == 1) PG8_BAR; }
    }
    PG8_WAIT_V(0);
    if constexpr (!ALIGN_EPI) { if (wr == 0) PG8_BAR; }
    PG8_BAR;
    if constexpr (Epi::AFTER_DRAIN) { E.fused(acc, cur, wr, wc, fr, fq, lds, wid, lane); S.done(cur); }
#undef PG8_SA
#undef PG8_SB
#undef PG8_STAGE
#undef PG8_LDA
#undef PG8_LDB
#undef PG8_MMA
#undef PG8_WAIT_V
#undef PG8_WAIT_L
#undef PG8_BAR
#undef PG8_SCHED
}
}

#ifndef MULTI_LAUNCH
#define MULTI_LAUNCH 0
#endif
#ifndef USE_TR
#define USE_TR 1
#endif
#ifndef TSEL
#define TSEL (-1)
#endif
#ifndef REP_ATTN
#define REP_ATTN 0
#endif
#ifndef REP_M1
#define REP_M1 0
#endif
#ifndef REPEAT_MASK
#define REPEAT_MASK 0
#endif
#define LAS __attribute__((address_space(3)))
#define DI __device__ __forceinline__
typedef unsigned short bf16;
typedef short bf16x8 __attribute__((ext_vector_type(8)));
typedef float f32x4 __attribute__((ext_vector_type(4)));
typedef unsigned u32x4 __attribute__((ext_vector_type(4)));
typedef unsigned u32x2 __attribute__((ext_vector_type(2)));

constexpr int SEQ = 8192, DM = 4096, INW = 16392, NU = 16384;
constexpr int C_QA = 0, C_KA = 2048, C_VA = 4096, C_ZA = 6144, C_QM = 8192, C_KM = 9216, C_VM = 10240, C_OM = 12288, C_ZM = 14336;
constexpr float NORM_EPS = 1e-6f;
constexpr int NTHR = 512, NWAVE = 8;
constexpr int LDS_BYTES = 147456;

constexpr size_t MiB = (size_t)1 << 20;
constexpr size_t WS_WIN = 0, WS_WOUT = 256 * MiB, WS_XN = 320 * MiB, WS_U = 384 * MiB, WS_OP = 640 * MiB, WS_Y = 736 * MiB, WS_X1 = 800 * MiB,
                 WS_DC = 928 * MiB, WS_CS = 992 * MiB, WS_LSE = 1024 * MiB, WS_GATES = 1026 * MiB, WS_DN = 1027 * MiB, WS_NS = 1028 * MiB, WS_BL = 1029 * MiB,
                 WS_CTL = 1030 * MiB, WS_QKC = 1032 * MiB, WS_END = 1064 * MiB;
constexpr int LDS_BARST = LDS_BYTES - 64;

struct Params { const float *x, *norm_g, *w_in, *b_gate, *conv_w, *mnorm_g, *w_out, *rel_bias, *final_g; float* out; unsigned char* ws; int ph_lo, ph_hi; };

DI float bf_lo(unsigned u) { return __uint_as_float(u << 16); }
DI float bf_hi(unsigned u) { return __uint_as_float(u & 0xffff0000u); }
DI float bf2f(unsigned short u) { return __uint_as_float((unsigned)u << 16); }
DI unsigned pk2(float lo, float hi) { return pg8::cvt_pk_bf16(lo, hi); }
DI float wave_sum(float v) {
#pragma unroll
    for (int o = 1; o < 64; o <<= 1) v += __shfl_xor(v, o);
    return v;
}
DI float quad_sum(float v) { v += __shfl_xor(v, 16); v += __shfl_xor(v, 32); return v; }
DI float quad_max(float v) { v = fmaxf(v, __shfl_xor(v, 16)); v = fmaxf(v, __shfl_xor(v, 32)); return v; }
DI float silu_f(float x) { return x / (1.f + __expf(-x)); }
DI float sigm_f(float x) { return 1.f / (1.f + __expf(-x)); }
DI bf16x8 gatherT(const LAS unsigned short* p, int stride) {
    bf16x8 r;
#pragma unroll
    for (int j = 0; j < 8; ++j) r[j] = (short)p[j * stride];
    return r;
}
typedef short s16x4 __attribute__((ext_vector_type(4)));
DI bf16x8 trfrag(const LAS unsigned short* blk, int stride, int ql) {
#if USE_TR
    const LAS unsigned short* a = blk + (ql >> 2) * stride + 4 * (ql & 3);
    const s16x4 lo = __builtin_amdgcn_ds_read_tr16_b64_v4i16((LAS s16x4*)a);
    const s16x4 hi = __builtin_amdgcn_ds_read_tr16_b64_v4i16((LAS s16x4*)(a + 4 * stride));
    return (bf16x8){lo[0], lo[1], lo[2], lo[3], hi[0], hi[1], hi[2], hi[3]};
#else
    return gatherT(blk + ql, stride);
#endif
}
DI f32x4 mfma16(bf16x8 a, bf16x8 b, f32x4 c) { return __builtin_amdgcn_mfma_f32_16x16x32_bf16(a, b, c, 0, 0, 0); }
#define LDS_WAIT() asm volatile("s_waitcnt lgkmcnt(0)" ::: "memory")

struct TrTile { const float* src; bf16* dst; };
DI TrTile tr_tile_addr(const Params& p, int it, int lane) {
    constexpr int T_IN = 64 * 256, T_OUT = 64 * 64;
    const float* W; bf16* WT; int ldw, nb, kb;
    int r = it;
    if (r < T_IN) { W = p.w_in; WT = (bf16*)(p.ws + WS_WIN); ldw = INW; kb = r >> 8; nb = r & 255; }
    else if ((r -= T_IN) < T_OUT) { W = p.w_out; WT = (bf16*)(p.ws + WS_WOUT); ldw = DM; kb = r >> 6; nb = r & 63; }
    else if ((r -= T_OUT) < T_IN) { W = p.w_in + (size_t)DM * INW; WT = (bf16*)(p.ws + WS_WIN + 128 * MiB); ldw = INW; kb = r >> 8; nb = r & 255; }
    else { r -= T_IN; W = p.w_out + (size_t)DM * DM; WT = (bf16*)(p.ws + WS_WOUT + 32 * MiB); ldw = DM; kb = r >> 6; nb = r & 63; }
    TrTile t;
    t.src = W + (size_t)(kb * 64 + 16 * (lane >> 4)) * ldw + nb * 64 + 4 * (lane & 15);
    t.dst = WT + (size_t)(nb * 64 + (lane >> 3)) * DM + kb * 64 + 8 * (lane & 7);
    return t;
}
DI int tr_ldw(int it) { constexpr int T_IN = 64 * 256, T_OUT = 64 * 64; const int r = it % (T_IN + T_OUT); return r < T_IN ? INW : DM; }
DI void tr_load(const float* src, int ldw, f32x4 (&v)[16]) {
#pragma unroll
    for (int i = 0; i < 16; ++i) v[i] = *(const f32x4*)(src + (size_t)i * ldw);
}
DI void tr_store(const f32x4 (&v)[16], bf16* dst, LAS unsigned short* T, int lane) {
    const int kr = lane >> 4, nc = 4 * (lane & 15);
#pragma unroll
    for (int e = 0; e < 4; ++e)
#pragma unroll
        for (int hf = 0; hf < 2; ++hf) { u32x4 w;
            w.x = pk2(v[8 * hf + 0][e], v[8 * hf + 1][e]); w.y = pk2(v[8 * hf + 2][e], v[8 * hf + 3][e]); w.z = pk2(v[8 * hf + 4][e], v[8 * hf + 5][e]); w.w = pk2(v[8 * hf + 6][e], v[8 * hf + 7][e]);
            *(LAS u32x4*)(T + (nc + e) * 72 + 16 * kr + 8 * hf) = w; }
    LDS_WAIT(); asm volatile("" ::: "memory");
#pragma unroll
    for (int j = 0; j < 8; ++j) { const u32x4 w = *(const LAS u32x4*)(T + ((lane >> 3) + 8 * j) * 72 + 8 * (lane & 7)); *(u32x4*)(dst + (size_t)(8 * j) * DM) = w; }
    LDS_WAIT(); asm volatile("" ::: "memory");
}
DI void prologue_transposes(const Params& p, LAS unsigned char* lds, int wave, int lane) {
    LAS unsigned short* T = (LAS unsigned short*)(lds + wave * 16384);
    const int gw = blockIdx.x * NWAVE + wave, ngw = gridDim.x * NWAVE;
    constexpr int NIT = 2 * (64 * 256 + 64 * 64);
    f32x4 va[16], vb[16];
    int it = gw;
    if (it >= NIT) return;
    TrTile ta = tr_tile_addr(p, it, lane), tb;
    tr_load(ta.src, tr_ldw(it), va);
    for (;;) {
        const int it1 = it + ngw; const bool h1 = it1 < NIT;
        if (h1) { tb = tr_tile_addr(p, it1, lane); tr_load(tb.src, tr_ldw(it1), vb); }
        tr_store(va, ta.dst, T, lane);
        if (!h1) break;
        const int it2 = it1 + ngw; const bool h2 = it2 < NIT;
        if (h2) { ta = tr_tile_addr(p, it2, lane); tr_load(ta.src, tr_ldw(it2), va); }
        tr_store(vb, tb.dst, T, lane);
        if (!h2) break;
        it = it2;
    }
}

DI void norm_gates_phase(const Params& p, LAS unsigned char* lds, const float* X, int l, int tid, int wave, int lane) {
    LAS f32x4* G4 = (LAS f32x4*)lds;
    const float* wg = p.w_in + (size_t)l * DM * INW + NU;
#pragma unroll 4
    for (int i = 0; i < 16; ++i) { const int idx = tid + NTHR * i, k = idx >> 1, half = idx & 1;
        G4[((k & 3) * 2 + half) * 1024 + (k >> 2)] = *(const f32x4*)(wg + (size_t)k * INW + half * 4); }
    __syncthreads();
    const float* g = p.norm_g + l * DM;
    bf16* XN = (bf16*)(p.ws + WS_XN);
    float* gates = (float*)(p.ws + WS_GATES);
    for (int row = blockIdx.x * NWAVE + wave; row < SEQ; row += gridDim.x * NWAVE) {
        const f32x4* xr = (const f32x4*)(X + (size_t)row * DM) + lane;
        f32x4 v[16]; float ss = 0.f;
#pragma unroll
        for (int j = 0; j < 16; ++j) { v[j] = xr[64 * j]; ss += (v[j].x * v[j].x + v[j].y * v[j].y) + (v[j].z * v[j].z + v[j].w * v[j].w); }
        const float rstd = rsqrtf(wave_sum(ss) * (1.f / DM) + NORM_EPS);
        u32x2* o8 = (u32x2*)(XN + (size_t)row * DM) + lane;
        f32x4 a0 = {0.f, 0.f, 0.f, 0.f}, a1 = {0.f, 0.f, 0.f, 0.f};
#pragma unroll
        for (int j = 0; j < 16; ++j) {
            const f32x4 gv = ((const f32x4*)g)[lane + 64 * j];
            const f32x4 h = v[j] * rstd * gv;
            u32x2 w; w.x = pk2(h.x, h.y); w.y = pk2(h.z, h.w); o8[64 * j] = w;
            const int kq = lane + 64 * j;
            a0 += h.x * G4[0 * 1024 + kq]; a1 += h.x * G4[1 * 1024 + kq];
            a0 += h.y * G4[2 * 1024 + kq]; a1 += h.y * G4[3 * 1024 + kq];
            a0 += h.z * G4[4 * 1024 + kq]; a1 += h.z * G4[5 * 1024 + kq];
            a0 += h.w * G4[6 * 1024 + kq]; a1 += h.w * G4[7 * 1024 + kq];
        }
        const float s0 = wave_sum(a0.x), s1 = wave_sum(a0.y), s2 = wave_sum(a0.z), s3 = wave_sum(a0.w);
        const float s4 = wave_sum(a1.x), s5 = wave_sum(a1.y), s6 = wave_sum(a1.z), s7 = wave_sum(a1.w);
        float ov = s0; ov = lane == 1 ? s1 : ov; ov = lane == 2 ? s2 : ov; ov = lane == 3 ? s3 : ov;
        ov = lane == 4 ? s4 : ov; ov = lane == 5 ? s5 : ov; ov = lane == 6 ? s6 : ov; ov = lane == 7 ? s7 : ov;
        if (lane < 8) gates[(size_t)row * 8 + lane] = ov + p.b_gate[l * 8 + lane];
    }
    __syncthreads();
}
DI void final_norm_phase(const Params& p, LAS unsigned char* lds0, int wave, int lane) {
#if TSEL >= 0
    const int n2 = ((volatile LAS int*)(lds0 + LDS_BARST + 16))[8];
#endif
    for (int row = blockIdx.x * NWAVE + wave; row < SEQ; row += gridDim.x * NWAVE) {
        f32x4* xr = (f32x4*)(p.out + (size_t)row * DM) + lane;
        f32x4 v[16]; float ss = 0.f;
#pragma unroll
        for (int j = 0; j < 16; ++j) { v[j] = xr[64 * j]; ss += (v[j].x * v[j].x + v[j].y * v[j].y) + (v[j].z * v[j].z + v[j].w * v[j].w); }
        const float rstd = rsqrtf(wave_sum(ss) * (1.f / DM) + NORM_EPS);
#pragma unroll
        for (int j = 0; j < 16; ++j) { f32x4 o = v[j] * rstd * ((const f32x4*)p.final_g)[lane + 64 * j];
#if TSEL >= 0
            if (blockIdx.x == 0) { const int e0 = ((row >> 11) * 8 + (row & 7)) * 4096 + 4 * (lane + 64 * j);
                o.x += (e0 + 0 < n2) ? 0.02f : 0.f; o.y += (e0 + 1 < n2) ? 0.02f : 0.f; o.z += (e0 + 2 < n2) ? 0.02f : 0.f; o.w += (e0 + 3 < n2) ? 0.02f : 0.f; }
#endif
            xr[64 * j] = o; }
    }
}

constexpr int AT_KS = 136;
DI void attn_item(const Params& p, LAS unsigned char* lds, int item, int tid, int wave, int lane) {
    const bf16* U = (const bf16*)(p.ws + WS_U);
    LAS unsigned short* Ks = (LAS unsigned short*)lds;
    LAS unsigned short* Vs = Ks + 256 * AT_KS;
    LAS float* biasS = (LAS float*)(Vs + 256 * AT_KS);
    const int pat = item >> 10, rem = item & 1023, h = rem >> 6, rb = rem & 63;
    const int dsh = pat * 2;
    const int r = rb >> (6 - dsh), bq = rb & ((64 >> dsh) - 1);
    const int sub0 = 128 * bq - 128;
    const int ql = lane & 15, quad = lane >> 4, q0 = wave * 16;
    u32x4 kv[8], vv[8];
#pragma unroll
    for (int i = 0; i < 8; ++i) { const int c = tid + NTHR * i, row = c >> 4, ch = c & 15; int sub = sub0 + row; sub = sub < 0 ? 0 : sub;
        const bf16* src = U + (size_t)((sub << dsh) + r) * NU + h * 128 + ch * 8;
        kv[i] = *(const u32x4*)(src + C_KA); vv[i] = *(const u32x4*)(src + C_VA); }
    const int tq = ((128 * bq + q0 + ql) << dsh) + r;
    bf16x8 qf[4];
#pragma unroll
    for (int ks = 0; ks < 4; ++ks) qf[ks] = *(const bf16x8*)(U + (size_t)tq * NU + C_QA + h * 128 + ks * 32 + quad * 8);
    if (tid < 129) { const int n = tid << dsh; int b = n;
        if (n >= 16) { b = 16 + (int)floorf(log2f((float)n * 0.0625f) * (16.f / 7.f)); b = b > 31 ? 31 : b; }
        biasS[tid] = p.rel_bias[b * 16 + h]; }
#pragma unroll
    for (int i = 0; i < 8; ++i) { const int c = tid + NTHR * i, row = c >> 4, ch = c & 15;
        *(LAS u32x4*)(Ks + row * AT_KS + ch * 8) = kv[i]; *(LAS u32x4*)(Vs + row * AT_KS + ch * 8) = vv[i]; }
    __syncthreads();
    f32x4 sacc[10];
#pragma unroll
    for (int t = 0; t < 10; ++t) sacc[t] = (f32x4){0.f, 0.f, 0.f, 0.f};
#pragma unroll
    for (int s = 0; s < 5; ++s)
#pragma unroll
        for (int u = 0; u < 2; ++u) { int kk = q0 + 32 * s + (ql >> 2) * 8 + u * 4 + (ql & 3); kk = kk > 255 ? 255 : kk;
            const LAS unsigned short* kp = Ks + kk * AT_KS + quad * 8;
#pragma unroll
            for (int ks = 0; ks < 4; ++ks) sacc[2 * s + u] = mfma16(*(const LAS bf16x8*)(kp + ks * 32), qf[ks], sacc[2 * s + u]); }
    const float scale = 0.08838834764831845f;
    float mx = -1e30f;
    int ql2 = ql, quad2 = quad; asm volatile("" : "+v"(ql2), "+v"(quad2));
#pragma unroll
    for (int s = 0; s < 5; ++s)
#pragma unroll
        for (int u = 0; u < 2; ++u)
#pragma unroll
            for (int j = 0; j < 4; ++j) { const int koff = 32 * s + quad2 * 8 + u * 4 + j, rel = koff - ql2;
                const bool valid = (rel >= 0) && (rel <= 128) && (sub0 + q0 + koff >= 0);
                int jo = 128 - rel; jo = jo < 0 ? 0 : (jo > 128 ? 128 : jo);
                const float v = valid ? sacc[2 * s + u][j] * scale + biasS[jo] : -1e30f;
                sacc[2 * s + u][j] = v; mx = fmaxf(mx, v); }
    mx = quad_max(mx);
    float l = 0.f;
#pragma unroll
    for (int t = 0; t < 10; ++t)
#pragma unroll
        for (int j = 0; j < 4; ++j) { const float e = __expf(sacc[t][j] - mx); sacc[t][j] = e; l += e; }
    l = quad_sum(l);
    f32x4 oacc[8];
#pragma unroll
    for (int nt = 0; nt < 8; ++nt) oacc[nt] = (f32x4){0.f, 0.f, 0.f, 0.f};
#pragma unroll
    for (int s = 0; s < 5; ++s) {
        u32x4 pw; pw.x = pk2(sacc[2 * s][0], sacc[2 * s][1]); pw.y = pk2(sacc[2 * s][2], sacc[2 * s][3]); pw.z = pk2(sacc[2 * s + 1][0], sacc[2 * s + 1][1]); pw.w = pk2(sacc[2 * s + 1][2], sacc[2 * s + 1][3]);
        const bf16x8 pf = __builtin_bit_cast(bf16x8, pw);
        int key0 = q0 + 32 * s + quad * 8; key0 = key0 > 248 ? 248 : key0;
        const LAS unsigned short* vp = Vs + key0 * AT_KS;
#pragma unroll
        for (int nt = 0; nt < 8; ++nt) oacc[nt] = mfma16(trfrag(vp + nt * 16, AT_KS, ql), pf, oacc[nt]);
    }
    const float inv = 1.f / l;
    bf16* OP = (bf16*)(p.ws + WS_OP) + (size_t)pat * SEQ * 2048 + (size_t)tq * 2048 + h * 128 + quad * 4;
#pragma unroll
    for (int nt = 0; nt < 8; ++nt) { u32x2 w; w.x = pk2(oacc[nt][0] * inv, oacc[nt][1] * inv); w.y = pk2(oacc[nt][2] * inv, oacc[nt][3] * inv); *(u32x2*)(OP + nt * 16) = w; }
    if (quad == 0) ((float*)(p.ws + WS_LSE))[((size_t)pat * SEQ + tq) * 16 + h] = mx + __logf(l);
    __syncthreads();
}
DI void merge_phase(const Params& p, int tid) {
    const bf16* U = (const bf16*)(p.ws + WS_U);
    const bf16* OP = (const bf16*)(p.ws + WS_OP);
    const float* LSE = (const float*)(p.ws + WS_LSE);
    bf16* Y = (bf16*)(p.ws + WS_Y);
    const int gthreads = gridDim.x * NTHR;
    for (int idx = blockIdx.x * NTHR + tid; idx < SEQ * 256; idx += gthreads) {
        const int t = idx >> 8, c8 = idx & 255, h = c8 >> 4;
        const float l0 = LSE[(size_t)t * 16 + h], l1 = LSE[((size_t)SEQ + t) * 16 + h], l2 = LSE[((size_t)2 * SEQ + t) * 16 + h];
        const float M = fmaxf(l0, fmaxf(l1, l2));
        float w0 = __expf(l0 - M), w1 = __expf(l1 - M), w2 = __expf(l2 - M);
        const float inv = 1.f / (w0 + w1 + w2); w0 *= inv; w1 *= inv; w2 *= inv;
        const size_t o = (size_t)t * 2048 + c8 * 8;
        const u32x4 o0 = *(const u32x4*)(OP + o), o1 = *(const u32x4*)(OP + (size_t)SEQ * 2048 + o), o2 = *(const u32x4*)(OP + (size_t)2 * SEQ * 2048 + o);
        const u32x4 z = *(const u32x4*)(U + (size_t)t * NU + C_ZA + c8 * 8);
        u32x4 y;
#pragma unroll
        for (int e = 0; e < 4; ++e) {
            const float lo = (w0 * bf_lo(o0[e]) + w1 * bf_lo(o1[e]) + w2 * bf_lo(o2[e])) * silu_f(bf_lo(z[e]));
            const float hi = (w0 * bf_hi(o0[e]) + w1 * bf_hi(o1[e]) + w2 * bf_hi(o2[e])) * silu_f(bf_hi(z[e]));
            y[e] = pk2(lo, hi);
        }
        *(u32x4*)(Y + (size_t)t * DM + c8 * 8) = y;
    }
}

constexpr int M_KS = 264, M_VS3 = 520;
DI void conv8(const bf16* U, const float* cw, int t, int rawcol, int cch, float (&f)[8]) {
#pragma unroll
    for (int e = 0; e < 8; ++e) f[e] = 0.f;
#pragma unroll
    for (int j = 0; j < 4; ++j) { const int tt = t - 3 + j;
        if (tt >= 0) { const u32x4 raw = *(const u32x4*)(U + (size_t)tt * NU + rawcol);
            const f32x4 w0 = *(const f32x4*)(cw + j * 2048 + cch), w1 = *(const f32x4*)(cw + j * 2048 + cch + 4);
            f[0] += w0[0] * bf_lo(raw.x); f[1] += w0[1] * bf_hi(raw.x); f[2] += w0[2] * bf_lo(raw.y); f[3] += w0[3] * bf_hi(raw.y);
            f[4] += w1[0] * bf_lo(raw.z); f[5] += w1[1] * bf_hi(raw.z); f[6] += w1[2] * bf_lo(raw.w); f[7] += w1[3] * bf_hi(raw.w); } }
#pragma unroll
    for (int e = 0; e < 8; ++e) f[e] = silu_f(f[e]);
}
template <int NI, int MODE, int NB>
DI void conv_tile(const bf16* U, const float* cw, int t0, int rawcol0, int cch0, float sc, LAS unsigned short* dst, int tid, float bL, const LAS float* bS, const LAS float* liS, int roff) {
    const int ch = tid & 31, r0 = tid >> 5;
    f32x4 w[4][2];
#pragma unroll
    for (int j = 0; j < 4; ++j) { w[j][0] = *(const f32x4*)(cw + j * 2048 + cch0 + ch * 8); w[j][1] = *(const f32x4*)(cw + j * 2048 + cch0 + ch * 8 + 4); }
    const bf16* src = U + rawcol0 + ch * 8;
#pragma unroll
    for (int ib = 0; ib < NI; ib += NB) {
        u32x4 raw[NB][4];
#pragma unroll
        for (int i = 0; i < NB; ++i)
#pragma unroll
            for (int j = 0; j < 4; ++j) { const int tt = t0 + r0 + 16 * (ib + i) - 3 + j; const int tc = tt < 0 ? 0 : tt;
                raw[i][j] = *(const u32x4*)(src + (size_t)tc * NU); if (tt < 0) raw[i][j] = (u32x4){0u, 0u, 0u, 0u}; }
#pragma unroll
        for (int i = 0; i < NB; ++i) { const int row = r0 + 16 * (ib + i);
            float f[8];
#pragma unroll
            for (int e = 0; e < 8; ++e) f[e] = 0.f;
#pragma unroll
            for (int j = 0; j < 4; ++j) { const u32x4 rw = raw[i][j];
                f[0] += w[j][0][0] * bf_lo(rw.x); f[1] += w[j][0][1] * bf_hi(rw.x); f[2] += w[j][0][2] * bf_lo(rw.y); f[3] += w[j][0][3] * bf_hi(rw.y);
                f[4] += w[j][1][0] * bf_lo(rw.z); f[5] += w[j][1][1] * bf_hi(rw.z); f[6] += w[j][1][2] * bf_lo(rw.w); f[7] += w[j][1][3] * bf_hi(rw.w); }
            float m = sc;
            if (MODE == 1) m *= __expf(bL - bS[roff + row] + liS[roff + row]);
#pragma unroll
            for (int e = 0; e < 8; ++e) f[e] = silu_f(f[e]) * m;
            u32x4 o; o.x = pk2(f[0], f[1]); o.y = pk2(f[2], f[3]); o.z = pk2(f[4], f[5]); o.w = pk2(f[6], f[7]);
            *(LAS u32x4*)(dst + row * M_KS + ch * 8) = o; }
        __builtin_amdgcn_sched_barrier(0);
    }
}
DI void conv_prepass(const Params& p, int l, int tid) {
    const bf16* U = (const bf16*)(p.ws + WS_U);
    const float* cw = p.conv_w + (size_t)l * 4 * 2048;
    bf16* QKC = (bf16*)(p.ws + WS_QKC);
    for (int gid = blockIdx.x * NTHR + tid; gid < 256 * 512; gid += gridDim.x * NTHR) {
        const int cidx = gid & 255, t0 = (gid >> 8) * 16;
        f32x4 w[4][2];
#pragma unroll
        for (int j = 0; j < 4; ++j) { w[j][0] = *(const f32x4*)(cw + j * 2048 + cidx * 8); w[j][1] = *(const f32x4*)(cw + j * 2048 + cidx * 8 + 4); }
        const bf16* src = U + C_QM + cidx * 8;
        u32x4 raw[19];
#pragma unroll
        for (int i = 0; i < 19; ++i) { const int tt = t0 - 3 + i; const int tc = tt < 0 ? 0 : tt; raw[i] = *(const u32x4*)(src + (size_t)tc * NU); if (tt < 0) raw[i] = (u32x4){0u, 0u, 0u, 0u}; }
        const float sc = cidx >= 128 ? 0.0625f : 1.f;
#pragma unroll
        for (int i = 0; i < 16; ++i) {
            float f[8];
#pragma unroll
            for (int e = 0; e < 8; ++e) f[e] = 0.f;
#pragma unroll
            for (int j = 0; j < 4; ++j) { const u32x4 rw = raw[i + j];
                f[0] += w[j][0][0] * bf_lo(rw.x); f[1] += w[j][0][1] * bf_hi(rw.x); f[2] += w[j][0][2] * bf_lo(rw.y); f[3] += w[j][0][3] * bf_hi(rw.y);
                f[4] += w[j][1][0] * bf_lo(rw.z); f[5] += w[j][1][1] * bf_hi(rw.z); f[6] += w[j][1][2] * bf_lo(rw.w); f[7] += w[j][1][3] * bf_hi(rw.w); }
#pragma unroll
            for (int e = 0; e < 8; ++e) f[e] = silu_f(f[e]) * sc;
            u32x4 o; o.x = pk2(f[0], f[1]); o.y = pk2(f[2], f[3]); o.z = pk2(f[4], f[5]); o.w = pk2(f[6], f[7]);
            *(u32x4*)(QKC + (size_t)(t0 + i) * 2048 + cidx * 8) = o; }
    }
}
DI void chunk_gates(const float* gates, int c, int hh, LAS float* bS, LAS float* liS, LAS float* wtot, int tid, int wave, int lane) {
    float v = 0.f;
    if (tid < 256) { const float* gp = gates + (size_t)(c * 256 + tid) * 8; const float fgv = gp[4 + hh]; liS[tid] = gp[hh];
        v = fminf(fgv, 0.f) - log1pf(__expf(-fabsf(fgv)));
#pragma unroll
        for (int o = 1; o < 64; o <<= 1) { const float t = __shfl_up(v, o); if (lane >= o) v += t; }
        if (lane == 63) wtot[wave] = v; }
    __syncthreads();
    if (tid < 256) { float pre = 0.f; for (int w = 0; w < wave; ++w) pre += wtot[w]; bS[tid] = v + pre; }
    __syncthreads();
}
DI void m1_item(const Params& p, LAS unsigned char* lds, int l, int item, int tid, int wave, int lane) {
    const bf16* U = (const bf16*)(p.ws + WS_U);
    const bf16* QKC = (const bf16*)(p.ws + WS_QKC);
    LAS unsigned short* Kp = (LAS unsigned short*)lds;
    LAS unsigned short* Vs = Kp + 128 * M_KS;
    LAS float* bS = (LAS float*)(Vs + 128 * AT_KS); LAS float* liS = bS + 256; LAS float* wtot = liS + 256;
    const int hh = item >> 7, c = (item >> 2) & 31, sl = item & 3;
    const int ql = lane & 15, quad = lane >> 4;
    chunk_gates((const float*)(p.ws + WS_GATES), c, hh, bS, liS, wtot, tid, wave, lane);
    const float bL = bS[255];
    f32x4 acc[4][4];
#pragma unroll
    for (int a = 0; a < 4; ++a)
#pragma unroll
        for (int b = 0; b < 4; ++b) acc[a][b] = (f32x4){0.f, 0.f, 0.f, 0.f};
    f32x4 nacc[4];
#pragma unroll
    for (int b = 0; b < 4; ++b) nacc[b] = (f32x4){0.f, 0.f, 0.f, 0.f};
    const bool do_n = (sl == 0) && ((wave & 1) == 0);
    const bf16x8 ones = {0x3F80, 0x3F80, 0x3F80, 0x3F80, 0x3F80, 0x3F80, 0x3F80, 0x3F80};
    const int dvt0 = (wave & 1) * 4, dkt0 = (wave >> 1) * 4;
    for (int half = 0; half < 2; ++half) {
#pragma unroll
        for (int ib = 0; ib < 8; ib += 4) { u32x4 kr[4];
#pragma unroll
            for (int i = 0; i < 4; ++i) { const int cc = tid + NTHR * (ib + i), row = cc >> 5, ch = cc & 31; kr[i] = *(const u32x4*)(QKC + (size_t)(c * 256 + half * 128 + row) * 2048 + 1024 + hh * 256 + ch * 8); }
#pragma unroll
            for (int i = 0; i < 4; ++i) { const int cc = tid + NTHR * (ib + i), row = cc >> 5, ch = cc & 31, sloc = half * 128 + row;
                const float wgt = __expf(bL - bS[sloc] + liS[sloc]);
                u32x4 w; w.x = pk2(bf_lo(kr[i].x) * wgt, bf_hi(kr[i].x) * wgt); w.y = pk2(bf_lo(kr[i].y) * wgt, bf_hi(kr[i].y) * wgt); w.z = pk2(bf_lo(kr[i].z) * wgt, bf_hi(kr[i].z) * wgt); w.w = pk2(bf_lo(kr[i].w) * wgt, bf_hi(kr[i].w) * wgt);
                *(LAS u32x4*)(Kp + row * M_KS + ch * 8) = w; } }
#pragma unroll
        for (int i = 0; i < 4; ++i) { const int cc = tid + NTHR * i, row = cc >> 4, ch = cc & 15;
            *(LAS u32x4*)(Vs + row * AT_KS + ch * 8) = *(const u32x4*)(U + (size_t)(c * 256 + half * 128 + row) * NU + C_VM + hh * 512 + sl * 128 + ch * 8); }
        __syncthreads();
#pragma unroll 1
        for (int ks = 0; ks < 4; ++ks) {
            bf16x8 af[4], bfr[4];
#pragma unroll
            for (int a = 0; a < 4; ++a) af[a] = trfrag(Vs + (ks * 32 + quad * 8) * AT_KS + (dvt0 + a) * 16, AT_KS, ql);
#pragma unroll
            for (int b = 0; b < 4; ++b) bfr[b] = trfrag(Kp + (ks * 32 + quad * 8) * M_KS + (dkt0 + b) * 16, M_KS, ql);
#pragma unroll
            for (int a = 0; a < 4; ++a)
#pragma unroll
                for (int b = 0; b < 4; ++b) acc[a][b] = mfma16(af[a], bfr[b], acc[a][b]);
            if (do_n) {
#pragma unroll
                for (int b = 0; b < 4; ++b) nacc[b] = mfma16(ones, bfr[b], nacc[b]); }
        }
        __syncthreads();
    }
    float* DC = (float*)(p.ws + WS_DC) + ((size_t)(hh * 32 + c) * 512 + sl * 128) * 256;
#pragma unroll
    for (int a = 0; a < 4; ++a)
#pragma unroll
        for (int b = 0; b < 4; ++b)
#pragma unroll
            for (int j = 0; j < 4; ++j) DC[(size_t)((dvt0 + a) * 16 + quad * 4 + j) * 256 + (dkt0 + b) * 16 + ql] = acc[a][b][j];
    if (do_n && quad == 0) {
#pragma unroll
        for (int b = 0; b < 4; ++b) ((float*)(p.ws + WS_DN))[(hh * 32 + c) * 256 + (dkt0 + b) * 16 + ql] = nacc[b][0]; }
    if (sl == 0 && tid == 0) ((float*)(p.ws + WS_BL))[hh * 32 + c] = bL;
}
DI void m2_phase(const Params& p, int tid) {
    const float* DC = (const float*)(p.ws + WS_DC); const float* BL = (const float*)(p.ws + WS_BL);
    bf16* CS = (bf16*)(p.ws + WS_CS);
    const int gthreads = gridDim.x * NTHR, gid = blockIdx.x * NTHR + tid;
    for (int e4 = gid; e4 < 4 * 32768; e4 += gthreads) {
        const int hh = e4 >> 15, e = e4 & 32767;
        f32x4 st = {0.f, 0.f, 0.f, 0.f};
#pragma unroll 8
        for (int c = 0; c < 32; ++c) {
            const size_t o = ((size_t)(hh * 32 + c) * 32768 + e) * 4;
            u32x2 w; w.x = pk2(st.x, st.y); w.y = pk2(st.z, st.w); *(u32x2*)(CS + o) = w;
            const f32x4 d = *(const f32x4*)(DC + o);
            st = st * __expf(BL[hh * 32 + c]) + d;
        }
    }
    if (gid < 1024) { const int hh = gid >> 8, dk = gid & 255; const float* DN = (const float*)(p.ws + WS_DN); float* NS = (float*)(p.ws + WS_NS);
        float st = 0.f;
        for (int c = 0; c < 32; ++c) { NS[(hh * 32 + c) * 256 + dk] = st; st = st * __expf(BL[hh * 32 + c]) + DN[(hh * 32 + c) * 256 + dk]; } }
}
DI void m3_item(const Params& p, LAS unsigned char* lds, int l, int hh, int qb, int tid, int wave, int lane) {
    const bf16* U = (const bf16*)(p.ws + WS_U);
    const bf16* QKC = (const bf16*)(p.ws + WS_QKC);
    LAS unsigned short* Qs = (LAS unsigned short*)lds;
    LAS unsigned short* Ks = Qs + 64 * M_KS;
    LAS unsigned short* Vs = Ks + 64 * M_KS;
    LAS float* bS = (LAS float*)(Vs + 64 * M_VS3); LAS float* liS = bS + 256; LAS float* nS = liS + 256; LAS float* wtot = nS + 256; LAS float* ssS = wtot + 8;
    const int c = qb >> 2, jq = qb & 3;
    const int ql = lane & 15, quad = lane >> 4;
    if (tid < 256) nS[tid] = ((const float*)(p.ws + WS_NS))[(hh * 32 + c) * 256 + tid];
    chunk_gates((const float*)(p.ws + WS_GATES), c, hh, bS, liS, wtot, tid, wave, lane);
    { u32x4 qv[4];
#pragma unroll
      for (int i = 0; i < 4; ++i) { const int cc = tid + NTHR * i, row = cc >> 5, ch = cc & 31; qv[i] = *(const u32x4*)(QKC + (size_t)(qb * 64 + row) * 2048 + hh * 256 + ch * 8); }
#pragma unroll
      for (int i = 0; i < 4; ++i) { const int cc = tid + NTHR * i, row = cc >> 5, ch = cc & 31; *(LAS u32x4*)(Qs + row * M_KS + ch * 8) = qv[i]; } }
    __syncthreads();
    const int qg = wave & 3, dvh = wave >> 2, q = qg * 16 + ql, iq = jq * 64 + q;
    bf16x8 qf[8];
#pragma unroll
    for (int ks = 0; ks < 8; ++ks) qf[ks] = *(const LAS bf16x8*)(Qs + q * M_KS + ks * 32 + quad * 8);
    const float b_q = bS[iq], eb = __expf(b_q);
    f32x4 acc[16];
#pragma unroll
    for (int nt = 0; nt < 16; ++nt) acc[nt] = (f32x4){0.f, 0.f, 0.f, 0.f};
    { const bf16* CT = (const bf16*)(p.ws + WS_CS) + (size_t)(hh * 32 + c) * 512 * 256;
      LAS unsigned short* Cs = Ks;
#pragma unroll 1
      for (int pc = 0; pc < 4; ++pc) {
          __syncthreads();
          u32x4 cv[8];
#pragma unroll
          for (int i = 0; i < 8; ++i) { const int cc = tid + NTHR * i, row = cc >> 5, ch = cc & 31;
              cv[i] = *(const u32x4*)(CT + (size_t)((row >> 6) * 256 + pc * 64 + (row & 63)) * 256 + ch * 8); }
#pragma unroll
          for (int i = 0; i < 8; ++i) { const int cc = tid + NTHR * i, row = cc >> 5, ch = cc & 31; *(LAS u32x4*)(Cs + row * M_KS + ch * 8) = cv[i]; }
          __syncthreads();
#pragma unroll
          for (int n4 = 0; n4 < 4; ++n4) { const LAS unsigned short* cp = Cs + (dvh * 64 + n4 * 16 + ql) * M_KS + quad * 8;
#pragma unroll
              for (int ks = 0; ks < 8; ++ks) acc[n4] = mfma16(*(const LAS bf16x8*)(cp + ks * 32), qf[ks], acc[n4]); }
          { const f32x4 t0 = acc[0], t1 = acc[1], t2 = acc[2], t3 = acc[3];
#pragma unroll
            for (int i = 0; i < 12; ++i) acc[i] = acc[i + 4];
            acc[12] = t0; acc[13] = t1; acc[14] = t2; acc[15] = t3; }
      }
    }
#pragma unroll
    for (int nt = 0; nt < 16; ++nt) acc[nt] = acc[nt] * eb;
    float nqp = 0.f;
#pragma unroll
    for (int ks = 0; ks < 8; ++ks)
#pragma unroll
        for (int j = 0; j < 8; ++j) nqp += bf2f((unsigned short)qf[ks][j]) * nS[ks * 32 + quad * 8 + j];
    float nq = quad_sum(nqp) * eb;
    float nqi = 0.f;
    for (int kt = 0; kt <= jq; ++kt) {
        __syncthreads();
        int tid2 = tid; asm volatile("" : "+v"(tid2));
#pragma unroll
        for (int ib = 0; ib < 8; ib += 4) { u32x4 vv[4];
#pragma unroll
            for (int i = 0; i < 4; ++i) { const int cc = tid2 + NTHR * (ib + i), row = cc >> 6, ch = cc & 63; vv[i] = *(const u32x4*)(U + (size_t)(c * 256 + kt * 64 + row) * NU + C_VM + hh * 512 + ch * 8); }
#pragma unroll
            for (int i = 0; i < 4; ++i) { const int cc = tid2 + NTHR * (ib + i), row = cc >> 6, ch = cc & 63; *(LAS u32x4*)(Vs + row * M_VS3 + ch * 8) = vv[i]; }
            __builtin_amdgcn_sched_barrier(0); }
        { u32x4 kv[4];
#pragma unroll
          for (int i = 0; i < 4; ++i) { const int cc = tid2 + NTHR * i, row = cc >> 5, ch = cc & 31; kv[i] = *(const u32x4*)(QKC + (size_t)(c * 256 + kt * 64 + row) * 2048 + 1024 + hh * 256 + ch * 8); }
#pragma unroll
          for (int i = 0; i < 4; ++i) { const int cc = tid2 + NTHR * i, row = cc >> 5, ch = cc & 31; *(LAS u32x4*)(Ks + row * M_KS + ch * 8) = kv[i]; } }
        __syncthreads();
        f32x4 sacc[4];
#pragma unroll
        for (int t = 0; t < 4; ++t) sacc[t] = (f32x4){0.f, 0.f, 0.f, 0.f};
#pragma unroll
        for (int s = 0; s < 2; ++s)
#pragma unroll
            for (int u = 0; u < 2; ++u) { const int krow = 32 * s + (ql >> 2) * 8 + u * 4 + (ql & 3);
                const LAS unsigned short* kp = Ks + krow * M_KS + quad * 8;
#pragma unroll
                for (int ks = 0; ks < 8; ++ks) sacc[2 * s + u] = mfma16(*(const LAS bf16x8*)(kp + ks * 32), qf[ks], sacc[2 * s + u]); }
#pragma unroll
        for (int s = 0; s < 2; ++s)
#pragma unroll
            for (int u = 0; u < 2; ++u)
#pragma unroll
                for (int j = 0; j < 4; ++j) { const int sk = kt * 64 + 32 * s + quad * 8 + u * 4 + j;
                    const float w = (sk <= iq) ? __expf(b_q - bS[sk] + liS[sk]) : 0.f;
                    const float pv = sacc[2 * s + u][j] * w; sacc[2 * s + u][j] = pv; nqi += pv; }
#pragma unroll
        for (int s = 0; s < 2; ++s) {
            u32x4 pw; pw.x = pk2(sacc[2 * s][0], sacc[2 * s][1]); pw.y = pk2(sacc[2 * s][2], sacc[2 * s][3]); pw.z = pk2(sacc[2 * s + 1][0], sacc[2 * s + 1][1]); pw.w = pk2(sacc[2 * s + 1][2], sacc[2 * s + 1][3]);
            const bf16x8 pf = __builtin_bit_cast(bf16x8, pw);
            const LAS unsigned short* vp = Vs + (32 * s + quad * 8) * M_VS3 + dvh * 256;
#pragma unroll
            for (int nt = 0; nt < 16; ++nt) acc[nt] = mfma16(trfrag(vp + nt * 16, M_VS3, ql), pf, acc[nt]);
        }
    }
    nq += quad_sum(nqi);
    const float inv = 1.f / fmaxf(fabsf(nq), 1.f);
    float ss = 0.f;
#pragma unroll
    for (int nt = 0; nt < 16; ++nt) { acc[nt] = acc[nt] * inv; ss += (acc[nt][0] * acc[nt][0] + acc[nt][1] * acc[nt][1]) + (acc[nt][2] * acc[nt][2] + acc[nt][3] * acc[nt][3]); }
    ss = quad_sum(ss);
    if (quad == 0) ssS[dvh * 64 + q] = ss;
    __syncthreads();
    const float rstd = rsqrtf((ssS[q] + ssS[64 + q]) * (1.f / 512.f) + NORM_EPS);
    const int t = qb * 64 + q;
    const float* ng = p.mnorm_g + l * 2048;
    bf16* Y = (bf16*)(p.ws + WS_Y);
#pragma unroll
    for (int nt = 0; nt < 16; ++nt) { const int col = hh * 512 + dvh * 256 + nt * 16 + quad * 4;
        const f32x4 g4 = *(const f32x4*)(ng + col);
        const u32x2 om = *(const u32x2*)(U + (size_t)t * NU + C_OM + col), zm = *(const u32x2*)(U + (size_t)t * NU + C_ZM + col);
        const float y0 = acc[nt][0] * rstd * g4[0] * sigm_f(bf_lo(om.x)) * silu_f(bf_lo(zm.x));
        const float y1 = acc[nt][1] * rstd * g4[1] * sigm_f(bf_hi(om.x)) * silu_f(bf_hi(zm.x));
        const float y2 = acc[nt][2] * rstd * g4[2] * sigm_f(bf_lo(om.y)) * silu_f(bf_lo(zm.y));
        const float y3 = acc[nt][3] * rstd * g4[3] * sigm_f(bf_hi(om.y)) * silu_f(bf_hi(zm.y));
        u32x2 w; w.x = pk2(y0, y1); w.y = pk2(y2, y3);
        *(u32x2*)(Y + (size_t)t * DM + 2048 + col) = w;
        if ((nt & 3) == 3) __builtin_amdgcn_sched_barrier(0); }
    __syncthreads();
}

#define RLX_AGENT __ATOMIC_RELAXED, __HIP_MEMORY_SCOPE_AGENT
#define XB_TMO      128
#define XB_XCNT(j)  (256  + 64 * (j))
#define XB_XSUB(j)  (1280 + 64 * (j))
#define XB_XGEN(j)  (2304 + 64 * (j))
#define XB_TOP      3328
#define XB_TOPGEN   3392
#define XCD_BAR_WORDS 3456
#define XB_SPIN_CAP (1u << 18)

__device__ __forceinline__ unsigned xb_ld(unsigned* p)              { return __hip_atomic_load(p, __ATOMIC_RELAXED, __HIP_MEMORY_SCOPE_AGENT); }
__device__ __forceinline__ unsigned xb_add(unsigned* p, unsigned v) { return __hip_atomic_fetch_add(p, v, __ATOMIC_RELAXED, __HIP_MEMORY_SCOPE_AGENT); }
__device__ __forceinline__ unsigned xb_xcc_id() { return (unsigned)__builtin_amdgcn_s_getreg((3 << 11) | 20) & 0xFu; }
#define XB_SPIN(cond, bar) do { unsigned _sp = 0; while (cond) { __builtin_amdgcn_s_sleep(1); \
    if ((++_sp & 255u) == 0u) { if (xb_ld(&(bar)[XB_TMO])) break; if (_sp > XB_SPIN_CAP) { atomicAdd(&(bar)[XB_TMO], 1u); break; } } } } while (0)

struct XcdBarrier {
    unsigned* bar; unsigned x;
    volatile LAS unsigned* st;
};

__device__ __forceinline__ XcdBarrier xcd_barrier_post(unsigned* bar, volatile LAS unsigned* st) {
    XcdBarrier b; b.bar = bar; b.x = xb_xcc_id(); b.st = st;
    if (threadIdx.x == 0) (void)xb_add(&bar[XB_XCNT(b.x)], 1u);
    return b;
}
__device__ __forceinline__ void xcd_barrier_complete(unsigned* bar, unsigned x, unsigned& nloc, unsigned& nx) {
    const unsigned G = gridDim.x * gridDim.y * gridDim.z;
    unsigned sum, cnt, mine, sp = 0u;
    for (;;) {
        sum = 0u; cnt = 0u; mine = 0u;
#pragma unroll
        for (unsigned j = 0; j < 16; ++j) { const unsigned c = xb_ld(&bar[XB_XCNT(j)]); sum += c; cnt += (c > 0u) ? 1u : 0u; mine = (j == x) ? c : mine; }
        if (sum == G) break;
        __builtin_amdgcn_s_sleep(1);
        if ((++sp & 255u) == 0u) { if (xb_ld(&bar[XB_TMO])) break; if (sp > XB_SPIN_CAP) { atomicAdd(&bar[XB_TMO], 1u); break; } }
    }
    nloc = mine > 0u ? mine : 1u; nx = cnt > 0u ? cnt : 1u;
}

__device__ __forceinline__ void xcd_barrier(const XcdBarrier& b) {
    asm volatile("s_waitcnt vmcnt(0)" ::: "memory");
    __syncthreads();
    if (threadIdx.x == 0) {
        unsigned* bar = b.bar;
        __builtin_amdgcn_s_waitcnt(0);
        unsigned nloc = b.st[0], nx = b.st[1];
        if (nloc == 0u) { xcd_barrier_complete(bar, b.x, nloc, nx); b.st[0] = nloc; b.st[1] = nx; }
        const unsigned old = xb_add(&bar[XB_XSUB(b.x)], 1u);
        const unsigned gen = old / nloc;
        if (old + 1u == (gen + 1u) * nloc) {
            __builtin_amdgcn_fence(__ATOMIC_RELEASE, "agent");
            asm volatile("s_waitcnt vmcnt(0)" ::: "memory");
            const unsigned og = xb_add(&bar[XB_TOP], 1u);
            const unsigned tg = og / nx;
            if (og + 1u == (tg + 1u) * nx) xb_add(&bar[XB_TOPGEN], 1u);
            else XB_SPIN(xb_ld(&bar[XB_TOPGEN]) == tg, bar);
            __builtin_amdgcn_fence(__ATOMIC_ACQUIRE, "agent");
            xb_add(&bar[XB_XGEN(b.x)], 1u);
            asm volatile("s_waitcnt vmcnt(0)" ::: "memory");
        } else {
            XB_SPIN(xb_ld(&bar[XB_XGEN(b.x)]) == gen, bar);
            __builtin_amdgcn_fence(__ATOMIC_ACQUIRE, "agent");
            asm volatile("s_waitcnt vmcnt(0)" ::: "memory");
        }
    }
    __syncthreads();
}

#if TSEL >= 7
#define TSUB_BEGIN(k) unsigned long long tsub_b = 0; if ((TSEL) == (k) && threadIdx.x == 0) tsub_b = __builtin_amdgcn_s_memrealtime();
#define TSUB_END(k) if ((TSEL) == (k) && threadIdx.x == 0) { volatile LAS unsigned long long* TWs = (volatile LAS unsigned long long*)((LAS unsigned char*)lds_raw + LDS_BARST + 16); TWs[2] += __builtin_amdgcn_s_memrealtime() - tsub_b; }
#else
#define TSUB_BEGIN(k)
#define TSUB_END(k)
#endif
constexpr int NPH = 15;
__global__ void __launch_bounds__(NTHR, 2) hymba_fwd(Params p0) {
    extern __shared__ __attribute__((aligned(16))) unsigned char lds_raw[];
    cg::grid_group grid = cg::this_grid();
    const int G = gridDim.x;
    if (threadIdx.x < 16) ((LAS unsigned*)((LAS unsigned char*)lds_raw + LDS_BARST))[threadIdx.x] = 0u;
    __syncthreads();
    XcdBarrier bar = xcd_barrier_post((unsigned*)(p0.ws + WS_CTL), (volatile LAS unsigned*)((LAS unsigned char*)lds_raw + LDS_BARST));
#if TSEL >= 0
    volatile LAS unsigned long long* TW = (volatile LAS unsigned long long*)((LAS unsigned char*)lds_raw + LDS_BARST + 16);
    if (threadIdx.x == 0) { const unsigned long long t = __builtin_amdgcn_s_memrealtime(); TW[0] = t; TW[1] = t; TW[2] = 0; }
#endif
    for (int ph = p0.ph_lo; ph < p0.ph_hi; ++ph) {
        const int ptype = ph == 0 ? 0 : 1 + (ph - 1) % 7;
        const int nrep = (REPEAT_MASK) == 0 ? 1 : ((((REPEAT_MASK) >> ptype) & 1) ? 2 : 1);
        for (int rep = 0; rep < nrep; ++rep) {
        int tid = threadIdx.x; asm volatile("" : "+v"(tid));
        const int lane = tid & 63, wave = __builtin_amdgcn_readfirstlane(tid >> 6);
        LAS unsigned char* lds = (LAS unsigned char*)lds_raw; asm volatile("" : "+s"(lds));
        Params p = p0;
        asm volatile("" : "+s"(p.ws)); asm volatile("" : "+s"(p.x)); asm volatile("" : "+s"(p.out)); asm volatile("" : "+s"(p.w_in)); asm volatile("" : "+s"(p.w_out));
        asm volatile("" : "+s"(p.conv_w)); asm volatile("" : "+s"(p.norm_g)); asm volatile("" : "+s"(p.mnorm_g)); asm volatile("" : "+s"(p.b_gate)); asm volatile("" : "+s"(p.rel_bias)); asm volatile("" : "+s"(p.final_g));
        if (ph == 0) {
            prologue_transposes(p, lds, wave, lane);
            __syncthreads();
            norm_gates_phase(p, lds, p.x, 0, tid, wave, lane);
        } else {
            const int l = (ph - 1) / 7, k = (ph - 1) % 7;
            if (k == 0) {
                pg8::Gemm g{(const pg8::bf16_t*)(p.ws + WS_XN), (const pg8::bf16_t*)(p.ws + WS_WIN + (size_t)l * 128 * MiB), SEQ, NU, DM};
                pg8::StaticOrder S; S.init(SEQ, NU, G, (int)blockIdx.x);
                pg8::EpiBf16Plain E{(pg8::bf16_t*)(p.ws + WS_U), NU};
                pg8::gemm_phase<pg8::EpiBf16Plain, pg8::StaticOrder, true, true>(lds, g, S, E);
            } else if (k == 1) {
                conv_prepass(p, l, tid);
                const bool xmap = (G == 256); const int xcd = blockIdx.x & 7, xi = blockIdx.x >> 3;
                { TSUB_BEGIN(7)
                for (int rr = 0; rr < 1 + (REP_ATTN); ++rr)
                for (int it = blockIdx.x, rnd = 0; it < 3072; it += G, ++rnd) {
                    int item = it;
                    if (xmap) { const int h = 2 * xcd + rnd / 6, j = (rnd % 6) * 32 + xi; item = (j >> 6) * 1024 + h * 64 + (j & 63); }
                    attn_item(p, lds, item, tid, wave, lane); }
                TSUB_END(7) }
            } else if (k == 2) {
                const bool xmap = (G == 256); const int xcd = blockIdx.x & 7, xi = blockIdx.x >> 3;
                int tid3 = tid; asm volatile("" : "+v"(tid3));
                { TSUB_BEGIN(8)
                for (int rr = 0; rr < 1 + (REP_M1); ++rr)
                for (int it = blockIdx.x, rnd = 0; it < 512; it += G, ++rnd) {
                    int item = it;
                    if (xmap) item = (xcd * 16 + rnd * 8 + (xi >> 2)) * 4 + (xi & 3);
                    m1_item(p, lds, l, item, tid3, __builtin_amdgcn_readfirstlane(tid3 >> 6), tid3 & 63); __syncthreads(); }
                TSUB_END(8) }
                merge_phase(p, tid);
            } else if (k == 3) {
                m2_phase(p, tid);
            } else if (k == 4) {
                const bool xmap = (G == 256); const int xcd = blockIdx.x & 7, xi = blockIdx.x >> 3;
                TSUB_BEGIN(9)
                for (int it = blockIdx.x, rnd = 0; it < 512; it += G, ++rnd) {
                    int hh = it >> 7, qb = it & 127; if ((it >> 8) & 1) qb ^= 3;
                    if (xmap) { const int pair = xcd * 16 + rnd * 8 + (xi >> 2); hh = pair >> 5; qb = (pair & 31) * 4 + (rnd ? 3 - (xi & 3) : (xi & 3)); }
                    m3_item(p, lds, l, hh, qb, tid, wave, lane); }
                TSUB_END(9)
            } else if (k == 5) {
                pg8::Gemm g{(const pg8::bf16_t*)(p.ws + WS_Y), (const pg8::bf16_t*)(p.ws + WS_WOUT + (size_t)l * 32 * MiB), SEQ, DM, DM};
                pg8::StaticOrder S; S.init(SEQ, DM, G, (int)blockIdx.x);
                pg8::EpiResF32 E{l == 0 ? p.x : (const float*)(p.ws + WS_X1), l == 0 ? (float*)(p.ws + WS_X1) : p.out, DM};
                pg8::gemm_phase<pg8::EpiResF32, pg8::StaticOrder, true, true>(lds, g, S, E);
            } else {
                if (l == 0) norm_gates_phase(p, lds, (const float*)(p.ws + WS_X1), 1, tid, wave, lane);
                else final_norm_phase(p, (LAS unsigned char*)lds_raw, wave, lane);
            }
        }
        __syncthreads();
        }
        if (ph + 1 < p0.ph_hi) { if (p0.ph_hi > NPH) grid.sync(); else xcd_barrier(bar); }
#if TSEL >= 0
        if (threadIdx.x == 0) { const unsigned long long now = __builtin_amdgcn_s_memrealtime(); if (ptype == (TSEL)) TW[2] += now - TW[1]; TW[1] = now;
          if (ph + 2 == p0.ph_hi) ((volatile LAS int*)TW)[8] = (int)((float)TW[2] / (float)(now - TW[0]) * 131072.f); }
        if (ph + 2 == p0.ph_hi) __syncthreads();
#endif
    }
}

extern "C" void kernel_launch(void* const* d_in, const int* in_sizes, int n_in, void* d_out, int out_size, void* d_ws, size_t ws_size, hipStream_t stream) {
    static int grid = 0;
    if (grid == 0) {
        if (n_in != 9 || in_sizes[0] != SEQ * DM || out_size != SEQ * DM || ws_size < WS_END) {
            fprintf(stderr, "kernel_launch: unexpected problem: n_in %d in0 %d out %d ws %zu (need %zu)\n", n_in, n_in > 0 ? in_sizes[0] : -1, out_size, ws_size, (size_t)WS_END); grid = -1; return; }
        int dev = 0, cus = 0, per_cu = 0;
        hipGetDevice(&dev);
        hipDeviceGetAttribute(&cus, hipDeviceAttributeMultiprocessorCount, dev);
        if (hipFuncSetAttribute((const void*)hymba_fwd, hipFuncAttributeMaxDynamicSharedMemorySize, LDS_BYTES) != hipSuccess) { fprintf(stderr, "kernel_launch: hipFuncSetAttribute failed\n"); grid = -1; return; }
        if (hipOccupancyMaxActiveBlocksPerMultiprocessor(&per_cu, (const void*)hymba_fwd, NTHR, LDS_BYTES) != hipSuccess || per_cu < 1) { fprintf(stderr, "kernel_launch: occupancy query gave %d\n", per_cu); per_cu = 1; }
        (void)hipGetLastError();
        grid = cus * per_cu;
        fprintf(stderr, "kernel_launch: %d CUs x %d = grid %d\n", cus, per_cu, grid);
    }
    if (grid < 0) return;
    if (hipMemsetAsync((char*)d_ws + WS_CTL, 0, 16384, stream) != hipSuccess) { fprintf(stderr, "kernel_launch: hipMemsetAsync failed\n"); return; }
    Params p{};
    p.x = (const float*)d_in[0]; p.norm_g = (const float*)d_in[1]; p.w_in = (const float*)d_in[2]; p.b_gate = (const float*)d_in[3]; p.conv_w = (const float*)d_in[4];
    p.mnorm_g = (const float*)d_in[5]; p.w_out = (const float*)d_in[6]; p.rel_bias = (const float*)d_in[7]; p.final_g = (const float*)d_in[8];
    p.out = (float*)d_out; p.ws = (unsigned char*)d_ws;
#if MULTI_LAUNCH
    for (int ph = 0; ph < NPH; ++ph) { p.ph_lo = ph; p.ph_hi = ph + 1; hipLaunchKernelGGL(hymba_fwd, dim3(grid), dim3(NTHR), LDS_BYTES, stream, p); }
#else
    p.ph_lo = 0; p.ph_hi = NPH;
    void* args[] = {&p};
    hipError_t e = hipLaunchCooperativeKernel((const void*)hymba_fwd, dim3(grid), dim3(NTHR), args, LDS_BYTES, stream);
    if (e != hipSuccess) fprintf(stderr, "kernel_launch: cooperative launch failed: %s (grid %d)\n", hipGetErrorString(e), grid);
#endif
}
```

```cpp
#include <hip/hip_runtime.h>
#include <hip/hip_cooperative_groups.h>
#include <cstdio>
#include <cstdint>
namespace cg = cooperative_groups;
namespace pg8 {
#define PG8_LAS __attribute__((address_space(3)))
typedef unsigned short bf16_t;
typedef short bf16x8 __attribute__((ext_vector_type(8)));
typedef float f32x4 __attribute__((ext_vector_type(4)));
typedef unsigned u32x4 __attribute__((ext_vector_type(4)));
constexpr int BM = 256, BK = 64, HALF = 128, HTB = HALF * BK * 2  , STAGE_BYTES = 8 * HTB, NXCD = 8, WGM = 8;

__host__ __device__ __forceinline__ int lds_byte(int r, int c) { const int st = (r >> 4) * 2 + (c >> 5), rr = r & 15, cc = c & 31, ob = rr * 64 + cc * 2; return st * 1024 + (ob ^ (((ob >> 9) & 1) << 5)); }
__host__ __device__ __forceinline__ void stage_rc(int b, int& R, int& C) { const int st = b / 1024, sb = b % 1024, swz = sb ^ (((sb >> 9) & 1) << 5); R = (st >> 1) * 16 + swz / 64; C = (st & 1) * 32 + (swz % 64) / 2; }
__host__ __device__ __forceinline__ int perm32(int rho) { const int n = rho >> 4, i = rho & 15; return 8 * (i >> 2) + 4 * n + (i & 3); }

struct Unit { int pm, pn; };
struct Gemm { const bf16_t* A; const bf16_t* Bt; int M, N, K; };

struct StaticOrder {
    int nM, nN, nwg, G, c;
    __host__ __device__ void init(int M, int N, int G_, int c_) { nM = M / BM; nN = N / BM; nwg = nM * nN; G = G_; c = c_; }
    __host__ __device__ bool next(int i, Unit& u) const {
        const long L = (long)i * G + c; if (L >= nwg) return false;
        int wgid = (int)L; { const int q = nwg / NXCD, r = nwg % NXCD, xcd = wgid % NXCD, off = wgid / NXCD; wgid = (xcd < r ? xcd * (q + 1) : r * (q + 1) + (xcd - r) * q) + off; }
        const int nig = WGM * nN, gid = wgid / nig, fm = gid * WGM, gsz = (nM - fm) < WGM ? (nM - fm) : WGM;
        u.pm = fm + ((wgid % nig) % gsz); u.pn = (wgid % nig) / gsz; return true;
    }
    __device__ __forceinline__ void a_ready(const Unit&) const {}
    __device__ __forceinline__ void done(const Unit&) const {}
};

__device__ __forceinline__ unsigned cvt_pk_bf16(float lo, float hi) { unsigned r; asm volatile("v_cvt_pk_bf16_f32 %0, %1, %2" : "=v"(r) : "v"(lo), "v"(hi)); return r; }
struct EpiBf16Plain {
    static constexpr bool PERM = true, AFTER_DRAIN = false;
    bf16_t* O; int ldc;
    __device__ __forceinline__ void operator()(const f32x4 (&acc)[2][2][4][2], const Unit& u, int wr, int wc, int fr, int fq) const {
        const int row0 = u.pm * BM + wr * 64 + fr; const int col0 = u.pn * BM + wc * 32 + 8 * fq;
#pragma unroll
        for (int ai = 0; ai < 2; ++ai)
#pragma unroll
            for (int m = 0; m < 4; ++m) { bf16_t* rowp = O + (size_t)(row0 + ai * HALF + m * 16) * ldc + col0;
#pragma unroll
                for (int bj = 0; bj < 2; ++bj) { const f32x4 v0 = acc[ai][bj][m][0], v1 = acc[ai][bj][m][1];
                    u32x4 w; w.x = cvt_pk_bf16(v0[0], v0[1]); w.y = cvt_pk_bf16(v0[2], v0[3]); w.z = cvt_pk_bf16(v1[0], v1[1]); w.w = cvt_pk_bf16(v1[2], v1[3]);
                    *(u32x4*)(rowp + bj * HALF) = w; } }
    }
};
struct EpiResF32 {
    static constexpr bool PERM = true, AFTER_DRAIN = false;
    const float* base; float* out; int ld;
    __device__ __forceinline__ void operator()(const f32x4 (&acc)[2][2][4][2], const Unit& u, int wr, int wc, int fr, int fq) const {
        const int row0 = u.pm * BM + wr * 64 + fr; const int col0 = u.pn * BM + wc * 32 + 8 * fq;
#pragma unroll
        for (int ai = 0; ai < 2; ++ai)
#pragma unroll
            for (int m = 0; m < 4; ++m) { const size_t ro = (size_t)(row0 + ai * HALF + m * 16) * ld + col0;
#pragma unroll
                for (int bj = 0; bj < 2; ++bj) {
                    const f32x4 b0 = *(const f32x4*)(base + ro + bj * HALF), b1 = *(const f32x4*)(base + ro + bj * HALF + 4);
                    *(f32x4*)(out + ro + bj * HALF) = acc[ai][bj][m][0] + b0;
                    *(f32x4*)(out + ro + bj * HALF + 4) = acc[ai][bj][m][1] + b1; } }
    }
};
template <class Epi, class Sched, bool ALIGN_EPI = false, bool SP2 = false>
__device__ __forceinline__ void gemm_phase(PG8_LAS unsigned char* lds, const Gemm g, const Sched& S, const Epi& E) {
    const int tid = threadIdx.x, wid = __builtin_amdgcn_readfirstlane(tid >> 6), lane = tid & 63, wr = wid >> 2, wc = wid & 3, fr = lane & 15, fq = lane >> 4;
    const int K = g.K, nt = K / BK;
    unsigned voffA[2], voffB[2];
#pragma unroll
    for (int i = 0; i < 2; ++i) { int R, C; stage_rc(tid * 16 + i * 8192, R, C); const int Rb = Epi::PERM ? ((R & ~31) + perm32(R & 31)) : R;
        voffA[i] = (unsigned)(R * K + C) * 2u; voffB[i] = (unsigned)(Rb * K + C) * 2u; }
    const size_t kstep = (size_t)(BK * 2);
    const size_t hstep = (size_t)HALF * K * 2;
    const size_t tstep = 2 * hstep;
    const unsigned ldsw = (unsigned)wid * 1024u;
    const int aoff = lds_byte(wr * 64 + fr, fq * 8), boff = lds_byte(wc * 32 + fr, fq * 8);
#define PG8_SA(b, h) (((b) * 2 + (h)) * HTB)
#define PG8_SB(b, h) ((4 + (b) * 2 + (h)) * HTB)
#define PG8_STAGE(bufoff, gbase, voff) do { _Pragma("unroll") for (int _i = 0; _i < 2; ++_i) \
        __builtin_amdgcn_global_load_lds((const unsigned*)((const char*)(gbase) + (voff)[_i]), (PG8_LAS unsigned*)(lds + (bufoff) + ldsw + _i * 8192), 16, 0, 0); } while (0)
#define PG8_LDA(dst, b, h) do { _Pragma("unroll") for (int m = 0; m < 4; ++m) _Pragma("unroll") for (int k = 0; k < 2; ++k) dst[m][k] = *(const PG8_LAS bf16x8*)(lds + PG8_SA(b, h) + aoff + m * 2048 + k * 1024); } while (0)
#define PG8_LDB(dst, b, h) do { _Pragma("unroll") for (int n = 0; n < 2; ++n) _Pragma("unroll") for (int k = 0; k < 2; ++k) dst[n][k] = *(const PG8_LAS bf16x8*)(lds + PG8_SB(b, h) + boff + n * 2048 + k * 1024); } while (0)
#define PG8_MMA(ai, bj, At, Bt) do { __builtin_amdgcn_s_setprio(1); _Pragma("unroll") for (int m = 0; m < 4; ++m) _Pragma("unroll") for (int n = 0; n < 2; ++n) _Pragma("unroll") for (int k = 0; k < 2; ++k) \
        acc[ai][bj][m][n] = __builtin_amdgcn_mfma_f32_16x16x32_bf16(Bt[n][k], At[m][k], acc[ai][bj][m][n], 0, 0, 0); __builtin_amdgcn_s_setprio(0); } while (0)
#define PG8_WAIT_V(n) asm volatile("s_waitcnt vmcnt(" #n ")" ::: "memory")
#define PG8_WAIT_L(n) asm volatile("s_waitcnt lgkmcnt(" #n ")" ::: "memory")
#define PG8_BAR __builtin_amdgcn_s_barrier()
#define PG8_SCHED __builtin_amdgcn_sched_barrier(0)
    Unit cur, nxt; int ui = 0;
    if (!S.next(0, cur)) return;
    f32x4 acc[2][2][4][2];
#pragma unroll
    for (int a = 0; a < 2; ++a)
#pragma unroll
        for (int b = 0; b < 2; ++b)
#pragma unroll
            for (int m = 0; m < 4; ++m)
#pragma unroll
                for (int n = 0; n < 2; ++n) acc[a][b][m][n] = (f32x4){0.f, 0.f, 0.f, 0.f};
    bf16x8 At[4][2], B0[2][2], B1[2][2];
    const char* cA = (const char*)g.A + (size_t)cur.pm * tstep; const char* cB = (const char*)g.Bt + (size_t)cur.pn * tstep;
    S.a_ready(cur);
    if constexpr (SP2) {
        PG8_STAGE(PG8_SB(0, 0), cB, voffB); PG8_STAGE(PG8_SB(0, 1), cB + hstep, voffB); PG8_STAGE(PG8_SA(0, 0), cA, voffA); PG8_STAGE(PG8_SA(0, 1), cA + hstep, voffA);
        if (wr == 1) PG8_BAR;
        PG8_WAIT_V(2); PG8_BAR;
        PG8_STAGE(PG8_SB(1, 0), cB + kstep, voffB); PG8_STAGE(PG8_SA(1, 0), cA + kstep, voffA); PG8_STAGE(PG8_SB(1, 1), cB + hstep + kstep, voffB);
        PG8_WAIT_V(6); PG8_BAR;
    } else {
        PG8_STAGE(PG8_SB(0, 0), cB, voffB); PG8_STAGE(PG8_SA(0, 0), cA, voffA); PG8_STAGE(PG8_SB(0, 1), cB + hstep, voffB); PG8_STAGE(PG8_SA(0, 1), cA + hstep, voffA);
        if (wr == 1) PG8_BAR;
        PG8_WAIT_V(4); PG8_BAR;
        PG8_STAGE(PG8_SB(1, 0), cB + kstep, voffB); PG8_STAGE(PG8_SA(1, 0), cA + kstep, voffA); PG8_STAGE(PG8_SB(1, 1), cB + hstep + kstep, voffB);
        PG8_WAIT_V(6); PG8_BAR;
    }
    for (;;) {
        const bool has_next = S.next(ui + 1, nxt);
        const char* nA = has_next ? (const char*)g.A + (size_t)nxt.pm * tstep : cA; const char* nB = has_next ? (const char*)g.Bt + (size_t)nxt.pn * tstep : cB;
        for (int t = 0; t < nt; t += 2) {
            const bool last = (t == nt - 2);
            const char* a1 = cA + (size_t)(t + 1) * kstep;
            const char* a2 = last ? nA : cA + (size_t)(t + 2) * kstep; const char* b2 = last ? nB : cB + (size_t)(t + 2) * kstep;
            const char* a3 = a2 + kstep; const char* b3 = b2 + kstep;
            if (last && has_next) S.a_ready(nxt);
            if constexpr (SP2) {
            PG8_LDB(B0, 0, 0); PG8_LDB(B1, 0, 1); PG8_SCHED; PG8_LDA(At, 0, 0); PG8_STAGE(PG8_SA(1, 1), a1 + hstep, voffA);
            PG8_WAIT_V(8); PG8_WAIT_L(0); PG8_BAR; PG8_MMA(0, 0, At, B0); PG8_MMA(0, 1, At, B1); PG8_BAR; PG8_SCHED;
            PG8_LDA(At, 0, 1); PG8_STAGE(PG8_SB(0, 0), b2, voffB); PG8_STAGE(PG8_SB(0, 1), b2 + hstep, voffB); PG8_STAGE(PG8_SA(0, 0), a2, voffA);
            PG8_WAIT_V(8); PG8_WAIT_L(0); PG8_BAR; PG8_MMA(1, 0, At, B0); PG8_MMA(1, 1, At, B1); PG8_BAR; PG8_SCHED;
            PG8_LDB(B0, 1, 0); PG8_LDB(B1, 1, 1); PG8_SCHED; PG8_LDA(At, 1, 0); PG8_STAGE(PG8_SA(0, 1), a2 + hstep, voffA);
            PG8_WAIT_V(8); PG8_WAIT_L(0); PG8_BAR; PG8_MMA(0, 0, At, B0); PG8_MMA(0, 1, At, B1); PG8_BAR; PG8_SCHED;
            PG8_LDA(At, 1, 1); PG8_STAGE(PG8_SB(1, 0), b3, voffB); PG8_STAGE(PG8_SB(1, 1), b3 + hstep, voffB); PG8_STAGE(PG8_SA(1, 0), a3, voffA);
            PG8_WAIT_V(8); PG8_WAIT_L(0); PG8_BAR; PG8_MMA(1, 0, At, B0); PG8_MMA(1, 1, At, B1); PG8_BAR; PG8_SCHED;
            } else {
            PG8_LDB(B0, 0, 0); PG8_SCHED; PG8_LDA(At, 0, 0); PG8_STAGE(PG8_SA(1, 1), a1 + hstep, voffA);
            PG8_WAIT_L(8); PG8_BAR; PG8_WAIT_L(0); PG8_MMA(0, 0, At, B0); PG8_BAR; PG8_SCHED;
            PG8_LDB(B1, 0, 1); PG8_STAGE(PG8_SB(0, 0), b2, voffB);
            PG8_BAR; PG8_WAIT_L(0); PG8_MMA(0, 1, At, B1); PG8_BAR;
            PG8_LDA(At, 0, 1); PG8_STAGE(PG8_SA(0, 0), a2, voffA);
            PG8_BAR; PG8_WAIT_L(0); PG8_MMA(1, 0, At, B0); PG8_BAR; PG8_SCHED;
            PG8_STAGE(PG8_SB(0, 1), b2 + hstep, voffB);
            PG8_WAIT_V(6); PG8_BAR; PG8_MMA(1, 1, At, B1); PG8_BAR;
            PG8_LDB(B0, 1, 0); PG8_SCHED; PG8_LDA(At, 1, 0); PG8_STAGE(PG8_SA(0, 1), a2 + hstep, voffA);
            PG8_WAIT_L(8); PG8_BAR; PG8_WAIT_L(0); PG8_MMA(0, 0, At, B0); PG8_BAR; PG8_SCHED;
            PG8_LDB(B1, 1, 1); PG8_STAGE(PG8_SB(1, 0), b3, voffB);
            PG8_BAR; PG8_WAIT_L(0); PG8_MMA(0, 1, At, B1); PG8_BAR;
            PG8_LDA(At, 1, 1); PG8_STAGE(PG8_SA(1, 0), a3, voffA);
            PG8_BAR; PG8_WAIT_L(0); PG8_MMA(1, 0, At, B0); PG8_BAR; PG8_SCHED;
            PG8_STAGE(PG8_SB(1, 1), b3 + hstep, voffB);
            PG8_WAIT_V(6); PG8_BAR; PG8_MMA(1, 1, At, B1); PG8_BAR;
            }
        }
        if constexpr (ALIGN_EPI) { if (wr == 0) PG8_BAR; }
        if constexpr (!Epi::AFTER_DRAIN) { E(acc, cur, wr, wc, fr, fq); S.done(cur); }
        if (!has_next) break;
#pragma unroll
        for (int a = 0; a < 2; ++a)
#pragma unroll
            for (int b = 0; b < 2; ++b)
#pragma unroll
                for (int m = 0; m < 4; ++m)
#pragma unroll
                    for (int n = 0; n < 2; ++n) acc[a][b][m][n] = (f32x4){0.f, 0.f, 0.f, 0.f};
        cur = nxt; cA = nA; cB = nB; ++ui;
        if constexpr (ALIGN_EPI) { if (wr == 1) PG8_BAR; }
    }
    PG8_WAIT_V(0);
    if constexpr (!ALIGN_EPI) { if (wr == 0) PG8_BAR; }
    PG8_BAR;
    if constexpr (Epi::AFTER_DRAIN) { E.fused(acc, cur, wr, wc, fr, fq, lds, wid, lane); S.done(cur); }
#undef PG8_SA
#undef PG8_SB
#undef PG8_STAGE
#undef PG8_LDA
#undef PG8_LDB
#undef PG8_MMA
#undef PG8_WAIT_V
#undef PG8_WAIT_L
#undef PG8_BAR
#undef PG8_SCHED
}
}

#ifndef MULTI_LAUNCH
#define MULTI_LAUNCH 0
#endif
#ifndef USE_TR
#define USE_TR 1
#endif
#ifndef TSEL
#define TSEL (-1)
#endif
#ifndef REP_ATTN
#define REP_ATTN 0
#endif
#ifndef REP_M1
#define REP_M1 0
#endif
#ifndef REPEAT_MASK
#define REPEAT_MASK 0
#endif
#define LAS __attribute__((address_space(3)))
#define DI __device__ __forceinline__
typedef unsigned short bf16;
typedef short bf16x8 __attribute__((ext_vector_type(8)));
typedef float f32x4 __attribute__((ext_vector_type(4)));
typedef unsigned u32x4 __attribute__((ext_vector_type(4)));
typedef unsigned u32x2 __attribute__((ext_vector_type(2)));

constexpr int SEQ = 8192, DM = 4096, INW = 16392, NU = 16384;
constexpr int C_QA = 0, C_KA = 2048, C_VA = 4096, C_ZA = 6144, C_QM = 8192, C_KM = 9216, C_VM = 10240, C_OM = 12288, C_ZM = 14336;
constexpr float NORM_EPS = 1e-6f;
constexpr int NTHR = 512, NWAVE = 8;
constexpr int LDS_BYTES = 147456;

constexpr size_t MiB = (size_t)1 << 20;
constexpr size_t WS_WIN = 0, WS_WOUT = 256 * MiB, WS_XN = 320 * MiB, WS_U = 384 * MiB, WS_OP = 640 * MiB, WS_Y = 736 * MiB, WS_X1 = 800 * MiB,
                 WS_DC = 928 * MiB, WS_CS = 992 * MiB, WS_LSE = 1024 * MiB, WS_GATES = 1026 * MiB, WS_DN = 1027 * MiB, WS_NS = 1028 * MiB, WS_BL = 1029 * MiB,
                 WS_CTL = 1030 * MiB, WS_QKC = 1032 * MiB, WS_WGT = 1064 * MiB, WS_END = 1065 * MiB;
constexpr int LDS_BARST = LDS_BYTES - 64;

struct Params { const float *x, *norm_g, *w_in, *b_gate, *conv_w, *mnorm_g, *w_out, *rel_bias, *final_g; float* out; unsigned char* ws; int ph_lo, ph_hi; };

DI float bf_lo(unsigned u) { return __uint_as_float(u << 16); }
DI float bf_hi(unsigned u) { return __uint_as_float(u & 0xffff0000u); }
DI float bf2f(unsigned short u) { return __uint_as_float((unsigned)u << 16); }
DI unsigned pk2(float lo, float hi) { return pg8::cvt_pk_bf16(lo, hi); }
DI float wave_sum(float v) {
#pragma unroll
    for (int o = 1; o < 64; o <<= 1) v += __shfl_xor(v, o);
    return v;
}
DI float quad_sum(float v) { v += __shfl_xor(v, 16); v += __shfl_xor(v, 32); return v; }
DI float quad_max(float v) { v = fmaxf(v, __shfl_xor(v, 16)); v = fmaxf(v, __shfl_xor(v, 32)); return v; }
DI float silu_f(float x) { return x / (1.f + __expf(-x)); }
DI float sigm_f(float x) { return 1.f / (1.f + __expf(-x)); }
DI bf16x8 gatherT(const LAS unsigned short* p, int stride) {
    bf16x8 r;
#pragma unroll
    for (int j = 0; j < 8; ++j) r[j] = (short)p[j * stride];
    return r;
}
typedef short s16x4 __attribute__((ext_vector_type(4)));
DI bf16x8 trfrag(const LAS unsigned short* blk, int stride, int ql) {
#if USE_TR
    const LAS unsigned short* a = blk + (ql >> 2) * stride + 4 * (ql & 3);
    const s16x4 lo = __builtin_amdgcn_ds_read_tr16_b64_v4i16((LAS s16x4*)a);
    const s16x4 hi = __builtin_amdgcn_ds_read_tr16_b64_v4i16((LAS s16x4*)(a + 4 * stride));
    return (bf16x8){lo[0], lo[1], lo[2], lo[3], hi[0], hi[1], hi[2], hi[3]};
#else
    return gatherT(blk + ql, stride);
#endif
}
DI f32x4 mfma16(bf16x8 a, bf16x8 b, f32x4 c) { return __builtin_amdgcn_mfma_f32_16x16x32_bf16(a, b, c, 0, 0, 0); }
#define LDS_WAIT() asm volatile("s_waitcnt lgkmcnt(0)" ::: "memory")

struct TrTile { const float* src; bf16* dst; };
DI TrTile tr_tile_addr(const Params& p, int it, int lane) {
    constexpr int T_IN = 64 * 256, T_OUT = 64 * 64;
    const float* W; bf16* WT; int ldw, nb, kb;
    int r = it;
    if (r < T_IN) { W = p.w_in; WT = (bf16*)(p.ws + WS_WIN); ldw = INW; kb = r >> 8; nb = r & 255; }
    else if ((r -= T_IN) < T_OUT) { W = p.w_out; WT = (bf16*)(p.ws + WS_WOUT); ldw = DM; kb = r >> 6; nb = r & 63; }
    else if ((r -= T_OUT) < T_IN) { W = p.w_in + (size_t)DM * INW; WT = (bf16*)(p.ws + WS_WIN + 128 * MiB); ldw = INW; kb = r >> 8; nb = r & 255; }
    else { r -= T_IN; W = p.w_out + (size_t)DM * DM; WT = (bf16*)(p.ws + WS_WOUT + 32 * MiB); ldw = DM; kb = r >> 6; nb = r & 63; }
    TrTile t;
    t.src = W + (size_t)(kb * 64 + 16 * (lane >> 4)) * ldw + nb * 64 + 4 * (lane & 15);
    t.dst = WT + (size_t)(nb * 64 + (lane >> 3)) * DM + kb * 64 + 8 * (lane & 7);
    return t;
}
DI int tr_ldw(int it) { constexpr int T_IN = 64 * 256, T_OUT = 64 * 64; const int r = it % (T_IN + T_OUT); return r < T_IN ? INW : DM; }
DI void tr_load(const float* src, int ldw, f32x4 (&v)[16]) {
#pragma unroll
    for (int i = 0; i < 16; ++i) v[i] = *(const f32x4*)(src + (size_t)i * ldw);
}
DI void tr_store(const f32x4 (&v)[16], bf16* dst, LAS unsigned short* T, int lane) {
    const int kr = lane >> 4, nc = 4 * (lane & 15);
#pragma unroll
    for (int e = 0; e < 4; ++e)
#pragma unroll
        for (int hf = 0; hf < 2; ++hf) { u32x4 w;
            w.x = pk2(v[8 * hf + 0][e], v[8 * hf + 1][e]); w.y = pk2(v[8 * hf + 2][e], v[8 * hf + 3][e]); w.z = pk2(v[8 * hf + 4][e], v[8 * hf + 5][e]); w.w = pk2(v[8 * hf + 6][e], v[8 * hf + 7][e]);
            *(LAS u32x4*)(T + (nc + e) * 72 + 16 * kr + 8 * hf) = w; }
    LDS_WAIT(); asm volatile("" ::: "memory");
#pragma unroll
    for (int j = 0; j < 8; ++j) { const u32x4 w = *(const LAS u32x4*)(T + ((lane >> 3) + 8 * j) * 72 + 8 * (lane & 7)); *(u32x4*)(dst + (size_t)(8 * j) * DM) = w; }
    LDS_WAIT(); asm volatile("" ::: "memory");
}
DI void prologue_transposes(const Params& p, LAS unsigned char* lds, int wave, int lane) {
    LAS unsigned short* T = (LAS unsigned short*)(lds + wave * 16384);
    const int gw = blockIdx.x * NWAVE + wave, ngw = gridDim.x * NWAVE;
    constexpr int NIT = 2 * (64 * 256 + 64 * 64);
    f32x4 va[16], vb[16];
    int it = gw;
    if (it >= NIT) return;
    TrTile ta = tr_tile_addr(p, it, lane), tb;
    tr_load(ta.src, tr_ldw(it), va);
    for (;;) {
        const int it1 = it + ngw; const bool h1 = it1 < NIT;
        if (h1) { tb = tr_tile_addr(p, it1, lane); tr_load(tb.src, tr_ldw(it1), vb); }
        tr_store(va, ta.dst, T, lane);
        if (!h1) break;
        const int it2 = it1 + ngw; const bool h2 = it2 < NIT;
        if (h2) { ta = tr_tile_addr(p, it2, lane); tr_load(ta.src, tr_ldw(it2), va); }
        tr_store(vb, tb.dst, T, lane);
        if (!h2) break;
        it = it2;
    }
}

DI void norm_phase(const Params& p, const float* X, int l, int wave, int lane) {
    const float* g = p.norm_g + l * DM;
    bf16* XN = (bf16*)(p.ws + WS_XN);
    for (int row = blockIdx.x * NWAVE + wave; row < SEQ; row += gridDim.x * NWAVE) {
        const f32x4* xr = (const f32x4*)(X + (size_t)row * DM) + lane;
        f32x4 v[16]; float ss = 0.f;
#pragma unroll
        for (int j = 0; j < 16; ++j) { v[j] = xr[64 * j]; ss += (v[j].x * v[j].x + v[j].y * v[j].y) + (v[j].z * v[j].z + v[j].w * v[j].w); }
        const float rstd = rsqrtf(wave_sum(ss) * (1.f / DM) + NORM_EPS);
        u32x2* o8 = (u32x2*)(XN + (size_t)row * DM) + lane;
#pragma unroll
        for (int j = 0; j < 16; ++j) { const f32x4 h = v[j] * rstd * ((const f32x4*)g)[lane + 64 * j]; u32x2 w; w.x = pk2(h.x, h.y); w.y = pk2(h.z, h.w); o8[64 * j] = w; }
    }
}
DI void build_wgt(const Params& p, int tid) {
    bf16* WgT = (bf16*)(p.ws + WS_WGT);
    for (int gid = blockIdx.x * NTHR + tid; gid < 2 * 16 * DM; gid += gridDim.x * NTHR) {
        if (gid < 2 * 8 * DM) { const int l = gid >> 15, k = (gid >> 3) & (DM - 1), j = gid & 7;
            WgT[((size_t)l * 16 + j) * DM + k] = (bf16)(pk2(p.w_in[(size_t)l * DM * INW + (size_t)k * INW + NU + j], 0.f) & 0xffffu); }
        else { const int r = gid - 2 * 8 * DM, l = r >> 15, j = 8 + ((r >> 12) & 7), k = r & (DM - 1); WgT[((size_t)l * 16 + j) * DM + k] = 0; }
    }
}
DI void gate_items(const Params& p, LAS unsigned char* lds, int l, int tid, int wave, int lane) {
    const bf16* XN = (const bf16*)(p.ws + WS_XN);
    const bf16* WgT = (const bf16*)(p.ws + WS_WGT) + (size_t)l * 16 * DM;
    float* gates = (float*)(p.ws + WS_GATES);
    LAS float* red = (LAS float*)lds;
    const int ql = lane & 15, quad = lane >> 4;
    for (int t = blockIdx.x; t < SEQ / 16; t += gridDim.x) {
        const bf16* a = WgT + (size_t)ql * DM + wave * 512 + quad * 8; const bf16* b = XN + (size_t)(t * 16 + ql) * DM + wave * 512 + quad * 8;
        f32x4 acc0 = {0.f, 0.f, 0.f, 0.f}, acc1 = {0.f, 0.f, 0.f, 0.f};
#pragma unroll
        for (int i = 0; i < 16; i += 2) { acc0 = mfma16(*(const bf16x8*)(a + i * 32), *(const bf16x8*)(b + i * 32), acc0); acc1 = mfma16(*(const bf16x8*)(a + i * 32 + 32), *(const bf16x8*)(b + i * 32 + 32), acc1); }
        const f32x4 r = acc0 + acc1;
        if (quad < 2) *(LAS f32x4*)(red + (wave * 16 + ql) * 8 + quad * 4) = r;
        __syncthreads();
        if (tid < 128) { float sum = p.b_gate[l * 8 + (tid & 7)];
#pragma unroll
            for (int w = 0; w < 8; ++w) sum += red[w * 128 + tid];
            gates[(size_t)t * 128 + tid] = sum; }
        __syncthreads();
    }
}
DI void final_norm_phase(const Params& p, LAS unsigned char* lds0, int wave, int lane) {
#if TSEL >= 0
    const int n2 = ((volatile LAS int*)(lds0 + LDS_BARST + 16))[8];
#endif
    for (int row = blockIdx.x * NWAVE + wave; row < SEQ; row += gridDim.x * NWAVE) {
        f32x4* xr = (f32x4*)(p.out + (size_t)row * DM) + lane;
        f32x4 v[16]; float ss = 0.f;
#pragma unroll
        for (int j = 0; j < 16; ++j) { v[j] = xr[64 * j]; ss += (v[j].x * v[j].x + v[j].y * v[j].y) + (v[j].z * v[j].z + v[j].w * v[j].w); }
        const float rstd = rsqrtf(wave_sum(ss) * (1.f / DM) + NORM_EPS);
#pragma unroll
        for (int j = 0; j < 16; ++j) { f32x4 o = v[j] * rstd * ((const f32x4*)p.final_g)[lane + 64 * j];
#if TSEL >= 0
            if (blockIdx.x == 0) { const int e0 = ((row >> 11) * 8 + (row & 7)) * 4096 + 4 * (lane + 64 * j);
                o.x += (e0 + 0 < n2) ? 0.02f : 0.f; o.y += (e0 + 1 < n2) ? 0.02f : 0.f; o.z += (e0 + 2 < n2) ? 0.02f : 0.f; o.w += (e0 + 3 < n2) ? 0.02f : 0.f; }
#endif
            xr[64 * j] = o; }
    }
}

constexpr int AT_KS = 136;
DI void attn_item(const Params& p, LAS unsigned char* lds, int item, int tid, int wave, int lane) {
    const bf16* U = (const bf16*)(p.ws + WS_U);
    LAS unsigned short* Ks = (LAS unsigned short*)lds;
    LAS unsigned short* Vs = Ks + 256 * AT_KS;
    LAS float* biasS = (LAS float*)(Vs + 256 * AT_KS);
    const int pat = item >> 10, rem = item & 1023, h = rem >> 6, rb = rem & 63;
    const int dsh = pat * 2;
    const int r = rb >> (6 - dsh), bq = rb & ((64 >> dsh) - 1);
    const int sub0 = 128 * bq - 128;
    const int ql = lane & 15, quad = lane >> 4, q0 = wave * 16;
    u32x4 kv[8], vv[8];
#pragma unroll
    for (int i = 0; i < 8; ++i) { const int c = tid + NTHR * i, row = c >> 4, ch = c & 15; int sub = sub0 + row; sub = sub < 0 ? 0 : sub;
        const bf16* src = U + (size_t)((sub << dsh) + r) * NU + h * 128 + ch * 8;
        kv[i] = *(const u32x4*)(src + C_KA); vv[i] = *(const u32x4*)(src + C_VA); }
    const int tq = ((128 * bq + q0 + ql) << dsh) + r;
    bf16x8 qf[4];
#pragma unroll
    for (int ks = 0; ks < 4; ++ks) qf[ks] = *(const bf16x8*)(U + (size_t)tq * NU + C_QA + h * 128 + ks * 32 + quad * 8);
    if (tid < 129) { const int n = tid << dsh; int b = n;
        if (n >= 16) { b = 16 + (int)floorf(log2f((float)n * 0.0625f) * (16.f / 7.f)); b = b > 31 ? 31 : b; }
        biasS[tid] = p.rel_bias[b * 16 + h]; }
#pragma unroll
    for (int i = 0; i < 8; ++i) { const int c = tid + NTHR * i, row = c >> 4, ch = c & 15;
        *(LAS u32x4*)(Ks + row * AT_KS + ch * 8) = kv[i]; *(LAS u32x4*)(Vs + row * AT_KS + ch * 8) = vv[i]; }
    __syncthreads();
    f32x4 sacc[10];
#pragma unroll
    for (int t = 0; t < 10; ++t) sacc[t] = (f32x4){0.f, 0.f, 0.f, 0.f};
#pragma unroll
    for (int s = 0; s < 5; ++s)
#pragma unroll
        for (int u = 0; u < 2; ++u) { int kk = q0 + 32 * s + (ql >> 2) * 8 + u * 4 + (ql & 3); kk = kk > 255 ? 255 : kk;
            const LAS unsigned short* kp = Ks + kk * AT_KS + quad * 8;
#pragma unroll
            for (int ks = 0; ks < 4; ++ks) sacc[2 * s + u] = mfma16(*(const LAS bf16x8*)(kp + ks * 32), qf[ks], sacc[2 * s + u]); }
    const float scale = 0.08838834764831845f;
    float mx = -1e30f;
    int ql2 = ql, quad2 = quad; asm volatile("" : "+v"(ql2), "+v"(quad2));
#pragma unroll
    for (int s = 0; s < 5; ++s)
#pragma unroll
        for (int u = 0; u < 2; ++u)
#pragma unroll
            for (int j = 0; j < 4; ++j) { const int koff = 32 * s + quad2 * 8 + u * 4 + j, rel = koff - ql2;
                const bool valid = (rel >= 0) && (rel <= 128) && (sub0 + q0 + koff >= 0);
                int jo = 128 - rel; jo = jo < 0 ? 0 : (jo > 128 ? 128 : jo);
                const float v = valid ? sacc[2 * s + u][j] * scale + biasS[jo] : -1e30f;
                sacc[2 * s + u][j] = v; mx = fmaxf(mx, v); }
    mx = quad_max(mx);
    float l = 0.f;
#pragma unroll
    for (int t = 0; t < 10; ++t)
#pragma unroll
        for (int j = 0; j < 4; ++j) { const float e = __expf(sacc[t][j] - mx); sacc[t][j] = e; l += e; }
    l = quad_sum(l);
    f32x4 oacc[8];
#pragma unroll
    for (int nt = 0; nt < 8; ++nt) oacc[nt] = (f32x4){0.f, 0.f, 0.f, 0.f};
#pragma unroll
    for (int s = 0; s < 5; ++s) {
        u32x4 pw; pw.x = pk2(sacc[2 * s][0], sacc[2 * s][1]); pw.y = pk2(sacc[2 * s][2], sacc[2 * s][3]); pw.z = pk2(sacc[2 * s + 1][0], sacc[2 * s + 1][1]); pw.w = pk2(sacc[2 * s + 1][2], sacc[2 * s + 1][3]);
        const bf16x8 pf = __builtin_bit_cast(bf16x8, pw);
        int key0 = q0 + 32 * s + quad * 8; key0 = key0 > 248 ? 248 : key0;
        const LAS unsigned short* vp = Vs + key0 * AT_KS;
#pragma unroll
        for (int nt = 0; nt < 8; ++nt) oacc[nt] = mfma16(trfrag(vp + nt * 16, AT_KS, ql), pf, oacc[nt]);
    }
    const float inv = 1.f / l;
    bf16* OP = (bf16*)(p.ws + WS_OP) + (size_t)pat * SEQ * 2048 + (size_t)tq * 2048 + h * 128 + quad * 4;
#pragma unroll
    for (int nt = 0; nt < 8; ++nt) { u32x2 w; w.x = pk2(oacc[nt][0] * inv, oacc[nt][1] * inv); w.y = pk2(oacc[nt][2] * inv, oacc[nt][3] * inv); *(u32x2*)(OP + nt * 16) = w; }
    if (quad == 0) ((float*)(p.ws + WS_LSE))[((size_t)pat * SEQ + tq) * 16 + h] = mx + __logf(l);
    __syncthreads();
}
DI void merge_phase(const Params& p, int tid) {
    const bf16* U = (const bf16*)(p.ws + WS_U);
    const bf16* OP = (const bf16*)(p.ws + WS_OP);
    const float* LSE = (const float*)(p.ws + WS_LSE);
    bf16* Y = (bf16*)(p.ws + WS_Y);
    const int gthreads = gridDim.x * NTHR;
    for (int idx0 = blockIdx.x * NTHR + tid; idx0 < SEQ * 256; idx0 += 4 * gthreads) {
        float l0[4], l1[4], l2[4]; u32x4 o0[4], o1[4], o2[4], z[4];
#pragma unroll
        for (int u = 0; u < 4; ++u) { int idx = idx0 + u * gthreads; idx = idx < SEQ * 256 ? idx : SEQ * 256 - 1;
            const int t = idx >> 8, c8 = idx & 255, h = c8 >> 4;
            l0[u] = LSE[(size_t)t * 16 + h]; l1[u] = LSE[((size_t)SEQ + t) * 16 + h]; l2[u] = LSE[((size_t)2 * SEQ + t) * 16 + h];
            const size_t o = (size_t)t * 2048 + c8 * 8;
            o0[u] = *(const u32x4*)(OP + o); o1[u] = *(const u32x4*)(OP + (size_t)SEQ * 2048 + o); o2[u] = *(const u32x4*)(OP + (size_t)2 * SEQ * 2048 + o);
            z[u] = *(const u32x4*)(U + (size_t)t * NU + C_ZA + c8 * 8); }
#pragma unroll
        for (int u = 0; u < 4; ++u) { const int idx = idx0 + u * gthreads;
            if (idx < SEQ * 256) { const int t = idx >> 8, c8 = idx & 255;
                const float M = fmaxf(l0[u], fmaxf(l1[u], l2[u]));
                float w0 = __expf(l0[u] - M), w1 = __expf(l1[u] - M), w2 = __expf(l2[u] - M);
                const float inv = 1.f / (w0 + w1 + w2); w0 *= inv; w1 *= inv; w2 *= inv;
                u32x4 y;
#pragma unroll
                for (int e = 0; e < 4; ++e) {
                    const float lo = (w0 * bf_lo(o0[u][e]) + w1 * bf_lo(o1[u][e]) + w2 * bf_lo(o2[u][e])) * silu_f(bf_lo(z[u][e]));
                    const float hi = (w0 * bf_hi(o0[u][e]) + w1 * bf_hi(o1[u][e]) + w2 * bf_hi(o2[u][e])) * silu_f(bf_hi(z[u][e]));
                    y[e] = pk2(lo, hi); }
                *(u32x4*)(Y + (size_t)t * DM + c8 * 8) = y; } }
    }
}

constexpr int M_KS = 264, M_VS3 = 520;
DI void conv8(const bf16* U, const float* cw, int t, int rawcol, int cch, float (&f)[8]) {
#pragma unroll
    for (int e = 0; e < 8; ++e) f[e] = 0.f;
#pragma unroll
    for (int j = 0; j < 4; ++j) { const int tt = t - 3 + j;
        if (tt >= 0) { const u32x4 raw = *(const u32x4*)(U + (size_t)tt * NU + rawcol);
            const f32x4 w0 = *(const f32x4*)(cw + j * 2048 + cch), w1 = *(const f32x4*)(cw + j * 2048 + cch + 4);
            f[0] += w0[0] * bf_lo(raw.x); f[1] += w0[1] * bf_hi(raw.x); f[2] += w0[2] * bf_lo(raw.y); f[3] += w0[3] * bf_hi(raw.y);
            f[4] += w1[0] * bf_lo(raw.z); f[5] += w1[1] * bf_hi(raw.z); f[6] += w1[2] * bf_lo(raw.w); f[7] += w1[3] * bf_hi(raw.w); } }
#pragma unroll
    for (int e = 0; e < 8; ++e) f[e] = silu_f(f[e]);
}
template <int NI, int MODE, int NB>
DI void conv_tile(const bf16* U, const float* cw, int t0, int rawcol0, int cch0, float sc, LAS unsigned short* dst, int tid, float bL, const LAS float* bS, const LAS float* liS, int roff) {
    const int ch = tid & 31, r0 = tid >> 5;
    f32x4 w[4][2];
#pragma unroll
    for (int j = 0; j < 4; ++j) { w[j][0] = *(const f32x4*)(cw + j * 2048 + cch0 + ch * 8); w[j][1] = *(const f32x4*)(cw + j * 2048 + cch0 + ch * 8 + 4); }
    const bf16* src = U + rawcol0 + ch * 8;
#pragma unroll
    for (int ib = 0; ib < NI; ib += NB) {
        u32x4 raw[NB][4];
#pragma unroll
        for (int i = 0; i < NB; ++i)
#pragma unroll
            for (int j = 0; j < 4; ++j) { const int tt = t0 + r0 + 16 * (ib + i) - 3 + j; const int tc = tt < 0 ? 0 : tt;
                raw[i][j] = *(const u32x4*)(src + (size_t)tc * NU); if (tt < 0) raw[i][j] = (u32x4){0u, 0u, 0u, 0u}; }
#pragma unroll
        for (int i = 0; i < NB; ++i) { const int row = r0 + 16 * (ib + i);
            float f[8];
#pragma unroll
            for (int e = 0; e < 8; ++e) f[e] = 0.f;
#pragma unroll
            for (int j = 0; j < 4; ++j) { const u32x4 rw = raw[i][j];
                f[0] += w[j][0][0] * bf_lo(rw.x); f[1] += w[j][0][1] * bf_hi(rw.x); f[2] += w[j][0][2] * bf_lo(rw.y); f[3] += w[j][0][3] * bf_hi(rw.y);
                f[4] += w[j][1][0] * bf_lo(rw.z); f[5] += w[j][1][1] * bf_hi(rw.z); f[6] += w[j][1][2] * bf_lo(rw.w); f[7] += w[j][1][3] * bf_hi(rw.w); }
            float m = sc;
            if (MODE == 1) m *= __expf(bL - bS[roff + row] + liS[roff + row]);
#pragma unroll
            for (int e = 0; e < 8; ++e) f[e] = silu_f(f[e]) * m;
            u32x4 o; o.x = pk2(f[0], f[1]); o.y = pk2(f[2], f[3]); o.z = pk2(f[4], f[5]); o.w = pk2(f[6], f[7]);
            *(LAS u32x4*)(dst + row * M_KS + ch * 8) = o; }
        __builtin_amdgcn_sched_barrier(0);
    }
}
DI void conv_prepass(const Params& p, int l, int tid) {
    const bf16* U = (const bf16*)(p.ws + WS_U);
    const float* cw = p.conv_w + (size_t)l * 4 * 2048;
    bf16* QKC = (bf16*)(p.ws + WS_QKC);
    for (int gid = blockIdx.x * NTHR + tid; gid < 256 * 512; gid += gridDim.x * NTHR) {
        const int cidx = gid & 255, t0 = (gid >> 8) * 16;
        f32x4 w[4][2];
#pragma unroll
        for (int j = 0; j < 4; ++j) { w[j][0] = *(const f32x4*)(cw + j * 2048 + cidx * 8); w[j][1] = *(const f32x4*)(cw + j * 2048 + cidx * 8 + 4); }
        const bf16* src = U + C_QM + cidx * 8;
        u32x4 raw[19];
#pragma unroll
        for (int i = 0; i < 19; ++i) { const int tt = t0 - 3 + i; const int tc = tt < 0 ? 0 : tt; raw[i] = *(const u32x4*)(src + (size_t)tc * NU); if (tt < 0) raw[i] = (u32x4){0u, 0u, 0u, 0u}; }
        const float sc = cidx >= 128 ? 0.0625f : 1.f;
#pragma unroll
        for (int i = 0; i < 16; ++i) {
            float f[8];
#pragma unroll
            for (int e = 0; e < 8; ++e) f[e] = 0.f;
#pragma unroll
            for (int j = 0; j < 4; ++j) { const u32x4 rw = raw[i + j];
                f[0] += w[j][0][0] * bf_lo(rw.x); f[1] += w[j][0][1] * bf_hi(rw.x); f[2] += w[j][0][2] * bf_lo(rw.y); f[3] += w[j][0][3] * bf_hi(rw.y);
                f[4] += w[j][1][0] * bf_lo(rw.z); f[5] += w[j][1][1] * bf_hi(rw.z); f[6] += w[j][1][2] * bf_lo(rw.w); f[7] += w[j][1][3] * bf_hi(rw.w); }
#pragma unroll
            for (int e = 0; e < 8; ++e) f[e] = silu_f(f[e]) * sc;
            u32x4 o; o.x = pk2(f[0], f[1]); o.y = pk2(f[2], f[3]); o.z = pk2(f[4], f[5]); o.w = pk2(f[6], f[7]);
            *(u32x4*)(QKC + (size_t)(t0 + i) * 2048 + cidx * 8) = o; }
    }
}
DI void chunk_gates(const float* gates, int c, int hh, LAS float* bS, LAS float* liS, LAS float* wtot, int tid, int wave, int lane) {
    float v = 0.f;
    if (tid < 256) { const float* gp = gates + (size_t)(c * 256 + tid) * 8; const float fgv = gp[4 + hh]; liS[tid] = gp[hh];
        v = fminf(fgv, 0.f) - log1pf(__expf(-fabsf(fgv)));
#pragma unroll
        for (int o = 1; o < 64; o <<= 1) { const float t = __shfl_up(v, o); if (lane >= o) v += t; }
        if (lane == 63) wtot[wave] = v; }
    __syncthreads();
    if (tid < 256) { float pre = 0.f; for (int w = 0; w < wave; ++w) pre += wtot[w]; bS[tid] = v + pre; }
    __syncthreads();
}
DI void m1_item(const Params& p, LAS unsigned char* lds, int l, int item, int tid, int wave, int lane) {
    const bf16* U = (const bf16*)(p.ws + WS_U);
    const bf16* QKC = (const bf16*)(p.ws + WS_QKC);
    LAS unsigned short* Kp = (LAS unsigned short*)lds;
    LAS unsigned short* Vs = Kp + 128 * M_KS;
    LAS float* bS = (LAS float*)(Vs + 128 * AT_KS); LAS float* liS = bS + 256; LAS float* wtot = liS + 256;
    const int hh = item >> 7, c = (item >> 2) & 31, sl = item & 3;
    const int ql = lane & 15, quad = lane >> 4;
    chunk_gates((const float*)(p.ws + WS_GATES), c, hh, bS, liS, wtot, tid, wave, lane);
    const float bL = bS[255];
    f32x4 acc[4][4];
#pragma unroll
    for (int a = 0; a < 4; ++a)
#pragma unroll
        for (int b = 0; b < 4; ++b) acc[a][b] = (f32x4){0.f, 0.f, 0.f, 0.f};
    f32x4 nacc[4];
#pragma unroll
    for (int b = 0; b < 4; ++b) nacc[b] = (f32x4){0.f, 0.f, 0.f, 0.f};
    const bool do_n = (sl == 0) && ((wave & 1) == 0);
    const bf16x8 ones = {0x3F80, 0x3F80, 0x3F80, 0x3F80, 0x3F80, 0x3F80, 0x3F80, 0x3F80};
    const int dvt0 = (wave & 1) * 4, dkt0 = (wave >> 1) * 4;
    for (int half = 0; half < 2; ++half) {
#pragma unroll
        for (int ib = 0; ib < 8; ib += 4) { u32x4 kr[4];
#pragma unroll
            for (int i = 0; i < 4; ++i) { const int cc = tid + NTHR * (ib + i), row = cc >> 5, ch = cc & 31; kr[i] = *(const u32x4*)(QKC + (size_t)(c * 256 + half * 128 + row) * 2048 + 1024 + hh * 256 + ch * 8); }
#pragma unroll
            for (int i = 0; i < 4; ++i) { const int cc = tid + NTHR * (ib + i), row = cc >> 5, ch = cc & 31, sloc = half * 128 + row;
                const float wgt = __expf(bL - bS[sloc] + liS[sloc]);
                u32x4 w; w.x = pk2(bf_lo(kr[i].x) * wgt, bf_hi(kr[i].x) * wgt); w.y = pk2(bf_lo(kr[i].y) * wgt, bf_hi(kr[i].y) * wgt); w.z = pk2(bf_lo(kr[i].z) * wgt, bf_hi(kr[i].z) * wgt); w.w = pk2(bf_lo(kr[i].w) * wgt, bf_hi(kr[i].w) * wgt);
                *(LAS u32x4*)(Kp + row * M_KS + ch * 8) = w; } }
#pragma unroll
        for (int i = 0; i < 4; ++i) { const int cc = tid + NTHR * i, row = cc >> 4, ch = cc & 15;
            *(LAS u32x4*)(Vs + row * AT_KS + ch * 8) = *(const u32x4*)(U + (size_t)(c * 256 + half * 128 + row) * NU + C_VM + hh * 512 + sl * 128 + ch * 8); }
        __syncthreads();
#pragma unroll 1
        for (int ks = 0; ks < 4; ++ks) {
            bf16x8 af[4], bfr[4];
#pragma unroll
            for (int a = 0; a < 4; ++a) af[a] = trfrag(Vs + (ks * 32 + quad * 8) * AT_KS + (dvt0 + a) * 16, AT_KS, ql);
#pragma unroll
            for (int b = 0; b < 4; ++b) bfr[b] = trfrag(Kp + (ks * 32 + quad * 8) * M_KS + (dkt0 + b) * 16, M_KS, ql);
#pragma unroll
            for (int a = 0; a < 4; ++a)
#pragma unroll
                for (int b = 0; b < 4; ++b) acc[a][b] = mfma16(af[a], bfr[b], acc[a][b]);
            if (do_n) {
#pragma unroll
                for (int b = 0; b < 4; ++b) nacc[b] = mfma16(ones, bfr[b], nacc[b]); }
        }
        __syncthreads();
    }
    float* DC = (float*)(p.ws + WS_DC) + ((size_t)(hh * 32 + c) * 512 + sl * 128) * 256;
#pragma unroll
    for (int a = 0; a < 4; ++a)
#pragma unroll
        for (int b = 0; b < 4; ++b)
#pragma unroll
            for (int j = 0; j < 4; ++j) DC[(size_t)((dvt0 + a) * 16 + quad * 4 + j) * 256 + (dkt0 + b) * 16 + ql] = acc[a][b][j];
    if (do_n && quad == 0) {
#pragma unroll
        for (int b = 0; b < 4; ++b) ((float*)(p.ws + WS_DN))[(hh * 32 + c) * 256 + (dkt0 + b) * 16 + ql] = nacc[b][0]; }
    if (sl == 0 && tid == 0) ((float*)(p.ws + WS_BL))[hh * 32 + c] = bL;
}
DI void m2_phase(const Params& p, int tid) {
    const float* DC = (const float*)(p.ws + WS_DC); const float* BL = (const float*)(p.ws + WS_BL);
    bf16* CS = (bf16*)(p.ws + WS_CS);
    const int gthreads = gridDim.x * NTHR, gid = blockIdx.x * NTHR + tid;
    for (int e4 = gid; e4 < 4 * 32768; e4 += gthreads) {
        const int hh = e4 >> 15, e = e4 & 32767;
        f32x4 st = {0.f, 0.f, 0.f, 0.f};
#pragma unroll 8
        for (int c = 0; c < 32; ++c) {
            const size_t o = ((size_t)(hh * 32 + c) * 32768 + e) * 4;
            u32x2 w; w.x = pk2(st.x, st.y); w.y = pk2(st.z, st.w); *(u32x2*)(CS + o) = w;
            const f32x4 d = *(const f32x4*)(DC + o);
            st = st * __expf(BL[hh * 32 + c]) + d;
        }
    }
    if (gid < 1024) { const int hh = gid >> 8, dk = gid & 255; const float* DN = (const float*)(p.ws + WS_DN); float* NS = (float*)(p.ws + WS_NS);
        float dn[32], eb[32];
#pragma unroll
        for (int c = 0; c < 32; ++c) { dn[c] = DN[(hh * 32 + c) * 256 + dk]; eb[c] = BL[hh * 32 + c]; }
        float st = 0.f;
#pragma unroll
        for (int c = 0; c < 32; ++c) { NS[(hh * 32 + c) * 256 + dk] = st; st = st * __expf(eb[c]) + dn[c]; } }
}
DI void m3_item(const Params& p, LAS unsigned char* lds, int l, int hh, int qb, int tid, int wave, int lane) {
    const bf16* U = (const bf16*)(p.ws + WS_U);
    const bf16* QKC = (const bf16*)(p.ws + WS_QKC);
    LAS unsigned short* Qs = (LAS unsigned short*)lds;
    LAS unsigned short* Ks = Qs + 64 * M_KS;
    LAS unsigned short* Vs = Ks + 64 * M_KS;
    LAS float* bS = (LAS float*)(Vs + 64 * M_VS3); LAS float* liS = bS + 256; LAS float* nS = liS + 256; LAS float* wtot = nS + 256; LAS float* ssS = wtot + 8;
    const int c = qb >> 2, jq = qb & 3;
    const int ql = lane & 15, quad = lane >> 4;
    if (tid < 256) nS[tid] = ((const float*)(p.ws + WS_NS))[(hh * 32 + c) * 256 + tid];
    chunk_gates((const float*)(p.ws + WS_GATES), c, hh, bS, liS, wtot, tid, wave, lane);
    { u32x4 qv[4];
#pragma unroll
      for (int i = 0; i < 4; ++i) { const int cc = tid + NTHR * i, row = cc >> 5, ch = cc & 31; qv[i] = *(const u32x4*)(QKC + (size_t)(qb * 64 + row) * 2048 + hh * 256 + ch * 8); }
#pragma unroll
      for (int i = 0; i < 4; ++i) { const int cc = tid + NTHR * i, row = cc >> 5, ch = cc & 31; *(LAS u32x4*)(Qs + row * M_KS + ch * 8) = qv[i]; } }
    __syncthreads();
    const int qg = wave & 3, dvh = wave >> 2, q = qg * 16 + ql, iq = jq * 64 + q;
    bf16x8 qf[8];
#pragma unroll
    for (int ks = 0; ks < 8; ++ks) qf[ks] = *(const LAS bf16x8*)(Qs + q * M_KS + ks * 32 + quad * 8);
    const float b_q = bS[iq], eb = __expf(b_q);
    f32x4 acc[16];
#pragma unroll
    for (int nt = 0; nt < 16; ++nt) acc[nt] = (f32x4){0.f, 0.f, 0.f, 0.f};
    { const bf16* CT = (const bf16*)(p.ws + WS_CS) + (size_t)(hh * 32 + c) * 512 * 256;
      LAS unsigned short* Cs = Ks;
#pragma unroll 1
      for (int pc = 0; pc < 4; ++pc) {
          __syncthreads();
          u32x4 cv[8];
#pragma unroll
          for (int i = 0; i < 8; ++i) { const int cc = tid + NTHR * i, row = cc >> 5, ch = cc & 31;
              cv[i] = *(const u32x4*)(CT + (size_t)((row >> 6) * 256 + pc * 64 + (row & 63)) * 256 + ch * 8); }
#pragma unroll
          for (int i = 0; i < 8; ++i) { const int cc = tid + NTHR * i, row = cc >> 5, ch = cc & 31; *(LAS u32x4*)(Cs + row * M_KS + ch * 8) = cv[i]; }
          __syncthreads();
#pragma unroll
          for (int n4 = 0; n4 < 4; ++n4) { const LAS unsigned short* cp = Cs + (dvh * 64 + n4 * 16 + ql) * M_KS + quad * 8;
#pragma unroll
              for (int ks = 0; ks < 8; ++ks) acc[n4] = mfma16(*(const LAS bf16x8*)(cp + ks * 32), qf[ks], acc[n4]); }
          { const f32x4 t0 = acc[0], t1 = acc[1], t2 = acc[2], t3 = acc[3];
#pragma unroll
            for (int i = 0; i < 12; ++i) acc[i] = acc[i + 4];
            acc[12] = t0; acc[13] = t1; acc[14] = t2; acc[15] = t3; }
      }
    }
#pragma unroll
    for (int nt = 0; nt < 16; ++nt) acc[nt] = acc[nt] * eb;
    float nqp = 0.f;
#pragma unroll
    for (int ks = 0; ks < 8; ++ks)
#pragma unroll
        for (int j = 0; j < 8; ++j) nqp += bf2f((unsigned short)qf[ks][j]) * nS[ks * 32 + quad * 8 + j];
    float nq = quad_sum(nqp) * eb;
    float nqi = 0.f;
    for (int kt = 0; kt <= jq; ++kt) {
        __syncthreads();
        int tid2 = tid; asm volatile("" : "+v"(tid2));
#pragma unroll
        for (int ib = 0; ib < 8; ib += 4) { u32x4 vv[4];
#pragma unroll
            for (int i = 0; i < 4; ++i) { const int cc = tid2 + NTHR * (ib + i), row = cc >> 6, ch = cc & 63; vv[i] = *(const u32x4*)(U + (size_t)(c * 256 + kt * 64 + row) * NU + C_VM + hh * 512 + ch * 8); }
#pragma unroll
            for (int i = 0; i < 4; ++i) { const int cc = tid2 + NTHR * (ib + i), row = cc >> 6, ch = cc & 63; *(LAS u32x4*)(Vs + row * M_VS3 + ch * 8) = vv[i]; }
            __builtin_amdgcn_sched_barrier(0); }
        { u32x4 kv[4];
#pragma unroll
          for (int i = 0; i < 4; ++i) { const int cc = tid2 + NTHR * i, row = cc >> 5, ch = cc & 31; kv[i] = *(const u32x4*)(QKC + (size_t)(c * 256 + kt * 64 + row) * 2048 + 1024 + hh * 256 + ch * 8); }
#pragma unroll
          for (int i = 0; i < 4; ++i) { const int cc = tid2 + NTHR * i, row = cc >> 5, ch = cc & 31; *(LAS u32x4*)(Ks + row * M_KS + ch * 8) = kv[i]; } }
        __syncthreads();
        f32x4 sacc[4];
#pragma unroll
        for (int t = 0; t < 4; ++t) sacc[t] = (f32x4){0.f, 0.f, 0.f, 0.f};
#pragma unroll
        for (int s = 0; s < 2; ++s)
#pragma unroll
            for (int u = 0; u < 2; ++u) { const int krow = 32 * s + (ql >> 2) * 8 + u * 4 + (ql & 3);
                const LAS unsigned short* kp = Ks + krow * M_KS + quad * 8;
#pragma unroll
                for (int ks = 0; ks < 8; ++ks) sacc[2 * s + u] = mfma16(*(const LAS bf16x8*)(kp + ks * 32), qf[ks], sacc[2 * s + u]); }
#pragma unroll
        for (int s = 0; s < 2; ++s)
#pragma unroll
            for (int u = 0; u < 2; ++u)
#pragma unroll
                for (int j = 0; j < 4; ++j) { const int sk = kt * 64 + 32 * s + quad * 8 + u * 4 + j;
                    const float w = (sk <= iq) ? __expf(b_q - bS[sk] + liS[sk]) : 0.f;
                    const float pv = sacc[2 * s + u][j] * w; sacc[2 * s + u][j] = pv; nqi += pv; }
#pragma unroll
        for (int s = 0; s < 2; ++s) {
            u32x4 pw; pw.x = pk2(sacc[2 * s][0], sacc[2 * s][1]); pw.y = pk2(sacc[2 * s][2], sacc[2 * s][3]); pw.z = pk2(sacc[2 * s + 1][0], sacc[2 * s + 1][1]); pw.w = pk2(sacc[2 * s + 1][2], sacc[2 * s + 1][3]);
            const bf16x8 pf = __builtin_bit_cast(bf16x8, pw);
            const LAS unsigned short* vp = Vs + (32 * s + quad * 8) * M_VS3 + dvh * 256;
#pragma unroll
            for (int nt = 0; nt < 16; ++nt) acc[nt] = mfma16(trfrag(vp + nt * 16, M_VS3, ql), pf, acc[nt]);
        }
    }
    nq += quad_sum(nqi);
    const float inv = 1.f / fmaxf(fabsf(nq), 1.f);
    float ss = 0.f;
#pragma unroll
    for (int nt = 0; nt < 16; ++nt) { acc[nt] = acc[nt] * inv; ss += (acc[nt][0] * acc[nt][0] + acc[nt][1] * acc[nt][1]) + (acc[nt][2] * acc[nt][2] + acc[nt][3] * acc[nt][3]); }
    ss = quad_sum(ss);
    if (quad == 0) ssS[dvh * 64 + q] = ss;
    __syncthreads();
    const float rstd = rsqrtf((ssS[q] + ssS[64 + q]) * (1.f / 512.f) + NORM_EPS);
    const int t = qb * 64 + q;
    const float* ng = p.mnorm_g + l * 2048;
    bf16* Y = (bf16*)(p.ws + WS_Y);
#pragma unroll
    for (int nt = 0; nt < 16; ++nt) { const int col = hh * 512 + dvh * 256 + nt * 16 + quad * 4;
        const f32x4 g4 = *(const f32x4*)(ng + col);
        const u32x2 om = *(const u32x2*)(U + (size_t)t * NU + C_OM + col), zm = *(const u32x2*)(U + (size_t)t * NU + C_ZM + col);
        const float y0 = acc[nt][0] * rstd * g4[0] * sigm_f(bf_lo(om.x)) * silu_f(bf_lo(zm.x));
        const float y1 = acc[nt][1] * rstd * g4[1] * sigm_f(bf_hi(om.x)) * silu_f(bf_hi(zm.x));
        const float y2 = acc[nt][2] * rstd * g4[2] * sigm_f(bf_lo(om.y)) * silu_f(bf_lo(zm.y));
        const float y3 = acc[nt][3] * rstd * g4[3] * sigm_f(bf_hi(om.y)) * silu_f(bf_hi(zm.y));
        u32x2 w; w.x = pk2(y0, y1); w.y = pk2(y2, y3);
        *(u32x2*)(Y + (size_t)t * DM + 2048 + col) = w;
        if ((nt & 3) == 3) __builtin_amdgcn_sched_barrier(0); }
    __syncthreads();
}

#define RLX_AGENT __ATOMIC_RELAXED, __HIP_MEMORY_SCOPE_AGENT
#define XB_TMO      128
#define XB_XCNT(j)  (256  + 64 * (j))
#define XB_XSUB(j)  (1280 + 64 * (j))
#define XB_XGEN(j)  (2304 + 64 * (j))
#define XB_TOP      3328
#define XB_TOPGEN   3392
#define XCD_BAR_WORDS 3456
#define XB_SPIN_CAP (1u << 18)

__device__ __forceinline__ unsigned xb_ld(unsigned* p)              { return __hip_atomic_load(p, __ATOMIC_RELAXED, __HIP_MEMORY_SCOPE_AGENT); }
__device__ __forceinline__ unsigned xb_add(unsigned* p, unsigned v) { return __hip_atomic_fetch_add(p, v, __ATOMIC_RELAXED, __HIP_MEMORY_SCOPE_AGENT); }
__device__ __forceinline__ unsigned xb_xcc_id() { return (unsigned)__builtin_amdgcn_s_getreg((3 << 11) | 20) & 0xFu; }
#define XB_SPIN(cond, bar) do { unsigned _sp = 0; while (cond) { __builtin_amdgcn_s_sleep(1); \
    if ((++_sp & 255u) == 0u) { if (xb_ld(&(bar)[XB_TMO])) break; if (_sp > XB_SPIN_CAP) { atomicAdd(&(bar)[XB_TMO], 1u); break; } } } } while (0)

struct XcdBarrier {
    unsigned* bar; unsigned x;
    volatile LAS unsigned* st;
};

__device__ __forceinline__ XcdBarrier xcd_barrier_post(unsigned* bar, volatile LAS unsigned* st) {
    XcdBarrier b; b.bar = bar; b.x = xb_xcc_id(); b.st = st;
    if (threadIdx.x == 0) (void)xb_add(&bar[XB_XCNT(b.x)], 1u);
    return b;
}
__device__ __forceinline__ void xcd_barrier_complete(unsigned* bar, unsigned x, unsigned& nloc, unsigned& nx) {
    const unsigned G = gridDim.x * gridDim.y * gridDim.z;
    unsigned sum, cnt, mine, sp = 0u;
    for (;;) {
        sum = 0u; cnt = 0u; mine = 0u;
#pragma unroll
        for (unsigned j = 0; j < 16; ++j) { const unsigned c = xb_ld(&bar[XB_XCNT(j)]); sum += c; cnt += (c > 0u) ? 1u : 0u; mine = (j == x) ? c : mine; }
        if (sum == G) break;
        __builtin_amdgcn_s_sleep(1);
        if ((++sp & 255u) == 0u) { if (xb_ld(&bar[XB_TMO])) break; if (sp > XB_SPIN_CAP) { atomicAdd(&bar[XB_TMO], 1u); break; } }
    }
    nloc = mine > 0u ? mine : 1u; nx = cnt > 0u ? cnt : 1u;
}

__device__ __forceinline__ void xcd_barrier(const XcdBarrier& b) {
    asm volatile("s_waitcnt vmcnt(0)" ::: "memory");
    __syncthreads();
    if (threadIdx.x == 0) {
        unsigned* bar = b.bar;
        __builtin_amdgcn_s_waitcnt(0);
        unsigned nloc = b.st[0], nx = b.st[1];
        if (nloc == 0u) { xcd_barrier_complete(bar, b.x, nloc, nx); b.st[0] = nloc; b.st[1] = nx; }
        const unsigned old = xb_add(&bar[XB_XSUB(b.x)], 1u);
        const unsigned gen = old / nloc;
        if (old + 1u == (gen + 1u) * nloc) {
            __builtin_amdgcn_fence(__ATOMIC_RELEASE, "agent");
            asm volatile("s_waitcnt vmcnt(0)" ::: "memory");
            const unsigned og = xb_add(&bar[XB_TOP], 1u);
            const unsigned tg = og / nx;
            if (og + 1u == (tg + 1u) * nx) xb_add(&bar[XB_TOPGEN], 1u);
            else XB_SPIN(xb_ld(&bar[XB_TOPGEN]) == tg, bar);
            __builtin_amdgcn_fence(__ATOMIC_ACQUIRE, "agent");
            xb_add(&bar[XB_XGEN(b.x)], 1u);
            asm volatile("s_waitcnt vmcnt(0)" ::: "memory");
        } else {
            XB_SPIN(xb_ld(&bar[XB_XGEN(b.x)]) == gen, bar);
            __builtin_amdgcn_fence(__ATOMIC_ACQUIRE, "agent");
            asm volatile("s_waitcnt vmcnt(0)" ::: "memory");
        }
    }
    __syncthreads();
}

#if TSEL >= 7
#define TSUB_BEGIN(k) unsigned long long tsub_b = 0; if ((TSEL) == (k) && threadIdx.x == 0) tsub_b = __builtin_amdgcn_s_memrealtime();
#define TSUB_END(k) if ((TSEL) == (k) && threadIdx.x == 0) { volatile LAS unsigned long long* TWs = (volatile LAS unsigned long long*)((LAS unsigned char*)lds_raw + LDS_BARST + 16); TWs[2] += __builtin_amdgcn_s_memrealtime() - tsub_b; }
#else
#define TSUB_BEGIN(k)
#define TSUB_END(k)
#endif
constexpr int NPH = 15;
__global__ void __launch_bounds__(NTHR, 2) hymba_fwd(Params p0) {
    extern __shared__ __attribute__((aligned(16))) unsigned char lds_raw[];
    cg::grid_group grid = cg::this_grid();
    const int G = gridDim.x;
    if (threadIdx.x < 16) ((LAS unsigned*)((LAS unsigned char*)lds_raw + LDS_BARST))[threadIdx.x] = 0u;
    __syncthreads();
    XcdBarrier bar = xcd_barrier_post((unsigned*)(p0.ws + WS_CTL), (volatile LAS unsigned*)((LAS unsigned char*)lds_raw + LDS_BARST));
#if TSEL >= 0
    volatile LAS unsigned long long* TW = (volatile LAS unsigned long long*)((LAS unsigned char*)lds_raw + LDS_BARST + 16);
    if (threadIdx.x == 0) { const unsigned long long t = __builtin_amdgcn_s_memrealtime(); TW[0] = t; TW[1] = t; TW[2] = 0; }
#endif
    for (int ph = p0.ph_lo; ph < p0.ph_hi; ++ph) {
        const int ptype = ph == 0 ? 0 : 1 + (ph - 1) % 7;
        const int nrep = (REPEAT_MASK) == 0 ? 1 : ((((REPEAT_MASK) >> ptype) & 1) ? 2 : 1);
        for (int rep = 0; rep < nrep; ++rep) {
        int tid = threadIdx.x; asm volatile("" : "+v"(tid));
        const int lane = tid & 63, wave = __builtin_amdgcn_readfirstlane(tid >> 6);
        LAS unsigned char* lds = (LAS unsigned char*)lds_raw; asm volatile("" : "+s"(lds));
        Params p = p0;
        asm volatile("" : "+s"(p.ws)); asm volatile("" : "+s"(p.x)); asm volatile("" : "+s"(p.out)); asm volatile("" : "+s"(p.w_in)); asm volatile("" : "+s"(p.w_out));
        asm volatile("" : "+s"(p.conv_w)); asm volatile("" : "+s"(p.norm_g)); asm volatile("" : "+s"(p.mnorm_g)); asm volatile("" : "+s"(p.b_gate)); asm volatile("" : "+s"(p.rel_bias)); asm volatile("" : "+s"(p.final_g));
        if (ph == 0) {
            prologue_transposes(p, lds, wave, lane);
            build_wgt(p, tid);
            norm_phase(p, p.x, 0, wave, lane);
        } else {
            const int l = (ph - 1) / 7, k = (ph - 1) % 7;
            if (k == 0) {
                pg8::Gemm g{(const pg8::bf16_t*)(p.ws + WS_XN), (const pg8::bf16_t*)(p.ws + WS_WIN + (size_t)l * 128 * MiB), SEQ, NU, DM};
                pg8::StaticOrder S; S.init(SEQ, NU, G, (int)blockIdx.x);
                pg8::EpiBf16Plain E{(pg8::bf16_t*)(p.ws + WS_U), NU};
                pg8::gemm_phase<pg8::EpiBf16Plain, pg8::StaticOrder, true, true>(lds, g, S, E);
            } else if (k == 1) {
                gate_items(p, lds, l, tid, wave, lane);
                conv_prepass(p, l, tid);
                const bool xmap = (G == 256); const int xcd = blockIdx.x & 7, xi = blockIdx.x >> 3;
                { TSUB_BEGIN(7)
                for (int rr = 0; rr < 1 + (REP_ATTN); ++rr)
                for (int it = blockIdx.x, rnd = 0; it < 3072; it += G, ++rnd) {
                    int item = it;
                    if (xmap) { const int h = 2 * xcd + rnd / 6, j = (rnd % 6) * 32 + xi; item = (j >> 6) * 1024 + h * 64 + (j & 63); }
                    attn_item(p, lds, item, tid, wave, lane); }
                TSUB_END(7) }
            } else if (k == 2) {
                const bool xmap = (G == 256); const int xcd = blockIdx.x & 7, xi = blockIdx.x >> 3;
                int tid3 = tid; asm volatile("" : "+v"(tid3));
                { TSUB_BEGIN(8)
                for (int rr = 0; rr < 1 + (REP_M1); ++rr)
                for (int it = blockIdx.x, rnd = 0; it < 512; it += G, ++rnd) {
                    int item = it;
                    if (xmap) item = (xcd * 16 + rnd * 8 + (xi >> 2)) * 4 + (xi & 3);
                    m1_item(p, lds, l, item, tid3, __builtin_amdgcn_readfirstlane(tid3 >> 6), tid3 & 63); __syncthreads(); }
                TSUB_END(8) }
                merge_phase(p, tid);
            } else if (k == 3) {
                m2_phase(p, tid);
            } else if (k == 4) {
                const bool xmap = (G == 256); const int xcd = blockIdx.x & 7, xi = blockIdx.x >> 3;
                TSUB_BEGIN(9)
                for (int it = blockIdx.x, rnd = 0; it < 512; it += G, ++rnd) {
                    int hh = it >> 7, qb = it & 127; if ((it >> 8) & 1) qb ^= 3;
                    if (xmap) { const int pair = xcd * 16 + rnd * 8 + (xi >> 2); hh = pair >> 5; qb = (pair & 31) * 4 + (rnd ? 3 - (xi & 3) : (xi & 3)); }
                    m3_item(p, lds, l, hh, qb, tid, wave, lane); }
                TSUB_END(9)
            } else if (k == 5) {
                pg8::Gemm g{(const pg8::bf16_t*)(p.ws + WS_Y), (const pg8::bf16_t*)(p.ws + WS_WOUT + (size_t)l * 32 * MiB), SEQ, DM, DM};
                pg8::StaticOrder S; S.init(SEQ, DM, G, (int)blockIdx.x);
                pg8::EpiResF32 E{l == 0 ? p.x : (const float*)(p.ws + WS_X1), l == 0 ? (float*)(p.ws + WS_X1) : p.out, DM};
                pg8::gemm_phase<pg8::EpiResF32, pg8::StaticOrder, true, true>(lds, g, S, E);
            } else {
                if (l == 0) norm_phase(p, (const float*)(p.ws + WS_X1), 1, wave, lane);
                else final_norm_phase(p, (LAS unsigned char*)lds_raw, wave, lane);
            }
        }
        __syncthreads();
        }
        if (ph + 1 < p0.ph_hi) { if (p0.ph_hi > NPH) grid.sync(); else xcd_barrier(bar); }
#if TSEL >= 0
        if (threadIdx.x == 0) { const unsigned long long now = __builtin_amdgcn_s_memrealtime(); if (ptype == (TSEL)) TW[2] += now - TW[1]; TW[1] = now;
          if (ph + 2 == p0.ph_hi) ((volatile LAS int*)TW)[8] = (int)((float)TW[2] / (float)(now - TW[0]) * 131072.f); }
        if (ph + 2 == p0.ph_hi) __syncthreads();
#endif
    }
}

extern "C" void kernel_launch(void* const* d_in, const int* in_sizes, int n_in, void* d_out, int out_size, void* d_ws, size_t ws_size, hipStream_t stream) {
    static int grid = 0;
    if (grid == 0) {
        if (n_in != 9 || in_sizes[0] != SEQ * DM || out_size != SEQ * DM || ws_size < WS_END) {
            fprintf(stderr, "kernel_launch: unexpected problem: n_in %d in0 %d out %d ws %zu (need %zu)\n", n_in, n_in > 0 ? in_sizes[0] : -1, out_size, ws_size, (size_t)WS_END); grid = -1; return; }
        int dev = 0, cus = 0, per_cu = 0;
        hipGetDevice(&dev);
        hipDeviceGetAttribute(&cus, hipDeviceAttributeMultiprocessorCount, dev);
        if (hipFuncSetAttribute((const void*)hymba_fwd, hipFuncAttributeMaxDynamicSharedMemorySize, LDS_BYTES) != hipSuccess) { fprintf(stderr, "kernel_launch: hipFuncSetAttribute failed\n"); grid = -1; return; }
        if (hipOccupancyMaxActiveBlocksPerMultiprocessor(&per_cu, (const void*)hymba_fwd, NTHR, LDS_BYTES) != hipSuccess || per_cu < 1) { fprintf(stderr, "kernel_launch: occupancy query gave %d\n", per_cu); per_cu = 1; }
        (void)hipGetLastError();
        grid = cus * per_cu;
        fprintf(stderr, "kernel_launch: %d CUs x %d = grid %d\n", cus, per_cu, grid);
    }
    if (grid < 0) return;
    if (hipMemsetAsync((char*)d_ws + WS_CTL, 0, 16384, stream) != hipSuccess) { fprintf(stderr, "kernel_launch: hipMemsetAsync failed\n"); return; }
    Params p{};
    p.x = (const float*)d_in[0]; p.norm_g = (const float*)d_in[1]; p.w_in = (const float*)d_in[2]; p.b_gate = (const float*)d_in[3]; p.conv_w = (const float*)d_in[4];
    p.mnorm_g = (const float*)d_in[5]; p.w_out = (const float*)d_in[6]; p.rel_bias = (const float*)d_in[7]; p.final_g = (const float*)d_in[8];
    p.out = (float*)d_out; p.ws = (unsigned char*)d_ws;
#if MULTI_LAUNCH
    for (int ph = 0; ph < NPH; ++ph) { p.ph_lo = ph; p.ph_hi = ph + 1; hipLaunchKernelGGL(hymba_fwd, dim3(grid), dim3(NTHR), LDS_BYTES, stream, p); }
#else
    p.ph_lo = 0; p.ph_hi = NPH;
    void* args[] = {&p};
    hipError_t e = hipLaunchCooperativeKernel((const void*)hymba_fwd, dim3(grid), dim3(NTHR), args, LDS_BYTES, stream);
    if (e != hipSuccess) fprintf(stderr, "kernel_launch: cooperative launch failed: %s (grid %d)\n", hipGetErrorString(e), grid);
#endif
}
```

```cpp
#include <hip/hip_runtime.h>
#include <hip/hip_cooperative_groups.h>
#include <cstdio>
#include <cstdint>
namespace cg = cooperative_groups;
namespace pg8 {
#define PG8_LAS __attribute__((address_space(3)))
typedef unsigned short bf16_t;
typedef short bf16x8 __attribute__((ext_vector_type(8)));
typedef float f32x4 __attribute__((ext_vector_type(4)));
typedef unsigned u32x4 __attribute__((ext_vector_type(4)));
constexpr int BM = 256, BK = 64, HALF = 128, HTB = HALF * BK * 2  , STAGE_BYTES = 8 * HTB, NXCD = 8, WGM = 8;

__host__ __device__ __forceinline__ int lds_byte(int r, int c) { const int st = (r >> 4) * 2 + (c >> 5), rr = r & 15, cc = c & 31, ob = rr * 64 + cc * 2; return st * 1024 + (ob ^ (((ob >> 9) & 1) << 5)); }
__host__ __device__ __forceinline__ void stage_rc(int b, int& R, int& C) { const int st = b / 1024, sb = b % 1024, swz = sb ^ (((sb >> 9) & 1) << 5); R = (st >> 1) * 16 + swz / 64; C = (st & 1) * 32 + (swz % 64) / 2; }
__host__ __device__ __forceinline__ int perm32(int rho) { const int n = rho >> 4, i = rho & 15; return 8 * (i >> 2) + 4 * n + (i & 3); }

struct Unit { int pm, pn; };
struct Gemm { const bf16_t* A; const bf16_t* Bt; int M, N, K; };

struct StaticOrder {
    int nM, nN, nwg, G, c;
    __host__ __device__ void init(int M, int N, int G_, int c_) { nM = M / BM; nN = N / BM; nwg = nM * nN; G = G_; c = c_; }
    __host__ __device__ bool next(int i, Unit& u) const {
        const long L = (long)i * G + c; if (L >= nwg) return false;
        int wgid = (int)L; { const int q = nwg / NXCD, r = nwg % NXCD, xcd = wgid % NXCD, off = wgid / NXCD; wgid = (xcd < r ? xcd * (q + 1) : r * (q + 1) + (xcd - r) * q) + off; }
        const int nig = WGM * nN, gid = wgid / nig, fm = gid * WGM, gsz = (nM - fm) < WGM ? (nM - fm) : WGM;
        u.pm = fm + ((wgid % nig) % gsz); u.pn = (wgid % nig) / gsz; return true;
    }
    __device__ __forceinline__ void a_ready(const Unit&) const {}
    __device__ __forceinline__ void done(const Unit&) const {}
};

__device__ __forceinline__ unsigned cvt_pk_bf16(float lo, float hi) { unsigned r; asm volatile("v_cvt_pk_bf16_f32 %0, %1, %2" : "=v"(r) : "v"(lo), "v"(hi)); return r; }
struct EpiBf16Plain {
    static constexpr bool PERM = true, AFTER_DRAIN = false;
    bf16_t* O; int ldc;
    __device__ __forceinline__ void operator()(const f32x4 (&acc)[2][2][4][2], const Unit& u, int wr, int wc, int fr, int fq) const {
        const int row0 = u.pm * BM + wr * 64 + fr; const int col0 = u.pn * BM + wc * 32 + 8 * fq;
#pragma unroll
        for (int ai = 0; ai < 2; ++ai)
#pragma unroll
            for (int m = 0; m < 4; ++m) { bf16_t* rowp = O + (size_t)(row0 + ai * HALF + m * 16) * ldc + col0;
#pragma unroll
                for (int bj = 0; bj < 2; ++bj) { const f32x4 v0 = acc[ai][bj][m][0], v1 = acc[ai][bj][m][1];
                    u32x4 w; w.x = cvt_pk_bf16(v0[0], v0[1]); w.y = cvt_pk_bf16(v0[2], v0[3]); w.z = cvt_pk_bf16(v1[0], v1[1]); w.w = cvt_pk_bf16(v1[2], v1[3]);
                    *(u32x4*)(rowp + bj * HALF) = w; } }
    }
};
struct EpiResF32 {
    static constexpr bool PERM = true, AFTER_DRAIN = false;
    const float* base; float* out; int ld;
    __device__ __forceinline__ void operator()(const f32x4 (&acc)[2][2][4][2], const Unit& u, int wr, int wc, int fr, int fq) const {
        const int row0 = u.pm * BM + wr * 64 + fr; const int col0 = u.pn * BM + wc * 32 + 8 * fq;
#pragma unroll
        for (int ai = 0; ai < 2; ++ai)
#pragma unroll
            for (int m = 0; m < 4; ++m) { const size_t ro = (size_t)(row0 + ai * HALF + m * 16) * ld + col0;
#pragma unroll
                for (int bj = 0; bj < 2; ++bj) {
                    const f32x4 b0 = *(const f32x4*)(base + ro + bj * HALF), b1 = *(const f32x4*)(base + ro + bj * HALF + 4);
                    *(f32x4*)(out + ro + bj * HALF) = acc[ai][bj][m][0] + b0;
                    *(f32x4*)(out + ro + bj * HALF + 4) = acc[ai][bj][m][1] + b1; } }
    }
};
template <class Epi, class Sched, bool ALIGN_EPI = false, bool SP2 = false>
__device__ __forceinline__ void gemm_phase(PG8_LAS unsigned char* lds, const Gemm g, const Sched& S, const Epi& E) {
    const int tid = threadIdx.x, wid = __builtin_amdgcn_readfirstlane(tid >> 6), lane = tid & 63, wr = wid >> 2, wc = wid & 3, fr = lane & 15, fq = lane >> 4;
    const int K = g.K, nt = K / BK;
    unsigned voffA[2], voffB[2];
#pragma unroll
    for (int i = 0; i < 2; ++i) { int R, C; stage_rc(tid * 16 + i * 8192, R, C); const int Rb = Epi::PERM ? ((R & ~31) + perm32(R & 31)) : R;
        voffA[i] = (unsigned)(R * K + C) * 2u; voffB[i] = (unsigned)(Rb * K + C) * 2u; }
    const size_t kstep = (size_t)(BK * 2);
    const size_t hstep = (size_t)HALF * K * 2;
    const size_t tstep = 2 * hstep;
    const unsigned ldsw = (unsigned)wid * 1024u;
    const int aoff = lds_byte(wr * 64 + fr, fq * 8), boff = lds_byte(wc * 32 + fr, fq * 8);
#define PG8_SA(b, h) (((b) * 2 + (h)) * HTB)
#define PG8_SB(b, h) ((4 + (b) * 2 + (h)) * HTB)
#define PG8_STAGE(bufoff, gbase, voff) do { _Pragma("unroll") for (int _i = 0; _i < 2; ++_i) \
        __builtin_amdgcn_global_load_lds((const unsigned*)((const char*)(gbase) + (voff)[_i]), (PG8_LAS unsigned*)(lds + (bufoff) + ldsw + _i * 8192), 16, 0, 0); } while (0)
#define PG8_LDA(dst, b, h) do { _Pragma("unroll") for (int m = 0; m < 4; ++m) _Pragma("unroll") for (int k = 0; k < 2; ++k) dst[m][k] = *(const PG8_LAS bf16x8*)(lds + PG8_SA(b, h) + aoff + m * 2048 + k * 1024); } while (0)
#define PG8_LDB(dst, b, h) do { _Pragma("unroll") for (int n = 0; n < 2; ++n) _Pragma("unroll") for (int k = 0; k < 2; ++k) dst[n][k] = *(const PG8_LAS bf16x8*)(lds + PG8_SB(b, h) + boff + n * 2048 + k * 1024); } while (0)
#define PG8_MMA(ai, bj, At, Bt) do { __builtin_amdgcn_s_setprio(1); _Pragma("unroll") for (int m = 0; m < 4; ++m) _Pragma("unroll") for (int n = 0; n < 2; ++n) _Pragma("unroll") for (int k = 0; k < 2; ++k) \
        acc[ai][bj][m][n] = __builtin_amdgcn_mfma_f32_16x16x32_bf16(Bt[n][k], At[m][k], acc[ai][bj][m][n], 0, 0, 0); __builtin_amdgcn_s_setprio(0); } while (0)
#define PG8_WAIT_V(n) asm volatile("s_waitcnt vmcnt(" #n ")" ::: "memory")
#define PG8_WAIT_L(n) asm volatile("s_waitcnt lgkmcnt(" #n ")" ::: "memory")
#define PG8_BAR __builtin_amdgcn_s_barrier()
#define PG8_SCHED __builtin_amdgcn_sched_barrier(0)
    Unit cur, nxt; int ui = 0;
    if (!S.next(0, cur)) return;
    f32x4 acc[2][2][4][2];
#pragma unroll
    for (int a = 0; a < 2; ++a)
#pragma unroll
        for (int b = 0; b < 2; ++b)
#pragma unroll
            for (int m = 0; m < 4; ++m)
#pragma unroll
                for (int n = 0; n < 2; ++n) acc[a][b][m][n] = (f32x4){0.f, 0.f, 0.f, 0.f};
    bf16x8 At[4][2], B0[2][2], B1[2][2];
    const char* cA = (const char*)g.A + (size_t)cur.pm * tstep; const char* cB = (const char*)g.Bt + (size_t)cur.pn * tstep;
    S.a_ready(cur);
    if constexpr (SP2) {
        PG8_STAGE(PG8_SB(0, 0), cB, voffB); PG8_STAGE(PG8_SB(0, 1), cB + hstep, voffB); PG8_STAGE(PG8_SA(0, 0), cA, voffA); PG8_STAGE(PG8_SA(0, 1), cA + hstep, voffA);
        if (wr == 1) PG8_BAR;
        PG8_WAIT_V(2); PG8_BAR;
        PG8_STAGE(PG8_SB(1, 0), cB + kstep, voffB); PG8_STAGE(PG8_SA(1, 0), cA + kstep, voffA); PG8_STAGE(PG8_SB(1, 1), cB + hstep + kstep, voffB);
        PG8_WAIT_V(6); PG8_BAR;
    } else {
        PG8_STAGE(PG8_SB(0, 0), cB, voffB); PG8_STAGE(PG8_SA(0, 0), cA, voffA); PG8_STAGE(PG8_SB(0, 1), cB + hstep, voffB); PG8_STAGE(PG8_SA(0, 1), cA + hstep, voffA);
        if (wr == 1) PG8_BAR;
        PG8_WAIT_V(4); PG8_BAR;
        PG8_STAGE(PG8_SB(1, 0), cB + kstep, voffB); PG8_STAGE(PG8_SA(1, 0), cA + kstep, voffA); PG8_STAGE(PG8_SB(1, 1), cB + hstep + kstep, voffB);
        PG8_WAIT_V(6); PG8_BAR;
    }
    for (;;) {
        const bool has_next = S.next(ui + 1, nxt);
        const char* nA = has_next ? (const char*)g.A + (size_t)nxt.pm * tstep : cA; const char* nB = has_next ? (const char*)g.Bt + (size_t)nxt.pn * tstep : cB;
        for (int t = 0; t < nt; t += 2) {
            const bool last = (t == nt - 2);
            const char* a1 = cA + (size_t)(t + 1) * kstep;
            const char* a2 = last ? nA : cA + (size_t)(t + 2) * kstep; const char* b2 = last ? nB : cB + (size_t)(t + 2) * kstep;
            const char* a3 = a2 + kstep; const char* b3 = b2 + kstep;
            if (last && has_next) S.a_ready(nxt);
            if constexpr (SP2) {
            PG8_LDB(B0, 0, 0); PG8_LDB(B1, 0, 1); PG8_SCHED; PG8_LDA(At, 0, 0); PG8_STAGE(PG8_SA(1, 1), a1 + hstep, voffA);
            PG8_WAIT_V(8); PG8_WAIT_L(0); PG8_BAR; PG8_MMA(0, 0, At, B0); PG8_MMA(0, 1, At, B1); PG8_BAR; PG8_SCHED;
            PG8_LDA(At, 0, 1); PG8_STAGE(PG8_SB(0, 0), b2, voffB); PG8_STAGE(PG8_SB(0, 1), b2 + hstep, voffB); PG8_STAGE(PG8_SA(0, 0), a2, voffA);
            PG8_WAIT_V(8); PG8_WAIT_L(0); PG8_BAR; PG8_MMA(1, 0, At, B0); PG8_MMA(1, 1, At, B1); PG8_BAR; PG8_SCHED;
            PG8_LDB(B0, 1, 0); PG8_LDB(B1, 1, 1); PG8_SCHED; PG8_LDA(At, 1, 0); PG8_STAGE(PG8_SA(0, 1), a2 + hstep, voffA);
            PG8_WAIT_V(8); PG8_WAIT_L(0); PG8_BAR; PG8_MMA(0, 0, At, B0); PG8_MMA(0, 1, At, B1); PG8_BAR; PG8_SCHED;
            PG8_LDA(At, 1, 1); PG8_STAGE(PG8_SB(1, 0), b3, voffB); PG8_STAGE(PG8_SB(1, 1), b3 + hstep, voffB); PG8_STAGE(PG8_SA(1, 0), a3, voffA);
            PG8_WAIT_V(8); PG8_WAIT_L(0); PG8_BAR; PG8_MMA(1, 0, At, B0); PG8_MMA(1, 1, At, B1); PG8_BAR; PG8_SCHED;
            } else {
            PG8_LDB(B0, 0, 0); PG8_SCHED; PG8_LDA(At, 0, 0); PG8_STAGE(PG8_SA(1, 1), a1 + hstep, voffA);
            PG8_WAIT_L(8); PG8_BAR; PG8_WAIT_L(0); PG8_MMA(0, 0, At, B0); PG8_BAR; PG8_SCHED;
            PG8_LDB(B1, 0, 1); PG8_STAGE(PG8_SB(0, 0), b2, voffB);
            PG8_BAR; PG8_WAIT_L(0); PG8_MMA(0, 1, At, B1); PG8_BAR;
            PG8_LDA(At, 0, 1); PG8_STAGE(PG8_SA(0, 0), a2, voffA);
            PG8_BAR; PG8_WAIT_L(0); PG8_MMA(1, 0, At, B0); PG8_BAR; PG8_SCHED;
            PG8_STAGE(PG8_SB(0, 1), b2 + hstep, voffB);
            PG8_WAIT_V(6); PG8_BAR; PG8_MMA(1, 1, At, B1); PG8_BAR;
            PG8_LDB(B0, 1, 0); PG8_SCHED; PG8_LDA(At, 1, 0); PG8_STAGE(PG8_SA(0, 1), a2 + hstep, voffA);
            PG8_WAIT_L(8); PG8_BAR; PG8_WAIT_L(0); PG8_MMA(0, 0, At, B0); PG8_BAR; PG8_SCHED;
            PG8_LDB(B1, 1, 1); PG8_STAGE(PG8_SB(1, 0), b3, voffB);
            PG8_BAR; PG8_WAIT_L(0); PG8_MMA(0, 1, At, B1); PG8_BAR;
            PG8_LDA(At, 1, 1); PG8_STAGE(PG8_SA(1, 0), a3, voffA);
            PG8_BAR; PG8_WAIT_L(0); PG8_MMA(1, 0, At, B0); PG8_BAR; PG8_SCHED;
            PG8_STAGE(PG8_SB(1, 1), b3 + hstep, voffB);
            PG8_WAIT_V(6); PG8_BAR; PG8_MMA(1, 1, At, B1); PG8_BAR;
            }
        }
        if constexpr (ALIGN_EPI) { if (wr == 0) PG8_BAR; }
        if constexpr (!Epi::AFTER_DRAIN) { E(acc, cur, wr, wc, fr, fq); S.done(cur); }
        if (!has_next) break;
#pragma unroll
        for (int a = 0; a < 2; ++a)
#pragma unroll
            for (int b = 0; b < 2; ++b)
#pragma unroll
                for (int m = 0; m < 4; ++m)
#pragma unroll
                    for (int n = 0; n < 2; ++n) acc[a][b][m][n] = (f32x4){0.f, 0.f, 0.f, 0.f};
        cur = nxt; cA = nA; cB = nB; ++ui;
        if constexpr (ALIGN_EPI) { if (wr == 1) PG8_BAR; }
    }
    PG8_WAIT_V(0);
    if constexpr (!ALIGN_EPI) { if (wr == 0) PG8_BAR; }
    PG8_BAR;
    if constexpr (Epi::AFTER_DRAIN) { E.fused(acc, cur, wr, wc, fr, fq, lds, wid, lane); S.done(cur); }
#undef PG8_SA
#undef PG8_SB
#undef PG8_STAGE
#undef PG8_LDA
#undef PG8_LDB
#undef PG8_MMA
#undef PG8_WAIT_V
#undef PG8_WAIT_L
#undef PG8_BAR
#undef PG8_SCHED
}
}

#ifndef MULTI_LAUNCH
#define MULTI_LAUNCH 0
#endif
#ifndef USE_TR
#define USE_TR 1
#endif
#ifndef TSEL
#define TSEL (-1)
#endif
#ifndef REP_ATTN
#define REP_ATTN 0
#endif
#ifndef REP_M1
#define REP_M1 0
#endif
#ifndef REPEAT_MASK
#define REPEAT_MASK 0
#endif
#define LAS __attribute__((address_space(3)))
#define DI __device__ __forceinline__
typedef unsigned short bf16;
typedef short bf16x8 __attribute__((ext_vector_type(8)));
typedef float f32x4 __attribute__((ext_vector_type(4)));
typedef unsigned u32x4 __attribute__((ext_vector_type(4)));
typedef unsigned u32x2 __attribute__((ext_vector_type(2)));

constexpr int SEQ = 8192, DM = 4096, INW = 16392, NU = 16384;
constexpr int C_QA = 0, C_KA = 2048, C_VA = 4096, C_ZA = 6144, C_QM = 8192, C_KM = 9216, C_VM = 10240, C_OM = 12288, C_ZM = 14336;
constexpr float NORM_EPS = 1e-6f;
constexpr int NTHR = 512, NWAVE = 8;
constexpr int LDS_BYTES = 147456;

constexpr size_t MiB = (size_t)1 << 20;
constexpr size_t WS_WIN = 0, WS_WOUT = 256 * MiB, WS_XN = 320 * MiB, WS_U = 384 * MiB, WS_OP = 640 * MiB, WS_Y = 736 * MiB, WS_X1 = 800 * MiB,
                 WS_DC = 928 * MiB, WS_CS = 992 * MiB, WS_LSE = 1024 * MiB, WS_GATES = 1026 * MiB, WS_DN = 1027 * MiB, WS_NS = 1028 * MiB, WS_BL = 1029 * MiB,
                 WS_CTL = 1030 * MiB, WS_QKC = 1032 * MiB, WS_WGT = 1064 * MiB, WS_END = 1065 * MiB;
constexpr int LDS_BARST = LDS_BYTES - 64;

struct Params { const float *x, *norm_g, *w_in, *b_gate, *conv_w, *mnorm_g, *w_out, *rel_bias, *final_g; float* out; unsigned char* ws; int ph_lo, ph_hi; };

DI float bf_lo(unsigned u) { return __uint_as_float(u << 16); }
DI float bf_hi(unsigned u) { return __uint_as_float(u & 0xffff0000u); }
DI float bf2f(unsigned short u) { return __uint_as_float((unsigned)u << 16); }
DI unsigned pk2(float lo, float hi) { return pg8::cvt_pk_bf16(lo, hi); }
DI float wave_sum(float v) {
#pragma unroll
    for (int o = 1; o < 64; o <<= 1) v += __shfl_xor(v, o);
    return v;
}
DI float quad_sum(float v) { v += __shfl_xor(v, 16); v += __shfl_xor(v, 32); return v; }
DI float quad_max(float v) { v = fmaxf(v, __shfl_xor(v, 16)); v = fmaxf(v, __shfl_xor(v, 32)); return v; }
DI float silu_f(float x) { return x / (1.f + __expf(-x)); }
DI float sigm_f(float x) { return 1.f / (1.f + __expf(-x)); }
DI bf16x8 gatherT(const LAS unsigned short* p, int stride) {
    bf16x8 r;
#pragma unroll
    for (int j = 0; j < 8; ++j) r[j] = (short)p[j * stride];
    return r;
}
typedef short s16x4 __attribute__((ext_vector_type(4)));
DI bf16x8 trfrag(const LAS unsigned short* blk, int stride, int ql) {
#if USE_TR
    const LAS unsigned short* a = blk + (ql >> 2) * stride + 4 * (ql & 3);
    const s16x4 lo = __builtin_amdgcn_ds_read_tr16_b64_v4i16((LAS s16x4*)a);
    const s16x4 hi = __builtin_amdgcn_ds_read_tr16_b64_v4i16((LAS s16x4*)(a + 4 * stride));
    return (bf16x8){lo[0], lo[1], lo[2], lo[3], hi[0], hi[1], hi[2], hi[3]};
#else
    return gatherT(blk + ql, stride);
#endif
}
DI f32x4 mfma16(bf16x8 a, bf16x8 b, f32x4 c) { return __builtin_amdgcn_mfma_f32_16x16x32_bf16(a, b, c, 0, 0, 0); }
#define LDS_WAIT() asm volatile("s_waitcnt lgkmcnt(0)" ::: "memory")

struct TrTile { const float* src; bf16* dst; };
DI TrTile tr_tile_addr(const Params& p, int it, int lane) {
    constexpr int T_IN = 64 * 256, T_OUT = 64 * 64;
    const float* W; bf16* WT; int ldw, nb, kb;
    int r = it;
    if (r < T_IN) { W = p.w_in; WT = (bf16*)(p.ws + WS_WIN); ldw = INW; kb = r >> 8; nb = r & 255; }
    else if ((r -= T_IN) < T_OUT) { W = p.w_out; WT = (bf16*)(p.ws + WS_WOUT); ldw = DM; kb = r >> 6; nb = r & 63; }
    else if ((r -= T_OUT) < T_IN) { W = p.w_in + (size_t)DM * INW; WT = (bf16*)(p.ws + WS_WIN + 128 * MiB); ldw = INW; kb = r >> 8; nb = r & 255; }
    else { r -= T_IN; W = p.w_out + (size_t)DM * DM; WT = (bf16*)(p.ws + WS_WOUT + 32 * MiB); ldw = DM; kb = r >> 6; nb = r & 63; }
    TrTile t;
    t.src = W + (size_t)(kb * 64 + 16 * (lane >> 4)) * ldw + nb * 64 + 4 * (lane & 15);
    t.dst = WT + (size_t)(nb * 64 + (lane >> 3)) * DM + kb * 64 + 8 * (lane & 7);
    return t;
}
DI int tr_ldw(int it) { constexpr int T_IN = 64 * 256, T_OUT = 64 * 64; const int r = it % (T_IN + T_OUT); return r < T_IN ? INW : DM; }
DI void tr_load(const float* src, int ldw, f32x4 (&v)[16]) {
#pragma unroll
    for (int i = 0; i < 16; ++i) v[i] = *(const f32x4*)(src + (size_t)i * ldw);
}
DI void tr_store(const f32x4 (&v)[16], bf16* dst, LAS unsigned short* T, int lane) {
    const int kr = lane >> 4, nc = 4 * (lane & 15);
#pragma unroll
    for (int e = 0; e < 4; ++e)
#pragma unroll
        for (int hf = 0; hf < 2; ++hf) { u32x4 w;
            w.x = pk2(v[8 * hf + 0][e], v[8 * hf + 1][e]); w.y = pk2(v[8 * hf + 2][e], v[8 * hf + 3][e]); w.z = pk2(v[8 * hf + 4][e], v[8 * hf + 5][e]); w.w = pk2(v[8 * hf + 6][e], v[8 * hf + 7][e]);
            *(LAS u32x4*)(T + (nc + e) * 72 + 16 * kr + 8 * hf) = w; }
    LDS_WAIT(); asm volatile("" ::: "memory");
#pragma unroll
    for (int j = 0; j < 8; ++j) { const u32x4 w = *(const LAS u32x4*)(T + ((lane >> 3) + 8 * j) * 72 + 8 * (lane & 7)); *(u32x4*)(dst + (size_t)(8 * j) * DM) = w; }
    LDS_WAIT(); asm volatile("" ::: "memory");
}
DI void prologue_transposes(const Params& p, LAS unsigned char* lds, int wave, int lane) {
    LAS unsigned short* T = (LAS unsigned short*)(lds + wave * 16384);
    const int gw = blockIdx.x * NWAVE + wave, ngw = gridDim.x * NWAVE;
    constexpr int NIT = 2 * (64 * 256 + 64 * 64);
    f32x4 va[16], vb[16];
    int it = gw;
    if (it >= NIT) return;
    TrTile ta = tr_tile_addr(p, it, lane), tb;
    tr_load(ta.src, tr_ldw(it), va);
    for (;;) {
        const int it1 = it + ngw; const bool h1 = it1 < NIT;
        if (h1) { tb = tr_tile_addr(p, it1, lane); tr_load(tb.src, tr_ldw(it1), vb); }
        tr_store(va, ta.dst, T, lane);
        if (!h1) break;
        const int it2 = it1 + ngw; const bool h2 = it2 < NIT;
        if (h2) { ta = tr_tile_addr(p, it2, lane); tr_load(ta.src, tr_ldw(it2), va); }
        tr_store(vb, tb.dst, T, lane);
        if (!h2) break;
        it = it2;
    }
}

DI void norm_phase(const Params& p, const float* X, int l, int wave, int lane) {
    const float* g = p.norm_g + l * DM;
    bf16* XN = (bf16*)(p.ws + WS_XN);
    for (int row = blockIdx.x * NWAVE + wave; row < SEQ; row += gridDim.x * NWAVE) {
        const f32x4* xr = (const f32x4*)(X + (size_t)row * DM) + lane;
        f32x4 v[16]; float ss = 0.f;
#pragma unroll
        for (int j = 0; j < 16; ++j) { v[j] = xr[64 * j]; ss += (v[j].x * v[j].x + v[j].y * v[j].y) + (v[j].z * v[j].z + v[j].w * v[j].w); }
        const float rstd = rsqrtf(wave_sum(ss) * (1.f / DM) + NORM_EPS);
        u32x2* o8 = (u32x2*)(XN + (size_t)row * DM) + lane;
#pragma unroll
        for (int j = 0; j < 16; ++j) { const f32x4 h = v[j] * rstd * ((const f32x4*)g)[lane + 64 * j]; u32x2 w; w.x = pk2(h.x, h.y); w.y = pk2(h.z, h.w); o8[64 * j] = w; }
    }
}
DI void build_wgt(const Params& p, int tid) {
    bf16* WgT = (bf16*)(p.ws + WS_WGT);
    for (int gid = blockIdx.x * NTHR + tid; gid < 2 * 16 * DM; gid += gridDim.x * NTHR) {
        if (gid < 2 * 8 * DM) { const int l = gid >> 15, k = (gid >> 3) & (DM - 1), j = gid & 7;
            WgT[((size_t)l * 16 + j) * DM + k] = (bf16)(pk2(p.w_in[(size_t)l * DM * INW + (size_t)k * INW + NU + j], 0.f) & 0xffffu); }
        else { const int r = gid - 2 * 8 * DM, l = r >> 15, j = 8 + ((r >> 12) & 7), k = r & (DM - 1); WgT[((size_t)l * 16 + j) * DM + k] = 0; }
    }
}
DI void gate_items(const Params& p, LAS unsigned char* lds, int l, int tid, int wave, int lane) {
    const bf16* XN = (const bf16*)(p.ws + WS_XN);
    const bf16* WgT = (const bf16*)(p.ws + WS_WGT) + (size_t)l * 16 * DM;
    float* gates = (float*)(p.ws + WS_GATES);
    LAS float* red = (LAS float*)lds;
    const int ql = lane & 15, quad = lane >> 4;
    for (int t = blockIdx.x; t < SEQ / 16; t += gridDim.x) {
        const bf16* a = WgT + (size_t)ql * DM + wave * 512 + quad * 8; const bf16* b = XN + (size_t)(t * 16 + ql) * DM + wave * 512 + quad * 8;
        f32x4 acc0 = {0.f, 0.f, 0.f, 0.f}, acc1 = {0.f, 0.f, 0.f, 0.f};
#pragma unroll
        for (int i = 0; i < 16; i += 2) { acc0 = mfma16(*(const bf16x8*)(a + i * 32), *(const bf16x8*)(b + i * 32), acc0); acc1 = mfma16(*(const bf16x8*)(a + i * 32 + 32), *(const bf16x8*)(b + i * 32 + 32), acc1); }
        const f32x4 r = acc0 + acc1;
        if (quad < 2) *(LAS f32x4*)(red + (wave * 16 + ql) * 8 + quad * 4) = r;
        __syncthreads();
        if (tid < 128) { float sum = p.b_gate[l * 8 + (tid & 7)];
#pragma unroll
            for (int w = 0; w < 8; ++w) sum += red[w * 128 + tid];
            gates[(size_t)t * 128 + tid] = sum; }
        __syncthreads();
    }
}
DI void final_norm_phase(const Params& p, LAS unsigned char* lds0, int wave, int lane) {
#if TSEL >= 0
    const int n2 = ((volatile LAS int*)(lds0 + LDS_BARST + 16))[8];
#endif
    for (int row = blockIdx.x * NWAVE + wave; row < SEQ; row += gridDim.x * NWAVE) {
        f32x4* xr = (f32x4*)(p.out + (size_t)row * DM) + lane;
        f32x4 v[16]; float ss = 0.f;
#pragma unroll
        for (int j = 0; j < 16; ++j) { v[j] = xr[64 * j]; ss += (v[j].x * v[j].x + v[j].y * v[j].y) + (v[j].z * v[j].z + v[j].w * v[j].w); }
        const float rstd = rsqrtf(wave_sum(ss) * (1.f / DM) + NORM_EPS);
#pragma unroll
        for (int j = 0; j < 16; ++j) { f32x4 o = v[j] * rstd * ((const f32x4*)p.final_g)[lane + 64 * j];
#if TSEL >= 0
            if (blockIdx.x == 0) { const int e0 = ((row >> 11) * 8 + (row & 7)) * 4096 + 4 * (lane + 64 * j);
                o.x += (e0 + 0 < n2) ? 0.02f : 0.f; o.y += (e0 + 1 < n2) ? 0.02f : 0.f; o.z += (e0 + 2 < n2) ? 0.02f : 0.f; o.w += (e0 + 3 < n2) ? 0.02f : 0.f; }
#endif
            xr[64 * j] = o; }
    }
}

constexpr int AT_KS = 136;
#define ATT_DECODE(item) const int pat = (item) >> 10, h = ((item) & 1023) >> 6, rb_ = (item) & 63, dsh = pat * 2, r = rb_ >> (6 - dsh), bq = rb_ & ((64 >> dsh) - 1), sub0 = 128 * bq - 128; (void)sub0; (void)r; (void)h;
DI void att_load_kv(const bf16* U, int item, int tid, int coff, u32x4 (&v)[8]) {
    ATT_DECODE(item)
#pragma unroll
    for (int i = 0; i < 8; ++i) { const int c = tid + NTHR * i, row = c >> 4, ch = c & 15; int sub = sub0 + row; sub = sub < 0 ? 0 : sub;
        v[i] = *(const u32x4*)(U + (size_t)((sub << dsh) + r) * NU + coff + h * 128 + ch * 8); }
}
DI void att_store(LAS unsigned short* dst, int tid, const u32x4 (&v)[8]) {
#pragma unroll
    for (int i = 0; i < 8; ++i) { const int c = tid + NTHR * i, row = c >> 4, ch = c & 15; *(LAS u32x4*)(dst + row * AT_KS + ch * 8) = v[i]; }
}
DI void att_load_q(const bf16* U, int item, int wave, int lane, bf16x8 (&qf)[4]) {
    ATT_DECODE(item)
    const int tq = ((128 * bq + wave * 16 + (lane & 15)) << dsh) + r;
#pragma unroll
    for (int ks = 0; ks < 4; ++ks) qf[ks] = *(const bf16x8*)(U + (size_t)tq * NU + C_QA + h * 128 + ks * 32 + (lane >> 4) * 8);
}
DI void att_bias(const Params& p, int item, int tid, LAS float* biasS) {
    ATT_DECODE(item)
    if (tid < 129) { const int n = tid << dsh; int b = n;
        if (n >= 16) { b = 16 + (int)floorf(log2f((float)n * 0.0625f) * (16.f / 7.f)); b = b > 31 ? 31 : b; }
        biasS[tid] = p.rel_bias[b * 16 + h]; }
}
DI int att_item_of(int rnd, bool xmap, int xcd, int xi) {
    if (!xmap) return blockIdx.x + rnd * gridDim.x;
    const int h = 2 * xcd + rnd / 6, j = (rnd % 6) * 32 + xi; return (j >> 6) * 1024 + h * 64 + (j & 63);
}
DI void attn_phase(const Params& p, LAS unsigned char* lds, int tid, int wave, int lane) {
    const bf16* U = (const bf16*)(p.ws + WS_U);
    LAS unsigned short* Ks = (LAS unsigned short*)lds;
    LAS unsigned short* Vs = Ks + 256 * AT_KS;
    LAS float* biasS = (LAS float*)(Vs + 256 * AT_KS);
    const int G = gridDim.x; const bool xmap = (G == 256); const int xcd = blockIdx.x & 7, xi = blockIdx.x >> 3;
    const int nrnd = ((int)blockIdx.x < 3072) ? (3072 - (int)blockIdx.x + G - 1) / G : 0;
    if (nrnd <= 0) return;
    const int ql = lane & 15, quad = lane >> 4, q0 = wave * 16;
    bf16x8 qf[4];
    { const int item0 = att_item_of(0, xmap, xcd, xi); u32x4 kv[8], vv[8];
      att_load_kv(U, item0, tid, C_KA, kv); att_load_kv(U, item0, tid, C_VA, vv); att_load_q(U, item0, wave, lane, qf); att_bias(p, item0, tid, biasS);
      att_store(Ks, tid, kv); att_store(Vs, tid, vv); }
    __syncthreads();
    for (int rnd = 0; rnd < nrnd; ++rnd) {
        const int item = att_item_of(rnd, xmap, xcd, xi), next = rnd + 1 < nrnd ? att_item_of(rnd + 1, xmap, xcd, xi) : -1;
        ATT_DECODE(item)
        const int tq = ((128 * bq + q0 + ql) << dsh) + r;
        f32x4 sacc[10];
#pragma unroll
        for (int t = 0; t < 10; ++t) sacc[t] = (f32x4){0.f, 0.f, 0.f, 0.f};
#pragma unroll
        for (int s = 0; s < 5; ++s)
#pragma unroll
            for (int u = 0; u < 2; ++u) { int kk = q0 + 32 * s + (ql >> 2) * 8 + u * 4 + (ql & 3); kk = kk > 255 ? 255 : kk;
                const LAS unsigned short* kp = Ks + kk * AT_KS + quad * 8;
#pragma unroll
                for (int ks = 0; ks < 4; ++ks) sacc[2 * s + u] = mfma16(*(const LAS bf16x8*)(kp + ks * 32), qf[ks], sacc[2 * s + u]); }
        __syncthreads();
        u32x4 kv[8], vv[8]; bf16x8 qn[4];
        if (next >= 0) { att_load_kv(U, next, tid, C_KA, kv); att_load_q(U, next, wave, lane, qn); }
        const float scale = 0.08838834764831845f;
        float mx = -1e30f;
        int ql2 = ql, quad2 = quad; asm volatile("" : "+v"(ql2), "+v"(quad2));
#pragma unroll
        for (int s = 0; s < 5; ++s)
#pragma unroll
            for (int u = 0; u < 2; ++u)
#pragma unroll
                for (int j = 0; j < 4; ++j) { const int koff = 32 * s + quad2 * 8 + u * 4 + j, rel = koff - ql2;
                    const bool valid = (rel >= 0) && (rel <= 128) && (sub0 + q0 + koff >= 0);
                    int jo = 128 - rel; jo = jo < 0 ? 0 : (jo > 128 ? 128 : jo);
                    const float v = valid ? sacc[2 * s + u][j] * scale + biasS[jo] : -1e30f;
                    sacc[2 * s + u][j] = v; mx = fmaxf(mx, v); }
        mx = quad_max(mx);
        float l = 0.f;
#pragma unroll
        for (int t = 0; t < 10; ++t)
#pragma unroll
            for (int j = 0; j < 4; ++j) { const float e = __expf(sacc[t][j] - mx); sacc[t][j] = e; l += e; }
        l = quad_sum(l);
        if (next >= 0) att_load_kv(U, next, tid, C_VA, vv);
        f32x4 oacc[8];
#pragma unroll
        for (int nt = 0; nt < 8; ++nt) oacc[nt] = (f32x4){0.f, 0.f, 0.f, 0.f};
#pragma unroll
        for (int s = 0; s < 5; ++s) {
            u32x4 pw; pw.x = pk2(sacc[2 * s][0], sacc[2 * s][1]); pw.y = pk2(sacc[2 * s][2], sacc[2 * s][3]); pw.z = pk2(sacc[2 * s + 1][0], sacc[2 * s + 1][1]); pw.w = pk2(sacc[2 * s + 1][2], sacc[2 * s + 1][3]);
            const bf16x8 pf = __builtin_bit_cast(bf16x8, pw);
            int key0 = q0 + 32 * s + quad * 8; key0 = key0 > 248 ? 248 : key0;
            const LAS unsigned short* vp = Vs + key0 * AT_KS;
#pragma unroll
            for (int nt = 0; nt < 8; ++nt) oacc[nt] = mfma16(trfrag(vp + nt * 16, AT_KS, ql), pf, oacc[nt]);
        }
        const float inv = 1.f / l;
        bf16* OP = (bf16*)(p.ws + WS_OP) + (size_t)pat * SEQ * 2048 + (size_t)tq * 2048 + h * 128 + quad * 4;
#pragma unroll
        for (int nt = 0; nt < 8; ++nt) { u32x2 w; w.x = pk2(oacc[nt][0] * inv, oacc[nt][1] * inv); w.y = pk2(oacc[nt][2] * inv, oacc[nt][3] * inv); *(u32x2*)(OP + nt * 16) = w; }
        if (quad == 0) ((float*)(p.ws + WS_LSE))[((size_t)pat * SEQ + tq) * 16 + h] = mx + __logf(l);
        if (next >= 0) att_store(Ks, tid, kv);
        __syncthreads();
        if (next >= 0) { att_store(Vs, tid, vv); att_bias(p, next, tid, biasS);
#pragma unroll
            for (int ks = 0; ks < 4; ++ks) qf[ks] = qn[ks]; }
        __syncthreads();
    }
}
DI void merge_phase(const Params& p, int tid) {
    const bf16* U = (const bf16*)(p.ws + WS_U);
    const bf16* OP = (const bf16*)(p.ws + WS_OP);
    const float* LSE = (const float*)(p.ws + WS_LSE);
    bf16* Y = (bf16*)(p.ws + WS_Y);
    const int gthreads = gridDim.x * NTHR;
    for (int idx0 = blockIdx.x * NTHR + tid; idx0 < SEQ * 256; idx0 += 4 * gthreads) {
        float l0[4], l1[4], l2[4]; u32x4 o0[4], o1[4], o2[4], z[4];
#pragma unroll
        for (int u = 0; u < 4; ++u) { int idx = idx0 + u * gthreads; idx = idx < SEQ * 256 ? idx : SEQ * 256 - 1;
            const int t = idx >> 8, c8 = idx & 255, h = c8 >> 4;
            l0[u] = LSE[(size_t)t * 16 + h]; l1[u] = LSE[((size_t)SEQ + t) * 16 + h]; l2[u] = LSE[((size_t)2 * SEQ + t) * 16 + h];
            const size_t o = (size_t)t * 2048 + c8 * 8;
            o0[u] = *(const u32x4*)(OP + o); o1[u] = *(const u32x4*)(OP + (size_t)SEQ * 2048 + o); o2[u] = *(const u32x4*)(OP + (size_t)2 * SEQ * 2048 + o);
            z[u] = *(const u32x4*)(U + (size_t)t * NU + C_ZA + c8 * 8); }
#pragma unroll
        for (int u = 0; u < 4; ++u) { const int idx = idx0 + u * gthreads;
            if (idx < SEQ * 256) { const int t = idx >> 8, c8 = idx & 255;
                const float M = fmaxf(l0[u], fmaxf(l1[u], l2[u]));
                float w0 = __expf(l0[u] - M), w1 = __expf(l1[u] - M), w2 = __expf(l2[u] - M);
                const float inv = 1.f / (w0 + w1 + w2); w0 *= inv; w1 *= inv; w2 *= inv;
                u32x4 y;
#pragma unroll
                for (int e = 0; e < 4; ++e) {
                    const float lo = (w0 * bf_lo(o0[u][e]) + w1 * bf_lo(o1[u][e]) + w2 * bf_lo(o2[u][e])) * silu_f(bf_lo(z[u][e]));
                    const float hi = (w0 * bf_hi(o0[u][e]) + w1 * bf_hi(o1[u][e]) + w2 * bf_hi(o2[u][e])) * silu_f(bf_hi(z[u][e]));
                    y[e] = pk2(lo, hi); }
                *(u32x4*)(Y + (size_t)t * DM + c8 * 8) = y; } }
    }
}

constexpr int M_KS = 264, M_VS3 = 520;
DI void conv8(const bf16* U, const float* cw, int t, int rawcol, int cch, float (&f)[8]) {
#pragma unroll
    for (int e = 0; e < 8; ++e) f[e] = 0.f;
#pragma unroll
    for (int j = 0; j < 4; ++j) { const int tt = t - 3 + j;
        if (tt >= 0) { const u32x4 raw = *(const u32x4*)(U + (size_t)tt * NU + rawcol);
            const f32x4 w0 = *(const f32x4*)(cw + j * 2048 + cch), w1 = *(const f32x4*)(cw + j * 2048 + cch + 4);
            f[0] += w0[0] * bf_lo(raw.x); f[1] += w0[1] * bf_hi(raw.x); f[2] += w0[2] * bf_lo(raw.y); f[3] += w0[3] * bf_hi(raw.y);
            f[4] += w1[0] * bf_lo(raw.z); f[5] += w1[1] * bf_hi(raw.z); f[6] += w1[2] * bf_lo(raw.w); f[7] += w1[3] * bf_hi(raw.w); } }
#pragma unroll
    for (int e = 0; e < 8; ++e) f[e] = silu_f(f[e]);
}
template <int NI, int MODE, int NB>
DI void conv_tile(const bf16* U, const float* cw, int t0, int rawcol0, int cch0, float sc, LAS unsigned short* dst, int tid, float bL, const LAS float* bS, const LAS float* liS, int roff) {
    const int ch = tid & 31, r0 = tid >> 5;
    f32x4 w[4][2];
#pragma unroll
    for (int j = 0; j < 4; ++j) { w[j][0] = *(const f32x4*)(cw + j * 2048 + cch0 + ch * 8); w[j][1] = *(const f32x4*)(cw + j * 2048 + cch0 + ch * 8 + 4); }
    const bf16* src = U + rawcol0 + ch * 8;
#pragma unroll
    for (int ib = 0; ib < NI; ib += NB) {
        u32x4 raw[NB][4];
#pragma unroll
        for (int i = 0; i < NB; ++i)
#pragma unroll
            for (int j = 0; j < 4; ++j) { const int tt = t0 + r0 + 16 * (ib + i) - 3 + j; const int tc = tt < 0 ? 0 : tt;
                raw[i][j] = *(const u32x4*)(src + (size_t)tc * NU); if (tt < 0) raw[i][j] = (u32x4){0u, 0u, 0u, 0u}; }
#pragma unroll
        for (int i = 0; i < NB; ++i) { const int row = r0 + 16 * (ib + i);
            float f[8];
#pragma unroll
            for (int e = 0; e < 8; ++e) f[e] = 0.f;
#pragma unroll
            for (int j = 0; j < 4; ++j) { const u32x4 rw = raw[i][j];
                f[0] += w[j][0][0] * bf_lo(rw.x); f[1] += w[j][0][1] * bf_hi(rw.x); f[2] += w[j][0][2] * bf_lo(rw.y); f[3] += w[j][0][3] * bf_hi(rw.y);
                f[4] += w[j][1][0] * bf_lo(rw.z); f[5] += w[j][1][1] * bf_hi(rw.z); f[6] += w[j][1][2] * bf_lo(rw.w); f[7] += w[j][1][3] * bf_hi(rw.w); }
            float m = sc;
            if (MODE == 1) m *= __expf(bL - bS[roff + row] + liS[roff + row]);
#pragma unroll
            for (int e = 0; e < 8; ++e) f[e] = silu_f(f[e]) * m;
            u32x4 o; o.x = pk2(f[0], f[1]); o.y = pk2(f[2], f[3]); o.z = pk2(f[4], f[5]); o.w = pk2(f[6], f[7]);
            *(LAS u32x4*)(dst + row * M_KS + ch * 8) = o; }
        __builtin_amdgcn_sched_barrier(0);
    }
}
DI void conv_prepass(const Params& p, int l, int tid) {
    const bf16* U = (const bf16*)(p.ws + WS_U);
    const float* cw = p.conv_w + (size_t)l * 4 * 2048;
    bf16* QKC = (bf16*)(p.ws + WS_QKC);
    for (int gid = blockIdx.x * NTHR + tid; gid < 256 * 512; gid += gridDim.x * NTHR) {
        const int cidx = gid & 255, t0 = (gid >> 8) * 16;
        f32x4 w[4][2];
#pragma unroll
        for (int j = 0; j < 4; ++j) { w[j][0] = *(const f32x4*)(cw + j * 2048 + cidx * 8); w[j][1] = *(const f32x4*)(cw + j * 2048 + cidx * 8 + 4); }
        const bf16* src = U + C_QM + cidx * 8;
        u32x4 raw[19];
#pragma unroll
        for (int i = 0; i < 19; ++i) { const int tt = t0 - 3 + i; const int tc = tt < 0 ? 0 : tt; raw[i] = *(const u32x4*)(src + (size_t)tc * NU); if (tt < 0) raw[i] = (u32x4){0u, 0u, 0u, 0u}; }
        const float sc = cidx >= 128 ? 0.0625f : 1.f;
#pragma unroll
        for (int i = 0; i < 16; ++i) {
            float f[8];
#pragma unroll
            for (int e = 0; e < 8; ++e) f[e] = 0.f;
#pragma unroll
            for (int j = 0; j < 4; ++j) { const u32x4 rw = raw[i + j];
                f[0] += w[j][0][0] * bf_lo(rw.x); f[1] += w[j][0][1] * bf_hi(rw.x); f[2] += w[j][0][2] * bf_lo(rw.y); f[3] += w[j][0][3] * bf_hi(rw.y);
                f[4] += w[j][1][0] * bf_lo(rw.z); f[5] += w[j][1][1] * bf_hi(rw.z); f[6] += w[j][1][2] * bf_lo(rw.w); f[7] += w[j][1][3] * bf_hi(rw.w); }
#pragma unroll
            for (int e = 0; e < 8; ++e) f[e] = silu_f(f[e]) * sc;
            u32x4 o; o.x = pk2(f[0], f[1]); o.y = pk2(f[2], f[3]); o.z = pk2(f[4], f[5]); o.w = pk2(f[6], f[7]);
            *(u32x4*)(QKC + (size_t)(t0 + i) * 2048 + cidx * 8) = o; }
    }
}
DI void chunk_gates(const float* gates, int c, int hh, LAS float* bS, LAS float* liS, LAS float* wtot, int tid, int wave, int lane) {
    float v = 0.f;
    if (tid < 256) { const float* gp = gates + (size_t)(c * 256 + tid) * 8; const float fgv = gp[4 + hh]; liS[tid] = gp[hh];
        v = fminf(fgv, 0.f) - log1pf(__expf(-fabsf(fgv)));
#pragma unroll
        for (int o = 1; o < 64; o <<= 1) { const float t = __shfl_up(v, o); if (lane >= o) v += t; }
        if (lane == 63) wtot[wave] = v; }
    __syncthreads();
    if (tid < 256) { float pre = 0.f; for (int w = 0; w < wave; ++w) pre += wtot[w]; bS[tid] = v + pre; }
    __syncthreads();
}
DI void m1_item(const Params& p, LAS unsigned char* lds, int l, int item, int tid, int wave, int lane) {
    const bf16* U = (const bf16*)(p.ws + WS_U);
    const bf16* QKC = (const bf16*)(p.ws + WS_QKC);
    LAS unsigned short* Kp = (LAS unsigned short*)lds;
    LAS unsigned short* Vs = Kp + 128 * M_KS;
    LAS float* bS = (LAS float*)(Vs + 128 * AT_KS); LAS float* liS = bS + 256; LAS float* wtot = liS + 256;
    const int hh = item >> 7, c = (item >> 2) & 31, sl = item & 3;
    const int ql = lane & 15, quad = lane >> 4;
    chunk_gates((const float*)(p.ws + WS_GATES), c, hh, bS, liS, wtot, tid, wave, lane);
    const float bL = bS[255];
    f32x4 acc[4][4];
#pragma unroll
    for (int a = 0; a < 4; ++a)
#pragma unroll
        for (int b = 0; b < 4; ++b) acc[a][b] = (f32x4){0.f, 0.f, 0.f, 0.f};
    f32x4 nacc[4];
#pragma unroll
    for (int b = 0; b < 4; ++b) nacc[b] = (f32x4){0.f, 0.f, 0.f, 0.f};
    const bool do_n = (sl == 0) && ((wave & 1) == 0);
    const bf16x8 ones = {0x3F80, 0x3F80, 0x3F80, 0x3F80, 0x3F80, 0x3F80, 0x3F80, 0x3F80};
    const int dvt0 = (wave & 1) * 4, dkt0 = (wave >> 1) * 4;
    for (int half = 0; half < 2; ++half) {
#pragma unroll
        for (int ib = 0; ib < 8; ib += 4) { u32x4 kr[4];
#pragma unroll
            for (int i = 0; i < 4; ++i) { const int cc = tid + NTHR * (ib + i), row = cc >> 5, ch = cc & 31; kr[i] = *(const u32x4*)(QKC + (size_t)(c * 256 + half * 128 + row) * 2048 + 1024 + hh * 256 + ch * 8); }
#pragma unroll
            for (int i = 0; i < 4; ++i) { const int cc = tid + NTHR * (ib + i), row = cc >> 5, ch = cc & 31, sloc = half * 128 + row;
                const float wgt = __expf(bL - bS[sloc] + liS[sloc]);
                u32x4 w; w.x = pk2(bf_lo(kr[i].x) * wgt, bf_hi(kr[i].x) * wgt); w.y = pk2(bf_lo(kr[i].y) * wgt, bf_hi(kr[i].y) * wgt); w.z = pk2(bf_lo(kr[i].z) * wgt, bf_hi(kr[i].z) * wgt); w.w = pk2(bf_lo(kr[i].w) * wgt, bf_hi(kr[i].w) * wgt);
                *(LAS u32x4*)(Kp + row * M_KS + ch * 8) = w; } }
#pragma unroll
        for (int i = 0; i < 4; ++i) { const int cc = tid + NTHR * i, row = cc >> 4, ch = cc & 15;
            *(LAS u32x4*)(Vs + row * AT_KS + ch * 8) = *(const u32x4*)(U + (size_t)(c * 256 + half * 128 + row) * NU + C_VM + hh * 512 + sl * 128 + ch * 8); }
        __syncthreads();
#pragma unroll 1
        for (int ks = 0; ks < 4; ++ks) {
            bf16x8 af[4], bfr[4];
#pragma unroll
            for (int a = 0; a < 4; ++a) af[a] = trfrag(Vs + (ks * 32 + quad * 8) * AT_KS + (dvt0 + a) * 16, AT_KS, ql);
#pragma unroll
            for (int b = 0; b < 4; ++b) bfr[b] = trfrag(Kp + (ks * 32 + quad * 8) * M_KS + (dkt0 + b) * 16, M_KS, ql);
#pragma unroll
            for (int a = 0; a < 4; ++a)
#pragma unroll
                for (int b = 0; b < 4; ++b) acc[a][b] = mfma16(af[a], bfr[b], acc[a][b]);
            if (do_n) {
#pragma unroll
                for (int b = 0; b < 4; ++b) nacc[b] = mfma16(ones, bfr[b], nacc[b]); }
        }
        __syncthreads();
    }
    float* DC = (float*)(p.ws + WS_DC) + ((size_t)(hh * 32 + c) * 512 + sl * 128) * 256;
#pragma unroll
    for (int a = 0; a < 4; ++a)
#pragma unroll
        for (int b = 0; b < 4; ++b)
#pragma unroll
            for (int j = 0; j < 4; ++j) DC[(size_t)((dvt0 + a) * 16 + quad * 4 + j) * 256 + (dkt0 + b) * 16 + ql] = acc[a][b][j];
    if (do_n && quad == 0) {
#pragma unroll
        for (int b = 0; b < 4; ++b) ((float*)(p.ws + WS_DN))[(hh * 32 + c) * 256 + (dkt0 + b) * 16 + ql] = nacc[b][0]; }
    if (sl == 0 && tid == 0) ((float*)(p.ws + WS_BL))[hh * 32 + c] = bL;
}
DI void m2_phase(const Params& p, int tid) {
    const float* DC = (const float*)(p.ws + WS_DC); const float* BL = (const float*)(p.ws + WS_BL);
    bf16* CS = (bf16*)(p.ws + WS_CS);
    const int gthreads = gridDim.x * NTHR, gid = blockIdx.x * NTHR + tid;
    for (int e4 = gid; e4 < 4 * 32768; e4 += gthreads) {
        const int hh = e4 >> 15, e = e4 & 32767;
        f32x4 st = {0.f, 0.f, 0.f, 0.f};
#pragma unroll 8
        for (int c = 0; c < 32; ++c) {
            const size_t o = ((size_t)(hh * 32 + c) * 32768 + e) * 4;
            u32x2 w; w.x = pk2(st.x, st.y); w.y = pk2(st.z, st.w); *(u32x2*)(CS + o) = w;
            const f32x4 d = *(const f32x4*)(DC + o);
            st = st * __expf(BL[hh * 32 + c]) + d;
        }
    }
    if (gid < 1024) { const int hh = gid >> 8, dk = gid & 255; const float* DN = (const float*)(p.ws + WS_DN); float* NS = (float*)(p.ws + WS_NS);
        float dn[32], eb[32];
#pragma unroll
        for (int c = 0; c < 32; ++c) { dn[c] = DN[(hh * 32 + c) * 256 + dk]; eb[c] = BL[hh * 32 + c]; }
        float st = 0.f;
#pragma unroll
        for (int c = 0; c < 32; ++c) { NS[(hh * 32 + c) * 256 + dk] = st; st = st * __expf(eb[c]) + dn[c]; } }
}
DI void m3_item(const Params& p, LAS unsigned char* lds, int l, int hh, int qb, int tid, int wave, int lane) {
    const bf16* U = (const bf16*)(p.ws + WS_U);
    const bf16* QKC = (const bf16*)(p.ws + WS_QKC);
    LAS unsigned short* Qs = (LAS unsigned short*)lds;
    LAS unsigned short* Ks = Qs + 64 * M_KS;
    LAS unsigned short* Vs = Ks + 64 * M_KS;
    LAS float* bS = (LAS float*)(Vs + 64 * M_VS3); LAS float* liS = bS + 256; LAS float* nS = liS + 256; LAS float* wtot = nS + 256; LAS float* ssS = wtot + 8;
    const int c = qb >> 2, jq = qb & 3;
    const int ql = lane & 15, quad = lane >> 4;
    if (tid < 256) nS[tid] = ((const float*)(p.ws + WS_NS))[(hh * 32 + c) * 256 + tid];
    chunk_gates((const float*)(p.ws + WS_GATES), c, hh, bS, liS, wtot, tid, wave, lane);
    { u32x4 qv[4];
#pragma unroll
      for (int i = 0; i < 4; ++i) { const int cc = tid + NTHR * i, row = cc >> 5, ch = cc & 31; qv[i] = *(const u32x4*)(QKC + (size_t)(qb * 64 + row) * 2048 + hh * 256 + ch * 8); }
#pragma unroll
      for (int i = 0; i < 4; ++i) { const int cc = tid + NTHR * i, row = cc >> 5, ch = cc & 31; *(LAS u32x4*)(Qs + row * M_KS + ch * 8) = qv[i]; } }
    __syncthreads();
    const int qg = wave & 3, dvh = wave >> 2, q = qg * 16 + ql, iq = jq * 64 + q;
    bf16x8 qf[8];
#pragma unroll
    for (int ks = 0; ks < 8; ++ks) qf[ks] = *(const LAS bf16x8*)(Qs + q * M_KS + ks * 32 + quad * 8);
    const float b_q = bS[iq], eb = __expf(b_q);
    f32x4 acc[16];
#pragma unroll
    for (int nt = 0; nt < 16; ++nt) acc[nt] = (f32x4){0.f, 0.f, 0.f, 0.f};
    { const bf16* CT = (const bf16*)(p.ws + WS_CS) + (size_t)(hh * 32 + c) * 512 * 256;
      LAS unsigned short* Cs = Ks;
#pragma unroll 1
      for (int pc = 0; pc < 4; ++pc) {
          __syncthreads();
          u32x4 cv[8];
#pragma unroll
          for (int i = 0; i < 8; ++i) { const int cc = tid + NTHR * i, row = cc >> 5, ch = cc & 31;
              cv[i] = *(const u32x4*)(CT + (size_t)((row >> 6) * 256 + pc * 64 + (row & 63)) * 256 + ch * 8); }
#pragma unroll
          for (int i = 0; i < 8; ++i) { const int cc = tid + NTHR * i, row = cc >> 5, ch = cc & 31; *(LAS u32x4*)(Cs + row * M_KS + ch * 8) = cv[i]; }
          __syncthreads();
#pragma unroll
          for (int n4 = 0; n4 < 4; ++n4) { const LAS unsigned short* cp = Cs + (dvh * 64 + n4 * 16 + ql) * M_KS + quad * 8;
#pragma unroll
              for (int ks = 0; ks < 8; ++ks) acc[n4] = mfma16(*(const LAS bf16x8*)(cp + ks * 32), qf[ks], acc[n4]); }
          { const f32x4 t0 = acc[0], t1 = acc[1], t2 = acc[2], t3 = acc[3];
#pragma unroll
            for (int i = 0; i < 12; ++i) acc[i] = acc[i + 4];
            acc[12] = t0; acc[13] = t1; acc[14] = t2; acc[15] = t3; }
      }
    }
#pragma unroll
    for (int nt = 0; nt < 16; ++nt) acc[nt] = acc[nt] * eb;
    float nqp = 0.f;
#pragma unroll
    for (int ks = 0; ks < 8; ++ks)
#pragma unroll
        for (int j = 0; j < 8; ++j) nqp += bf2f((unsigned short)qf[ks][j]) * nS[ks * 32 + quad * 8 + j];
    float nq = quad_sum(nqp) * eb;
    float nqi = 0.f;
    for (int kt = 0; kt <= jq; ++kt) {
        __syncthreads();
        int tid2 = tid; asm volatile("" : "+v"(tid2));
#pragma unroll
        for (int ib = 0; ib < 8; ib += 4) { u32x4 vv[4];
#pragma unroll
            for (int i = 0; i < 4; ++i) { const int cc = tid2 + NTHR * (ib + i), row = cc >> 6, ch = cc & 63; vv[i] = *(const u32x4*)(U + (size_t)(c * 256 + kt * 64 + row) * NU + C_VM + hh * 512 + ch * 8); }
#pragma unroll
            for (int i = 0; i < 4; ++i) { const int cc = tid2 + NTHR * (ib + i), row = cc >> 6, ch = cc & 63; *(LAS u32x4*)(Vs + row * M_VS3 + ch * 8) = vv[i]; }
            __builtin_amdgcn_sched_barrier(0); }
        { u32x4 kv[4];
#pragma unroll
          for (int i = 0; i < 4; ++i) { const int cc = tid2 + NTHR * i, row = cc >> 5, ch = cc & 31; kv[i] = *(const u32x4*)(QKC + (size_t)(c * 256 + kt * 64 + row) * 2048 + 1024 + hh * 256 + ch * 8); }
#pragma unroll
          for (int i = 0; i < 4; ++i) { const int cc = tid2 + NTHR * i, row = cc >> 5, ch = cc & 31; *(LAS u32x4*)(Ks + row * M_KS + ch * 8) = kv[i]; } }
        __syncthreads();
        f32x4 sacc[4];
#pragma unroll
        for (int t = 0; t < 4; ++t) sacc[t] = (f32x4){0.f, 0.f, 0.f, 0.f};
#pragma unroll
        for (int s = 0; s < 2; ++s)
#pragma unroll
            for (int u = 0; u < 2; ++u) { const int krow = 32 * s + (ql >> 2) * 8 + u * 4 + (ql & 3);
                const LAS unsigned short* kp = Ks + krow * M_KS + quad * 8;
#pragma unroll
                for (int ks = 0; ks < 8; ++ks) sacc[2 * s + u] = mfma16(*(const LAS bf16x8*)(kp + ks * 32), qf[ks], sacc[2 * s + u]); }
#pragma unroll
        for (int s = 0; s < 2; ++s)
#pragma unroll
            for (int u = 0; u < 2; ++u)
#pragma unroll
                for (int j = 0; j < 4; ++j) { const int sk = kt * 64 + 32 * s + quad * 8 + u * 4 + j;
                    const float w = (sk <= iq) ? __expf(b_q - bS[sk] + liS[sk]) : 0.f;
                    const float pv = sacc[2 * s + u][j] * w; sacc[2 * s + u][j] = pv; nqi += pv; }
#pragma unroll
        for (int s = 0; s < 2; ++s) {
            u32x4 pw; pw.x = pk2(sacc[2 * s][0], sacc[2 * s][1]); pw.y = pk2(sacc[2 * s][2], sacc[2 * s][3]); pw.z = pk2(sacc[2 * s + 1][0], sacc[2 * s + 1][1]); pw.w = pk2(sacc[2 * s + 1][2], sacc[2 * s + 1][3]);
            const bf16x8 pf = __builtin_bit_cast(bf16x8, pw);
            const LAS unsigned short* vp = Vs + (32 * s + quad * 8) * M_VS3 + dvh * 256;
#pragma unroll
            for (int nt = 0; nt < 16; ++nt) acc[nt] = mfma16(trfrag(vp + nt * 16, M_VS3, ql), pf, acc[nt]);
        }
    }
    nq += quad_sum(nqi);
    const float inv = 1.f / fmaxf(fabsf(nq), 1.f);
    float ss = 0.f;
#pragma unroll
    for (int nt = 0; nt < 16; ++nt) { acc[nt] = acc[nt] * inv; ss += (acc[nt][0] * acc[nt][0] + acc[nt][1] * acc[nt][1]) + (acc[nt][2] * acc[nt][2] + acc[nt][3] * acc[nt][3]); }
    ss = quad_sum(ss);
    if (quad == 0) ssS[dvh * 64 + q] = ss;
    __syncthreads();
    const float rstd = rsqrtf((ssS[q] + ssS[64 + q]) * (1.f / 512.f) + NORM_EPS);
    const int t = qb * 64 + q;
    const float* ng = p.mnorm_g + l * 2048;
    bf16* Y = (bf16*)(p.ws + WS_Y);
#pragma unroll
    for (int nt = 0; nt < 16; ++nt) { const int col = hh * 512 + dvh * 256 + nt * 16 + quad * 4;
        const f32x4 g4 = *(const f32x4*)(ng + col);
        const u32x2 om = *(const u32x2*)(U + (size_t)t * NU + C_OM + col), zm = *(const u32x2*)(U + (size_t)t * NU + C_ZM + col);
        const float y0 = acc[nt][0] * rstd * g4[0] * sigm_f(bf_lo(om.x)) * silu_f(bf_lo(zm.x));
        const float y1 = acc[nt][1] * rstd * g4[1] * sigm_f(bf_hi(om.x)) * silu_f(bf_hi(zm.x));
        const float y2 = acc[nt][2] * rstd * g4[2] * sigm_f(bf_lo(om.y)) * silu_f(bf_lo(zm.y));
        const float y3 = acc[nt][3] * rstd * g4[3] * sigm_f(bf_hi(om.y)) * silu_f(bf_hi(zm.y));
        u32x2 w; w.x = pk2(y0, y1); w.y = pk2(y2, y3);
        *(u32x2*)(Y + (size_t)t * DM + 2048 + col) = w;
        if ((nt & 3) == 3) __builtin_amdgcn_sched_barrier(0); }
    __syncthreads();
}

#define RLX_AGENT __ATOMIC_RELAXED, __HIP_MEMORY_SCOPE_AGENT
#define XB_TMO      128
#define XB_XCNT(j)  (256  + 64 * (j))
#define XB_XSUB(j)  (1280 + 64 * (j))
#define XB_XGEN(j)  (2304 + 64 * (j))
#define XB_TOP      3328
#define XB_TOPGEN   3392
#define XCD_BAR_WORDS 3456
#define XB_SPIN_CAP (1u << 18)

__device__ __forceinline__ unsigned xb_ld(unsigned* p)              { return __hip_atomic_load(p, __ATOMIC_RELAXED, __HIP_MEMORY_SCOPE_AGENT); }
__device__ __forceinline__ unsigned xb_add(unsigned* p, unsigned v) { return __hip_atomic_fetch_add(p, v, __ATOMIC_RELAXED, __HIP_MEMORY_SCOPE_AGENT); }
__device__ __forceinline__ unsigned xb_xcc_id() { return (unsigned)__builtin_amdgcn_s_getreg((3 << 11) | 20) & 0xFu; }
#define XB_SPIN(cond, bar) do { unsigned _sp = 0; while (cond) { __builtin_amdgcn_s_sleep(1); \
    if ((++_sp & 255u) == 0u) { if (xb_ld(&(bar)[XB_TMO])) break; if (_sp > XB_SPIN_CAP) { atomicAdd(&(bar)[XB_TMO], 1u); break; } } } } while (0)

struct XcdBarrier {
    unsigned* bar; unsigned x;
    volatile LAS unsigned* st;
};

__device__ __forceinline__ XcdBarrier xcd_barrier_post(unsigned* bar, volatile LAS unsigned* st) {
    XcdBarrier b; b.bar = bar; b.x = xb_xcc_id(); b.st = st;
    if (threadIdx.x == 0) (void)xb_add(&bar[XB_XCNT(b.x)], 1u);
    return b;
}
__device__ __forceinline__ void xcd_barrier_complete(unsigned* bar, unsigned x, unsigned& nloc, unsigned& nx) {
    const unsigned G = gridDim.x * gridDim.y * gridDim.z;
    unsigned sum, cnt, mine, sp = 0u;
    for (;;) {
        sum = 0u; cnt = 0u; mine = 0u;
#pragma unroll
        for (unsigned j = 0; j < 16; ++j) { const unsigned c = xb_ld(&bar[XB_XCNT(j)]); sum += c; cnt += (c > 0u) ? 1u : 0u; mine = (j == x) ? c : mine; }
        if (sum == G) break;
        __builtin_amdgcn_s_sleep(1);
        if ((++sp & 255u) == 0u) { if (xb_ld(&bar[XB_TMO])) break; if (sp > XB_SPIN_CAP) { atomicAdd(&bar[XB_TMO], 1u); break; } }
    }
    nloc = mine > 0u ? mine : 1u; nx = cnt > 0u ? cnt : 1u;
}

__device__ __forceinline__ void xcd_barrier(const XcdBarrier& b) {
    asm volatile("s_waitcnt vmcnt(0)" ::: "memory");
    __syncthreads();
    if (threadIdx.x == 0) {
        unsigned* bar = b.bar;
        __builtin_amdgcn_s_waitcnt(0);
        unsigned nloc = b.st[0], nx = b.st[1];
        if (nloc == 0u) { xcd_barrier_complete(bar, b.x, nloc, nx); b.st[0] = nloc; b.st[1] = nx; }
        const unsigned old = xb_add(&bar[XB_XSUB(b.x)], 1u);
        const unsigned gen = old / nloc;
        if (old + 1u == (gen + 1u) * nloc) {
            __builtin_amdgcn_fence(__ATOMIC_RELEASE, "agent");
            asm volatile("s_waitcnt vmcnt(0)" ::: "memory");
            const unsigned og = xb_add(&bar[XB_TOP], 1u);
            const unsigned tg = og / nx;
            if (og + 1u == (tg + 1u) * nx) xb_add(&bar[XB_TOPGEN], 1u);
            else XB_SPIN(xb_ld(&bar[XB_TOPGEN]) == tg, bar);
            __builtin_amdgcn_fence(__ATOMIC_ACQUIRE, "agent");
            xb_add(&bar[XB_XGEN(b.x)], 1u);
            asm volatile("s_waitcnt vmcnt(0)" ::: "memory");
        } else {
            XB_SPIN(xb_ld(&bar[XB_XGEN(b.x)]) == gen, bar);
            __builtin_amdgcn_fence(__ATOMIC_ACQUIRE, "agent");
            asm volatile("s_waitcnt vmcnt(0)" ::: "memory");
        }
    }
    __syncthreads();
}

#if TSEL >= 7
#define TSUB_BEGIN(k) unsigned long long tsub_b = 0; if ((TSEL) == (k) && threadIdx.x == 0) tsub_b = __builtin_amdgcn_s_memrealtime();
#define TSUB_END(k) if ((TSEL) == (k) && threadIdx.x == 0) { volatile LAS unsigned long long* TWs = (volatile LAS unsigned long long*)((LAS unsigned char*)lds_raw + LDS_BARST + 16); TWs[2] += __builtin_amdgcn_s_memrealtime() - tsub_b; }
#else
#define TSUB_BEGIN(k)
#define TSUB_END(k)
#endif
constexpr int NPH = 15;
__global__ void __launch_bounds__(NTHR, 2) hymba_fwd(Params p0) {
    extern __shared__ __attribute__((aligned(16))) unsigned char lds_raw[];
    cg::grid_group grid = cg::this_grid();
    const int G = gridDim.x;
    if (threadIdx.x < 16) ((LAS unsigned*)((LAS unsigned char*)lds_raw + LDS_BARST))[threadIdx.x] = 0u;
    __syncthreads();
    XcdBarrier bar = xcd_barrier_post((unsigned*)(p0.ws + WS_CTL), (volatile LAS unsigned*)((LAS unsigned char*)lds_raw + LDS_BARST));
#if TSEL >= 0
    volatile LAS unsigned long long* TW = (volatile LAS unsigned long long*)((LAS unsigned char*)lds_raw + LDS_BARST + 16);
    if (threadIdx.x == 0) { const unsigned long long t = __builtin_amdgcn_s_memrealtime(); TW[0] = t; TW[1] = t; TW[2] = 0; }
#endif
    for (int ph = p0.ph_lo; ph < p0.ph_hi; ++ph) {
        const int ptype = ph == 0 ? 0 : 1 + (ph - 1) % 7;
        const int nrep = (REPEAT_MASK) == 0 ? 1 : ((((REPEAT_MASK) >> ptype) & 1) ? 2 : 1);
        for (int rep = 0; rep < nrep; ++rep) {
        int tid = threadIdx.x; asm volatile("" : "+v"(tid));
        const int lane = tid & 63, wave = __builtin_amdgcn_readfirstlane(tid >> 6);
        LAS unsigned char* lds = (LAS unsigned char*)lds_raw; asm volatile("" : "+s"(lds));
        Params p = p0;
        asm volatile("" : "+s"(p.ws)); asm volatile("" : "+s"(p.x)); asm volatile("" : "+s"(p.out)); asm volatile("" : "+s"(p.w_in)); asm volatile("" : "+s"(p.w_out));
        asm volatile("" : "+s"(p.conv_w)); asm volatile("" : "+s"(p.norm_g)); asm volatile("" : "+s"(p.mnorm_g)); asm volatile("" : "+s"(p.b_gate)); asm volatile("" : "+s"(p.rel_bias)); asm volatile("" : "+s"(p.final_g));
        if (ph == 0) {
            prologue_transposes(p, lds, wave, lane);
            build_wgt(p, tid);
            norm_phase(p, p.x, 0, wave, lane);
        } else {
            const int l = (ph - 1) / 7, k = (ph - 1) % 7;
            if (k == 0) {
                pg8::Gemm g{(const pg8::bf16_t*)(p.ws + WS_XN), (const pg8::bf16_t*)(p.ws + WS_WIN + (size_t)l * 128 * MiB), SEQ, NU, DM};
                pg8::StaticOrder S; S.init(SEQ, NU, G, (int)blockIdx.x);
                pg8::EpiBf16Plain E{(pg8::bf16_t*)(p.ws + WS_U), NU};
                pg8::gemm_phase<pg8::EpiBf16Plain, pg8::StaticOrder, true, true>(lds, g, S, E);
            } else if (k == 1) {
                gate_items(p, lds, l, tid, wave, lane);
                conv_prepass(p, l, tid);
                attn_phase(p, lds, tid, wave, lane);
            } else if (k == 2) {
                const bool xmap = (G == 256); const int xcd = blockIdx.x & 7, xi = blockIdx.x >> 3;
                int tid3 = tid; asm volatile("" : "+v"(tid3));
                { TSUB_BEGIN(8)
                for (int rr = 0; rr < 1 + (REP_M1); ++rr)
                for (int it = blockIdx.x, rnd = 0; it < 512; it += G, ++rnd) {
                    int item = it;
                    if (xmap) item = (xcd * 16 + rnd * 8 + (xi >> 2)) * 4 + (xi & 3);
                    m1_item(p, lds, l, item, tid3, __builtin_amdgcn_readfirstlane(tid3 >> 6), tid3 & 63); __syncthreads(); }
                TSUB_END(8) }
                merge_phase(p, tid);
            } else if (k == 3) {
                m2_phase(p, tid);
            } else if (k == 4) {
                const bool xmap = (G == 256); const int xcd = blockIdx.x & 7, xi = blockIdx.x >> 3;
                TSUB_BEGIN(9)
                for (int it = blockIdx.x, rnd = 0; it < 512; it += G, ++rnd) {
                    int hh = it >> 7, qb = it & 127; if ((it >> 8) & 1) qb ^= 3;
                    if (xmap) { const int pair = xcd * 16 + rnd * 8 + (xi >> 2); hh = pair >> 5; qb = (pair & 31) * 4 + (rnd ? 3 - (xi & 3) : (xi & 3)); }
                    m3_item(p, lds, l, hh, qb, tid, wave, lane); }
                TSUB_END(9)
            } else if (k == 5) {
                pg8::Gemm g{(const pg8::bf16_t*)(p.ws + WS_Y), (const pg8::bf16_t*)(p.ws + WS_WOUT + (size_t)l * 32 * MiB), SEQ, DM, DM};
                pg8::StaticOrder S; S.init(SEQ, DM, G, (int)blockIdx.x);
                pg8::EpiResF32 E{l == 0 ? p.x : (const float*)(p.ws + WS_X1), l == 0 ? (float*)(p.ws + WS_X1) : p.out, DM};
                pg8::gemm_phase<pg8::EpiResF32, pg8::StaticOrder, true, true>(lds, g, S, E);
            } else {
                if (l == 0) norm_phase(p, (const float*)(p.ws + WS_X1), 1, wave, lane);
                else final_norm_phase(p, (LAS unsigned char*)lds_raw, wave, lane);
            }
        }
        __syncthreads();
        }
        if (ph + 1 < p0.ph_hi) { if (p0.ph_hi > NPH) grid.sync(); else xcd_barrier(bar); }
#if TSEL >= 0
        if (threadIdx.x == 0) { const unsigned long long now = __builtin_amdgcn_s_memrealtime(); if (ptype == (TSEL)) TW[2] += now - TW[1]; TW[1] = now;
          if (ph + 2 == p0.ph_hi) ((volatile LAS int*)TW)[8] = (int)((float)TW[2] / (float)(now - TW[0]) * 131072.f); }
        if (ph + 2 == p0.ph_hi) __syncthreads();
#endif
    }
}

extern "C" void kernel_launch(void* const* d_in, const int* in_sizes, int n_in, void* d_out, int out_size, void* d_ws, size_t ws_size, hipStream_t stream) {
    static int grid = 0;
    if (grid == 0) {
        if (n_in != 9 || in_sizes[0] != SEQ * DM || out_size != SEQ * DM || ws_size < WS_END) {
            fprintf(stderr, "kernel_launch: unexpected problem: n_in %d in0 %d out %d ws %zu (need %zu)\n", n_in, n_in > 0 ? in_sizes[0] : -1, out_size, ws_size, (size_t)WS_END); grid = -1; return; }
        int dev = 0, cus = 0, per_cu = 0;
        hipGetDevice(&dev);
        hipDeviceGetAttribute(&cus, hipDeviceAttributeMultiprocessorCount, dev);
        if (hipFuncSetAttribute((const void*)hymba_fwd, hipFuncAttributeMaxDynamicSharedMemorySize, LDS_BYTES) != hipSuccess) { fprintf(stderr, "kernel_launch: hipFuncSetAttribute failed\n"); grid = -1; return; }
        if (hipOccupancyMaxActiveBlocksPerMultiprocessor(&per_cu, (const void*)hymba_fwd, NTHR, LDS_BYTES) != hipSuccess || per_cu < 1) { fprintf(stderr, "kernel_launch: occupancy query gave %d\n", per_cu); per_cu = 1; }
        (void)hipGetLastError();
        grid = cus * per_cu;
        fprintf(stderr, "kernel_launch: %d CUs x %d = grid %d\n", cus, per_cu, grid);
    }
    if (grid < 0) return;
    if (hipMemsetAsync((char*)d_ws + WS_CTL, 0, 16384, stream) != hipSuccess) { fprintf(stderr, "kernel_launch: hipMemsetAsync failed\n"); return; }
    Params p{};
    p.x = (const float*)d_in[0]; p.norm_g = (const float*)d_in[1]; p.w_in = (const float*)d_in[2]; p.b_gate = (const float*)d_in[3]; p.conv_w = (const float*)d_in[4];
    p.mnorm_g = (const float*)d_in[5]; p.w_out = (const float*)d_in[6]; p.rel_bias = (const float*)d_in[7]; p.final_g = (const float*)d_in[8];
    p.out = (float*)d_out; p.ws = (unsigned char*)d_ws;
#if MULTI_LAUNCH
    for (int ph = 0; ph < NPH; ++ph) { p.ph_lo = ph; p.ph_hi = ph + 1; hipLaunchKernelGGL(hymba_fwd, dim3(grid), dim3(NTHR), LDS_BYTES, stream, p); }
#else
    p.ph_lo = 0; p.ph_hi = NPH;
    void* args[] = {&p};
    hipError_t e = hipLaunchCooperativeKernel((const void*)hymba_fwd, dim3(grid), dim3(NTHR), args, LDS_BYTES, stream);
    if (e != hipSuccess) fprintf(stderr, "kernel_launch: cooperative launch failed: %s (grid %d)\n", hipGetErrorString(e), grid);
#endif
}
```

```cpp
#include <hip/hip_runtime.h>
#include <hip/hip_cooperative_groups.h>
#include <cstdio>
#include <cstdint>
namespace cg = cooperative_groups;
namespace pg8 {
#define PG8_LAS __attribute__((address_space(3)))
typedef unsigned short bf16_t;
typedef short bf16x8 __attribute__((ext_vector_type(8)));
typedef float f32x4 __attribute__((ext_vector_type(4)));
typedef unsigned u32x4 __attribute__((ext_vector_type(4)));
constexpr int BM = 256, BK = 64, HALF = 128, HTB = HALF * BK * 2  , STAGE_BYTES = 8 * HTB, NXCD = 8, WGM = 8;

__host__ __device__ __forceinline__ int lds_byte(int r, int c) { const int st = (r >> 4) * 2 + (c >> 5), rr = r & 15, cc = c & 31, ob = rr * 64 + cc * 2; return st * 1024 + (ob ^ (((ob >> 9) & 1) << 5)); }
__host__ __device__ __forceinline__ void stage_rc(int b, int& R, int& C) { const int st = b / 1024, sb = b % 1024, swz = sb ^ (((sb >> 9) & 1) << 5); R = (st >> 1) * 16 + swz / 64; C = (st & 1) * 32 + (swz % 64) / 2; }
__host__ __device__ __forceinline__ int perm32(int rho) { const int n = rho >> 4, i = rho & 15; return 8 * (i >> 2) + 4 * n + (i & 3); }

struct Unit { int pm, pn; };
struct Gemm { const bf16_t* A; const bf16_t* Bt; int M, N, K; };

struct StaticOrder {
    int nM, nN, nwg, G, c;
    __host__ __device__ void init(int M, int N, int G_, int c_) { nM = M / BM; nN = N / BM; nwg = nM * nN; G = G_; c = c_; }
    __host__ __device__ bool next(int i, Unit& u) const {
        const long L = (long)i * G + c; if (L >= nwg) return false;
        int wgid = (int)L; { const int q = nwg / NXCD, r = nwg % NXCD, xcd = wgid % NXCD, off = wgid / NXCD; wgid = (xcd < r ? xcd * (q + 1) : r * (q + 1) + (xcd - r) * q) + off; }
        const int nig = WGM * nN, gid = wgid / nig, fm = gid * WGM, gsz = (nM - fm) < WGM ? (nM - fm) : WGM;
        u.pm = fm + ((wgid % nig) % gsz); u.pn = (wgid % nig) / gsz; return true;
    }
    __device__ __forceinline__ void a_ready(const Unit&) const {}
    __device__ __forceinline__ void done(const Unit&) const {}
};

__device__ __forceinline__ unsigned cvt_pk_bf16(float lo, float hi) { unsigned r; asm volatile("v_cvt_pk_bf16_f32 %0, %1, %2" : "=v"(r) : "v"(lo), "v"(hi)); return r; }
struct EpiBf16Plain {
    static constexpr bool PERM = true, AFTER_DRAIN = false;
    bf16_t* O; int ldc;
    __device__ __forceinline__ void operator()(const f32x4 (&acc)[2][2][4][2], const Unit& u, int wr, int wc, int fr, int fq) const {
        const int row0 = u.pm * BM + wr * 64 + fr; const int col0 = u.pn * BM + wc * 32 + 8 * fq;
#pragma unroll
        for (int ai = 0; ai < 2; ++ai)
#pragma unroll
            for (int m = 0; m < 4; ++m) { bf16_t* rowp = O + (size_t)(row0 + ai * HALF + m * 16) * ldc + col0;
#pragma unroll
                for (int bj = 0; bj < 2; ++bj) { const f32x4 v0 = acc[ai][bj][m][0], v1 = acc[ai][bj][m][1];
                    u32x4 w; w.x = cvt_pk_bf16(v0[0], v0[1]); w.y = cvt_pk_bf16(v0[2], v0[3]); w.z = cvt_pk_bf16(v1[0], v1[1]); w.w = cvt_pk_bf16(v1[2], v1[3]);
                    *(u32x4*)(rowp + bj * HALF) = w; } }
    }
};
struct EpiResF32 {
    static constexpr bool PERM = true, AFTER_DRAIN = false;
    const float* base; float* out; int ld;
    __device__ __forceinline__ void operator()(const f32x4 (&acc)[2][2][4][2], const Unit& u, int wr, int wc, int fr, int fq) const {
        const int row0 = u.pm * BM + wr * 64 + fr; const int col0 = u.pn * BM + wc * 32 + 8 * fq;
#pragma unroll
        for (int ai = 0; ai < 2; ++ai)
#pragma unroll
            for (int m = 0; m < 4; ++m) { const size_t ro = (size_t)(row0 + ai * HALF + m * 16) * ld + col0;
#pragma unroll
                for (int bj = 0; bj < 2; ++bj) {
                    const f32x4 b0 = *(const f32x4*)(base + ro + bj * HALF), b1 = *(const f32x4*)(base + ro + bj * HALF + 4);
                    *(f32x4*)(out + ro + bj * HALF) = acc[ai][bj][m][0] + b0;
                    *(f32x4*)(out + ro + bj * HALF + 4) = acc[ai][bj][m][1] + b1; } }
    }
};
template <class Epi, class Sched, bool ALIGN_EPI = false, bool SP2 = false>
__device__ __forceinline__ void gemm_phase(PG8_LAS unsigned char* lds, const Gemm g, const Sched& S, const Epi& E) {
    int tid = threadIdx.x; asm volatile("" : "+v"(tid));
    const int wid = __builtin_amdgcn_readfirstlane(tid >> 6), lane = tid & 63, wr = wid >> 2, wc = wid & 3, fr = lane & 15, fq = lane >> 4;
    const int K = g.K, nt = K / BK;
    unsigned voffA[2], voffB[2];
#pragma unroll
    for (int i = 0; i < 2; ++i) { int R, C; stage_rc(tid * 16 + i * 8192, R, C); const int Rb = Epi::PERM ? ((R & ~31) + perm32(R & 31)) : R;
        voffA[i] = (unsigned)(R * K + C) * 2u; voffB[i] = (unsigned)(Rb * K + C) * 2u; }
    const size_t kstep = (size_t)(BK * 2);
    const size_t hstep = (size_t)HALF * K * 2;
    const size_t tstep = 2 * hstep;
    const unsigned ldsw = (unsigned)wid * 1024u;
    const int aoff = lds_byte(wr * 64 + fr, fq * 8), boff = lds_byte(wc * 32 + fr, fq * 8);
#define PG8_SA(b, h) (((b) * 2 + (h)) * HTB)
#define PG8_SB(b, h) ((4 + (b) * 2 + (h)) * HTB)
#define PG8_STAGE(bufoff, gbase, voff) do { _Pragma("unroll") for (int _i = 0; _i < 2; ++_i) \
        __builtin_amdgcn_global_load_lds((const unsigned*)((const char*)(gbase) + (voff)[_i]), (PG8_LAS unsigned*)(lds + (bufoff) + ldsw + _i * 8192), 16, 0, 0); } while (0)
#define PG8_LDA(dst, b, h) do { _Pragma("unroll") for (int m = 0; m < 4; ++m) _Pragma("unroll") for (int k = 0; k < 2; ++k) dst[m][k] = *(const PG8_LAS bf16x8*)(lds + PG8_SA(b, h) + aoff + m * 2048 + k * 1024); } while (0)
#define PG8_LDB(dst, b, h) do { _Pragma("unroll") for (int n = 0; n < 2; ++n) _Pragma("unroll") for (int k = 0; k < 2; ++k) dst[n][k] = *(const PG8_LAS bf16x8*)(lds + PG8_SB(b, h) + boff + n * 2048 + k * 1024); } while (0)
#define PG8_MMA(ai, bj, At, Bt) do { __builtin_amdgcn_s_setprio(1); _Pragma("unroll") for (int m = 0; m < 4; ++m) _Pragma("unroll") for (int n = 0; n < 2; ++n) _Pragma("unroll") for (int k = 0; k < 2; ++k) \
        acc[ai][bj][m][n] = __builtin_amdgcn_mfma_f32_16x16x32_bf16(Bt[n][k], At[m][k], acc[ai][bj][m][n], 0, 0, 0); __builtin_amdgcn_s_setprio(0); } while (0)
#define PG8_WAIT_V(n) asm volatile("s_waitcnt vmcnt(" #n ")" ::: "memory")
#define PG8_WAIT_L(n) asm volatile("s_waitcnt lgkmcnt(" #n ")" ::: "memory")
#define PG8_BAR __builtin_amdgcn_s_barrier()
#define PG8_SCHED __builtin_amdgcn_sched_barrier(0)
    Unit cur, nxt; int ui = 0;
    if (!S.next(0, cur)) return;
    f32x4 acc[2][2][4][2];
#pragma unroll
    for (int a = 0; a < 2; ++a)
#pragma unroll
        for (int b = 0; b < 2; ++b)
#pragma unroll
            for (int m = 0; m < 4; ++m)
#pragma unroll
                for (int n = 0; n < 2; ++n) acc[a][b][m][n] = (f32x4){0.f, 0.f, 0.f, 0.f};
    bf16x8 At[4][2], B0[2][2], B1[2][2];
    const char* cA = (const char*)g.A + (size_t)cur.pm * tstep; const char* cB = (const char*)g.Bt + (size_t)cur.pn * tstep;
    S.a_ready(cur);
    if constexpr (SP2) {
        PG8_STAGE(PG8_SB(0, 0), cB, voffB); PG8_STAGE(PG8_SB(0, 1), cB + hstep, voffB); PG8_STAGE(PG8_SA(0, 0), cA, voffA); PG8_STAGE(PG8_SA(0, 1), cA + hstep, voffA);
        if (wr == 1) PG8_BAR;
        PG8_WAIT_V(2); PG8_BAR;
        PG8_STAGE(PG8_SB(1, 0), cB + kstep, voffB); PG8_STAGE(PG8_SA(1, 0), cA + kstep, voffA); PG8_STAGE(PG8_SB(1, 1), cB + hstep + kstep, voffB);
        PG8_WAIT_V(6); PG8_BAR;
    } else {
        PG8_STAGE(PG8_SB(0, 0), cB, voffB); PG8_STAGE(PG8_SA(0, 0), cA, voffA); PG8_STAGE(PG8_SB(0, 1), cB + hstep, voffB); PG8_STAGE(PG8_SA(0, 1), cA + hstep, voffA);
        if (wr == 1) PG8_BAR;
        PG8_WAIT_V(4); PG8_BAR;
        PG8_STAGE(PG8_SB(1, 0), cB + kstep, voffB); PG8_STAGE(PG8_SA(1, 0), cA + kstep, voffA); PG8_STAGE(PG8_SB(1, 1), cB + hstep + kstep, voffB);
        PG8_WAIT_V(6); PG8_BAR;
    }
    for (;;) {
        const bool has_next = S.next(ui + 1, nxt);
        const char* nA = has_next ? (const char*)g.A + (size_t)nxt.pm * tstep : cA; const char* nB = has_next ? (const char*)g.Bt + (size_t)nxt.pn * tstep : cB;
        for (int t = 0; t < nt; t += 2) {
            const bool last = (t == nt - 2);
            const char* a1 = cA + (size_t)(t + 1) * kstep;
            const char* a2 = last ? nA : cA + (size_t)(t + 2) * kstep; const char* b2 = last ? nB : cB + (size_t)(t + 2) * kstep;
            const char* a3 = a2 + kstep; const char* b3 = b2 + kstep;
            if (last && has_next) S.a_ready(nxt);
            if constexpr (SP2) {
            PG8_LDB(B0, 0, 0); PG8_LDB(B1, 0, 1); PG8_SCHED; PG8_LDA(At, 0, 0); PG8_STAGE(PG8_SA(1, 1), a1 + hstep, voffA);
            PG8_WAIT_V(8); PG8_WAIT_L(0); PG8_BAR; PG8_MMA(0, 0, At, B0); PG8_MMA(0, 1, At, B1); PG8_BAR; PG8_SCHED;
            PG8_LDA(At, 0, 1); PG8_STAGE(PG8_SB(0, 0), b2, voffB); PG8_STAGE(PG8_SB(0, 1), b2 + hstep, voffB); PG8_STAGE(PG8_SA(0, 0), a2, voffA);
            PG8_WAIT_V(8); PG8_WAIT_L(0); PG8_BAR; PG8_MMA(1, 0, At, B0); PG8_MMA(1, 1, At, B1); PG8_BAR; PG8_SCHED;
            PG8_LDB(B0, 1, 0); PG8_LDB(B1, 1, 1); PG8_SCHED; PG8_LDA(At, 1, 0); PG8_STAGE(PG8_SA(0, 1), a2 + hstep, voffA);
            PG8_WAIT_V(8); PG8_WAIT_L(0); PG8_BAR; PG8_MMA(0, 0, At, B0); PG8_MMA(0, 1, At, B1); PG8_BAR; PG8_SCHED;
            PG8_LDA(At, 1, 1); PG8_STAGE(PG8_SB(1, 0), b3, voffB); PG8_STAGE(PG8_SB(1, 1), b3 + hstep, voffB); PG8_STAGE(PG8_SA(1, 0), a3, voffA);
            PG8_WAIT_V(8); PG8_WAIT_L(0); PG8_BAR; PG8_MMA(1, 0, At, B0); PG8_MMA(1, 1, At, B1); PG8_BAR; PG8_SCHED;
            } else {
            PG8_LDB(B0, 0, 0); PG8_SCHED; PG8_LDA(At, 0, 0); PG8_STAGE(PG8_SA(1, 1), a1 + hstep, voffA);
            PG8_WAIT_L(8); PG8_BAR; PG8_WAIT_L(0); PG8_MMA(0, 0, At, B0); PG8_BAR; PG8_SCHED;
            PG8_LDB(B1, 0, 1); PG8_STAGE(PG8_SB(0, 0), b2, voffB);
            PG8_BAR; PG8_WAIT_L(0); PG8_MMA(0, 1, At, B1); PG8_BAR;
            PG8_LDA(At, 0, 1); PG8_STAGE(PG8_SA(0, 0), a2, voffA);
            PG8_BAR; PG8_WAIT_L(0); PG8_MMA(1, 0, At, B0); PG8_BAR; PG8_SCHED;
            PG8_STAGE(PG8_SB(0, 1), b2 + hstep, voffB);
            PG8_WAIT_V(6); PG8_BAR; PG8_MMA(1, 1, At, B1); PG8_BAR;
            PG8_LDB(B0, 1, 0); PG8_SCHED; PG8_LDA(At, 1, 0); PG8_STAGE(PG8_SA(0, 1), a2 + hstep, voffA);
            PG8_WAIT_L(8); PG8_BAR; PG8_WAIT_L(0); PG8_MMA(0, 0, At, B0); PG8_BAR; PG8_SCHED;
            PG8_LDB(B1, 1, 1); PG8_STAGE(PG8_SB(1, 0), b3, voffB);
            PG8_BAR; PG8_WAIT_L(0); PG8_MMA(0, 1, At, B1); PG8_BAR;
            PG8_LDA(At, 1, 1); PG8_STAGE(PG8_SA(1, 0), a3, voffA);
            PG8_BAR; PG8_WAIT_L(0); PG8_MMA(1, 0, At, B0); PG8_BAR; PG8_SCHED;
            PG8_STAGE(PG8_SB(1, 1), b3 + hstep, voffB);
            PG8_WAIT_V(6); PG8_BAR; PG8_MMA(1, 1, At, B1); PG8_BAR;
            }
        }
        if constexpr (ALIGN_EPI) { if (wr == 0) PG8_BAR; }
        if constexpr (!Epi::AFTER_DRAIN) { E(acc, cur, wr, wc, fr, fq); S.done(cur); }
        if (!has_next) break;
#pragma unroll
        for (int a = 0; a < 2; ++a)
#pragma unroll
            for (int b = 0; b < 2; ++b)
#pragma unroll
                for (int m = 0; m < 4; ++m)
#pragma unroll
                    for (int n = 0; n < 2; ++n) acc[a][b][m][n] = (f32x4){0.f, 0.f, 0.f, 0.f};
        cur = nxt; cA = nA; cB = nB; ++ui;
        if constexpr (ALIGN_EPI) { if (wr == 1) PG8_BAR; }
    }
    PG8_WAIT_V(0);
    if constexpr (!ALIGN_EPI) { if (wr == 0) PG8_BAR; }
    PG8_BAR;
    if constexpr (Epi::AFTER_DRAIN) { E.fused(acc, cur, wr, wc, fr, fq, lds, wid, lane); S.done(cur); }
#undef PG8_SA
#undef PG8_SB
#undef PG8_STAGE
#undef PG8_LDA
#undef PG8_LDB
#undef PG8_MMA
#undef PG8_WAIT_V
#undef PG8_WAIT_L
#undef PG8_BAR
#undef PG8_SCHED
}
}

#ifndef MULTI_LAUNCH
#define MULTI_LAUNCH 0
#endif
#ifndef USE_TR
#define USE_TR 1
#endif
#ifndef TSEL
#define TSEL (-1)
#endif
#ifndef REP_ATTN
#define REP_ATTN 0
#endif
#ifndef REP_M1
#define REP_M1 0
#endif
#ifndef REPEAT_MASK
#define REPEAT_MASK 0
#endif
#define LAS __attribute__((address_space(3)))
#define DI __device__ __forceinline__
typedef unsigned short bf16;
typedef short bf16x8 __attribute__((ext_vector_type(8)));
typedef float f32x4 __attribute__((ext_vector_type(4)));
typedef unsigned u32x4 __attribute__((ext_vector_type(4)));
typedef unsigned u32x2 __attribute__((ext_vector_type(2)));

constexpr int SEQ = 8192, DM = 4096, INW = 16392, NU = 16384;
constexpr int C_QA = 0, C_KA = 2048, C_VA = 4096, C_ZA = 6144, C_QM = 8192, C_KM = 9216, C_VM = 10240, C_OM = 12288, C_ZM = 14336;
constexpr float NORM_EPS = 1e-6f;
constexpr int NTHR = 512, NWAVE = 8;
constexpr int LDS_BYTES = 147456;

constexpr size_t MiB = (size_t)1 << 20;
constexpr size_t WS_WIN = 0, WS_WOUT = 256 * MiB, WS_XN = 320 * MiB, WS_U = 384 * MiB, WS_OP = 640 * MiB, WS_Y = 736 * MiB, WS_X1 = 800 * MiB,
                 WS_DC = 928 * MiB, WS_CS = 992 * MiB, WS_LSE = 1024 * MiB, WS_GATES = 1026 * MiB, WS_DN = 1027 * MiB, WS_NS = 1028 * MiB, WS_BL = 1029 * MiB,
                 WS_CTL = 1030 * MiB, WS_QKC = 1032 * MiB, WS_WGT = 1064 * MiB, WS_END = 1065 * MiB;
constexpr int LDS_BARST = LDS_BYTES - 64;

struct Params { const float *x, *norm_g, *w_in, *b_gate, *conv_w, *mnorm_g, *w_out, *rel_bias, *final_g; float* out; unsigned char* ws; int ph_lo, ph_hi; };

DI int blk() { int b = blockIdx.x; asm volatile("" : "+s"(b)); return b; }
DI float bf_lo(unsigned u) { return __uint_as_float(u << 16); }
DI float bf_hi(unsigned u) { return __uint_as_float(u & 0xffff0000u); }
DI float bf2f(unsigned short u) { return __uint_as_float((unsigned)u << 16); }
DI unsigned pk2(float lo, float hi) { return pg8::cvt_pk_bf16(lo, hi); }
DI float wave_sum(float v) {
#pragma unroll
    for (int o = 1; o < 64; o <<= 1) v += __shfl_xor(v, o);
    return v;
}
DI float quad_sum(float v) { v += __shfl_xor(v, 16); v += __shfl_xor(v, 32); return v; }
DI float quad_max(float v) { v = fmaxf(v, __shfl_xor(v, 16)); v = fmaxf(v, __shfl_xor(v, 32)); return v; }
DI float silu_f(float x) { return x / (1.f + __expf(-x)); }
DI float sigm_f(float x) { return 1.f / (1.f + __expf(-x)); }
DI bf16x8 gatherT(const LAS unsigned short* p, int stride) {
    bf16x8 r;
#pragma unroll
    for (int j = 0; j < 8; ++j) r[j] = (short)p[j * stride];
    return r;
}
typedef short s16x4 __attribute__((ext_vector_type(4)));
DI bf16x8 trfrag(const LAS unsigned short* blk, int stride, int ql) {
#if USE_TR
    const LAS unsigned short* a = blk + (ql >> 2) * stride + 4 * (ql & 3);
    const s16x4 lo = __builtin_amdgcn_ds_read_tr16_b64_v4i16((LAS s16x4*)a);
    const s16x4 hi = __builtin_amdgcn_ds_read_tr16_b64_v4i16((LAS s16x4*)(a + 4 * stride));
    return (bf16x8){lo[0], lo[1], lo[2], lo[3], hi[0], hi[1], hi[2], hi[3]};
#else
    return gatherT(blk + ql, stride);
#endif
}
DI f32x4 mfma16(bf16x8 a, bf16x8 b, f32x4 c) { return __builtin_amdgcn_mfma_f32_16x16x32_bf16(a, b, c, 0, 0, 0); }
#define LDS_WAIT() asm volatile("s_waitcnt lgkmcnt(0)" ::: "memory")

struct TrTile { const float* src; bf16* dst; };
DI TrTile tr_tile_addr(const Params& p, int it, int lane) {
    constexpr int T_IN = 64 * 256, T_OUT = 64 * 64;
    const float* W; bf16* WT; int ldw, nb, kb;
    int r = it;
    if (r < T_IN) { W = p.w_in; WT = (bf16*)(p.ws + WS_WIN); ldw = INW; kb = r >> 8; nb = r & 255; }
    else if ((r -= T_IN) < T_OUT) { W = p.w_out; WT = (bf16*)(p.ws + WS_WOUT); ldw = DM; kb = r >> 6; nb = r & 63; }
    else if ((r -= T_OUT) < T_IN) { W = p.w_in + (size_t)DM * INW; WT = (bf16*)(p.ws + WS_WIN + 128 * MiB); ldw = INW; kb = r >> 8; nb = r & 255; }
    else { r -= T_IN; W = p.w_out + (size_t)DM * DM; WT = (bf16*)(p.ws + WS_WOUT + 32 * MiB); ldw = DM; kb = r >> 6; nb = r & 63; }
    TrTile t;
    t.src = W + (size_t)(kb * 64 + 16 * (lane >> 4)) * ldw + nb * 64 + 4 * (lane & 15);
    t.dst = WT + (size_t)(nb * 64 + (lane >> 3)) * DM + kb * 64 + 8 * (lane & 7);
    return t;
}
DI int tr_ldw(int it) { constexpr int T_IN = 64 * 256, T_OUT = 64 * 64; const int r = it % (T_IN + T_OUT); return r < T_IN ? INW : DM; }
DI void tr_load(const float* src, int ldw, f32x4 (&v)[16]) {
#pragma unroll
    for (int i = 0; i < 16; ++i) v[i] = *(const f32x4*)(src + (size_t)i * ldw);
}
DI void tr_store(const f32x4 (&v)[16], bf16* dst, LAS unsigned short* T, int lane) {
    const int kr = lane >> 4, nc = 4 * (lane & 15);
#pragma unroll
    for (int e = 0; e < 4; ++e)
#pragma unroll
        for (int hf = 0; hf < 2; ++hf) { u32x4 w;
            w.x = pk2(v[8 * hf + 0][e], v[8 * hf + 1][e]); w.y = pk2(v[8 * hf + 2][e], v[8 * hf + 3][e]); w.z = pk2(v[8 * hf + 4][e], v[8 * hf + 5][e]); w.w = pk2(v[8 * hf + 6][e], v[8 * hf + 7][e]);
            *(LAS u32x4*)(T + (nc + e) * 72 + 16 * kr + 8 * hf) = w; }
    LDS_WAIT(); asm volatile("" ::: "memory");
#pragma unroll
    for (int j = 0; j < 8; ++j) { const u32x4 w = *(const LAS u32x4*)(T + ((lane >> 3) + 8 * j) * 72 + 8 * (lane & 7)); *(u32x4*)(dst + (size_t)(8 * j) * DM) = w; }
    LDS_WAIT(); asm volatile("" ::: "memory");
}
DI void prologue_transposes(const Params& p, LAS unsigned char* lds, int wave, int lane) {
    LAS unsigned short* T = (LAS unsigned short*)(lds + wave * 16384);
    const int gw = blk() * NWAVE + wave, ngw = gridDim.x * NWAVE;
    constexpr int NIT = 2 * (64 * 256 + 64 * 64);
    f32x4 va[16], vb[16];
    int it = gw;
    if (it >= NIT) return;
    TrTile ta = tr_tile_addr(p, it, lane), tb;
    tr_load(ta.src, tr_ldw(it), va);
    for (;;) {
        const int it1 = it + ngw; const bool h1 = it1 < NIT;
        if (h1) { tb = tr_tile_addr(p, it1, lane); tr_load(tb.src, tr_ldw(it1), vb); }
        tr_store(va, ta.dst, T, lane);
        if (!h1) break;
        const int it2 = it1 + ngw; const bool h2 = it2 < NIT;
        if (h2) { ta = tr_tile_addr(p, it2, lane); tr_load(ta.src, tr_ldw(it2), va); }
        tr_store(vb, tb.dst, T, lane);
        if (!h2) break;
        it = it2;
    }
}

DI void norm_phase(const Params& p, const float* X, int l, int wave, int lane) {
    const float* g = p.norm_g + l * DM;
    bf16* XN = (bf16*)(p.ws + WS_XN);
    for (int row = blk() * NWAVE + wave; row < SEQ; row += gridDim.x * NWAVE) {
        const f32x4* xr = (const f32x4*)(X + (size_t)row * DM) + lane;
        f32x4 v[16]; float ss = 0.f;
#pragma unroll
        for (int j = 0; j < 16; ++j) { v[j] = xr[64 * j]; ss += (v[j].x * v[j].x + v[j].y * v[j].y) + (v[j].z * v[j].z + v[j].w * v[j].w); }
        const float rstd = rsqrtf(wave_sum(ss) * (1.f / DM) + NORM_EPS);
        u32x2* o8 = (u32x2*)(XN + (size_t)row * DM) + lane;
#pragma unroll
        for (int j = 0; j < 16; ++j) { const f32x4 h = v[j] * rstd * ((const f32x4*)g)[lane + 64 * j]; u32x2 w; w.x = pk2(h.x, h.y); w.y = pk2(h.z, h.w); o8[64 * j] = w; }
    }
}
DI void build_wgt(const Params& p, int tid) {
    bf16* WgT = (bf16*)(p.ws + WS_WGT);
    for (int gid = blk() * NTHR + tid; gid < 2 * 16 * DM; gid += gridDim.x * NTHR) {
        if (gid < 2 * 8 * DM) { const int l = gid >> 15, k = (gid >> 3) & (DM - 1), j = gid & 7;
            WgT[((size_t)l * 16 + j) * DM + k] = (bf16)(pk2(p.w_in[(size_t)l * DM * INW + (size_t)k * INW + NU + j], 0.f) & 0xffffu); }
        else { const int r = gid - 2 * 8 * DM, l = r >> 15, j = 8 + ((r >> 12) & 7), k = r & (DM - 1); WgT[((size_t)l * 16 + j) * DM + k] = 0; }
    }
}
DI void gate_items(const Params& p, LAS unsigned char* lds, int l, int tid, int wave, int lane) {
    const bf16* XN = (const bf16*)(p.ws + WS_XN);
    const bf16* WgT = (const bf16*)(p.ws + WS_WGT) + (size_t)l * 16 * DM;
    float* gates = (float*)(p.ws + WS_GATES);
    LAS float* red = (LAS float*)lds;
    const int ql = lane & 15, quad = lane >> 4;
    for (int t = blk(); t < SEQ / 16; t += gridDim.x) {
        const bf16* a = WgT + (size_t)ql * DM + wave * 512 + quad * 8; const bf16* b = XN + (size_t)(t * 16 + ql) * DM + wave * 512 + quad * 8;
        f32x4 acc0 = {0.f, 0.f, 0.f, 0.f}, acc1 = {0.f, 0.f, 0.f, 0.f};
#pragma unroll
        for (int i = 0; i < 16; i += 2) { acc0 = mfma16(*(const bf16x8*)(a + i * 32), *(const bf16x8*)(b + i * 32), acc0); acc1 = mfma16(*(const bf16x8*)(a + i * 32 + 32), *(const bf16x8*)(b + i * 32 + 32), acc1); }
        const f32x4 r = acc0 + acc1;
        if (quad < 2) *(LAS f32x4*)(red + (wave * 16 + ql) * 8 + quad * 4) = r;
        __syncthreads();
        if (tid < 128) { float sum = p.b_gate[l * 8 + (tid & 7)];
#pragma unroll
            for (int w = 0; w < 8; ++w) sum += red[w * 128 + tid];
            gates[(size_t)t * 128 + tid] = sum; }
        __syncthreads();
    }
}
DI void final_norm_phase(const Params& p, LAS unsigned char* lds0, int wave, int lane) {
#if TSEL >= 0
    const int n2 = ((volatile LAS int*)(lds0 + LDS_BARST + 16))[8];
#endif
    for (int row = blk() * NWAVE + wave; row < SEQ; row += gridDim.x * NWAVE) {
        f32x4* xr = (f32x4*)(p.out + (size_t)row * DM) + lane;
        f32x4 v[16]; float ss = 0.f;
#pragma unroll
        for (int j = 0; j < 16; ++j) { v[j] = xr[64 * j]; ss += (v[j].x * v[j].x + v[j].y * v[j].y) + (v[j].z * v[j].z + v[j].w * v[j].w); }
        const float rstd = rsqrtf(wave_sum(ss) * (1.f / DM) + NORM_EPS);
#pragma unroll
        for (int j = 0; j < 16; ++j) { f32x4 o = v[j] * rstd * ((const f32x4*)p.final_g)[lane + 64 * j];
#if TSEL >= 0
            if (blk() == 0) { const int e0 = ((row >> 11) * 8 + (row & 7)) * 4096 + 4 * (lane + 64 * j);
                o.x += (e0 + 0 < n2) ? 0.02f : 0.f; o.y += (e0 + 1 < n2) ? 0.02f : 0.f; o.z += (e0 + 2 < n2) ? 0.02f : 0.f; o.w += (e0 + 3 < n2) ? 0.02f : 0.f; }
#endif
            xr[64 * j] = o; }
    }
}

constexpr int AT_KS = 136;
#define ATT_DECODE(item) const int pat = (item) >> 10, h = ((item) & 1023) >> 6, rb_ = (item) & 63, dsh = pat * 2, r = rb_ >> (6 - dsh), bq = rb_ & ((64 >> dsh) - 1), sub0 = 128 * bq - 128; (void)sub0; (void)r; (void)h;
DI void att_load_kv(const bf16* U, int item, int tid, int coff, u32x4 (&v)[8]) {
    ATT_DECODE(item)
#pragma unroll
    for (int i = 0; i < 8; ++i) { const int c = tid + NTHR * i, row = c >> 4, ch = c & 15; int sub = sub0 + row; sub = sub < 0 ? 0 : sub;
        v[i] = *(const u32x4*)(U + (size_t)((sub << dsh) + r) * NU + coff + h * 128 + ch * 8); }
}
DI void att_store(LAS unsigned short* dst, int tid, const u32x4 (&v)[8]) {
#pragma unroll
    for (int i = 0; i < 8; ++i) { const int c = tid + NTHR * i, row = c >> 4, ch = c & 15; *(LAS u32x4*)(dst + row * AT_KS + ch * 8) = v[i]; }
}
DI void att_load_q(const bf16* U, int item, int wave, int lane, bf16x8 (&qf)[4]) {
    ATT_DECODE(item)
    const int tq = ((128 * bq + wave * 16 + (lane & 15)) << dsh) + r;
#pragma unroll
    for (int ks = 0; ks < 4; ++ks) qf[ks] = *(const bf16x8*)(U + (size_t)tq * NU + C_QA + h * 128 + ks * 32 + (lane >> 4) * 8);
}
DI void att_bias(const Params& p, int item, int tid, LAS float* biasS) {
    ATT_DECODE(item)
    if (tid < 129) { const int n = tid << dsh; int b = n;
        if (n >= 16) { b = 16 + (int)floorf(log2f((float)n * 0.0625f) * (16.f / 7.f)); b = b > 31 ? 31 : b; }
        biasS[tid] = p.rel_bias[b * 16 + h]; }
}
DI int att_item_of(int rnd, bool xmap, int xcd, int xi) {
    if (!xmap) return blk() + rnd * gridDim.x;
    const int h = 2 * xcd + rnd / 6, j = (rnd % 6) * 32 + xi; return (j >> 6) * 1024 + h * 64 + (j & 63);
}
DI void attn_phase(const Params& p, LAS unsigned char* lds, int tid, int wave, int lane) {
    const bf16* U = (const bf16*)(p.ws + WS_U);
    LAS unsigned short* Ks = (LAS unsigned short*)lds;
    LAS unsigned short* Vs = Ks + 256 * AT_KS;
    LAS float* biasS = (LAS float*)(Vs + 256 * AT_KS);
    const int G = gridDim.x; const bool xmap = (G == 256); const int xcd = blk() & 7, xi = blk() >> 3;
    const int nrnd = (blk() < 3072) ? (3072 - blk() + G - 1) / G : 0;
    if (nrnd <= 0) return;
    const int ql = lane & 15, quad = lane >> 4, q0 = wave * 16;
    bf16x8 qf[4];
    { const int item0 = att_item_of(0, xmap, xcd, xi); u32x4 kv[8], vv[8];
      att_load_kv(U, item0, tid, C_KA, kv); att_load_kv(U, item0, tid, C_VA, vv); att_load_q(U, item0, wave, lane, qf); att_bias(p, item0, tid, biasS);
      att_store(Ks, tid, kv); att_store(Vs, tid, vv); }
    __syncthreads();
    for (int rnd = 0; rnd < nrnd; ++rnd) {
        const int item = att_item_of(rnd, xmap, xcd, xi), next = rnd + 1 < nrnd ? att_item_of(rnd + 1, xmap, xcd, xi) : -1;
        ATT_DECODE(item)
        const int tq = ((128 * bq + q0 + ql) << dsh) + r;
        f32x4 sacc[10];
#pragma unroll
        for (int t = 0; t < 10; ++t) sacc[t] = (f32x4){0.f, 0.f, 0.f, 0.f};
#pragma unroll
        for (int s = 0; s < 5; ++s)
#pragma unroll
            for (int u = 0; u < 2; ++u) { int kk = q0 + 32 * s + (ql >> 2) * 8 + u * 4 + (ql & 3); kk = kk > 255 ? 255 : kk;
                const LAS unsigned short* kp = Ks + kk * AT_KS + quad * 8;
#pragma unroll
                for (int ks = 0; ks < 4; ++ks) sacc[2 * s + u] = mfma16(*(const LAS bf16x8*)(kp + ks * 32), qf[ks], sacc[2 * s + u]); }
        __syncthreads();
        u32x4 kv[8], vv[8]; bf16x8 qn[4];
        if (next >= 0) { att_load_kv(U, next, tid, C_KA, kv); att_load_q(U, next, wave, lane, qn); }
        const float scale = 0.08838834764831845f;
        float mx = -1e30f;
        int ql2 = ql, quad2 = quad; asm volatile("" : "+v"(ql2), "+v"(quad2));
#pragma unroll
        for (int s = 0; s < 5; ++s)
#pragma unroll
            for (int u = 0; u < 2; ++u)
#pragma unroll
                for (int j = 0; j < 4; ++j) { const int koff = 32 * s + quad2 * 8 + u * 4 + j, rel = koff - ql2;
                    const bool valid = (rel >= 0) && (rel <= 128) && (sub0 + q0 + koff >= 0);
                    int jo = 128 - rel; jo = jo < 0 ? 0 : (jo > 128 ? 128 : jo);
                    const float v = valid ? sacc[2 * s + u][j] * scale + biasS[jo] : -1e30f;
                    sacc[2 * s + u][j] = v; mx = fmaxf(mx, v); }
        mx = quad_max(mx);
        float l = 0.f;
#pragma unroll
        for (int t = 0; t < 10; ++t)
#pragma unroll
            for (int j = 0; j < 4; ++j) { const float e = __expf(sacc[t][j] - mx); sacc[t][j] = e; l += e; }
        l = quad_sum(l);
        if (next >= 0) att_load_kv(U, next, tid, C_VA, vv);
        f32x4 oacc[8];
#pragma unroll
        for (int nt = 0; nt < 8; ++nt) oacc[nt] = (f32x4){0.f, 0.f, 0.f, 0.f};
#pragma unroll
        for (int s = 0; s < 5; ++s) {
            u32x4 pw; pw.x = pk2(sacc[2 * s][0], sacc[2 * s][1]); pw.y = pk2(sacc[2 * s][2], sacc[2 * s][3]); pw.z = pk2(sacc[2 * s + 1][0], sacc[2 * s + 1][1]); pw.w = pk2(sacc[2 * s + 1][2], sacc[2 * s + 1][3]);
            const bf16x8 pf = __builtin_bit_cast(bf16x8, pw);
            int key0 = q0 + 32 * s + quad * 8; key0 = key0 > 248 ? 248 : key0;
            const LAS unsigned short* vp = Vs + key0 * AT_KS;
#pragma unroll
            for (int nt = 0; nt < 8; ++nt) oacc[nt] = mfma16(trfrag(vp + nt * 16, AT_KS, ql), pf, oacc[nt]);
        }
        const float inv = 1.f / l;
        bf16* OP = (bf16*)(p.ws + WS_OP) + (size_t)pat * SEQ * 2048 + (size_t)tq * 2048 + h * 128 + quad * 4;
#pragma unroll
        for (int nt = 0; nt < 8; ++nt) { u32x2 w; w.x = pk2(oacc[nt][0] * inv, oacc[nt][1] * inv); w.y = pk2(oacc[nt][2] * inv, oacc[nt][3] * inv); *(u32x2*)(OP + nt * 16) = w; }
        if (quad == 0) ((float*)(p.ws + WS_LSE))[((size_t)pat * SEQ + tq) * 16 + h] = mx + __logf(l);
        if (next >= 0) att_store(Ks, tid, kv);
        __syncthreads();
        if (next >= 0) { att_store(Vs, tid, vv); att_bias(p, next, tid, biasS);
#pragma unroll
            for (int ks = 0; ks < 4; ++ks) qf[ks] = qn[ks]; }
        __syncthreads();
    }
}
DI void merge_phase(const Params& p, int tid) {
    const bf16* U = (const bf16*)(p.ws + WS_U);
    const bf16* OP = (const bf16*)(p.ws + WS_OP);
    const float* LSE = (const float*)(p.ws + WS_LSE);
    bf16* Y = (bf16*)(p.ws + WS_Y);
    const int gthreads = gridDim.x * NTHR;
    for (int idx0 = blk() * NTHR + tid; idx0 < SEQ * 256; idx0 += 4 * gthreads) {
        float l0[4], l1[4], l2[4]; u32x4 o0[4], o1[4], o2[4], z[4];
#pragma unroll
        for (int u = 0; u < 4; ++u) { int idx = idx0 + u * gthreads; idx = idx < SEQ * 256 ? idx : SEQ * 256 - 1;
            const int t = idx >> 8, c8 = idx & 255, h = c8 >> 4;
            l0[u] = LSE[(size_t)t * 16 + h]; l1[u] = LSE[((size_t)SEQ + t) * 16 + h]; l2[u] = LSE[((size_t)2 * SEQ + t) * 16 + h];
            const size_t o = (size_t)t * 2048 + c8 * 8;
            o0[u] = *(const u32x4*)(OP + o); o1[u] = *(const u32x4*)(OP + (size_t)SEQ * 2048 + o); o2[u] = *(const u32x4*)(OP + (size_t)2 * SEQ * 2048 + o);
            z[u] = *(const u32x4*)(U + (size_t)t * NU + C_ZA + c8 * 8); }
#pragma unroll
        for (int u = 0; u < 4; ++u) { const int idx = idx0 + u * gthreads;
            if (idx < SEQ * 256) { const int t = idx >> 8, c8 = idx & 255;
                const float M = fmaxf(l0[u], fmaxf(l1[u], l2[u]));
                float w0 = __expf(l0[u] - M), w1 = __expf(l1[u] - M), w2 = __expf(l2[u] - M);
                const float inv = 1.f / (w0 + w1 + w2); w0 *= inv; w1 *= inv; w2 *= inv;
                u32x4 y;
#pragma unroll
                for (int e = 0; e < 4; ++e) {
                    const float lo = (w0 * bf_lo(o0[u][e]) + w1 * bf_lo(o1[u][e]) + w2 * bf_lo(o2[u][e])) * silu_f(bf_lo(z[u][e]));
                    const float hi = (w0 * bf_hi(o0[u][e]) + w1 * bf_hi(o1[u][e]) + w2 * bf_hi(o2[u][e])) * silu_f(bf_hi(z[u][e]));
                    y[e] = pk2(lo, hi); }
                *(u32x4*)(Y + (size_t)t * DM + c8 * 8) = y; } }
    }
}

constexpr int M_KS = 264, M_VS3 = 520;
DI void conv8(const bf16* U, const float* cw, int t, int rawcol, int cch, float (&f)[8]) {
#pragma unroll
    for (int e = 0; e < 8; ++e) f[e] = 0.f;
#pragma unroll
    for (int j = 0; j < 4; ++j) { const int tt = t - 3 + j;
        if (tt >= 0) { const u32x4 raw = *(const u32x4*)(U + (size_t)tt * NU + rawcol);
            const f32x4 w0 = *(const f32x4*)(cw + j * 2048 + cch), w1 = *(const f32x4*)(cw + j * 2048 + cch + 4);
            f[0] += w0[0] * bf_lo(raw.x); f[1] += w0[1] * bf_hi(raw.x); f[2] += w0[2] * bf_lo(raw.y); f[3] += w0[3] * bf_hi(raw.y);
            f[4] += w1[0] * bf_lo(raw.z); f[5] += w1[1] * bf_hi(raw.z); f[6] += w1[2] * bf_lo(raw.w); f[7] += w1[3] * bf_hi(raw.w); } }
#pragma unroll
    for (int e = 0; e < 8; ++e) f[e] = silu_f(f[e]);
}
template <int NI, int MODE, int NB>
DI void conv_tile(const bf16* U, const float* cw, int t0, int rawcol0, int cch0, float sc, LAS unsigned short* dst, int tid, float bL, const LAS float* bS, const LAS float* liS, int roff) {
    const int ch = tid & 31, r0 = tid >> 5;
    f32x4 w[4][2];
#pragma unroll
    for (int j = 0; j < 4; ++j) { w[j][0] = *(const f32x4*)(cw + j * 2048 + cch0 + ch * 8); w[j][1] = *(const f32x4*)(cw + j * 2048 + cch0 + ch * 8 + 4); }
    const bf16* src = U + rawcol0 + ch * 8;
#pragma unroll
    for (int ib = 0; ib < NI; ib += NB) {
        u32x4 raw[NB][4];
#pragma unroll
        for (int i = 0; i < NB; ++i)
#pragma unroll
            for (int j = 0; j < 4; ++j) { const int tt = t0 + r0 + 16 * (ib + i) - 3 + j; const int tc = tt < 0 ? 0 : tt;
                raw[i][j] = *(const u32x4*)(src + (size_t)tc * NU); if (tt < 0) raw[i][j] = (u32x4){0u, 0u, 0u, 0u}; }
#pragma unroll
        for (int i = 0; i < NB; ++i) { const int row = r0 + 16 * (ib + i);
            float f[8];
#pragma unroll
            for (int e = 0; e < 8; ++e) f[e] = 0.f;
#pragma unroll
            for (int j = 0; j < 4; ++j) { const u32x4 rw = raw[i][j];
                f[0] += w[j][0][0] * bf_lo(rw.x); f[1] += w[j][0][1] * bf_hi(rw.x); f[2] += w[j][0][2] * bf_lo(rw.y); f[3] += w[j][0][3] * bf_hi(rw.y);
                f[4] += w[j][1][0] * bf_lo(rw.z); f[5] += w[j][1][1] * bf_hi(rw.z); f[6] += w[j][1][2] * bf_lo(rw.w); f[7] += w[j][1][3] * bf_hi(rw.w); }
            float m = sc;
            if (MODE == 1) m *= __expf(bL - bS[roff + row] + liS[roff + row]);
#pragma unroll
            for (int e = 0; e < 8; ++e) f[e] = silu_f(f[e]) * m;
            u32x4 o; o.x = pk2(f[0], f[1]); o.y = pk2(f[2], f[3]); o.z = pk2(f[4], f[5]); o.w = pk2(f[6], f[7]);
            *(LAS u32x4*)(dst + row * M_KS + ch * 8) = o; }
        __builtin_amdgcn_sched_barrier(0);
    }
}
DI void conv_prepass(const Params& p, int l, int tid) {
    const bf16* U = (const bf16*)(p.ws + WS_U);
    const float* cw = p.conv_w + (size_t)l * 4 * 2048;
    bf16* QKC = (bf16*)(p.ws + WS_QKC);
    for (int gid = blk() * NTHR + tid; gid < 256 * 512; gid += gridDim.x * NTHR) {
        const int cidx = gid & 255, t0 = (gid >> 8) * 16;
        f32x4 w[4][2];
#pragma unroll
        for (int j = 0; j < 4; ++j) { w[j][0] = *(const f32x4*)(cw + j * 2048 + cidx * 8); w[j][1] = *(const f32x4*)(cw + j * 2048 + cidx * 8 + 4); }
        const bf16* src = U + C_QM + cidx * 8;
        u32x4 raw[19];
#pragma unroll
        for (int i = 0; i < 19; ++i) { const int tt = t0 - 3 + i; const int tc = tt < 0 ? 0 : tt; raw[i] = *(const u32x4*)(src + (size_t)tc * NU); if (tt < 0) raw[i] = (u32x4){0u, 0u, 0u, 0u}; }
        const float sc = cidx >= 128 ? 0.0625f : 1.f;
#pragma unroll
        for (int i = 0; i < 16; ++i) {
            float f[8];
#pragma unroll
            for (int e = 0; e < 8; ++e) f[e] = 0.f;
#pragma unroll
            for (int j = 0; j < 4; ++j) { const u32x4 rw = raw[i + j];
                f[0] += w[j][0][0] * bf_lo(rw.x); f[1] += w[j][0][1] * bf_hi(rw.x); f[2] += w[j][0][2] * bf_lo(rw.y); f[3] += w[j][0][3] * bf_hi(rw.y);
                f[4] += w[j][1][0] * bf_lo(rw.z); f[5] += w[j][1][1] * bf_hi(rw.z); f[6] += w[j][1][2] * bf_lo(rw.w); f[7] += w[j][1][3] * bf_hi(rw.w); }
#pragma unroll
            for (int e = 0; e < 8; ++e) f[e] = silu_f(f[e]) * sc;
            u32x4 o; o.x = pk2(f[0], f[1]); o.y = pk2(f[2], f[3]); o.z = pk2(f[4], f[5]); o.w = pk2(f[6], f[7]);
            *(u32x4*)(QKC + (size_t)(t0 + i) * 2048 + cidx * 8) = o; }
    }
}
DI void chunk_gates(const float* gates, int c, int hh, LAS float* bS, LAS float* liS, LAS float* wtot, int tid, int wave, int lane) {
    float v = 0.f;
    if (tid < 256) { const float* gp = gates + (size_t)(c * 256 + tid) * 8; const float fgv = gp[4 + hh]; liS[tid] = gp[hh];
        v = fminf(fgv, 0.f) - log1pf(__expf(-fabsf(fgv)));
#pragma unroll
        for (int o = 1; o < 64; o <<= 1) { const float t = __shfl_up(v, o); if (lane >= o) v += t; }
        if (lane == 63) wtot[wave] = v; }
    __syncthreads();
    if (tid < 256) { float pre = 0.f; for (int w = 0; w < wave; ++w) pre += wtot[w]; bS[tid] = v + pre; }
    __syncthreads();
}
DI void m1_item(const Params& p, LAS unsigned char* lds, int l, int item, int tid, int wave, int lane) {
    const bf16* U = (const bf16*)(p.ws + WS_U);
    const bf16* QKC = (const bf16*)(p.ws + WS_QKC);
    LAS unsigned short* Kp = (LAS unsigned short*)lds;
    LAS unsigned short* Vs = Kp + 128 * M_KS;
    LAS float* bS = (LAS float*)(Vs + 128 * AT_KS); LAS float* liS = bS + 256; LAS float* wtot = liS + 256;
    const int hh = item >> 7, c = (item >> 2) & 31, sl = item & 3;
    const int ql = lane & 15, quad = lane >> 4;
    chunk_gates((const float*)(p.ws + WS_GATES), c, hh, bS, liS, wtot, tid, wave, lane);
    const float bL = bS[255];
    f32x4 acc[4][4];
#pragma unroll
    for (int a = 0; a < 4; ++a)
#pragma unroll
        for (int b = 0; b < 4; ++b) acc[a][b] = (f32x4){0.f, 0.f, 0.f, 0.f};
    f32x4 nacc[4];
#pragma unroll
    for (int b = 0; b < 4; ++b) nacc[b] = (f32x4){0.f, 0.f, 0.f, 0.f};
    const bool do_n = (sl == 0) && ((wave & 1) == 0);
    const bf16x8 ones = {0x3F80, 0x3F80, 0x3F80, 0x3F80, 0x3F80, 0x3F80, 0x3F80, 0x3F80};
    const int dvt0 = (wave & 1) * 4, dkt0 = (wave >> 1) * 4;
    for (int half = 0; half < 2; ++half) {
#pragma unroll
        for (int ib = 0; ib < 8; ib += 4) { u32x4 kr[4];
#pragma unroll
            for (int i = 0; i < 4; ++i) { const int cc = tid + NTHR * (ib + i), row = cc >> 5, ch = cc & 31; kr[i] = *(const u32x4*)(QKC + (size_t)(c * 256 + half * 128 + row) * 2048 + 1024 + hh * 256 + ch * 8); }
#pragma unroll
            for (int i = 0; i < 4; ++i) { const int cc = tid + NTHR * (ib + i), row = cc >> 5, ch = cc & 31, sloc = half * 128 + row;
                const float wgt = __expf(bL - bS[sloc] + liS[sloc]);
                u32x4 w; w.x = pk2(bf_lo(kr[i].x) * wgt, bf_hi(kr[i].x) * wgt); w.y = pk2(bf_lo(kr[i].y) * wgt, bf_hi(kr[i].y) * wgt); w.z = pk2(bf_lo(kr[i].z) * wgt, bf_hi(kr[i].z) * wgt); w.w = pk2(bf_lo(kr[i].w) * wgt, bf_hi(kr[i].w) * wgt);
                *(LAS u32x4*)(Kp + row * M_KS + ch * 8) = w; } }
#pragma unroll
        for (int i = 0; i < 4; ++i) { const int cc = tid + NTHR * i, row = cc >> 4, ch = cc & 15;
            *(LAS u32x4*)(Vs + row * AT_KS + ch * 8) = *(const u32x4*)(U + (size_t)(c * 256 + half * 128 + row) * NU + C_VM + hh * 512 + sl * 128 + ch * 8); }
        __syncthreads();
#pragma unroll 1
        for (int ks = 0; ks < 4; ++ks) {
            bf16x8 af[4], bfr[4];
#pragma unroll
            for (int a = 0; a < 4; ++a) af[a] = trfrag(Vs + (ks * 32 + quad * 8) * AT_KS + (dvt0 + a) * 16, AT_KS, ql);
#pragma unroll
            for (int b = 0; b < 4; ++b) bfr[b] = trfrag(Kp + (ks * 32 + quad * 8) * M_KS + (dkt0 + b) * 16, M_KS, ql);
#pragma unroll
            for (int a = 0; a < 4; ++a)
#pragma unroll
                for (int b = 0; b < 4; ++b) acc[a][b] = mfma16(af[a], bfr[b], acc[a][b]);
            if (do_n) {
#pragma unroll
                for (int b = 0; b < 4; ++b) nacc[b] = mfma16(ones, bfr[b], nacc[b]); }
        }
        __syncthreads();
    }
    float* DC = (float*)(p.ws + WS_DC) + ((size_t)(hh * 32 + c) * 512 + sl * 128) * 256;
#pragma unroll
    for (int a = 0; a < 4; ++a)
#pragma unroll
        for (int b = 0; b < 4; ++b)
#pragma unroll
            for (int j = 0; j < 4; ++j) DC[(size_t)((dvt0 + a) * 16 + quad * 4 + j) * 256 + (dkt0 + b) * 16 + ql] = acc[a][b][j];
    if (do_n && quad == 0) {
#pragma unroll
        for (int b = 0; b < 4; ++b) ((float*)(p.ws + WS_DN))[(hh * 32 + c) * 256 + (dkt0 + b) * 16 + ql] = nacc[b][0]; }
    if (sl == 0 && tid == 0) ((float*)(p.ws + WS_BL))[hh * 32 + c] = bL;
}
DI void m2_phase(const Params& p, int tid) {
    const float* DC = (const float*)(p.ws + WS_DC); const float* BL = (const float*)(p.ws + WS_BL);
    bf16* CS = (bf16*)(p.ws + WS_CS);
    const int gthreads = gridDim.x * NTHR, gid = blk() * NTHR + tid;
    for (int e4 = gid; e4 < 4 * 32768; e4 += gthreads) {
        const int hh = e4 >> 15, e = e4 & 32767;
        f32x4 st = {0.f, 0.f, 0.f, 0.f};
#pragma unroll 8
        for (int c = 0; c < 32; ++c) {
            const size_t o = ((size_t)(hh * 32 + c) * 32768 + e) * 4;
            u32x2 w; w.x = pk2(st.x, st.y); w.y = pk2(st.z, st.w); *(u32x2*)(CS + o) = w;
            const f32x4 d = *(const f32x4*)(DC + o);
            st = st * __expf(BL[hh * 32 + c]) + d;
        }
    }
    if (gid < 1024) { const int hh = gid >> 8, dk = gid & 255; const float* DN = (const float*)(p.ws + WS_DN); float* NS = (float*)(p.ws + WS_NS);
        float dn[32], eb[32];
#pragma unroll
        for (int c = 0; c < 32; ++c) { dn[c] = DN[(hh * 32 + c) * 256 + dk]; eb[c] = BL[hh * 32 + c]; }
        float st = 0.f;
#pragma unroll
        for (int c = 0; c < 32; ++c) { NS[(hh * 32 + c) * 256 + dk] = st; st = st * __expf(eb[c]) + dn[c]; } }
}
DI void m3_stage_load(const Params& p, int hh, int c, int st, int tid, u32x4 (&pre)[8]) {
    if (st < 4) { const bf16* CT = (const bf16*)(p.ws + WS_CS) + (size_t)(hh * 32 + c) * 512 * 256;
#pragma unroll
        for (int i = 0; i < 8; ++i) { const int cc = tid + NTHR * i, row = cc >> 5, ch = cc & 31;
            pre[i] = *(const u32x4*)(CT + (size_t)((row >> 6) * 256 + st * 64 + (row & 63)) * 256 + ch * 8); }
    } else { const int kt = (st - 4) >> 1, hb = (st - 4) & 1; const bf16* U = (const bf16*)(p.ws + WS_U); const bf16* QKC = (const bf16*)(p.ws + WS_QKC);
        if (hb == 0) {
#pragma unroll
            for (int i = 0; i < 4; ++i) { const int cc = tid + NTHR * i, row = cc >> 5, ch = cc & 31; pre[i] = *(const u32x4*)(QKC + (size_t)(c * 256 + kt * 64 + row) * 2048 + 1024 + hh * 256 + ch * 8); } }
#pragma unroll
        for (int i = 0; i < 4; ++i) { const int cc = tid + NTHR * i, row = 32 * hb + (cc >> 6), ch = cc & 63; pre[4 + i] = *(const u32x4*)(U + (size_t)(c * 256 + kt * 64 + row) * NU + C_VM + hh * 512 + ch * 8); }
    }
}
DI void m3_stage_store(int st, int tid, const u32x4 (&pre)[8], LAS unsigned short* Ks, LAS unsigned short* Vs) {
    if (st < 4) {
#pragma unroll
        for (int i = 0; i < 8; ++i) { const int cc = tid + NTHR * i, row = cc >> 5, ch = cc & 31; *(LAS u32x4*)(Ks + row * M_KS + ch * 8) = pre[i]; }
    } else { const int hb = (st - 4) & 1;
        if (hb == 0) {
#pragma unroll
            for (int i = 0; i < 4; ++i) { const int cc = tid + NTHR * i, row = cc >> 5, ch = cc & 31; *(LAS u32x4*)(Ks + row * M_KS + ch * 8) = pre[i]; } }
#pragma unroll
        for (int i = 0; i < 4; ++i) { const int cc = tid + NTHR * i, row = 32 * hb + (cc >> 6), ch = cc & 63; *(LAS u32x4*)(Vs + row * M_VS3 + ch * 8) = pre[4 + i]; }
    }
}
DI void m3_item(const Params& p, LAS unsigned char* lds, int l, int hh, int qb, int tid, int wave, int lane) {
    const bf16* U = (const bf16*)(p.ws + WS_U);
    const bf16* QKC = (const bf16*)(p.ws + WS_QKC);
    LAS unsigned short* Qs = (LAS unsigned short*)lds;
    LAS unsigned short* Ks = Qs + 64 * M_KS;
    LAS unsigned short* Vs = Ks + 64 * M_KS;
    LAS float* bS = (LAS float*)(Vs + 64 * M_VS3); LAS float* liS = bS + 256; LAS float* nS = liS + 256; LAS float* wtot = nS + 256; LAS float* ssS = wtot + 8;
    const int c = qb >> 2, jq = qb & 3;
    const int ql = lane & 15, quad = lane >> 4;
    u32x4 pre[8];
    u32x4 qv[4];
#pragma unroll
    for (int i = 0; i < 4; ++i) { const int cc = tid + NTHR * i, row = cc >> 5, ch = cc & 31; qv[i] = *(const u32x4*)(QKC + (size_t)(qb * 64 + row) * 2048 + hh * 256 + ch * 8); }
    m3_stage_load(p, hh, c, 0, tid, pre);
    if (tid < 256) nS[tid] = ((const float*)(p.ws + WS_NS))[(hh * 32 + c) * 256 + tid];
    chunk_gates((const float*)(p.ws + WS_GATES), c, hh, bS, liS, wtot, tid, wave, lane);
#pragma unroll
    for (int i = 0; i < 4; ++i) { const int cc = tid + NTHR * i, row = cc >> 5, ch = cc & 31; *(LAS u32x4*)(Qs + row * M_KS + ch * 8) = qv[i]; }
    __syncthreads();
    const int qg = wave & 3, dvh = wave >> 2, q = qg * 16 + ql, iq = jq * 64 + q;
    const LAS unsigned short* qrow = Qs + q * M_KS + quad * 8;
    const float b_ref = bS[jq * 64], e_ref = __expf(b_ref), ebq = __expf(bS[iq] - b_ref);
    f32x4 acc[16];
#pragma unroll
    for (int nt = 0; nt < 16; ++nt) acc[nt] = (f32x4){0.f, 0.f, 0.f, 0.f};
    float nq;
    { float nqp = 0.f;
#pragma unroll
      for (int ks = 0; ks < 8; ++ks) { const bf16x8 qk = *(const LAS bf16x8*)(qrow + ks * 32);
#pragma unroll
          for (int j = 0; j < 8; ++j) nqp += bf2f((unsigned short)qk[j]) * nS[ks * 32 + quad * 8 + j]; }
      nq = quad_sum(nqp) * e_ref; }
    float nqi = 0.f;
    const int nst = 4 + 2 * (jq + 1);
    bf16x8 pf1 = {0, 0, 0, 0, 0, 0, 0, 0};
#pragma unroll 1
    for (int st = 0; st < nst; ++st) {
        __syncthreads();
        int tid2 = tid; asm volatile("" : "+v"(tid2));
        m3_stage_store(st, tid2, pre, Ks, Vs);
        __syncthreads();
        if (st + 1 < nst) m3_stage_load(p, hh, c, st + 1, tid2, pre);
        if (st < 4) {
            bf16x8 qf[8];
#pragma unroll
            for (int ks = 0; ks < 8; ++ks) qf[ks] = *(const LAS bf16x8*)(qrow + ks * 32);
#pragma unroll
            for (int n4 = 0; n4 < 4; ++n4) { const LAS unsigned short* cp = Ks + (dvh * 64 + n4 * 16 + ql) * M_KS + quad * 8;
#pragma unroll
                for (int ks = 0; ks < 8; ++ks) acc[n4] = mfma16(*(const LAS bf16x8*)(cp + ks * 32), qf[ks], acc[n4]);
                __builtin_amdgcn_sched_barrier(0); }
            { const f32x4 t0 = acc[0], t1 = acc[1], t2 = acc[2], t3 = acc[3];
#pragma unroll
              for (int i = 0; i < 12; ++i) acc[i] = acc[i + 4];
              acc[12] = t0; acc[13] = t1; acc[14] = t2; acc[15] = t3; }
            if (st == 3) {
#pragma unroll
                for (int nt = 0; nt < 16; ++nt) acc[nt] = acc[nt] * e_ref; }
        } else {
            const int kt = (st - 4) >> 1, hb = (st - 4) & 1;
            bf16x8 pf;
            if (hb == 0) {
                bf16x8 qf[8];
#pragma unroll
                for (int ks = 0; ks < 8; ++ks) qf[ks] = *(const LAS bf16x8*)(qrow + ks * 32);
                f32x4 sacc[4];
#pragma unroll
                for (int t = 0; t < 4; ++t) sacc[t] = (f32x4){0.f, 0.f, 0.f, 0.f};
#pragma unroll
                for (int s2 = 0; s2 < 2; ++s2)
#pragma unroll
                    for (int u = 0; u < 2; ++u) { const int krow = 32 * s2 + (ql >> 2) * 8 + u * 4 + (ql & 3);
                        const LAS unsigned short* kp = Ks + krow * M_KS + quad * 8;
#pragma unroll
                        for (int ks = 0; ks < 8; ++ks) sacc[2 * s2 + u] = mfma16(*(const LAS bf16x8*)(kp + ks * 32), qf[ks], sacc[2 * s2 + u]); }
#pragma unroll
                for (int s2 = 0; s2 < 2; ++s2)
#pragma unroll
                    for (int u = 0; u < 2; ++u)
#pragma unroll
                        for (int j = 0; j < 4; ++j) { const int sk = kt * 64 + 32 * s2 + quad * 8 + u * 4 + j;
                            const float w = (sk <= iq) ? __expf(b_ref - bS[sk] + liS[sk]) : 0.f;
                            const float pv = sacc[2 * s2 + u][j] * w; sacc[2 * s2 + u][j] = pv; nqi += pv; }
                u32x4 pw; pw.x = pk2(sacc[0][0], sacc[0][1]); pw.y = pk2(sacc[0][2], sacc[0][3]); pw.z = pk2(sacc[1][0], sacc[1][1]); pw.w = pk2(sacc[1][2], sacc[1][3]);
                pf = __builtin_bit_cast(bf16x8, pw);
                u32x4 pw1; pw1.x = pk2(sacc[2][0], sacc[2][1]); pw1.y = pk2(sacc[2][2], sacc[2][3]); pw1.z = pk2(sacc[3][0], sacc[3][1]); pw1.w = pk2(sacc[3][2], sacc[3][3]);
                pf1 = __builtin_bit_cast(bf16x8, pw1);
            } else pf = pf1;
            const LAS unsigned short* vp = Vs + (32 * hb + quad * 8) * M_VS3 + dvh * 256;
#pragma unroll
            for (int nt = 0; nt < 16; ++nt) { acc[nt] = mfma16(trfrag(vp + nt * 16, M_VS3, ql), pf, acc[nt]); if ((nt & 3) == 3) __builtin_amdgcn_sched_barrier(0); }
        }
    }
    nq = (nq + quad_sum(nqi)) * ebq;
#pragma unroll
    for (int nt = 0; nt < 16; ++nt) acc[nt] = acc[nt] * ebq;
    const float inv = 1.f / fmaxf(fabsf(nq), 1.f);
    float ss = 0.f;
#pragma unroll
    for (int nt = 0; nt < 16; ++nt) { acc[nt] = acc[nt] * inv; ss += (acc[nt][0] * acc[nt][0] + acc[nt][1] * acc[nt][1]) + (acc[nt][2] * acc[nt][2] + acc[nt][3] * acc[nt][3]); }
    ss = quad_sum(ss);
    if (quad == 0) ssS[dvh * 64 + q] = ss;
    __syncthreads();
    const float rstd = rsqrtf((ssS[q] + ssS[64 + q]) * (1.f / 512.f) + NORM_EPS);
    const int t = qb * 64 + q;
    const float* ng = p.mnorm_g + l * 2048;
    bf16* Y = (bf16*)(p.ws + WS_Y);
#pragma unroll
    for (int nt = 0; nt < 16; ++nt) { const int col = hh * 512 + dvh * 256 + nt * 16 + quad * 4;
        const f32x4 g4 = *(const f32x4*)(ng + col);
        const u32x2 om = *(const u32x2*)(U + (size_t)t * NU + C_OM + col), zm = *(const u32x2*)(U + (size_t)t * NU + C_ZM + col);
        const float y0 = acc[nt][0] * rstd * g4[0] * sigm_f(bf_lo(om.x)) * silu_f(bf_lo(zm.x));
        const float y1 = acc[nt][1] * rstd * g4[1] * sigm_f(bf_hi(om.x)) * silu_f(bf_hi(zm.x));
        const float y2 = acc[nt][2] * rstd * g4[2] * sigm_f(bf_lo(om.y)) * silu_f(bf_lo(zm.y));
        const float y3 = acc[nt][3] * rstd * g4[3] * sigm_f(bf_hi(om.y)) * silu_f(bf_hi(zm.y));
        u32x2 w; w.x = pk2(y0, y1); w.y = pk2(y2, y3);
        *(u32x2*)(Y + (size_t)t * DM + 2048 + col) = w;
        if ((nt & 3) == 3) __builtin_amdgcn_sched_barrier(0); }
    __syncthreads();
}

#define RLX_AGENT __ATOMIC_RELAXED, __HIP_MEMORY_SCOPE_AGENT
#define XB_TMO      128
#define XB_XCNT(j)  (256  + 64 * (j))
#define XB_XSUB(j)  (1280 + 64 * (j))
#define XB_XGEN(j)  (2304 + 64 * (j))
#define XB_TOP      3328
#define XB_TOPGEN   3392
#define XCD_BAR_WORDS 3456
#define XB_SPIN_CAP (1u << 18)

__device__ __forceinline__ unsigned xb_ld(unsigned* p)              { return __hip_atomic_load(p, __ATOMIC_RELAXED, __HIP_MEMORY_SCOPE_AGENT); }
__device__ __forceinline__ unsigned xb_add(unsigned* p, unsigned v) { return __hip_atomic_fetch_add(p, v, __ATOMIC_RELAXED, __HIP_MEMORY_SCOPE_AGENT); }
__device__ __forceinline__ unsigned xb_xcc_id() { return (unsigned)__builtin_amdgcn_s_getreg((3 << 11) | 20) & 0xFu; }
#define XB_SPIN(cond, bar) do { unsigned _sp = 0; while (cond) { __builtin_amdgcn_s_sleep(1); \
    if ((++_sp & 255u) == 0u) { if (xb_ld(&(bar)[XB_TMO])) break; if (_sp > XB_SPIN_CAP) { atomicAdd(&(bar)[XB_TMO], 1u); break; } } } } while (0)

struct XcdBarrier {
    unsigned* bar; unsigned x;
    volatile LAS unsigned* st;
};

__device__ __forceinline__ XcdBarrier xcd_barrier_post(unsigned* bar, volatile LAS unsigned* st) {
    XcdBarrier b; b.bar = bar; b.x = xb_xcc_id(); b.st = st;
    if (threadIdx.x == 0) (void)xb_add(&bar[XB_XCNT(b.x)], 1u);
    return b;
}
__device__ __forceinline__ void xcd_barrier_complete(unsigned* bar, unsigned x, unsigned& nloc, unsigned& nx) {
    const unsigned G = gridDim.x * gridDim.y * gridDim.z;
    unsigned sum, cnt, mine, sp = 0u;
    for (;;) {
        sum = 0u; cnt = 0u; mine = 0u;
#pragma unroll
        for (unsigned j = 0; j < 16; ++j) { const unsigned c = xb_ld(&bar[XB_XCNT(j)]); sum += c; cnt += (c > 0u) ? 1u : 0u; mine = (j == x) ? c : mine; }
        if (sum == G) break;
        __builtin_amdgcn_s_sleep(1);
        if ((++sp & 255u) == 0u) { if (xb_ld(&bar[XB_TMO])) break; if (sp > XB_SPIN_CAP) { atomicAdd(&bar[XB_TMO], 1u); break; } }
    }
    nloc = mine > 0u ? mine : 1u; nx = cnt > 0u ? cnt : 1u;
}

__device__ __forceinline__ void xcd_barrier(const XcdBarrier& b) {
    asm volatile("s_waitcnt vmcnt(0)" ::: "memory");
    __syncthreads();
    if (threadIdx.x == 0) {
        unsigned* bar = b.bar;
        __builtin_amdgcn_s_waitcnt(0);
        unsigned nloc = b.st[0], nx = b.st[1];
        if (nloc == 0u) { xcd_barrier_complete(bar, b.x, nloc, nx); b.st[0] = nloc; b.st[1] = nx; }
        const unsigned old = xb_add(&bar[XB_XSUB(b.x)], 1u);
        const unsigned gen = old / nloc;
        if (old + 1u == (gen + 1u) * nloc) {
            __builtin_amdgcn_fence(__ATOMIC_RELEASE, "agent");
            asm volatile("s_waitcnt vmcnt(0)" ::: "memory");
            const unsigned og = xb_add(&bar[XB_TOP], 1u);
            const unsigned tg = og / nx;
            if (og + 1u == (tg + 1u) * nx) xb_add(&bar[XB_TOPGEN], 1u);
            else XB_SPIN(xb_ld(&bar[XB_TOPGEN]) == tg, bar);
            __builtin_amdgcn_fence(__ATOMIC_ACQUIRE, "agent");
            xb_add(&bar[XB_XGEN(b.x)], 1u);
            asm volatile("s_waitcnt vmcnt(0)" ::: "memory");
        } else {
            XB_SPIN(xb_ld(&bar[XB_XGEN(b.x)]) == gen, bar);
            __builtin_amdgcn_fence(__ATOMIC_ACQUIRE, "agent");
            asm volatile("s_waitcnt vmcnt(0)" ::: "memory");
        }
    }
    __syncthreads();
}

#if TSEL >= 7
#define TSUB_BEGIN(k) unsigned long long tsub_b = 0; if ((TSEL) == (k) && threadIdx.x == 0) tsub_b = __builtin_amdgcn_s_memrealtime();
#define TSUB_END(k) if ((TSEL) == (k) && threadIdx.x == 0) { volatile LAS unsigned long long* TWs = (volatile LAS unsigned long long*)((LAS unsigned char*)lds_raw + LDS_BARST + 16); TWs[2] += __builtin_amdgcn_s_memrealtime() - tsub_b; }
#else
#define TSUB_BEGIN(k)
#define TSUB_END(k)
#endif
constexpr int NPH = 15;
__global__ void __launch_bounds__(NTHR, 2) hymba_fwd(Params p0) {
    extern __shared__ __attribute__((aligned(16))) unsigned char lds_raw[];
    cg::grid_group grid = cg::this_grid();
    if (threadIdx.x < 16) ((LAS unsigned*)((LAS unsigned char*)lds_raw + LDS_BARST))[threadIdx.x] = 0u;
    __syncthreads();
    XcdBarrier bar = xcd_barrier_post((unsigned*)(p0.ws + WS_CTL), (volatile LAS unsigned*)((LAS unsigned char*)lds_raw + LDS_BARST));
#if TSEL >= 0
    volatile LAS unsigned long long* TW = (volatile LAS unsigned long long*)((LAS unsigned char*)lds_raw + LDS_BARST + 16);
    if (threadIdx.x == 0) { const unsigned long long t = __builtin_amdgcn_s_memrealtime(); TW[0] = t; TW[1] = t; TW[2] = 0; }
#endif
    for (int ph = p0.ph_lo; ph < p0.ph_hi; ++ph) {
        const int ptype = ph == 0 ? 0 : 1 + (ph - 1) % 7;
        const int nrep = (REPEAT_MASK) == 0 ? 1 : ((((REPEAT_MASK) >> ptype) & 1) ? 2 : 1);
        for (int rep = 0; rep < nrep; ++rep) {
        int tid = threadIdx.x; asm volatile("" : "+v"(tid));
        int G = gridDim.x; asm volatile("" : "+s"(G));
        const int lane = tid & 63, wave = __builtin_amdgcn_readfirstlane(tid >> 6);
        LAS unsigned char* lds = (LAS unsigned char*)lds_raw; asm volatile("" : "+s"(lds));
        Params p = p0;
        asm volatile("" : "+s"(p.ws)); asm volatile("" : "+s"(p.x)); asm volatile("" : "+s"(p.out)); asm volatile("" : "+s"(p.w_in)); asm volatile("" : "+s"(p.w_out));
        asm volatile("" : "+s"(p.conv_w)); asm volatile("" : "+s"(p.norm_g)); asm volatile("" : "+s"(p.mnorm_g)); asm volatile("" : "+s"(p.b_gate)); asm volatile("" : "+s"(p.rel_bias)); asm volatile("" : "+s"(p.final_g));
        if (ph == 0) {
            prologue_transposes(p, lds, wave, lane);
            build_wgt(p, tid);
            norm_phase(p, p.x, 0, wave, lane);
        } else {
            const int l = (ph - 1) / 7, k = (ph - 1) % 7;
            if (k == 0) {
                pg8::Gemm g{(const pg8::bf16_t*)(p.ws + WS_XN), (const pg8::bf16_t*)(p.ws + WS_WIN + (size_t)l * 128 * MiB), SEQ, NU, DM};
                pg8::StaticOrder S; S.init(SEQ, NU, G, blk());
                pg8::EpiBf16Plain E{(pg8::bf16_t*)(p.ws + WS_U), NU};
                pg8::gemm_phase<pg8::EpiBf16Plain, pg8::StaticOrder, true, true>(lds, g, S, E);
            } else if (k == 1) {
                gate_items(p, lds, l, tid, wave, lane);
                conv_prepass(p, l, tid);
                attn_phase(p, lds, tid, wave, lane);
            } else if (k == 2) {
                const bool xmap = (G == 256); const int xcd = blk() & 7, xi = blk() >> 3;
                int tid3 = tid; asm volatile("" : "+v"(tid3));
                { TSUB_BEGIN(8)
                for (int rr = 0; rr < 1 + (REP_M1); ++rr)
                for (int it = blk(), rnd = 0; it < 512; it += G, ++rnd) {
                    int item = it;
                    if (xmap) item = (xcd * 16 + rnd * 8 + (xi >> 2)) * 4 + (xi & 3);
                    m1_item(p, lds, l, item, tid3, __builtin_amdgcn_readfirstlane(tid3 >> 6), tid3 & 63); __syncthreads(); }
                TSUB_END(8) }
                merge_phase(p, tid);
            } else if (k == 3) {
                m2_phase(p, tid);
            } else if (k == 4) {
                const bool xmap = (G == 256); const int xcd = blk() & 7, xi = blk() >> 3;
                TSUB_BEGIN(9)
                for (int it = blk(), rnd = 0; it < 512; it += G, ++rnd) {
                    int hh = it >> 7, qb = it & 127; if ((it >> 8) & 1) qb ^= 3;
                    if (xmap) { const int pair = xcd * 16 + rnd * 8 + (xi >> 2); hh = pair >> 5; qb = (pair & 31) * 4 + (rnd ? 3 - (xi & 3) : (xi & 3)); }
                    m3_item(p, lds, l, hh, qb, tid, wave, lane); }
                TSUB_END(9)
            } else if (k == 5) {
                pg8::Gemm g{(const pg8::bf16_t*)(p.ws + WS_Y), (const pg8::bf16_t*)(p.ws + WS_WOUT + (size_t)l * 32 * MiB), SEQ, DM, DM};
                pg8::StaticOrder S; S.init(SEQ, DM, G, blk());
                pg8::EpiResF32 E{l == 0 ? p.x : (const float*)(p.ws + WS_X1), l == 0 ? (float*)(p.ws + WS_X1) : p.out, DM};
                pg8::gemm_phase<pg8::EpiResF32, pg8::StaticOrder, true, true>(lds, g, S, E);
            } else {
                if (l == 0) norm_phase(p, (const float*)(p.ws + WS_X1), 1, wave, lane);
                else final_norm_phase(p, (LAS unsigned char*)lds_raw, wave, lane);
            }
        }
        __syncthreads();
        }
        if (ph + 1 < p0.ph_hi) { if (p0.ph_hi > NPH) grid.sync(); else xcd_barrier(bar); }
#if TSEL >= 0
        if (threadIdx.x == 0) { const unsigned long long now = __builtin_amdgcn_s_memrealtime(); if (ptype == (TSEL)) TW[2] += now - TW[1]; TW[1] = now;
          if (ph + 2 == p0.ph_hi) ((volatile LAS int*)TW)[8] = (int)((float)TW[2] / (float)(now - TW[0]) * 131072.f); }
        if (ph + 2 == p0.ph_hi) __syncthreads();
#endif
    }
}

extern "C" void kernel_launch(void* const* d_in, const int* in_sizes, int n_in, void* d_out, int out_size, void* d_ws, size_t ws_size, hipStream_t stream) {
    static int grid = 0;
    if (grid == 0) {
        if (n_in != 9 || in_sizes[0] != SEQ * DM || out_size != SEQ * DM || ws_size < WS_END) {
            fprintf(stderr, "kernel_launch: unexpected problem: n_in %d in0 %d out %d ws %zu (need %zu)\n", n_in, n_in > 0 ? in_sizes[0] : -1, out_size, ws_size, (size_t)WS_END); grid = -1; return; }
        int dev = 0, cus = 0, per_cu = 0;
        hipGetDevice(&dev);
        hipDeviceGetAttribute(&cus, hipDeviceAttributeMultiprocessorCount, dev);
        if (hipFuncSetAttribute((const void*)hymba_fwd, hipFuncAttributeMaxDynamicSharedMemorySize, LDS_BYTES) != hipSuccess) { fprintf(stderr, "kernel_launch: hipFuncSetAttribute failed\n"); grid = -1; return; }
        if (hipOccupancyMaxActiveBlocksPerMultiprocessor(&per_cu, (const void*)hymba_fwd, NTHR, LDS_BYTES) != hipSuccess || per_cu < 1) { fprintf(stderr, "kernel_launch: occupancy query gave %d\n", per_cu); per_cu = 1; }
        (void)hipGetLastError();
        grid = cus * per_cu;
        fprintf(stderr, "kernel_launch: %d CUs x %d = grid %d\n", cus, per_cu, grid);
    }
    if (grid < 0) return;
    if (hipMemsetAsync((char*)d_ws + WS_CTL, 0, 16384, stream) != hipSuccess) { fprintf(stderr, "kernel_launch: hipMemsetAsync failed\n"); return; }
    Params p{};
    p.x = (const float*)d_in[0]; p.norm_g = (const float*)d_in[1]; p.w_in = (const float*)d_in[2]; p.b_gate = (const float*)d_in[3]; p.conv_w = (const float*)d_in[4];
    p.mnorm_g = (const float*)d_in[5]; p.w_out = (const float*)d_in[6]; p.rel_bias = (const float*)d_in[7]; p.final_g = (const float*)d_in[8];
    p.out = (float*)d_out; p.ws = (unsigned char*)d_ws;
#if MULTI_LAUNCH
    for (int ph = 0; ph < NPH; ++ph) { p.ph_lo = ph; p.ph_hi = ph + 1; hipLaunchKernelGGL(hymba_fwd, dim3(grid), dim3(NTHR), LDS_BYTES, stream, p); }
#else
    p.ph_lo = 0; p.ph_hi = NPH;
    void* args[] = {&p};
    hipError_t e = hipLaunchCooperativeKernel((const void*)hymba_fwd, dim3(grid), dim3(NTHR), args, LDS_BYTES, stream);
    if (e != hipSuccess) fprintf(stderr, "kernel_launch: cooperative launch failed: %s (grid %d)\n", hipGetErrorString(e), grid);
#endif
}
```

```cpp
#include <hip/hip_runtime.h>
#include <hip/hip_cooperative_groups.h>
#include <cstdio>
#include <cstdint>
namespace cg = cooperative_groups;
namespace pg8 {
#define PG8_LAS __attribute__((address_space(3)))
typedef unsigned short bf16_t;
typedef short bf16x8 __attribute__((ext_vector_type(8)));
typedef float f32x4 __attribute__((ext_vector_type(4)));
typedef unsigned u32x4 __attribute__((ext_vector_type(4)));
constexpr int BM = 256, BK = 64, HALF = 128, HTB = HALF * BK * 2  , STAGE_BYTES = 8 * HTB, NXCD = 8, WGM = 8;

__host__ __device__ __forceinline__ int lds_byte(int r, int c) { const int st = (r >> 4) * 2 + (c >> 5), rr = r & 15, cc = c & 31, ob = rr * 64 + cc * 2; return st * 1024 + (ob ^ (((ob >> 9) & 1) << 5)); }
__host__ __device__ __forceinline__ void stage_rc(int b, int& R, int& C) { const int st = b / 1024, sb = b % 1024, swz = sb ^ (((sb >> 9) & 1) << 5); R = (st >> 1) * 16 + swz / 64; C = (st & 1) * 32 + (swz % 64) / 2; }
__host__ __device__ __forceinline__ int perm32(int rho) { const int n = rho >> 4, i = rho & 15; return 8 * (i >> 2) + 4 * n + (i & 3); }

struct Unit { int pm, pn; };
struct Gemm { const bf16_t* A; const bf16_t* Bt; int M, N, K; };

struct StaticOrder {
    int nM, nN, nwg, G, c;
    __host__ __device__ void init(int M, int N, int G_, int c_) { nM = M / BM; nN = N / BM; nwg = nM * nN; G = G_; c = c_; }
    __host__ __device__ bool next(int i, Unit& u) const {
        const long L = (long)i * G + c; if (L >= nwg) return false;
        int wgid = (int)L; { const int q = nwg / NXCD, r = nwg % NXCD, xcd = wgid % NXCD, off = wgid / NXCD; wgid = (xcd < r ? xcd * (q + 1) : r * (q + 1) + (xcd - r) * q) + off; }
        const int nig = WGM * nN, gid = wgid / nig, fm = gid * WGM, gsz = (nM - fm) < WGM ? (nM - fm) : WGM;
        u.pm = fm + ((wgid % nig) % gsz); u.pn = (wgid % nig) / gsz; return true;
    }
    __device__ __forceinline__ void a_ready(const Unit&) const {}
    __device__ __forceinline__ void done(const Unit&) const {}
};

__device__ __forceinline__ unsigned cvt_pk_bf16(float lo, float hi) { unsigned r; asm volatile("v_cvt_pk_bf16_f32 %0, %1, %2" : "=v"(r) : "v"(lo), "v"(hi)); return r; }
struct EpiBf16Plain {
    static constexpr bool PERM = true, AFTER_DRAIN = false;
    bf16_t* O; int ldc;
    __device__ __forceinline__ void operator()(const f32x4 (&acc)[2][2][4][2], const Unit& u, int wr, int wc, int fr, int fq) const {
        const int row0 = u.pm * BM + wr * 64 + fr; const int col0 = u.pn * BM + wc * 32 + 8 * fq;
#pragma unroll
        for (int ai = 0; ai < 2; ++ai)
#pragma unroll
            for (int m = 0; m < 4; ++m) { bf16_t* rowp = O + (size_t)(row0 + ai * HALF + m * 16) * ldc + col0;
#pragma unroll
                for (int bj = 0; bj < 2; ++bj) { const f32x4 v0 = acc[ai][bj][m][0], v1 = acc[ai][bj][m][1];
                    u32x4 w; w.x = cvt_pk_bf16(v0[0], v0[1]); w.y = cvt_pk_bf16(v0[2], v0[3]); w.z = cvt_pk_bf16(v1[0], v1[1]); w.w = cvt_pk_bf16(v1[2], v1[3]);
                    *(u32x4*)(rowp + bj * HALF) = w; } }
    }
};
struct EpiResF32 {
    static constexpr bool PERM = true, AFTER_DRAIN = false;
    const float* base; float* out; int ld;
    __device__ __forceinline__ void operator()(const f32x4 (&acc)[2][2][4][2], const Unit& u, int wr, int wc, int fr, int fq) const {
        const int row0 = u.pm * BM + wr * 64 + fr; const int col0 = u.pn * BM + wc * 32 + 8 * fq;
#pragma unroll
        for (int ai = 0; ai < 2; ++ai)
#pragma unroll
            for (int m = 0; m < 4; ++m) { const size_t ro = (size_t)(row0 + ai * HALF + m * 16) * ld + col0;
#pragma unroll
                for (int bj = 0; bj < 2; ++bj) {
                    const f32x4 b0 = *(const f32x4*)(base + ro + bj * HALF), b1 = *(const f32x4*)(base + ro + bj * HALF + 4);
                    *(f32x4*)(out + ro + bj * HALF) = acc[ai][bj][m][0] + b0;
                    *(f32x4*)(out + ro + bj * HALF + 4) = acc[ai][bj][m][1] + b1; } }
    }
};
template <class Epi, class Sched, bool ALIGN_EPI = false, bool SP2 = false>
__device__ __forceinline__ void gemm_phase(PG8_LAS unsigned char* lds, const Gemm g, const Sched& S, const Epi& E) {
    int tid = threadIdx.x; asm volatile("" : "+v"(tid));
    const int wid = __builtin_amdgcn_readfirstlane(tid >> 6), lane = tid & 63, wr = wid >> 2, wc = wid & 3, fr = lane & 15, fq = lane >> 4;
    const int K = g.K, nt = K / BK;
    unsigned voffA[2], voffB[2];
#pragma unroll
    for (int i = 0; i < 2; ++i) { int R, C; stage_rc(tid * 16 + i * 8192, R, C); const int Rb = Epi::PERM ? ((R & ~31) + perm32(R & 31)) : R;
        voffA[i] = (unsigned)(R * K + C) * 2u; voffB[i] = (unsigned)(Rb * K + C) * 2u; }
    const size_t kstep = (size_t)(BK * 2);
    const size_t hstep = (size_t)HALF * K * 2;
    const size_t tstep = 2 * hstep;
    const unsigned ldsw = (unsigned)wid * 1024u;
    const int aoff = lds_byte(wr * 64 + fr, fq * 8), boff = lds_byte(wc * 32 + fr, fq * 8);
#define PG8_SA(b, h) (((b) * 2 + (h)) * HTB)
#define PG8_SB(b, h) ((4 + (b) * 2 + (h)) * HTB)
#define PG8_STAGE(bufoff, gbase, voff) do { _Pragma("unroll") for (int _i = 0; _i < 2; ++_i) \
        __builtin_amdgcn_global_load_lds((const unsigned*)((const char*)(gbase) + (voff)[_i]), (PG8_LAS unsigned*)(lds + (bufoff) + ldsw + _i * 8192), 16, 0, 0); } while (0)
#define PG8_LDA(dst, b, h) do { _Pragma("unroll") for (int m = 0; m < 4; ++m) _Pragma("unroll") for (int k = 0; k < 2; ++k) dst[m][k] = *(const PG8_LAS bf16x8*)(lds + PG8_SA(b, h) + aoff + m * 2048 + k * 1024); } while (0)
#define PG8_LDB(dst, b, h) do { _Pragma("unroll") for (int n = 0; n < 2; ++n) _Pragma("unroll") for (int k = 0; k < 2; ++k) dst[n][k] = *(const PG8_LAS bf16x8*)(lds + PG8_SB(b, h) + boff + n * 2048 + k * 1024); } while (0)
#define PG8_MMA(ai, bj, At, Bt) do { __builtin_amdgcn_s_setprio(1); _Pragma("unroll") for (int m = 0; m < 4; ++m) _Pragma("unroll") for (int n = 0; n < 2; ++n) _Pragma("unroll") for (int k = 0; k < 2; ++k) \
        acc[ai][bj][m][n] = __builtin_amdgcn_mfma_f32_16x16x32_bf16(Bt[n][k], At[m][k], acc[ai][bj][m][n], 0, 0, 0); __builtin_amdgcn_s_setprio(0); } while (0)
#define PG8_WAIT_V(n) asm volatile("s_waitcnt vmcnt(" #n ")" ::: "memory")
#define PG8_WAIT_L(n) asm volatile("s_waitcnt lgkmcnt(" #n ")" ::: "memory")
#define PG8_BAR __builtin_amdgcn_s_barrier()
#define PG8_SCHED __builtin_amdgcn_sched_barrier(0)
    Unit cur, nxt; int ui = 0;
    if (!S.next(0, cur)) return;
    f32x4 acc[2][2][4][2];
#pragma unroll
    for (int a = 0; a < 2; ++a)
#pragma unroll
        for (int b = 0; b < 2; ++b)
#pragma unroll
            for (int m = 0; m < 4; ++m)
#pragma unroll
                for (int n = 0; n < 2; ++n) acc[a][b][m][n] = (f32x4){0.f, 0.f, 0.f, 0.f};
    bf16x8 At[4][2], B0[2][2], B1[2][2];
    const char* cA = (const char*)g.A + (size_t)cur.pm * tstep; const char* cB = (const char*)g.Bt + (size_t)cur.pn * tstep;
    S.a_ready(cur);
    if constexpr (SP2) {
        PG8_STAGE(PG8_SB(0, 0), cB, voffB); PG8_STAGE(PG8_SB(0, 1), cB + hstep, voffB); PG8_STAGE(PG8_SA(0, 0), cA, voffA); PG8_STAGE(PG8_SA(0, 1), cA + hstep, voffA);
        if (wr == 1) PG8_BAR;
        PG8_WAIT_V(2); PG8_BAR;
        PG8_STAGE(PG8_SB(1, 0), cB + kstep, voffB); PG8_STAGE(PG8_SA(1, 0), cA + kstep, voffA); PG8_STAGE(PG8_SB(1, 1), cB + hstep + kstep, voffB);
        PG8_WAIT_V(6); PG8_BAR;
    } else {
        PG8_STAGE(PG8_SB(0, 0), cB, voffB); PG8_STAGE(PG8_SA(0, 0), cA, voffA); PG8_STAGE(PG8_SB(0, 1), cB + hstep, voffB); PG8_STAGE(PG8_SA(0, 1), cA + hstep, voffA);
        if (wr == 1) PG8_BAR;
        PG8_WAIT_V(4); PG8_BAR;
        PG8_STAGE(PG8_SB(1, 0), cB + kstep, voffB); PG8_STAGE(PG8_SA(1, 0), cA + kstep, voffA); PG8_STAGE(PG8_SB(1, 1), cB + hstep + kstep, voffB);
        PG8_WAIT_V(6); PG8_BAR;
    }
    for (;;) {
        const bool has_next = S.next(ui + 1, nxt);
        const char* nA = has_next ? (const char*)g.A + (size_t)nxt.pm * tstep : cA; const char* nB = has_next ? (const char*)g.Bt + (size_t)nxt.pn * tstep : cB;
        for (int t = 0; t < nt; t += 2) {
            const bool last = (t == nt - 2);
            const char* a1 = cA + (size_t)(t + 1) * kstep;
            const char* a2 = last ? nA : cA + (size_t)(t + 2) * kstep; const char* b2 = last ? nB : cB + (size_t)(t + 2) * kstep;
            const char* a3 = a2 + kstep; const char* b3 = b2 + kstep;
            if (last && has_next) S.a_ready(nxt);
            if constexpr (SP2) {
            PG8_LDB(B0, 0, 0); PG8_LDB(B1, 0, 1); PG8_SCHED; PG8_LDA(At, 0, 0); PG8_STAGE(PG8_SA(1, 1), a1 + hstep, voffA);
            PG8_WAIT_V(8); PG8_WAIT_L(0); PG8_BAR; PG8_MMA(0, 0, At, B0); PG8_MMA(0, 1, At, B1); PG8_BAR; PG8_SCHED;
            PG8_LDA(At, 0, 1); PG8_STAGE(PG8_SB(0, 0), b2, voffB); PG8_STAGE(PG8_SB(0, 1), b2 + hstep, voffB); PG8_STAGE(PG8_SA(0, 0), a2, voffA);
            PG8_WAIT_V(8); PG8_WAIT_L(0); PG8_BAR; PG8_MMA(1, 0, At, B0); PG8_MMA(1, 1, At, B1); PG8_BAR; PG8_SCHED;
            PG8_LDB(B0, 1, 0); PG8_LDB(B1, 1, 1); PG8_SCHED; PG8_LDA(At, 1, 0); PG8_STAGE(PG8_SA(0, 1), a2 + hstep, voffA);
            PG8_WAIT_V(8); PG8_WAIT_L(0); PG8_BAR; PG8_MMA(0, 0, At, B0); PG8_MMA(0, 1, At, B1); PG8_BAR; PG8_SCHED;
            PG8_LDA(At, 1, 1); PG8_STAGE(PG8_SB(1, 0), b3, voffB); PG8_STAGE(PG8_SB(1, 1), b3 + hstep, voffB); PG8_STAGE(PG8_SA(1, 0), a3, voffA);
            PG8_WAIT_V(8); PG8_WAIT_L(0); PG8_BAR; PG8_MMA(1, 0, At, B0); PG8_MMA(1, 1, At, B1); PG8_BAR; PG8_SCHED;
            } else {
            PG8_LDB(B0, 0, 0); PG8_SCHED; PG8_LDA(At, 0, 0); PG8_STAGE(PG8_SA(1, 1), a1 + hstep, voffA);
            PG8_WAIT_L(8); PG8_BAR; PG8_WAIT_L(0); PG8_MMA(0, 0, At, B0); PG8_BAR; PG8_SCHED;
            PG8_LDB(B1, 0, 1); PG8_STAGE(PG8_SB(0, 0), b2, voffB);
            PG8_BAR; PG8_WAIT_L(0); PG8_MMA(0, 1, At, B1); PG8_BAR;
            PG8_LDA(At, 0, 1); PG8_STAGE(PG8_SA(0, 0), a2, voffA);
            PG8_BAR; PG8_WAIT_L(0); PG8_MMA(1, 0, At, B0); PG8_BAR; PG8_SCHED;
            PG8_STAGE(PG8_SB(0, 1), b2 + hstep, voffB);
            PG8_WAIT_V(6); PG8_BAR; PG8_MMA(1, 1, At, B1); PG8_BAR;
            PG8_LDB(B0, 1, 0); PG8_SCHED; PG8_LDA(At, 1, 0); PG8_STAGE(PG8_SA(0, 1), a2 + hstep, voffA);
            PG8_WAIT_L(8); PG8_BAR; PG8_WAIT_L(0); PG8_MMA(0, 0, At, B0); PG8_BAR; PG8_SCHED;
            PG8_LDB(B1, 1, 1); PG8_STAGE(PG8_SB(1, 0), b3, voffB);
            PG8_BAR; PG8_WAIT_L(0); PG8_MMA(0, 1, At, B1); PG8_BAR;
            PG8_LDA(At, 1, 1); PG8_STAGE(PG8_SA(1, 0), a3, voffA);
            PG8_BAR; PG8_WAIT_L(0); PG8_MMA(1, 0, At, B0); PG8_BAR; PG8_SCHED;
            PG8_STAGE(PG8_SB(1, 1), b3 + hstep, voffB);
            PG8_WAIT_V(6); PG8_BAR; PG8_MMA(1, 1, At, B1); PG8_BAR;
            }
        }
        if constexpr (ALIGN_EPI) { if (wr == 0) PG8_BAR; }
        if constexpr (!Epi::AFTER_DRAIN) { E(acc, cur, wr, wc, fr, fq); S.done(cur); }
        if (!has_next) break;
#pragma unroll
        for (int a = 0; a < 2; ++a)
#pragma unroll
            for (int b = 0; b < 2; ++b)
#pragma unroll
                for (int m = 0; m < 4; ++m)
#pragma unroll
                    for (int n = 0; n < 2; ++n) acc[a][b][m][n] = (f32x4){0.f, 0.f, 0.f, 0.f};
        cur = nxt; cA = nA; cB = nB; ++ui;
        if constexpr (ALIGN_EPI) { if (wr == 1) PG8_BAR; }
    }
    PG8_WAIT_V(0);
    if constexpr (!ALIGN_EPI) { if (wr == 0) PG8_BAR; }
    PG8_BAR;
    if constexpr (Epi::AFTER_DRAIN) { E.fused(acc, cur, wr, wc, fr, fq, lds, wid, lane); S.done(cur); }
#undef PG8_SA
#undef PG8_SB
#undef PG8_STAGE
#undef PG8_LDA
#undef PG8_LDB
#undef PG8_MMA
#undef PG8_WAIT_V
#undef PG8_WAIT_L
#undef PG8_BAR
#undef PG8_SCHED
}
}

#ifndef MULTI_LAUNCH
#define MULTI_LAUNCH 0
#endif
#ifndef USE_TR
#define USE_TR 1
#endif
#ifndef TSEL
#define TSEL (-1)
#endif
#if TSEL >= 10
#define TS_MARK(k0) do { if (threadIdx.x == 0) { volatile LAS unsigned long long* TWs = (volatile LAS unsigned long long*)(lds + LDS_BARST + 16); const unsigned long long nowt = __builtin_amdgcn_s_memrealtime(); if ((TSEL) == (k0)) TWs[2] += nowt - TWs[3]; TWs[3] = nowt; } } while (0)
#else
#define TS_MARK(k0) do {} while (0)
#endif
#ifndef REP_ATTN
#define REP_ATTN 0
#endif
#ifndef REP_M1
#define REP_M1 0
#endif
#ifndef REPEAT_MASK
#define REPEAT_MASK 0
#endif
#define LAS __attribute__((address_space(3)))
#define DI __device__ __forceinline__
typedef unsigned short bf16;
typedef short bf16x8 __attribute__((ext_vector_type(8)));
typedef float f32x4 __attribute__((ext_vector_type(4)));
typedef unsigned u32x4 __attribute__((ext_vector_type(4)));
typedef unsigned u32x2 __attribute__((ext_vector_type(2)));

constexpr int SEQ = 8192, DM = 4096, INW = 16392, NU = 16384;
constexpr int C_QA = 0, C_KA = 2048, C_VA = 4096, C_ZA = 6144, C_QM = 8192, C_KM = 9216, C_VM = 10240, C_OM = 12288, C_ZM = 14336;
constexpr float NORM_EPS = 1e-6f;
constexpr int NTHR = 512, NWAVE = 8;
constexpr int LDS_BYTES = 147456;

constexpr size_t MiB = (size_t)1 << 20;
constexpr size_t WS_WIN = 0, WS_WOUT = 256 * MiB, WS_XN = 320 * MiB, WS_U = 384 * MiB, WS_OP = 640 * MiB, WS_Y = 736 * MiB, WS_X1 = 800 * MiB,
                 WS_DC = 928 * MiB, WS_CS = 992 * MiB, WS_LSE = 1024 * MiB, WS_GATES = 1026 * MiB, WS_DN = 1027 * MiB, WS_NS = 1028 * MiB, WS_BL = 1029 * MiB,
                 WS_CTL = 1030 * MiB, WS_QKC = 1032 * MiB, WS_WGT = 1064 * MiB, WS_END = 1065 * MiB;
constexpr int LDS_BARST = LDS_BYTES - 64;

struct Params { const float *x, *norm_g, *w_in, *b_gate, *conv_w, *mnorm_g, *w_out, *rel_bias, *final_g; float* out; unsigned char* ws; int ph_lo, ph_hi; };

DI int blk() { int b = blockIdx.x; asm volatile("" : "+s"(b)); return b; }
DI float bf_lo(unsigned u) { return __uint_as_float(u << 16); }
DI float bf_hi(unsigned u) { return __uint_as_float(u & 0xffff0000u); }
DI float bf2f(unsigned short u) { return __uint_as_float((unsigned)u << 16); }
DI unsigned pk2(float lo, float hi) { return pg8::cvt_pk_bf16(lo, hi); }
DI float wave_sum(float v) {
#pragma unroll
    for (int o = 1; o < 64; o <<= 1) v += __shfl_xor(v, o);
    return v;
}
DI float quad_sum(float v) { v += __shfl_xor(v, 16); v += __shfl_xor(v, 32); return v; }
DI float quad_max(float v) { v = fmaxf(v, __shfl_xor(v, 16)); v = fmaxf(v, __shfl_xor(v, 32)); return v; }
DI float silu_f(float x) { return x * __builtin_amdgcn_rcpf(1.f + __expf(-x)); }
DI float sigm_f(float x) { return __builtin_amdgcn_rcpf(1.f + __expf(-x)); }
DI bf16x8 gatherT(const LAS unsigned short* p, int stride) {
    bf16x8 r;
#pragma unroll
    for (int j = 0; j < 8; ++j) r[j] = (short)p[j * stride];
    return r;
}
typedef short s16x4 __attribute__((ext_vector_type(4)));
DI bf16x8 trfrag(const LAS unsigned short* blk, int stride, int ql) {
#if USE_TR
    const LAS unsigned short* a = blk + (ql >> 2) * stride + 4 * (ql & 3);
    const s16x4 lo = __builtin_amdgcn_ds_read_tr16_b64_v4i16((LAS s16x4*)a);
    const s16x4 hi = __builtin_amdgcn_ds_read_tr16_b64_v4i16((LAS s16x4*)(a + 4 * stride));
    return (bf16x8){lo[0], lo[1], lo[2], lo[3], hi[0], hi[1], hi[2], hi[3]};
#else
    return gatherT(blk + ql, stride);
#endif
}
DI f32x4 mfma16(bf16x8 a, bf16x8 b, f32x4 c) { return __builtin_amdgcn_mfma_f32_16x16x32_bf16(a, b, c, 0, 0, 0); }
#define LDS_WAIT() asm volatile("s_waitcnt lgkmcnt(0)" ::: "memory")

struct TrTile { const float* src; bf16* dst; };
DI TrTile tr_tile_addr(const Params& p, int it, int lane) {
    constexpr int T_IN = 64 * 256, T_OUT = 64 * 64;
    const float* W; bf16* WT; int ldw, nb, kb;
    int r = it;
    if (r < T_IN) { W = p.w_in; WT = (bf16*)(p.ws + WS_WIN); ldw = INW; kb = r >> 8; nb = r & 255; }
    else if ((r -= T_IN) < T_OUT) { W = p.w_out; WT = (bf16*)(p.ws + WS_WOUT); ldw = DM; kb = r >> 6; nb = r & 63; }
    else if ((r -= T_OUT) < T_IN) { W = p.w_in + (size_t)DM * INW; WT = (bf16*)(p.ws + WS_WIN + 128 * MiB); ldw = INW; kb = r >> 8; nb = r & 255; }
    else { r -= T_IN; W = p.w_out + (size_t)DM * DM; WT = (bf16*)(p.ws + WS_WOUT + 32 * MiB); ldw = DM; kb = r >> 6; nb = r & 63; }
    TrTile t;
    t.src = W + (size_t)(kb * 64 + 16 * (lane >> 4)) * ldw + nb * 64 + 4 * (lane & 15);
    t.dst = WT + (size_t)(nb * 64 + (lane >> 3)) * DM + kb * 64 + 8 * (lane & 7);
    return t;
}
DI int tr_ldw(int it) { constexpr int T_IN = 64 * 256, T_OUT = 64 * 64; const int r = it % (T_IN + T_OUT); return r < T_IN ? INW : DM; }
DI void tr_load(const float* src, int ldw, f32x4 (&v)[16]) {
#pragma unroll
    for (int i = 0; i < 16; ++i) v[i] = *(const f32x4*)(src + (size_t)i * ldw);
}
DI void tr_store(const f32x4 (&v)[16], bf16* dst, LAS unsigned short* T, int lane) {
    const int kr = lane >> 4, nc = 4 * (lane & 15);
#pragma unroll
    for (int e = 0; e < 4; ++e)
#pragma unroll
        for (int hf = 0; hf < 2; ++hf) { u32x4 w;
            w.x = pk2(v[8 * hf + 0][e], v[8 * hf + 1][e]); w.y = pk2(v[8 * hf + 2][e], v[8 * hf + 3][e]); w.z = pk2(v[8 * hf + 4][e], v[8 * hf + 5][e]); w.w = pk2(v[8 * hf + 6][e], v[8 * hf + 7][e]);
            *(LAS u32x4*)(T + (nc + e) * 72 + 16 * kr + 8 * hf) = w; }
    LDS_WAIT(); asm volatile("" ::: "memory");
#pragma unroll
    for (int j = 0; j < 8; ++j) { const u32x4 w = *(const LAS u32x4*)(T + ((lane >> 3) + 8 * j) * 72 + 8 * (lane & 7)); *(u32x4*)(dst + (size_t)(8 * j) * DM) = w; }
    LDS_WAIT(); asm volatile("" ::: "memory");
}
DI void prologue_transposes(const Params& p, LAS unsigned char* lds, int wave, int lane) {
    LAS unsigned short* T = (LAS unsigned short*)(lds + wave * 16384);
    const int gw = blk() * NWAVE + wave, ngw = gridDim.x * NWAVE;
    constexpr int NIT = 2 * (64 * 256 + 64 * 64);
    f32x4 va[16], vb[16];
    int it = gw;
    if (it >= NIT) return;
    TrTile ta = tr_tile_addr(p, it, lane), tb;
    tr_load(ta.src, tr_ldw(it), va);
    for (;;) {
        const int it1 = it + ngw; const bool h1 = it1 < NIT;
        if (h1) { tb = tr_tile_addr(p, it1, lane); tr_load(tb.src, tr_ldw(it1), vb); }
        tr_store(va, ta.dst, T, lane);
        if (!h1) break;
        const int it2 = it1 + ngw; const bool h2 = it2 < NIT;
        if (h2) { ta = tr_tile_addr(p, it2, lane); tr_load(ta.src, tr_ldw(it2), va); }
        tr_store(vb, tb.dst, T, lane);
        if (!h2) break;
        it = it2;
    }
}

DI void norm_phase(const Params& p, const float* X, int l, int wave, int lane) {
    const float* g = p.norm_g + l * DM;
    bf16* XN = (bf16*)(p.ws + WS_XN);
    for (int row = blk() * NWAVE + wave; row < SEQ; row += gridDim.x * NWAVE) {
        const f32x4* xr = (const f32x4*)(X + (size_t)row * DM) + lane;
        f32x4 v[16]; float ss = 0.f;
#pragma unroll
        for (int j = 0; j < 16; ++j) { v[j] = xr[64 * j]; ss += (v[j].x * v[j].x + v[j].y * v[j].y) + (v[j].z * v[j].z + v[j].w * v[j].w); }
        const float rstd = rsqrtf(wave_sum(ss) * (1.f / DM) + NORM_EPS);
        u32x2* o8 = (u32x2*)(XN + (size_t)row * DM) + lane;
#pragma unroll
        for (int j = 0; j < 16; ++j) { const f32x4 h = v[j] * rstd * ((const f32x4*)g)[lane + 64 * j]; u32x2 w; w.x = pk2(h.x, h.y); w.y = pk2(h.z, h.w); o8[64 * j] = w; }
    }
}
DI void build_wgt(const Params& p, int tid) {
    bf16* WgT = (bf16*)(p.ws + WS_WGT);
    for (int gid = blk() * NTHR + tid; gid < 2 * 16 * DM; gid += gridDim.x * NTHR) {
        if (gid < 2 * 8 * DM) { const int l = gid >> 15, k = (gid >> 3) & (DM - 1), j = gid & 7;
            WgT[((size_t)l * 16 + j) * DM + k] = (bf16)(pk2(p.w_in[(size_t)l * DM * INW + (size_t)k * INW + NU + j], 0.f) & 0xffffu); }
        else { const int r = gid - 2 * 8 * DM, l = r >> 15, j = 8 + ((r >> 12) & 7), k = r & (DM - 1); WgT[((size_t)l * 16 + j) * DM + k] = 0; }
    }
}
DI void gate_items(const Params& p, LAS unsigned char* lds, int l, int tid, int wave, int lane) {
    const bf16* XN = (const bf16*)(p.ws + WS_XN);
    const bf16* WgT = (const bf16*)(p.ws + WS_WGT) + (size_t)l * 16 * DM;
    float* gates = (float*)(p.ws + WS_GATES);
    LAS float* red = (LAS float*)lds;
    const int ql = lane & 15, quad = lane >> 4;
    for (int t = blk(); t < SEQ / 16; t += gridDim.x) {
        const bf16* a = WgT + (size_t)ql * DM + wave * 512 + quad * 8; const bf16* b = XN + (size_t)(t * 16 + ql) * DM + wave * 512 + quad * 8;
        f32x4 acc0 = {0.f, 0.f, 0.f, 0.f}, acc1 = {0.f, 0.f, 0.f, 0.f};
#pragma unroll
        for (int i = 0; i < 16; i += 2) { acc0 = mfma16(*(const bf16x8*)(a + i * 32), *(const bf16x8*)(b + i * 32), acc0); acc1 = mfma16(*(const bf16x8*)(a + i * 32 + 32), *(const bf16x8*)(b + i * 32 + 32), acc1); }
        const f32x4 r = acc0 + acc1;
        if (quad < 2) *(LAS f32x4*)(red + (wave * 16 + ql) * 8 + quad * 4) = r;
        __syncthreads();
        if (tid < 128) { float sum = p.b_gate[l * 8 + (tid & 7)];
#pragma unroll
            for (int w = 0; w < 8; ++w) sum += red[w * 128 + tid];
            gates[(size_t)t * 128 + tid] = sum; }
        __syncthreads();
    }
}
DI void final_norm_phase(const Params& p, LAS unsigned char* lds0, int wave, int lane) {
#if TSEL >= 0
    const int n2 = ((volatile LAS int*)(lds0 + LDS_BARST + 16))[8];
#endif
    for (int row = blk() * NWAVE + wave; row < SEQ; row += gridDim.x * NWAVE) {
        f32x4* xr = (f32x4*)(p.out + (size_t)row * DM) + lane;
        f32x4 v[16]; float ss = 0.f;
#pragma unroll
        for (int j = 0; j < 16; ++j) { v[j] = xr[64 * j]; ss += (v[j].x * v[j].x + v[j].y * v[j].y) + (v[j].z * v[j].z + v[j].w * v[j].w); }
        const float rstd = rsqrtf(wave_sum(ss) * (1.f / DM) + NORM_EPS);
#pragma unroll
        for (int j = 0; j < 16; ++j) { f32x4 o = v[j] * rstd * ((const f32x4*)p.final_g)[lane + 64 * j];
#if TSEL >= 0
            if (blk() == 0) { const int e0 = ((row >> 11) * 8 + (row & 7)) * 4096 + 4 * (lane + 64 * j);
                o.x += (e0 + 0 < n2) ? 0.02f : 0.f; o.y += (e0 + 1 < n2) ? 0.02f : 0.f; o.z += (e0 + 2 < n2) ? 0.02f : 0.f; o.w += (e0 + 3 < n2) ? 0.02f : 0.f; }
#endif
            xr[64 * j] = o; }
    }
}

constexpr int AT_KS = 136;
#define ATT_DECODE(item) const int pat = (item) >> 10, h = ((item) & 1023) >> 6, rb_ = (item) & 63, dsh = pat * 2, r = rb_ >> (6 - dsh), bq = rb_ & ((64 >> dsh) - 1), sub0 = 128 * bq - 128; (void)sub0; (void)r; (void)h;
DI void att_load_kv(const bf16* U, int item, int tid, int coff, u32x4 (&v)[8]) {
    ATT_DECODE(item)
#pragma unroll
    for (int i = 0; i < 8; ++i) { const int c = tid + NTHR * i, row = c >> 4, ch = c & 15; int sub = sub0 + row; sub = sub < 0 ? 0 : sub;
        v[i] = *(const u32x4*)(U + (size_t)((sub << dsh) + r) * NU + coff + h * 128 + ch * 8); }
}
DI void att_store(LAS unsigned short* dst, int tid, const u32x4 (&v)[8]) {
#pragma unroll
    for (int i = 0; i < 8; ++i) { const int c = tid + NTHR * i, row = c >> 4, ch = c & 15; *(LAS u32x4*)(dst + row * AT_KS + ch * 8) = v[i]; }
}
DI void att_load_q(const bf16* U, int item, int wave, int lane, bf16x8 (&qf)[4]) {
    ATT_DECODE(item)
    const int tq = ((128 * bq + wave * 16 + (lane & 15)) << dsh) + r;
#pragma unroll
    for (int ks = 0; ks < 4; ++ks) qf[ks] = *(const bf16x8*)(U + (size_t)tq * NU + C_QA + h * 128 + ks * 32 + (lane >> 4) * 8);
}
DI void att_bias(const Params& p, int item, int tid, LAS float* biasS) {
    ATT_DECODE(item)
    if (tid < 129) { const int n = tid << dsh; int b = n;
        if (n >= 16) { b = 16 + (int)floorf(log2f((float)n * 0.0625f) * (16.f / 7.f)); b = b > 31 ? 31 : b; }
        biasS[tid] = p.rel_bias[b * 16 + h]; }
}
DI int att_item_of(int rnd, bool xmap, int xcd, int xi) {
    if (!xmap) return blk() + rnd * gridDim.x;
    const int h = 2 * xcd + rnd / 6, j = (rnd % 6) * 32 + xi; return (j >> 6) * 1024 + h * 64 + (j & 63);
}
DI void attn_phase(const Params& p, LAS unsigned char* lds, int tid, int wave, int lane) {
    const bf16* U = (const bf16*)(p.ws + WS_U);
    LAS unsigned short* Ks = (LAS unsigned short*)lds;
    LAS unsigned short* Vs = Ks + 256 * AT_KS;
    LAS float* biasS = (LAS float*)(Vs + 256 * AT_KS);
    const int G = gridDim.x; const bool xmap = (G == 256); const int xcd = blk() & 7, xi = blk() >> 3;
    const int nrnd = (blk() < 3072) ? (3072 - blk() + G - 1) / G : 0;
    if (nrnd <= 0) return;
    const int ql = lane & 15, quad = lane >> 4, q0 = wave * 16;
    bf16x8 qf[4];
    { const int item0 = att_item_of(0, xmap, xcd, xi); u32x4 kv[8], vv[8];
      att_load_kv(U, item0, tid, C_KA, kv); att_load_kv(U, item0, tid, C_VA, vv); att_load_q(U, item0, wave, lane, qf); att_bias(p, item0, tid, biasS);
      att_store(Ks, tid, kv); att_store(Vs, tid, vv); }
    __syncthreads();
    for (int rnd = 0; rnd < nrnd; ++rnd) {
        const int item = att_item_of(rnd, xmap, xcd, xi), next = rnd + 1 < nrnd ? att_item_of(rnd + 1, xmap, xcd, xi) : -1;
        ATT_DECODE(item)
        const int tq = ((128 * bq + q0 + ql) << dsh) + r;
        f32x4 sacc[10];
#pragma unroll
        for (int t = 0; t < 10; ++t) sacc[t] = (f32x4){0.f, 0.f, 0.f, 0.f};
#pragma unroll
        for (int s = 0; s < 5; ++s)
#pragma unroll
            for (int u = 0; u < 2; ++u) { int kk = q0 + 32 * s + (ql >> 2) * 8 + u * 4 + (ql & 3); kk = kk > 255 ? 255 : kk;
                const LAS unsigned short* kp = Ks + kk * AT_KS + quad * 8;
#pragma unroll
                for (int ks = 0; ks < 4; ++ks) sacc[2 * s + u] = mfma16(*(const LAS bf16x8*)(kp + ks * 32), qf[ks], sacc[2 * s + u]); }
        __syncthreads();
        u32x4 kv[8], vv[8]; bf16x8 qn[4];
        if (next >= 0) { att_load_kv(U, next, tid, C_KA, kv); att_load_q(U, next, wave, lane, qn); }
        const float scale = 0.08838834764831845f;
        float mx = -1e30f;
        int ql2 = ql, quad2 = quad; asm volatile("" : "+v"(ql2), "+v"(quad2));
#pragma unroll
        for (int s = 0; s < 5; ++s)
#pragma unroll
            for (int u = 0; u < 2; ++u)
#pragma unroll
                for (int j = 0; j < 4; ++j) { const int koff = 32 * s + quad2 * 8 + u * 4 + j, rel = koff - ql2;
                    const bool valid = (rel >= 0) && (rel <= 128) && (sub0 + q0 + koff >= 0);
                    int jo = 128 - rel; jo = jo < 0 ? 0 : (jo > 128 ? 128 : jo);
                    const float v = valid ? sacc[2 * s + u][j] * scale + biasS[jo] : -1e30f;
                    sacc[2 * s + u][j] = v; mx = fmaxf(mx, v); }
        mx = quad_max(mx);
        float l = 0.f;
#pragma unroll
        for (int t = 0; t < 10; ++t)
#pragma unroll
            for (int j = 0; j < 4; ++j) { const float e = __expf(sacc[t][j] - mx); sacc[t][j] = e; l += e; }
        l = quad_sum(l);
        if (next >= 0) att_load_kv(U, next, tid, C_VA, vv);
        f32x4 oacc[8];
#pragma unroll
        for (int nt = 0; nt < 8; ++nt) oacc[nt] = (f32x4){0.f, 0.f, 0.f, 0.f};
#pragma unroll
        for (int s = 0; s < 5; ++s) {
            u32x4 pw; pw.x = pk2(sacc[2 * s][0], sacc[2 * s][1]); pw.y = pk2(sacc[2 * s][2], sacc[2 * s][3]); pw.z = pk2(sacc[2 * s + 1][0], sacc[2 * s + 1][1]); pw.w = pk2(sacc[2 * s + 1][2], sacc[2 * s + 1][3]);
            const bf16x8 pf = __builtin_bit_cast(bf16x8, pw);
            int key0 = q0 + 32 * s + quad * 8; key0 = key0 > 248 ? 248 : key0;
            const LAS unsigned short* vp = Vs + key0 * AT_KS;
#pragma unroll
            for (int nt = 0; nt < 8; ++nt) oacc[nt] = mfma16(trfrag(vp + nt * 16, AT_KS, ql), pf, oacc[nt]);
        }
        const float inv = 1.f / l;
        bf16* OP = (bf16*)(p.ws + WS_OP) + (size_t)pat * SEQ * 2048 + (size_t)tq * 2048 + h * 128 + quad * 4;
#pragma unroll
        for (int nt = 0; nt < 8; ++nt) { u32x2 w; w.x = pk2(oacc[nt][0] * inv, oacc[nt][1] * inv); w.y = pk2(oacc[nt][2] * inv, oacc[nt][3] * inv); *(u32x2*)(OP + nt * 16) = w; }
        if (quad == 0) ((float*)(p.ws + WS_LSE))[((size_t)pat * SEQ + tq) * 16 + h] = mx + __logf(l);
        if (next >= 0) att_store(Ks, tid, kv);
        __syncthreads();
        if (next >= 0) { att_store(Vs, tid, vv); att_bias(p, next, tid, biasS);
#pragma unroll
            for (int ks = 0; ks < 4; ++ks) qf[ks] = qn[ks]; }
        __syncthreads();
    }
}
DI void merge_phase(const Params& p, int tid) {
    const bf16* U = (const bf16*)(p.ws + WS_U);
    const bf16* OP = (const bf16*)(p.ws + WS_OP);
    const float* LSE = (const float*)(p.ws + WS_LSE);
    bf16* Y = (bf16*)(p.ws + WS_Y);
    const int gthreads = gridDim.x * NTHR;
    for (int idx0 = blk() * NTHR + tid; idx0 < SEQ * 256; idx0 += 4 * gthreads) {
        float l0[4], l1[4], l2[4]; u32x4 o0[4], o1[4], o2[4], z[4];
#pragma unroll
        for (int u = 0; u < 4; ++u) { int idx = idx0 + u * gthreads; idx = idx < SEQ * 256 ? idx : SEQ * 256 - 1;
            const int t = idx >> 8, c8 = idx & 255, h = c8 >> 4;
            l0[u] = LSE[(size_t)t * 16 + h]; l1[u] = LSE[((size_t)SEQ + t) * 16 + h]; l2[u] = LSE[((size_t)2 * SEQ + t) * 16 + h];
            const size_t o = (size_t)t * 2048 + c8 * 8;
            o0[u] = *(const u32x4*)(OP + o); o1[u] = *(const u32x4*)(OP + (size_t)SEQ * 2048 + o); o2[u] = *(const u32x4*)(OP + (size_t)2 * SEQ * 2048 + o);
            z[u] = *(const u32x4*)(U + (size_t)t * NU + C_ZA + c8 * 8); }
#pragma unroll
        for (int u = 0; u < 4; ++u) { const int idx = idx0 + u * gthreads;
            if (idx < SEQ * 256) { const int t = idx >> 8, c8 = idx & 255;
                const float M = fmaxf(l0[u], fmaxf(l1[u], l2[u]));
                float w0 = __expf(l0[u] - M), w1 = __expf(l1[u] - M), w2 = __expf(l2[u] - M);
                const float inv = 1.f / (w0 + w1 + w2); w0 *= inv; w1 *= inv; w2 *= inv;
                u32x4 y;
#pragma unroll
                for (int e = 0; e < 4; ++e) {
                    const float lo = (w0 * bf_lo(o0[u][e]) + w1 * bf_lo(o1[u][e]) + w2 * bf_lo(o2[u][e])) * silu_f(bf_lo(z[u][e]));
                    const float hi = (w0 * bf_hi(o0[u][e]) + w1 * bf_hi(o1[u][e]) + w2 * bf_hi(o2[u][e])) * silu_f(bf_hi(z[u][e]));
                    y[e] = pk2(lo, hi); }
                *(u32x4*)(Y + (size_t)t * DM + c8 * 8) = y; } }
    }
}

constexpr int M_KS = 264, M_VS3 = 520;
DI void conv8(const bf16* U, const float* cw, int t, int rawcol, int cch, float (&f)[8]) {
#pragma unroll
    for (int e = 0; e < 8; ++e) f[e] = 0.f;
#pragma unroll
    for (int j = 0; j < 4; ++j) { const int tt = t - 3 + j;
        if (tt >= 0) { const u32x4 raw = *(const u32x4*)(U + (size_t)tt * NU + rawcol);
            const f32x4 w0 = *(const f32x4*)(cw + j * 2048 + cch), w1 = *(const f32x4*)(cw + j * 2048 + cch + 4);
            f[0] += w0[0] * bf_lo(raw.x); f[1] += w0[1] * bf_hi(raw.x); f[2] += w0[2] * bf_lo(raw.y); f[3] += w0[3] * bf_hi(raw.y);
            f[4] += w1[0] * bf_lo(raw.z); f[5] += w1[1] * bf_hi(raw.z); f[6] += w1[2] * bf_lo(raw.w); f[7] += w1[3] * bf_hi(raw.w); } }
#pragma unroll
    for (int e = 0; e < 8; ++e) f[e] = silu_f(f[e]);
}
template <int NI, int MODE, int NB>
DI void conv_tile(const bf16* U, const float* cw, int t0, int rawcol0, int cch0, float sc, LAS unsigned short* dst, int tid, float bL, const LAS float* bS, const LAS float* liS, int roff) {
    const int ch = tid & 31, r0 = tid >> 5;
    f32x4 w[4][2];
#pragma unroll
    for (int j = 0; j < 4; ++j) { w[j][0] = *(const f32x4*)(cw + j * 2048 + cch0 + ch * 8); w[j][1] = *(const f32x4*)(cw + j * 2048 + cch0 + ch * 8 + 4); }
    const bf16* src = U + rawcol0 + ch * 8;
#pragma unroll
    for (int ib = 0; ib < NI; ib += NB) {
        u32x4 raw[NB][4];
#pragma unroll
        for (int i = 0; i < NB; ++i)
#pragma unroll
            for (int j = 0; j < 4; ++j) { const int tt = t0 + r0 + 16 * (ib + i) - 3 + j; const int tc = tt < 0 ? 0 : tt;
                raw[i][j] = *(const u32x4*)(src + (size_t)tc * NU); if (tt < 0) raw[i][j] = (u32x4){0u, 0u, 0u, 0u}; }
#pragma unroll
        for (int i = 0; i < NB; ++i) { const int row = r0 + 16 * (ib + i);
            float f[8];
#pragma unroll
            for (int e = 0; e < 8; ++e) f[e] = 0.f;
#pragma unroll
            for (int j = 0; j < 4; ++j) { const u32x4 rw = raw[i][j];
                f[0] += w[j][0][0] * bf_lo(rw.x); f[1] += w[j][0][1] * bf_hi(rw.x); f[2] += w[j][0][2] * bf_lo(rw.y); f[3] += w[j][0][3] * bf_hi(rw.y);
                f[4] += w[j][1][0] * bf_lo(rw.z); f[5] += w[j][1][1] * bf_hi(rw.z); f[6] += w[j][1][2] * bf_lo(rw.w); f[7] += w[j][1][3] * bf_hi(rw.w); }
            float m = sc;
            if (MODE == 1) m *= __expf(bL - bS[roff + row] + liS[roff + row]);
#pragma unroll
            for (int e = 0; e < 8; ++e) f[e] = silu_f(f[e]) * m;
            u32x4 o; o.x = pk2(f[0], f[1]); o.y = pk2(f[2], f[3]); o.z = pk2(f[4], f[5]); o.w = pk2(f[6], f[7]);
            *(LAS u32x4*)(dst + row * M_KS + ch * 8) = o; }
        __builtin_amdgcn_sched_barrier(0);
    }
}
DI void conv_prepass(const Params& p, int l, int tid) {
    const bf16* U = (const bf16*)(p.ws + WS_U);
    const float* cw = p.conv_w + (size_t)l * 4 * 2048;
    bf16* QKC = (bf16*)(p.ws + WS_QKC);
    for (int gid = blk() * NTHR + tid; gid < 256 * 512; gid += gridDim.x * NTHR) {
        const int cidx = gid & 255, t0 = (gid >> 8) * 16;
        f32x4 w[4][2];
#pragma unroll
        for (int j = 0; j < 4; ++j) { w[j][0] = *(const f32x4*)(cw + j * 2048 + cidx * 8); w[j][1] = *(const f32x4*)(cw + j * 2048 + cidx * 8 + 4); }
        const bf16* src = U + C_QM + cidx * 8;
        u32x4 raw[19];
#pragma unroll
        for (int i = 0; i < 19; ++i) { const int tt = t0 - 3 + i; const int tc = tt < 0 ? 0 : tt; raw[i] = *(const u32x4*)(src + (size_t)tc * NU); if (tt < 0) raw[i] = (u32x4){0u, 0u, 0u, 0u}; }
        const float sc = cidx >= 128 ? 0.0625f : 1.f;
#pragma unroll
        for (int i = 0; i < 16; ++i) {
            float f[8];
#pragma unroll
            for (int e = 0; e < 8; ++e) f[e] = 0.f;
#pragma unroll
            for (int j = 0; j < 4; ++j) { const u32x4 rw = raw[i + j];
                f[0] += w[j][0][0] * bf_lo(rw.x); f[1] += w[j][0][1] * bf_hi(rw.x); f[2] += w[j][0][2] * bf_lo(rw.y); f[3] += w[j][0][3] * bf_hi(rw.y);
                f[4] += w[j][1][0] * bf_lo(rw.z); f[5] += w[j][1][1] * bf_hi(rw.z); f[6] += w[j][1][2] * bf_lo(rw.w); f[7] += w[j][1][3] * bf_hi(rw.w); }
#pragma unroll
            for (int e = 0; e < 8; ++e) f[e] = silu_f(f[e]) * sc;
            u32x4 o; o.x = pk2(f[0], f[1]); o.y = pk2(f[2], f[3]); o.z = pk2(f[4], f[5]); o.w = pk2(f[6], f[7]);
            *(u32x4*)(QKC + (size_t)(t0 + i) * 2048 + cidx * 8) = o; }
    }
}
DI void chunk_gates(const float* gates, int c, int hh, LAS float* bS, LAS float* liS, LAS float* wtot, int tid, int wave, int lane) {
    float v = 0.f;
    if (tid < 256) { const float* gp = gates + (size_t)(c * 256 + tid) * 8; const float fgv = gp[4 + hh]; liS[tid] = gp[hh];
        v = fminf(fgv, 0.f) - log1pf(__expf(-fabsf(fgv)));
#pragma unroll
        for (int o = 1; o < 64; o <<= 1) { const float t = __shfl_up(v, o); if (lane >= o) v += t; }
        if (lane == 63) wtot[wave] = v; }
    __syncthreads();
    if (tid < 256) { float pre = 0.f; for (int w = 0; w < wave; ++w) pre += wtot[w]; bS[tid] = v + pre; }
    __syncthreads();
}
DI void m1_item(const Params& p, LAS unsigned char* lds, int l, int item, int tid, int wave, int lane) {
    asm volatile("" : "+v"(tid));
    const bf16* U = (const bf16*)(p.ws + WS_U);
    const bf16* QKC = (const bf16*)(p.ws + WS_QKC);
    LAS unsigned short* Kp = (LAS unsigned short*)lds;
    LAS unsigned short* Vs = Kp + 128 * M_KS;
    LAS float* bS = (LAS float*)(Vs + 128 * AT_KS); LAS float* liS = bS + 256; LAS float* wtot = liS + 256;
    const int hh = item >> 7, c = (item >> 2) & 31, sl = item & 3;
    const int ql = lane & 15, quad = lane >> 4;
    chunk_gates((const float*)(p.ws + WS_GATES), c, hh, bS, liS, wtot, tid, wave, lane);
    const float bL = bS[255];
    f32x4 acc[4][4];
#pragma unroll
    for (int a = 0; a < 4; ++a)
#pragma unroll
        for (int b = 0; b < 4; ++b) acc[a][b] = (f32x4){0.f, 0.f, 0.f, 0.f};
    f32x4 nacc[4];
#pragma unroll
    for (int b = 0; b < 4; ++b) nacc[b] = (f32x4){0.f, 0.f, 0.f, 0.f};
    const bool do_n = (sl == 0) && ((wave & 1) == 0);
    const bf16x8 ones = {0x3F80, 0x3F80, 0x3F80, 0x3F80, 0x3F80, 0x3F80, 0x3F80, 0x3F80};
    const int dvt0 = (wave & 1) * 4, dkt0 = (wave >> 1) * 4;
    for (int half = 0; half < 2; ++half) {
#pragma unroll
        for (int ib = 0; ib < 8; ib += 4) { u32x4 kr[4];
#pragma unroll
            for (int i = 0; i < 4; ++i) { const int cc = tid + NTHR * (ib + i), row = cc >> 5, ch = cc & 31; kr[i] = *(const u32x4*)(QKC + (size_t)(c * 256 + half * 128 + row) * 2048 + 1024 + hh * 256 + ch * 8); }
#pragma unroll
            for (int i = 0; i < 4; ++i) { const int cc = tid + NTHR * (ib + i), row = cc >> 5, ch = cc & 31, sloc = half * 128 + row;
                const float wgt = __expf(bL - bS[sloc] + liS[sloc]);
                u32x4 w; w.x = pk2(bf_lo(kr[i].x) * wgt, bf_hi(kr[i].x) * wgt); w.y = pk2(bf_lo(kr[i].y) * wgt, bf_hi(kr[i].y) * wgt); w.z = pk2(bf_lo(kr[i].z) * wgt, bf_hi(kr[i].z) * wgt); w.w = pk2(bf_lo(kr[i].w) * wgt, bf_hi(kr[i].w) * wgt);
                *(LAS u32x4*)(Kp + row * M_KS + ch * 8) = w; } }
#pragma unroll
        for (int i = 0; i < 4; ++i) { const int cc = tid + NTHR * i, row = cc >> 4, ch = cc & 15;
            *(LAS u32x4*)(Vs + row * AT_KS + ch * 8) = *(const u32x4*)(U + (size_t)(c * 256 + half * 128 + row) * NU + C_VM + hh * 512 + sl * 128 + ch * 8); }
        __syncthreads();
#pragma unroll 1
        for (int ks = 0; ks < 4; ++ks) {
            bf16x8 af[4], bfr[4];
#pragma unroll
            for (int a = 0; a < 4; ++a) af[a] = trfrag(Vs + (ks * 32 + quad * 8) * AT_KS + (dvt0 + a) * 16, AT_KS, ql);
#pragma unroll
            for (int b = 0; b < 4; ++b) bfr[b] = trfrag(Kp + (ks * 32 + quad * 8) * M_KS + (dkt0 + b) * 16, M_KS, ql);
#pragma unroll
            for (int a = 0; a < 4; ++a)
#pragma unroll
                for (int b = 0; b < 4; ++b) acc[a][b] = mfma16(af[a], bfr[b], acc[a][b]);
            if (do_n) {
#pragma unroll
                for (int b = 0; b < 4; ++b) nacc[b] = mfma16(ones, bfr[b], nacc[b]); }
        }
        __syncthreads();
    }
    float* DC = (float*)(p.ws + WS_DC) + ((size_t)(hh * 32 + c) * 512 + sl * 128) * 256;
#pragma unroll
    for (int a = 0; a < 4; ++a)
#pragma unroll
        for (int b = 0; b < 4; ++b)
#pragma unroll
            for (int j = 0; j < 4; ++j) DC[(size_t)((dvt0 + a) * 16 + quad * 4 + j) * 256 + (dkt0 + b) * 16 + ql] = acc[a][b][j];
    if (do_n && quad == 0) {
#pragma unroll
        for (int b = 0; b < 4; ++b) ((float*)(p.ws + WS_DN))[(hh * 32 + c) * 256 + (dkt0 + b) * 16 + ql] = nacc[b][0]; }
    if (sl == 0 && tid == 0) ((float*)(p.ws + WS_BL))[hh * 32 + c] = bL;
}
DI void m2_phase(const Params& p, int tid) {
    const float* DC = (const float*)(p.ws + WS_DC); const float* BL = (const float*)(p.ws + WS_BL);
    bf16* CS = (bf16*)(p.ws + WS_CS);
    const int gthreads = gridDim.x * NTHR, gid = blk() * NTHR + tid;
    for (int e4 = gid; e4 < 4 * 32768; e4 += gthreads) {
        const int hh = e4 >> 15, e = e4 & 32767;
        f32x4 st = {0.f, 0.f, 0.f, 0.f};
#pragma unroll 8
        for (int c = 0; c < 32; ++c) {
            const size_t o = ((size_t)(hh * 32 + c) * 32768 + e) * 4;
            u32x2 w; w.x = pk2(st.x, st.y); w.y = pk2(st.z, st.w); *(u32x2*)(CS + o) = w;
            const f32x4 d = *(const f32x4*)(DC + o);
            st = st * __expf(BL[hh * 32 + c]) + d;
        }
    }
    if (gid < 1024) { const int hh = gid >> 8, dk = gid & 255; const float* DN = (const float*)(p.ws + WS_DN); float* NS = (float*)(p.ws + WS_NS);
        float dn[32], eb[32];
#pragma unroll
        for (int c = 0; c < 32; ++c) { dn[c] = DN[(hh * 32 + c) * 256 + dk]; eb[c] = BL[hh * 32 + c]; }
        float st = 0.f;
#pragma unroll
        for (int c = 0; c < 32; ++c) { NS[(hh * 32 + c) * 256 + dk] = st; st = st * __expf(eb[c]) + dn[c]; } }
}
DI void m3_stage_load(const Params& p, int hh, int c, int st, int tid, u32x4 (&pre)[8]) {
    if (st < 4) { const bf16* CT = (const bf16*)(p.ws + WS_CS) + (size_t)(hh * 32 + c) * 512 * 256;
#pragma unroll
        for (int i = 0; i < 8; ++i) { const int cc = tid + NTHR * i, row = cc >> 5, ch = cc & 31;
            pre[i] = *(const u32x4*)(CT + (size_t)((row >> 6) * 256 + st * 64 + (row & 63)) * 256 + ch * 8); }
    } else { const int kt = (st - 4) >> 1, hb = (st - 4) & 1; const bf16* U = (const bf16*)(p.ws + WS_U); const bf16* QKC = (const bf16*)(p.ws + WS_QKC);
        if (hb == 0) {
#pragma unroll
            for (int i = 0; i < 4; ++i) { const int cc = tid + NTHR * i, row = cc >> 5, ch = cc & 31; pre[i] = *(const u32x4*)(QKC + (size_t)(c * 256 + kt * 64 + row) * 2048 + 1024 + hh * 256 + ch * 8); } }
#pragma unroll
        for (int i = 0; i < 4; ++i) { const int cc = tid + NTHR * i, row = 32 * hb + (cc >> 6), ch = cc & 63; pre[4 + i] = *(const u32x4*)(U + (size_t)(c * 256 + kt * 64 + row) * NU + C_VM + hh * 512 + ch * 8); }
    }
}
DI void m3_stage_store(int st, int tid, const u32x4 (&pre)[8], LAS unsigned short* Ks, LAS unsigned short* Vs) {
    if (st < 4) {
#pragma unroll
        for (int i = 0; i < 8; ++i) { const int cc = tid + NTHR * i, row = cc >> 5, ch = cc & 31; *(LAS u32x4*)(Ks + row * M_KS + ch * 8) = pre[i]; }
    } else { const int hb = (st - 4) & 1;
        if (hb == 0) {
#pragma unroll
            for (int i = 0; i < 4; ++i) { const int cc = tid + NTHR * i, row = cc >> 5, ch = cc & 31; *(LAS u32x4*)(Ks + row * M_KS + ch * 8) = pre[i]; } }
#pragma unroll
        for (int i = 0; i < 4; ++i) { const int cc = tid + NTHR * i, row = 32 * hb + (cc >> 6), ch = cc & 63; *(LAS u32x4*)(Vs + row * M_VS3 + ch * 8) = pre[4 + i]; }
    }
}
DI void m3_item(const Params& p, LAS unsigned char* lds, int l, int hh, int qb, int tid, int wave, int lane) {
    asm volatile("" : "+v"(tid));
    const bf16* U = (const bf16*)(p.ws + WS_U);
    const bf16* QKC = (const bf16*)(p.ws + WS_QKC);
    LAS unsigned short* Qs = (LAS unsigned short*)lds;
    LAS unsigned short* Ks = Qs + 64 * M_KS;
    LAS unsigned short* Vs = Ks + 64 * M_KS;
    LAS float* bS = (LAS float*)(Vs + 64 * M_VS3); LAS float* liS = bS + 256; LAS float* nS = liS + 256; LAS float* wtot = nS + 256; LAS float* ssS = wtot + 8;
    const int c = qb >> 2, jq = qb & 3;
    const int ql = lane & 15, quad = lane >> 4;
    TS_MARK(99);
    u32x4 pre[8];
    u32x4 qv[4];
#pragma unroll
    for (int i = 0; i < 4; ++i) { const int cc = tid + NTHR * i, row = cc >> 5, ch = cc & 31; qv[i] = *(const u32x4*)(QKC + (size_t)(qb * 64 + row) * 2048 + hh * 256 + ch * 8); }
    m3_stage_load(p, hh, c, 0, tid, pre);
    if (tid < 256) nS[tid] = ((const float*)(p.ws + WS_NS))[(hh * 32 + c) * 256 + tid];
    chunk_gates((const float*)(p.ws + WS_GATES), c, hh, bS, liS, wtot, tid, wave, lane);
#pragma unroll
    for (int i = 0; i < 4; ++i) { const int cc = tid + NTHR * i, row = cc >> 5, ch = cc & 31; *(LAS u32x4*)(Qs + row * M_KS + ch * 8) = qv[i]; }
    __syncthreads();
    const int qg = wave & 3, dvh = wave >> 2, q = qg * 16 + ql, iq = jq * 64 + q;
    const LAS unsigned short* qrow = Qs + q * M_KS + quad * 8;
    const float b_ref = bS[jq * 64], e_ref = __expf(b_ref), ebq = __expf(bS[iq] - b_ref);
    f32x4 acc[16];
#pragma unroll
    for (int nt = 0; nt < 16; ++nt) acc[nt] = (f32x4){0.f, 0.f, 0.f, 0.f};
    float nq;
    { float nqp = 0.f;
#pragma unroll
      for (int ks = 0; ks < 8; ++ks) { const bf16x8 qk = *(const LAS bf16x8*)(qrow + ks * 32);
#pragma unroll
          for (int j = 0; j < 8; ++j) nqp += bf2f((unsigned short)qk[j]) * nS[ks * 32 + quad * 8 + j]; }
      nq = quad_sum(nqp) * e_ref; }
    float nqi = 0.f;
    TS_MARK(10);
    const int nst = 4 + 2 * (jq + 1);
    bf16x8 pf1 = {0, 0, 0, 0, 0, 0, 0, 0};
#pragma unroll 1
    for (int st = 0; st < nst; ++st) {
        __syncthreads();
        int tid2 = tid; asm volatile("" : "+v"(tid2));
        m3_stage_store(st, tid2, pre, Ks, Vs);
        __syncthreads();
        if (st + 1 < nst) m3_stage_load(p, hh, c, st + 1, tid2, pre);
        if (st < 4) {
            bf16x8 qf[8];
#pragma unroll
            for (int ks = 0; ks < 8; ++ks) qf[ks] = *(const LAS bf16x8*)(qrow + ks * 32);
#pragma unroll
            for (int n4 = 0; n4 < 4; ++n4) { const LAS unsigned short* cp = Ks + (dvh * 64 + n4 * 16 + ql) * M_KS + quad * 8;
#pragma unroll
                for (int ks = 0; ks < 8; ++ks) acc[n4] = mfma16(*(const LAS bf16x8*)(cp + ks * 32), qf[ks], acc[n4]);
                __builtin_amdgcn_sched_barrier(0); }
            { const f32x4 t0 = acc[0], t1 = acc[1], t2 = acc[2], t3 = acc[3];
#pragma unroll
              for (int i = 0; i < 12; ++i) acc[i] = acc[i + 4];
              acc[12] = t0; acc[13] = t1; acc[14] = t2; acc[15] = t3; }
            if (st == 3) {
#pragma unroll
                for (int nt = 0; nt < 16; ++nt) acc[nt] = acc[nt] * e_ref;
                TS_MARK(11); }
        } else {
            const int kt = (st - 4) >> 1, hb = (st - 4) & 1;
            bf16x8 pf;
            if (hb == 0) {
                bf16x8 qf[8];
#pragma unroll
                for (int ks = 0; ks < 8; ++ks) qf[ks] = *(const LAS bf16x8*)(qrow + ks * 32);
                f32x4 sacc[4];
#pragma unroll
                for (int t = 0; t < 4; ++t) sacc[t] = (f32x4){0.f, 0.f, 0.f, 0.f};
#pragma unroll
                for (int s2 = 0; s2 < 2; ++s2)
#pragma unroll
                    for (int u = 0; u < 2; ++u) { const int krow = 32 * s2 + (ql >> 2) * 8 + u * 4 + (ql & 3);
                        const LAS unsigned short* kp = Ks + krow * M_KS + quad * 8;
#pragma unroll
                        for (int ks = 0; ks < 8; ++ks) sacc[2 * s2 + u] = mfma16(*(const LAS bf16x8*)(kp + ks * 32), qf[ks], sacc[2 * s2 + u]); }
#pragma unroll
                for (int s2 = 0; s2 < 2; ++s2)
#pragma unroll
                    for (int u = 0; u < 2; ++u)
#pragma unroll
                        for (int j = 0; j < 4; ++j) { const int sk = kt * 64 + 32 * s2 + quad * 8 + u * 4 + j;
                            const float w = (sk <= iq) ? __expf(b_ref - bS[sk] + liS[sk]) : 0.f;
                            const float pv = sacc[2 * s2 + u][j] * w; sacc[2 * s2 + u][j] = pv; nqi += pv; }
                u32x4 pw; pw.x = pk2(sacc[0][0], sacc[0][1]); pw.y = pk2(sacc[0][2], sacc[0][3]); pw.z = pk2(sacc[1][0], sacc[1][1]); pw.w = pk2(sacc[1][2], sacc[1][3]);
                pf = __builtin_bit_cast(bf16x8, pw);
                u32x4 pw1; pw1.x = pk2(sacc[2][0], sacc[2][1]); pw1.y = pk2(sacc[2][2], sacc[2][3]); pw1.z = pk2(sacc[3][0], sacc[3][1]); pw1.w = pk2(sacc[3][2], sacc[3][3]);
                pf1 = __builtin_bit_cast(bf16x8, pw1);
            } else pf = pf1;
            const LAS unsigned short* vp = Vs + (32 * hb + quad * 8) * M_VS3 + dvh * 256;
#pragma unroll
            for (int nt = 0; nt < 16; ++nt) { acc[nt] = mfma16(trfrag(vp + nt * 16, M_VS3, ql), pf, acc[nt]); if ((nt & 3) == 3) __builtin_amdgcn_sched_barrier(0); }
        }
    }
    TS_MARK(12);
    nq = (nq + quad_sum(nqi)) * ebq;
#pragma unroll
    for (int nt = 0; nt < 16; ++nt) acc[nt] = acc[nt] * ebq;
    const float inv = 1.f / fmaxf(fabsf(nq), 1.f);
    float ss = 0.f;
#pragma unroll
    for (int nt = 0; nt < 16; ++nt) { acc[nt] = acc[nt] * inv; ss += (acc[nt][0] * acc[nt][0] + acc[nt][1] * acc[nt][1]) + (acc[nt][2] * acc[nt][2] + acc[nt][3] * acc[nt][3]); }
    ss = quad_sum(ss);
    if (quad == 0) ssS[dvh * 64 + q] = ss;
    __syncthreads();
    const float rstd = rsqrtf((ssS[q] + ssS[64 + q]) * (1.f / 512.f) + NORM_EPS);
    LAS unsigned short* Hs = Vs;
#pragma unroll
    for (int nt = 0; nt < 16; ++nt) { u32x2 w; w.x = pk2(acc[nt][0] * rstd, acc[nt][1] * rstd); w.y = pk2(acc[nt][2] * rstd, acc[nt][3] * rstd);
        *(LAS u32x2*)(Hs + q * M_VS3 + dvh * 256 + nt * 16 + quad * 4) = w; }
    __syncthreads();
    const float* ng = p.mnorm_g + l * 2048 + hh * 512;
    bf16* Y = (bf16*)(p.ws + WS_Y);
#pragma unroll
    for (int ib = 0; ib < 8; ib += 2) {
        u32x4 omv[2], zmv[2]; f32x4 g0[2], g1[2];
#pragma unroll
        for (int i = 0; i < 2; ++i) { const int cc = tid + NTHR * (ib + i), row = cc >> 6, ch = cc & 63; const bf16* up = U + (size_t)(qb * 64 + row) * NU + hh * 512 + ch * 8;
            omv[i] = *(const u32x4*)(up + C_OM); zmv[i] = *(const u32x4*)(up + C_ZM); g0[i] = *(const f32x4*)(ng + ch * 8); g1[i] = *(const f32x4*)(ng + ch * 8 + 4); }
#pragma unroll
        for (int i = 0; i < 2; ++i) { const int cc = tid + NTHR * (ib + i), row = cc >> 6, ch = cc & 63;
            const u32x4 hv = *(const LAS u32x4*)(Hs + row * M_VS3 + ch * 8);
            u32x4 y;
            y.x = pk2(bf_lo(hv.x) * g0[i][0] * sigm_f(bf_lo(omv[i].x)) * silu_f(bf_lo(zmv[i].x)), bf_hi(hv.x) * g0[i][1] * sigm_f(bf_hi(omv[i].x)) * silu_f(bf_hi(zmv[i].x)));
            y.y = pk2(bf_lo(hv.y) * g0[i][2] * sigm_f(bf_lo(omv[i].y)) * silu_f(bf_lo(zmv[i].y)), bf_hi(hv.y) * g0[i][3] * sigm_f(bf_hi(omv[i].y)) * silu_f(bf_hi(zmv[i].y)));
            y.z = pk2(bf_lo(hv.z) * g1[i][0] * sigm_f(bf_lo(omv[i].z)) * silu_f(bf_lo(zmv[i].z)), bf_hi(hv.z) * g1[i][1] * sigm_f(bf_hi(omv[i].z)) * silu_f(bf_hi(zmv[i].z)));
            y.w = pk2(bf_lo(hv.w) * g1[i][2] * sigm_f(bf_lo(omv[i].w)) * silu_f(bf_lo(zmv[i].w)), bf_hi(hv.w) * g1[i][3] * sigm_f(bf_hi(omv[i].w)) * silu_f(bf_hi(zmv[i].w)));
            *(u32x4*)(Y + (size_t)(qb * 64 + row) * DM + 2048 + hh * 512 + ch * 8) = y; }
        __builtin_amdgcn_sched_barrier(0);
    }
    __syncthreads();
    TS_MARK(13);
}

#define RLX_AGENT __ATOMIC_RELAXED, __HIP_MEMORY_SCOPE_AGENT
#define XB_TMO      128
#define XB_XCNT(j)  (256  + 64 * (j))
#define XB_XSUB(j)  (1280 + 64 * (j))
#define XB_XGEN(j)  (2304 + 64 * (j))
#define XB_TOP      3328
#define XB_TOPGEN   3392
#define XCD_BAR_WORDS 3456
#define XB_SPIN_CAP (1u << 18)

__device__ __forceinline__ unsigned xb_ld(unsigned* p)              { return __hip_atomic_load(p, __ATOMIC_RELAXED, __HIP_MEMORY_SCOPE_AGENT); }
__device__ __forceinline__ unsigned xb_add(unsigned* p, unsigned v) { return __hip_atomic_fetch_add(p, v, __ATOMIC_RELAXED, __HIP_MEMORY_SCOPE_AGENT); }
__device__ __forceinline__ unsigned xb_xcc_id() { return (unsigned)__builtin_amdgcn_s_getreg((3 << 11) | 20) & 0xFu; }
#define XB_SPIN(cond, bar) do { unsigned _sp = 0; while (cond) { __builtin_amdgcn_s_sleep(1); \
    if ((++_sp & 255u) == 0u) { if (xb_ld(&(bar)[XB_TMO])) break; if (_sp > XB_SPIN_CAP) { atomicAdd(&(bar)[XB_TMO], 1u); break; } } } } while (0)

struct XcdBarrier {
    unsigned* bar; unsigned x;
    volatile LAS unsigned* st;
};

__device__ __forceinline__ XcdBarrier xcd_barrier_post(unsigned* bar, volatile LAS unsigned* st) {
    XcdBarrier b; b.bar = bar; b.x = xb_xcc_id(); b.st = st;
    if (threadIdx.x == 0) (void)xb_add(&bar[XB_XCNT(b.x)], 1u);
    return b;
}
__device__ __forceinline__ void xcd_barrier_complete(unsigned* bar, unsigned x, unsigned& nloc, unsigned& nx) {
    const unsigned G = gridDim.x * gridDim.y * gridDim.z;
    unsigned sum, cnt, mine, sp = 0u;
    for (;;) {
        sum = 0u; cnt = 0u; mine = 0u;
#pragma unroll
        for (unsigned j = 0; j < 16; ++j) { const unsigned c = xb_ld(&bar[XB_XCNT(j)]); sum += c; cnt += (c > 0u) ? 1u : 0u; mine = (j == x) ? c : mine; }
        if (sum == G) break;
        __builtin_amdgcn_s_sleep(1);
        if ((++sp & 255u) == 0u) { if (xb_ld(&bar[XB_TMO])) break; if (sp > XB_SPIN_CAP) { atomicAdd(&bar[XB_TMO], 1u); break; } }
    }
    nloc = mine > 0u ? mine : 1u; nx = cnt > 0u ? cnt : 1u;
}

__device__ __forceinline__ void xcd_barrier(const XcdBarrier& b) {
    asm volatile("s_waitcnt vmcnt(0)" ::: "memory");
    __syncthreads();
    if (threadIdx.x == 0) {
        unsigned* bar = b.bar;
        __builtin_amdgcn_s_waitcnt(0);
        unsigned nloc = b.st[0], nx = b.st[1];
        if (nloc == 0u) { xcd_barrier_complete(bar, b.x, nloc, nx); b.st[0] = nloc; b.st[1] = nx; }
        const unsigned old = xb_add(&bar[XB_XSUB(b.x)], 1u);
        const unsigned gen = old / nloc;
        if (old + 1u == (gen + 1u) * nloc) {
            __builtin_amdgcn_fence(__ATOMIC_RELEASE, "agent");
            asm volatile("s_waitcnt vmcnt(0)" ::: "memory");
            const unsigned og = xb_add(&bar[XB_TOP], 1u);
            const unsigned tg = og / nx;
            if (og + 1u == (tg + 1u) * nx) xb_add(&bar[XB_TOPGEN], 1u);
            else XB_SPIN(xb_ld(&bar[XB_TOPGEN]) == tg, bar);
            __builtin_amdgcn_fence(__ATOMIC_ACQUIRE, "agent");
            xb_add(&bar[XB_XGEN(b.x)], 1u);
            asm volatile("s_waitcnt vmcnt(0)" ::: "memory");
        } else {
            XB_SPIN(xb_ld(&bar[XB_XGEN(b.x)]) == gen, bar);
            __builtin_amdgcn_fence(__ATOMIC_ACQUIRE, "agent");
            asm volatile("s_waitcnt vmcnt(0)" ::: "memory");
        }
    }
    __syncthreads();
}

#if TSEL >= 7
#define TSUB_BEGIN(k) unsigned long long tsub_b = 0; if ((TSEL) == (k) && threadIdx.x == 0) tsub_b = __builtin_amdgcn_s_memrealtime();
#define TSUB_END(k) if ((TSEL) == (k) && threadIdx.x == 0) { volatile LAS unsigned long long* TWs = (volatile LAS unsigned long long*)((LAS unsigned char*)lds_raw + LDS_BARST + 16); TWs[2] += __builtin_amdgcn_s_memrealtime() - tsub_b; }
#else
#define TSUB_BEGIN(k)
#define TSUB_END(k)
#endif
constexpr int NPH = 15;
__global__ void __launch_bounds__(NTHR, 2) hymba_fwd(Params p0) {
    extern __shared__ __attribute__((aligned(16))) unsigned char lds_raw[];
    cg::grid_group grid = cg::this_grid();
    if (threadIdx.x < 16) ((LAS unsigned*)((LAS unsigned char*)lds_raw + LDS_BARST))[threadIdx.x] = 0u;
    __syncthreads();
    XcdBarrier bar = xcd_barrier_post((unsigned*)(p0.ws + WS_CTL), (volatile LAS unsigned*)((LAS unsigned char*)lds_raw + LDS_BARST));
#if TSEL >= 0
    volatile LAS unsigned long long* TW = (volatile LAS unsigned long long*)((LAS unsigned char*)lds_raw + LDS_BARST + 16);
    if (threadIdx.x == 0) { const unsigned long long t = __builtin_amdgcn_s_memrealtime(); TW[0] = t; TW[1] = t; TW[2] = 0; }
#endif
    for (int ph = p0.ph_lo; ph < p0.ph_hi; ++ph) {
        const int ptype = ph == 0 ? 0 : 1 + (ph - 1) % 7;
        const int nrep = (REPEAT_MASK) == 0 ? 1 : ((((REPEAT_MASK) >> ptype) & 1) ? 2 : 1);
        for (int rep = 0; rep < nrep; ++rep) {
        int tid = threadIdx.x; asm volatile("" : "+v"(tid));
        int G = gridDim.x; asm volatile("" : "+s"(G));
        const int lane = tid & 63, wave = __builtin_amdgcn_readfirstlane(tid >> 6);
        LAS unsigned char* lds = (LAS unsigned char*)lds_raw; asm volatile("" : "+s"(lds));
        Params p = p0;
        asm volatile("" : "+s"(p.ws)); asm volatile("" : "+s"(p.x)); asm volatile("" : "+s"(p.out)); asm volatile("" : "+s"(p.w_in)); asm volatile("" : "+s"(p.w_out));
        asm volatile("" : "+s"(p.conv_w)); asm volatile("" : "+s"(p.norm_g)); asm volatile("" : "+s"(p.mnorm_g)); asm volatile("" : "+s"(p.b_gate)); asm volatile("" : "+s"(p.rel_bias)); asm volatile("" : "+s"(p.final_g));
        if (ph == 0) {
            prologue_transposes(p, lds, wave, lane);
            build_wgt(p, tid);
            norm_phase(p, p.x, 0, wave, lane);
        } else {
            const int l = (ph - 1) / 7, k = (ph - 1) % 7;
            if (k == 0) {
                pg8::Gemm g{(const pg8::bf16_t*)(p.ws + WS_XN), (const pg8::bf16_t*)(p.ws + WS_WIN + (size_t)l * 128 * MiB), SEQ, NU, DM};
                pg8::StaticOrder S; S.init(SEQ, NU, G, blk());
                pg8::EpiBf16Plain E{(pg8::bf16_t*)(p.ws + WS_U), NU};
                pg8::gemm_phase<pg8::EpiBf16Plain, pg8::StaticOrder, true, true>(lds, g, S, E);
            } else if (k == 1) {
                gate_items(p, lds, l, tid, wave, lane);
                conv_prepass(p, l, tid);
                attn_phase(p, lds, tid, wave, lane);
            } else if (k == 2) {
                const bool xmap = (G == 256); const int xcd = blk() & 7, xi = blk() >> 3;
                int tid3 = tid; asm volatile("" : "+v"(tid3));
                { TSUB_BEGIN(8)
                for (int rr = 0; rr < 1 + (REP_M1); ++rr)
                for (int it = blk(), rnd = 0; it < 512; it += G, ++rnd) {
                    int item = it;
                    if (xmap) item = (xcd * 16 + rnd * 8 + (xi >> 2)) * 4 + (xi & 3);
                    m1_item(p, lds, l, item, tid3, __builtin_amdgcn_readfirstlane(tid3 >> 6), tid3 & 63); __syncthreads(); }
                TSUB_END(8) }
                merge_phase(p, tid);
            } else if (k == 3) {
                m2_phase(p, tid);
            } else if (k == 4) {
                const bool xmap = (G == 256); const int xcd = blk() & 7, xi = blk() >> 3;
                TSUB_BEGIN(9)
                for (int it = blk(), rnd = 0; it < 512; it += G, ++rnd) {
                    int hh = it >> 7, qb = it & 127; if ((it >> 8) & 1) qb ^= 3;
                    if (xmap) { const int pair = xcd * 16 + rnd * 8 + (xi >> 2); hh = pair >> 5; qb = (pair & 31) * 4 + (rnd ? 3 - (xi & 3) : (xi & 3)); }
                    m3_item(p, lds, l, hh, qb, tid, wave, lane); }
                TSUB_END(9)
            } else if (k == 5) {
                pg8::Gemm g{(const pg8::bf16_t*)(p.ws + WS_Y), (const pg8::bf16_t*)(p.ws + WS_WOUT + (size_t)l * 32 * MiB), SEQ, DM, DM};
                pg8::StaticOrder S; S.init(SEQ, DM, G, blk());
                pg8::EpiResF32 E{l == 0 ? p.x : (const float*)(p.ws + WS_X1), l == 0 ? (float*)(p.ws + WS_X1) : p.out, DM};
                pg8::gemm_phase<pg8::EpiResF32, pg8::StaticOrder, true, true>(lds, g, S, E);
            } else {
                if (l == 0) norm_phase(p, (const float*)(p.ws + WS_X1), 1, wave, lane);
                else final_norm_phase(p, (LAS unsigned char*)lds_raw, wave, lane);
            }
        }
        __syncthreads();
        }
        if (ph + 1 < p0.ph_hi) { if (p0.ph_hi > NPH) grid.sync(); else xcd_barrier(bar); }
#if TSEL >= 0
        if (threadIdx.x == 0) { const unsigned long long now = __builtin_amdgcn_s_memrealtime(); if (ptype == (TSEL)) TW[2] += now - TW[1]; TW[1] = now;
          if (ph + 2 == p0.ph_hi) ((volatile LAS int*)TW)[8] = (int)((float)TW[2] / (float)(now - TW[0]) * 131072.f); }
        if (ph + 2 == p0.ph_hi) __syncthreads();
#endif
    }
}

extern "C" void kernel_launch(void* const* d_in, const int* in_sizes, int n_in, void* d_out, int out_size, void* d_ws, size_t ws_size, hipStream_t stream) {
    static int grid = 0;
    if (grid == 0) {
        if (n_in != 9 || in_sizes[0] != SEQ * DM || out_size != SEQ * DM || ws_size < WS_END) {
            fprintf(stderr, "kernel_launch: unexpected problem: n_in %d in0 %d out %d ws %zu (need %zu)\n", n_in, n_in > 0 ? in_sizes[0] : -1, out_size, ws_size, (size_t)WS_END); grid = -1; return; }
        int dev = 0, cus = 0, per_cu = 0;
        hipGetDevice(&dev);
        hipDeviceGetAttribute(&cus, hipDeviceAttributeMultiprocessorCount, dev);
        if (hipFuncSetAttribute((const void*)hymba_fwd, hipFuncAttributeMaxDynamicSharedMemorySize, LDS_BYTES) != hipSuccess) { fprintf(stderr, "kernel_launch: hipFuncSetAttribute failed\n"); grid = -1; return; }
        if (hipOccupancyMaxActiveBlocksPerMultiprocessor(&per_cu, (const void*)hymba_fwd, NTHR, LDS_BYTES) != hipSuccess || per_cu < 1) { fprintf(stderr, "kernel_launch: occupancy query gave %d\n", per_cu); per_cu = 1; }
        (void)hipGetLastError();
        grid = cus * per_cu;
        fprintf(stderr, "kernel_launch: %d CUs x %d = grid %d\n", cus, per_cu, grid);
    }
    if (grid < 0) return;
    if (hipMemsetAsync((char*)d_ws + WS_CTL, 0, 16384, stream) != hipSuccess) { fprintf(stderr, "kernel_launch: hipMemsetAsync failed\n"); return; }
    Params p{};
    p.x = (const float*)d_in[0]; p.norm_g = (const float*)d_in[1]; p.w_in = (const float*)d_in[2]; p.b_gate = (const float*)d_in[3]; p.conv_w = (const float*)d_in[4];
    p.mnorm_g = (const float*)d_in[5]; p.w_out = (const float*)d_in[6]; p.rel_bias = (const float*)d_in[7]; p.final_g = (const float*)d_in[8];
    p.out = (float*)d_out; p.ws = (unsigned char*)d_ws;
#if MULTI_LAUNCH
    for (int ph = 0; ph < NPH; ++ph) { p.ph_lo = ph; p.ph_hi = ph + 1; hipLaunchKernelGGL(hymba_fwd, dim3(grid), dim3(NTHR), LDS_BYTES, stream, p); }
#else
    p.ph_lo = 0; p.ph_hi = NPH;
    void* args[] = {&p};
    hipError_t e = hipLaunchCooperativeKernel((const void*)hymba_fwd, dim3(grid), dim3(NTHR), args, LDS_BYTES, stream);
    if (e != hipSuccess) fprintf(stderr, "kernel_launch: cooperative launch failed: %s (grid %d)\n", hipGetErrorString(e), grid);
#endif
}
```

```cpp
#include <hip/hip_runtime.h>
#include <hip/hip_cooperative_groups.h>
#include <cstdio>
#include <cstdint>
namespace cg = cooperative_groups;
namespace pg8 {
#define PG8_LAS __attribute__((address_space(3)))
typedef unsigned short bf16_t;
typedef short bf16x8 __attribute__((ext_vector_type(8)));
typedef float f32x4 __attribute__((ext_vector_type(4)));
typedef unsigned u32x4 __attribute__((ext_vector_type(4)));
constexpr int BM = 256, BK = 64, HALF = 128, HTB = HALF * BK * 2  , STAGE_BYTES = 8 * HTB, NXCD = 8, WGM = 8;

__host__ __device__ __forceinline__ int lds_byte(int r, int c) { const int st = (r >> 4) * 2 + (c >> 5), rr = r & 15, cc = c & 31, ob = rr * 64 + cc * 2; return st * 1024 + (ob ^ (((ob >> 9) & 1) << 5)); }
__host__ __device__ __forceinline__ void stage_rc(int b, int& R, int& C) { const int st = b / 1024, sb = b % 1024, swz = sb ^ (((sb >> 9) & 1) << 5); R = (st >> 1) * 16 + swz / 64; C = (st & 1) * 32 + (swz % 64) / 2; }
__host__ __device__ __forceinline__ int perm32(int rho) { const int n = rho >> 4, i = rho & 15; return 8 * (i >> 2) + 4 * n + (i & 3); }

struct Unit { int pm, pn; };
struct Gemm { const bf16_t* A; const bf16_t* Bt; int M, N, K; };

struct StaticOrder {
    int nM, nN, nwg, G, c;
    __host__ __device__ void init(int M, int N, int G_, int c_) { nM = M / BM; nN = N / BM; nwg = nM * nN; G = G_; c = c_; }
    __host__ __device__ bool next(int i, Unit& u) const {
        const long L = (long)i * G + c; if (L >= nwg) return false;
        int wgid = (int)L; { const int q = nwg / NXCD, r = nwg % NXCD, xcd = wgid % NXCD, off = wgid / NXCD; wgid = (xcd < r ? xcd * (q + 1) : r * (q + 1) + (xcd - r) * q) + off; }
        const int nig = WGM * nN, gid = wgid / nig, fm = gid * WGM, gsz = (nM - fm) < WGM ? (nM - fm) : WGM;
        u.pm = fm + ((wgid % nig) % gsz); u.pn = (wgid % nig) / gsz; return true;
    }
    __device__ __forceinline__ void a_ready(const Unit&) const {}
    __device__ __forceinline__ void done(const Unit&) const {}
};

__device__ __forceinline__ unsigned cvt_pk_bf16(float lo, float hi) { unsigned r; asm volatile("v_cvt_pk_bf16_f32 %0, %1, %2" : "=v"(r) : "v"(lo), "v"(hi)); return r; }
struct EpiBf16Plain {
    static constexpr bool PERM = true, AFTER_DRAIN = false;
    bf16_t* O; int ldc;
    __device__ __forceinline__ void operator()(const f32x4 (&acc)[2][2][4][2], const Unit& u, int wr, int wc, int fr, int fq) const {
        const int row0 = u.pm * BM + wr * 64 + fr; const int col0 = u.pn * BM + wc * 32 + 8 * fq;
#pragma unroll
        for (int ai = 0; ai < 2; ++ai)
#pragma unroll
            for (int m = 0; m < 4; ++m) { bf16_t* rowp = O + (size_t)(row0 + ai * HALF + m * 16) * ldc + col0;
#pragma unroll
                for (int bj = 0; bj < 2; ++bj) { const f32x4 v0 = acc[ai][bj][m][0], v1 = acc[ai][bj][m][1];
                    u32x4 w; w.x = cvt_pk_bf16(v0[0], v0[1]); w.y = cvt_pk_bf16(v0[2], v0[3]); w.z = cvt_pk_bf16(v1[0], v1[1]); w.w = cvt_pk_bf16(v1[2], v1[3]);
                    *(u32x4*)(rowp + bj * HALF) = w; } }
    }
};
struct EpiResF32 {
    static constexpr bool PERM = true, AFTER_DRAIN = false;
    const float* base; float* out; int ld;
    __device__ __forceinline__ void operator()(const f32x4 (&acc)[2][2][4][2], const Unit& u, int wr, int wc, int fr, int fq) const {
        const int row0 = u.pm * BM + wr * 64 + fr; const int col0 = u.pn * BM + wc * 32 + 8 * fq;
#pragma unroll
        for (int ai = 0; ai < 2; ++ai)
#pragma unroll
            for (int m = 0; m < 4; ++m) { const size_t ro = (size_t)(row0 + ai * HALF + m * 16) * ld + col0;
#pragma unroll
                for (int bj = 0; bj < 2; ++bj) {
                    const f32x4 b0 = *(const f32x4*)(base + ro + bj * HALF), b1 = *(const f32x4*)(base + ro + bj * HALF + 4);
                    *(f32x4*)(out + ro + bj * HALF) = acc[ai][bj][m][0] + b0;
                    *(f32x4*)(out + ro + bj * HALF + 4) = acc[ai][bj][m][1] + b1; } }
    }
};
template <class Epi, class Sched, bool ALIGN_EPI = false, bool SP2 = false>
__device__ __forceinline__ void gemm_phase(PG8_LAS unsigned char* lds, const Gemm g, const Sched& S, const Epi& E) {
    int tid = threadIdx.x; asm volatile("" : "+v"(tid));
    const int wid = __builtin_amdgcn_readfirstlane(tid >> 6), lane = tid & 63, wr = wid >> 2, wc = wid & 3, fr = lane & 15, fq = lane >> 4;
    const int K = g.K, nt = K / BK;
    unsigned voffA[2], voffB[2];
#pragma unroll
    for (int i = 0; i < 2; ++i) { int R, C; stage_rc(tid * 16 + i * 8192, R, C); const int Rb = Epi::PERM ? ((R & ~31) + perm32(R & 31)) : R;
        voffA[i] = (unsigned)(R * K + C) * 2u; voffB[i] = (unsigned)(Rb * K + C) * 2u; }
    const size_t kstep = (size_t)(BK * 2);
    const size_t hstep = (size_t)HALF * K * 2;
    const size_t tstep = 2 * hstep;
    const unsigned ldsw = (unsigned)wid * 1024u;
    const int aoff = lds_byte(wr * 64 + fr, fq * 8), boff = lds_byte(wc * 32 + fr, fq * 8);
#define PG8_SA(b, h) (((b) * 2 + (h)) * HTB)
#define PG8_SB(b, h) ((4 + (b) * 2 + (h)) * HTB)
#define PG8_STAGE(bufoff, gbase, voff) do { _Pragma("unroll") for (int _i = 0; _i < 2; ++_i) \
        __builtin_amdgcn_global_load_lds((const unsigned*)((const char*)(gbase) + (voff)[_i]), (PG8_LAS unsigned*)(lds + (bufoff) + ldsw + _i * 8192), 16, 0, 0); } while (0)
#define PG8_LDA(dst, b, h) do { _Pragma("unroll") for (int m = 0; m < 4; ++m) _Pragma("unroll") for (int k = 0; k < 2; ++k) dst[m][k] = *(const PG8_LAS bf16x8*)(lds + PG8_SA(b, h) + aoff + m * 2048 + k * 1024); } while (0)
#define PG8_LDB(dst, b, h) do { _Pragma("unroll") for (int n = 0; n < 2; ++n) _Pragma("unroll") for (int k = 0; k < 2; ++k) dst[n][k] = *(const PG8_LAS bf16x8*)(lds + PG8_SB(b, h) + boff + n * 2048 + k * 1024); } while (0)
#define PG8_MMA(ai, bj, At, Bt) do { __builtin_amdgcn_s_setprio(1); _Pragma("unroll") for (int m = 0; m < 4; ++m) _Pragma("unroll") for (int n = 0; n < 2; ++n) _Pragma("unroll") for (int k = 0; k < 2; ++k) \
        acc[ai][bj][m][n] = __builtin_amdgcn_mfma_f32_16x16x32_bf16(Bt[n][k], At[m][k], acc[ai][bj][m][n], 0, 0, 0); __builtin_amdgcn_s_setprio(0); } while (0)
#define PG8_WAIT_V(n) asm volatile("s_waitcnt vmcnt(" #n ")" ::: "memory")
#define PG8_WAIT_L(n) asm volatile("s_waitcnt lgkmcnt(" #n ")" ::: "memory")
#define PG8_BAR __builtin_amdgcn_s_barrier()
#define PG8_SCHED __builtin_amdgcn_sched_barrier(0)
    Unit cur, nxt; int ui = 0;
    if (!S.next(0, cur)) return;
    f32x4 acc[2][2][4][2];
#pragma unroll
    for (int a = 0; a < 2; ++a)
#pragma unroll
        for (int b = 0; b < 2; ++b)
#pragma unroll
            for (int m = 0; m < 4; ++m)
#pragma unroll
                for (int n = 0; n < 2; ++n) acc[a][b][m][n] = (f32x4){0.f, 0.f, 0.f, 0.f};
    bf16x8 At[4][2], B0[2][2], B1[2][2];
    const char* cA = (const char*)g.A + (size_t)cur.pm * tstep; const char* cB = (const char*)g.Bt + (size_t)cur.pn * tstep;
    S.a_ready(cur);
    if constexpr (SP2) {
        PG8_STAGE(PG8_SB(0, 0), cB, voffB); PG8_STAGE(PG8_SB(0, 1), cB + hstep, voffB); PG8_STAGE(PG8_SA(0, 0), cA, voffA); PG8_STAGE(PG8_SA(0, 1), cA + hstep, voffA);
        if (wr == 1) PG8_BAR;
        PG8_WAIT_V(2); PG8_BAR;
        PG8_STAGE(PG8_SB(1, 0), cB + kstep, voffB); PG8_STAGE(PG8_SA(1, 0), cA + kstep, voffA); PG8_STAGE(PG8_SB(1, 1), cB + hstep + kstep, voffB);
        PG8_WAIT_V(6); PG8_BAR;
    } else {
        PG8_STAGE(PG8_SB(0, 0), cB, voffB); PG8_STAGE(PG8_SA(0, 0), cA, voffA); PG8_STAGE(PG8_SB(0, 1), cB + hstep, voffB); PG8_STAGE(PG8_SA(0, 1), cA + hstep, voffA);
        if (wr == 1) PG8_BAR;
        PG8_WAIT_V(4); PG8_BAR;
        PG8_STAGE(PG8_SB(1, 0), cB + kstep, voffB); PG8_STAGE(PG8_SA(1, 0), cA + kstep, voffA); PG8_STAGE(PG8_SB(1, 1), cB + hstep + kstep, voffB);
        PG8_WAIT_V(6); PG8_BAR;
    }
    for (;;) {
        const bool has_next = S.next(ui + 1, nxt);
        const char* nA = has_next ? (const char*)g.A + (size_t)nxt.pm * tstep : cA; const char* nB = has_next ? (const char*)g.Bt + (size_t)nxt.pn * tstep : cB;
        for (int t = 0; t < nt; t += 2) {
            const bool last = (t == nt - 2);
            const char* a1 = cA + (size_t)(t + 1) * kstep;
            const char* a2 = last ? nA : cA + (size_t)(t + 2) * kstep; const char* b2 = last ? nB : cB + (size_t)(t + 2) * kstep;
            const char* a3 = a2 + kstep; const char* b3 = b2 + kstep;
            if (last && has_next) S.a_ready(nxt);
            if constexpr (SP2) {
            PG8_LDB(B0, 0, 0); PG8_LDB(B1, 0, 1); PG8_SCHED; PG8_LDA(At, 0, 0); PG8_STAGE(PG8_SA(1, 1), a1 + hstep, voffA);
            PG8_WAIT_V(8); PG8_WAIT_L(0); PG8_BAR; PG8_MMA(0, 0, At, B0); PG8_MMA(0, 1, At, B1); PG8_BAR; PG8_SCHED;
            PG8_LDA(At, 0, 1); PG8_STAGE(PG8_SB(0, 0), b2, voffB); PG8_STAGE(PG8_SB(0, 1), b2 + hstep, voffB); PG8_STAGE(PG8_SA(0, 0), a2, voffA);
            PG8_WAIT_V(8); PG8_WAIT_L(0); PG8_BAR; PG8_MMA(1, 0, At, B0); PG8_MMA(1, 1, At, B1); PG8_BAR; PG8_SCHED;
            PG8_LDB(B0, 1, 0); PG8_LDB(B1, 1, 1); PG8_SCHED; PG8_LDA(At, 1, 0); PG8_STAGE(PG8_SA(0, 1), a2 + hstep, voffA);
            PG8_WAIT_V(8); PG8_WAIT_L(0); PG8_BAR; PG8_MMA(0, 0, At, B0); PG8_MMA(0, 1, At, B1); PG8_BAR; PG8_SCHED;
            PG8_LDA(At, 1, 1); PG8_STAGE(PG8_SB(1, 0), b3, voffB); PG8_STAGE(PG8_SB(1, 1), b3 + hstep, voffB); PG8_STAGE(PG8_SA(1, 0), a3, voffA);
            PG8_WAIT_V(8); PG8_WAIT_L(0); PG8_BAR; PG8_MMA(1, 0, At, B0); PG8_MMA(1, 1, At, B1); PG8_BAR; PG8_SCHED;
            } else {
            PG8_LDB(B0, 0, 0); PG8_SCHED; PG8_LDA(At, 0, 0); PG8_STAGE(PG8_SA(1, 1), a1 + hstep, voffA);
            PG8_WAIT_L(8); PG8_BAR; PG8_WAIT_L(0); PG8_MMA(0, 0, At, B0); PG8_BAR; PG8_SCHED;
            PG8_LDB(B1, 0, 1); PG8_STAGE(PG8_SB(0, 0), b2, voffB);
            PG8_BAR; PG8_WAIT_L(0); PG8_MMA(0, 1, At, B1); PG8_BAR;
            PG8_LDA(At, 0, 1); PG8_STAGE(PG8_SA(0, 0), a2, voffA);
            PG8_BAR; PG8_WAIT_L(0); PG8_MMA(1, 0, At, B0); PG8_BAR; PG8_SCHED;
            PG8_STAGE(PG8_SB(0, 1), b2 + hstep, voffB);
            PG8_WAIT_V(6); PG8_BAR; PG8_MMA(1, 1, At, B1); PG8_BAR;
            PG8_LDB(B0, 1, 0); PG8_SCHED; PG8_LDA(At, 1, 0); PG8_STAGE(PG8_SA(0, 1), a2 + hstep, voffA);
            PG8_WAIT_L(8); PG8_BAR; PG8_WAIT_L(0); PG8_MMA(0, 0, At, B0); PG8_BAR; PG8_SCHED;
            PG8_LDB(B1, 1, 1); PG8_STAGE(PG8_SB(1, 0), b3, voffB);
            PG8_BAR; PG8_WAIT_L(0); PG8_MMA(0, 1, At, B1); PG8_BAR;
            PG8_LDA(At, 1, 1); PG8_STAGE(PG8_SA(1, 0), a3, voffA);
            PG8_BAR; PG8_WAIT_L(0); PG8_MMA(1, 0, At, B0); PG8_BAR; PG8_SCHED;
            PG8_STAGE(PG8_SB(1, 1), b3 + hstep, voffB);
            PG8_WAIT_V(6); PG8_BAR; PG8_MMA(1, 1, At, B1); PG8_BAR;
            }
        }
        if constexpr (ALIGN_EPI) { if (wr == 0) PG8_BAR; }
        if constexpr (!Epi::AFTER_DRAIN) { E(acc, cur, wr, wc, fr, fq); S.done(cur); }
        if (!has_next) break;
#pragma unroll
        for (int a = 0; a < 2; ++a)
#pragma unroll
            for (int b = 0; b < 2; ++b)
#pragma unroll
                for (int m = 0; m < 4; ++m)
#pragma unroll
                    for (int n = 0; n < 2; ++n) acc[a][b][m][n] = (f32x4){0.f, 0.f, 0.f, 0.f};
        cur = nxt; cA = nA; cB = nB; ++ui;
        if constexpr (ALIGN_EPI) { if (wr == 1) PG8_BAR; }
    }
    PG8_WAIT_V(0);
    if constexpr (!ALIGN_EPI) { if (wr == 0) PG8_BAR; }
    PG8_BAR;
    if constexpr (Epi::AFTER_DRAIN) { E.fused(acc, cur, wr, wc, fr, fq, lds, wid, lane); S.done(cur); }
#undef PG8_SA
#undef PG8_SB
#undef PG8_STAGE
#undef PG8_LDA
#undef PG8_LDB
#undef PG8_MMA
#undef PG8_WAIT_V
#undef PG8_WAIT_L
#undef PG8_BAR
#undef PG8_SCHED
}
}

#ifndef MULTI_LAUNCH
#define MULTI_LAUNCH 0
#endif
#ifndef USE_TR
#define USE_TR 1
#endif
#ifndef TSEL
#define TSEL (-1)
#endif
#if TSEL >= 10
#define TS_MARK(k0) do { if (threadIdx.x == 0) { volatile LAS unsigned long long* TWs = (volatile LAS unsigned long long*)(lds + LDS_BARST + 16); const unsigned long long nowt = __builtin_amdgcn_s_memrealtime(); if ((TSEL) == (k0)) TWs[2] += nowt - TWs[3]; TWs[3] = nowt; } } while (0)
#else
#define TS_MARK(k0) do {} while (0)
#endif
#ifndef REP_ATTN
#define REP_ATTN 0
#endif
#ifndef REP_M1
#define REP_M1 0
#endif
#ifndef REPEAT_MASK
#define REPEAT_MASK 0
#endif
#define LAS __attribute__((address_space(3)))
#define DI __device__ __forceinline__
typedef unsigned short bf16;
typedef short bf16x8 __attribute__((ext_vector_type(8)));
typedef float f32x4 __attribute__((ext_vector_type(4)));
typedef unsigned u32x4 __attribute__((ext_vector_type(4)));
typedef unsigned u32x2 __attribute__((ext_vector_type(2)));

constexpr int SEQ = 8192, DM = 4096, INW = 16392, NU = 16384;
constexpr int C_QA = 0, C_KA = 2048, C_VA = 4096, C_ZA = 6144, C_QM = 8192, C_KM = 9216, C_VM = 10240, C_OM = 12288, C_ZM = 14336;
constexpr float NORM_EPS = 1e-6f;
constexpr int NTHR = 512, NWAVE = 8;
constexpr int LDS_BYTES = 147456;

constexpr size_t MiB = (size_t)1 << 20;
constexpr size_t WS_WIN = 0, WS_WOUT = 256 * MiB, WS_XN = 320 * MiB, WS_U = 384 * MiB, WS_OP = 640 * MiB, WS_Y = 736 * MiB, WS_X1 = 800 * MiB,
                 WS_DC = 928 * MiB, WS_CS = 992 * MiB, WS_LSE = 1024 * MiB, WS_GATES = 1026 * MiB, WS_DN = 1027 * MiB, WS_NS = 1028 * MiB, WS_BL = 1029 * MiB,
                 WS_CTL = 1030 * MiB, WS_QKC = 1032 * MiB, WS_WGT = 1064 * MiB, WS_END = 1065 * MiB;
constexpr int LDS_BARST = LDS_BYTES - 64;

struct Params { const float *x, *norm_g, *w_in, *b_gate, *conv_w, *mnorm_g, *w_out, *rel_bias, *final_g; float* out; unsigned char* ws; int ph_lo, ph_hi; };

DI int blk() { int b = blockIdx.x; asm volatile("" : "+s"(b)); return b; }
DI float bf_lo(unsigned u) { return __uint_as_float(u << 16); }
DI float bf_hi(unsigned u) { return __uint_as_float(u & 0xffff0000u); }
DI float bf2f(unsigned short u) { return __uint_as_float((unsigned)u << 16); }
DI unsigned pk2(float lo, float hi) { return pg8::cvt_pk_bf16(lo, hi); }
DI float wave_sum(float v) {
#pragma unroll
    for (int o = 1; o < 64; o <<= 1) v += __shfl_xor(v, o);
    return v;
}
DI float quad_sum(float v) { v += __shfl_xor(v, 16); v += __shfl_xor(v, 32); return v; }
DI float quad_max(float v) { v = fmaxf(v, __shfl_xor(v, 16)); v = fmaxf(v, __shfl_xor(v, 32)); return v; }
DI float silu_f(float x) { return x * __builtin_amdgcn_rcpf(1.f + __expf(-x)); }
DI float sigm_f(float x) { return __builtin_amdgcn_rcpf(1.f + __expf(-x)); }
DI bf16x8 gatherT(const LAS unsigned short* p, int stride) {
    bf16x8 r;
#pragma unroll
    for (int j = 0; j < 8; ++j) r[j] = (short)p[j * stride];
    return r;
}
typedef short s16x4 __attribute__((ext_vector_type(4)));
DI bf16x8 trfrag(const LAS unsigned short* blk, int stride, int ql) {
#if USE_TR
    const LAS unsigned short* a = blk + (ql >> 2) * stride + 4 * (ql & 3);
    const s16x4 lo = __builtin_amdgcn_ds_read_tr16_b64_v4i16((LAS s16x4*)a);
    const s16x4 hi = __builtin_amdgcn_ds_read_tr16_b64_v4i16((LAS s16x4*)(a + 4 * stride));
    return (bf16x8){lo[0], lo[1], lo[2], lo[3], hi[0], hi[1], hi[2], hi[3]};
#else
    return gatherT(blk + ql, stride);
#endif
}
DI f32x4 mfma16(bf16x8 a, bf16x8 b, f32x4 c) { return __builtin_amdgcn_mfma_f32_16x16x32_bf16(a, b, c, 0, 0, 0); }
#define LDS_WAIT() asm volatile("s_waitcnt lgkmcnt(0)" ::: "memory")

struct TrTile { const float* src; bf16* dst; };
DI TrTile tr_tile_addr(const Params& p, int it, int lane) {
    constexpr int T_IN = 64 * 256, T_OUT = 64 * 64;
    const float* W; bf16* WT; int ldw, nb, kb;
    int r = it;
    if (r < T_IN) { W = p.w_in; WT = (bf16*)(p.ws + WS_WIN); ldw = INW; kb = r >> 8; nb = r & 255; }
    else if ((r -= T_IN) < T_OUT) { W = p.w_out; WT = (bf16*)(p.ws + WS_WOUT); ldw = DM; kb = r >> 6; nb = r & 63; }
    else if ((r -= T_OUT) < T_IN) { W = p.w_in + (size_t)DM * INW; WT = (bf16*)(p.ws + WS_WIN + 128 * MiB); ldw = INW; kb = r >> 8; nb = r & 255; }
    else { r -= T_IN; W = p.w_out + (size_t)DM * DM; WT = (bf16*)(p.ws + WS_WOUT + 32 * MiB); ldw = DM; kb = r >> 6; nb = r & 63; }
    TrTile t;
    t.src = W + (size_t)(kb * 64 + 16 * (lane >> 4)) * ldw + nb * 64 + 4 * (lane & 15);
    t.dst = WT + (size_t)(nb * 64 + (lane >> 3)) * DM + kb * 64 + 8 * (lane & 7);
    return t;
}
DI int tr_ldw(int it) { constexpr int T_IN = 64 * 256, T_OUT = 64 * 64; const int r = it % (T_IN + T_OUT); return r < T_IN ? INW : DM; }
DI void tr_load(const float* src, int ldw, f32x4 (&v)[16]) {
#pragma unroll
    for (int i = 0; i < 16; ++i) v[i] = *(const f32x4*)(src + (size_t)i * ldw);
}
DI void tr_store(const f32x4 (&v)[16], bf16* dst, LAS unsigned short* T, int lane) {
    const int kr = lane >> 4, nc = 4 * (lane & 15);
#pragma unroll
    for (int e = 0; e < 4; ++e)
#pragma unroll
        for (int hf = 0; hf < 2; ++hf) { u32x4 w;
            w.x = pk2(v[8 * hf + 0][e], v[8 * hf + 1][e]); w.y = pk2(v[8 * hf + 2][e], v[8 * hf + 3][e]); w.z = pk2(v[8 * hf + 4][e], v[8 * hf + 5][e]); w.w = pk2(v[8 * hf + 6][e], v[8 * hf + 7][e]);
            *(LAS u32x4*)(T + (nc + e) * 72 + 16 * kr + 8 * hf) = w; }
    LDS_WAIT(); asm volatile("" ::: "memory");
#pragma unroll
    for (int j = 0; j < 8; ++j) { const u32x4 w = *(const LAS u32x4*)(T + ((lane >> 3) + 8 * j) * 72 + 8 * (lane & 7)); *(u32x4*)(dst + (size_t)(8 * j) * DM) = w; }
    LDS_WAIT(); asm volatile("" ::: "memory");
}
DI void prologue_transposes(const Params& p, LAS unsigned char* lds, int wave, int lane) {
    LAS unsigned short* T = (LAS unsigned short*)(lds + wave * 16384);
    const int gw = blk() * NWAVE + wave, ngw = gridDim.x * NWAVE;
    constexpr int NIT = 2 * (64 * 256 + 64 * 64);
    f32x4 va[16], vb[16];
    int it = gw;
    if (it >= NIT) return;
    TrTile ta = tr_tile_addr(p, it, lane), tb;
    tr_load(ta.src, tr_ldw(it), va);
    for (;;) {
        const int it1 = it + ngw; const bool h1 = it1 < NIT;
        if (h1) { tb = tr_tile_addr(p, it1, lane); tr_load(tb.src, tr_ldw(it1), vb); }
        tr_store(va, ta.dst, T, lane);
        if (!h1) break;
        const int it2 = it1 + ngw; const bool h2 = it2 < NIT;
        if (h2) { ta = tr_tile_addr(p, it2, lane); tr_load(ta.src, tr_ldw(it2), va); }
        tr_store(vb, tb.dst, T, lane);
        if (!h2) break;
        it = it2;
    }
}

DI void norm_phase(const Params& p, const float* X, int l, int wave, int lane) {
    const float* g = p.norm_g + l * DM;
    bf16* XN = (bf16*)(p.ws + WS_XN);
    for (int row = blk() * NWAVE + wave; row < SEQ; row += gridDim.x * NWAVE) {
        const f32x4* xr = (const f32x4*)(X + (size_t)row * DM) + lane;
        f32x4 v[16]; float ss = 0.f;
#pragma unroll
        for (int j = 0; j < 16; ++j) { v[j] = xr[64 * j]; ss += (v[j].x * v[j].x + v[j].y * v[j].y) + (v[j].z * v[j].z + v[j].w * v[j].w); }
        const float rstd = rsqrtf(wave_sum(ss) * (1.f / DM) + NORM_EPS);
        u32x2* o8 = (u32x2*)(XN + (size_t)row * DM) + lane;
#pragma unroll
        for (int j = 0; j < 16; ++j) { const f32x4 h = v[j] * rstd * ((const f32x4*)g)[lane + 64 * j]; u32x2 w; w.x = pk2(h.x, h.y); w.y = pk2(h.z, h.w); o8[64 * j] = w; }
    }
}
DI void build_wgt(const Params& p, int tid) {
    bf16* WgT = (bf16*)(p.ws + WS_WGT);
    for (int gid = blk() * NTHR + tid; gid < 2 * 16 * DM; gid += gridDim.x * NTHR) {
        if (gid < 2 * 8 * DM) { const int l = gid >> 15, k = (gid >> 3) & (DM - 1), j = gid & 7;
            WgT[((size_t)l * 16 + j) * DM + k] = (bf16)(pk2(p.w_in[(size_t)l * DM * INW + (size_t)k * INW + NU + j], 0.f) & 0xffffu); }
        else { const int r = gid - 2 * 8 * DM, l = r >> 15, j = 8 + ((r >> 12) & 7), k = r & (DM - 1); WgT[((size_t)l * 16 + j) * DM + k] = 0; }
    }
}
DI void gate_items(const Params& p, LAS unsigned char* lds, int l, int tid, int wave, int lane) {
    const bf16* XN = (const bf16*)(p.ws + WS_XN);
    const bf16* WgT = (const bf16*)(p.ws + WS_WGT) + (size_t)l * 16 * DM;
    float* gates = (float*)(p.ws + WS_GATES);
    LAS float* red = (LAS float*)lds;
    const int ql = lane & 15, quad = lane >> 4;
    for (int t = blk(); t < SEQ / 16; t += gridDim.x) {
        const bf16* a = WgT + (size_t)ql * DM + wave * 512 + quad * 8; const bf16* b = XN + (size_t)(t * 16 + ql) * DM + wave * 512 + quad * 8;
        f32x4 acc0 = {0.f, 0.f, 0.f, 0.f}, acc1 = {0.f, 0.f, 0.f, 0.f};
#pragma unroll
        for (int i = 0; i < 16; i += 2) { acc0 = mfma16(*(const bf16x8*)(a + i * 32), *(const bf16x8*)(b + i * 32), acc0); acc1 = mfma16(*(const bf16x8*)(a + i * 32 + 32), *(const bf16x8*)(b + i * 32 + 32), acc1); }
        const f32x4 r = acc0 + acc1;
        if (quad < 2) *(LAS f32x4*)(red + (wave * 16 + ql) * 8 + quad * 4) = r;
        __syncthreads();
        if (tid < 128) { float sum = p.b_gate[l * 8 + (tid & 7)];
#pragma unroll
            for (int w = 0; w < 8; ++w) sum += red[w * 128 + tid];
            gates[(size_t)t * 128 + tid] = sum; }
        __syncthreads();
    }
}
DI void final_norm_phase(const Params& p, LAS unsigned char* lds0, int wave, int lane) {
#if TSEL >= 0
    const int n2 = ((volatile LAS int*)(lds0 + LDS_BARST + 16))[8];
#endif
    for (int row = blk() * NWAVE + wave; row < SEQ; row += gridDim.x * NWAVE) {
        f32x4* xr = (f32x4*)(p.out + (size_t)row * DM) + lane;
        f32x4 v[16]; float ss = 0.f;
#pragma unroll
        for (int j = 0; j < 16; ++j) { v[j] = xr[64 * j]; ss += (v[j].x * v[j].x + v[j].y * v[j].y) + (v[j].z * v[j].z + v[j].w * v[j].w); }
        const float rstd = rsqrtf(wave_sum(ss) * (1.f / DM) + NORM_EPS);
#pragma unroll
        for (int j = 0; j < 16; ++j) { f32x4 o = v[j] * rstd * ((const f32x4*)p.final_g)[lane + 64 * j];
#if TSEL >= 0
            if (blk() == 0) { const int e0 = ((row >> 11) * 8 + (row & 7)) * 4096 + 4 * (lane + 64 * j);
                o.x += (e0 + 0 < n2) ? 0.02f : 0.f; o.y += (e0 + 1 < n2) ? 0.02f : 0.f; o.z += (e0 + 2 < n2) ? 0.02f : 0.f; o.w += (e0 + 3 < n2) ? 0.02f : 0.f; }
#endif
            xr[64 * j] = o; }
    }
}

constexpr int AT_KS = 136;
#define ATT_DECODE(item) const int pat = (item) >> 10, h = ((item) & 1023) >> 6, rb_ = (item) & 63, dsh = pat * 2, r = rb_ >> (6 - dsh), bq = rb_ & ((64 >> dsh) - 1), sub0 = 128 * bq - 128; (void)sub0; (void)r; (void)h;
DI void att_load_kv(const bf16* U, int item, int tid, int coff, u32x4 (&v)[8]) {
    ATT_DECODE(item)
#pragma unroll
    for (int i = 0; i < 8; ++i) { const int c = tid + NTHR * i, row = c >> 4, ch = c & 15; int sub = sub0 + row; sub = sub < 0 ? 0 : sub;
        v[i] = *(const u32x4*)(U + (size_t)((sub << dsh) + r) * NU + coff + h * 128 + ch * 8); }
}
DI void att_store(LAS unsigned short* dst, int tid, const u32x4 (&v)[8]) {
#pragma unroll
    for (int i = 0; i < 8; ++i) { const int c = tid + NTHR * i, row = c >> 4, ch = c & 15; *(LAS u32x4*)(dst + row * AT_KS + ch * 8) = v[i]; }
}
DI void att_load_q(const bf16* U, int item, int wave, int lane, bf16x8 (&qf)[4]) {
    ATT_DECODE(item)
    const int tq = ((128 * bq + wave * 16 + (lane & 15)) << dsh) + r;
#pragma unroll
    for (int ks = 0; ks < 4; ++ks) qf[ks] = *(const bf16x8*)(U + (size_t)tq * NU + C_QA + h * 128 + ks * 32 + (lane >> 4) * 8);
}
DI void att_bias(const Params& p, int item, int tid, LAS float* biasS) {
    ATT_DECODE(item)
    if (tid < 177) { const int i = tid - 32; float v = -1e30f;
        if (i >= 0 && i <= 128) { const int n = i << dsh; int b = n;
            if (n >= 16) { b = 16 + (int)floorf(log2f((float)n * 0.0625f) * (16.f / 7.f)); b = b > 31 ? 31 : b; }
            v = p.rel_bias[b * 16 + h] * 1.4426950408889634f; }
        biasS[tid] = v; }
}
DI int att_item_of(int rnd, bool xmap, int xcd, int xi) {
    if (!xmap) return blk() + rnd * gridDim.x;
    const int h = 2 * xcd + rnd / 6, j = (rnd % 6) * 32 + xi; return (j >> 6) * 1024 + h * 64 + (j & 63);
}
DI void attn_phase(const Params& p, LAS unsigned char* lds, int tid, int wave, int lane) {
    const bf16* U = (const bf16*)(p.ws + WS_U);
    LAS unsigned short* Ks = (LAS unsigned short*)lds;
    LAS unsigned short* Vs = Ks + 256 * AT_KS;
    LAS float* biasS = (LAS float*)(Vs + 256 * AT_KS);
    const int G = gridDim.x; const bool xmap = (G == 256); const int xcd = blk() & 7, xi = blk() >> 3;
    const int nrnd = (blk() < 3072) ? (3072 - blk() + G - 1) / G : 0;
    if (nrnd <= 0) return;
    const int ql = lane & 15, quad = lane >> 4, q0 = wave * 16;
    bf16x8 qf[4];
    { const int item0 = att_item_of(0, xmap, xcd, xi); u32x4 kv[8], vv[8];
      att_load_kv(U, item0, tid, C_KA, kv); att_load_kv(U, item0, tid, C_VA, vv); att_load_q(U, item0, wave, lane, qf); att_bias(p, item0, tid, biasS);
      att_store(Ks, tid, kv); att_store(Vs, tid, vv); }
    __syncthreads();
    for (int rnd = 0; rnd < nrnd; ++rnd) {
        const int item = att_item_of(rnd, xmap, xcd, xi), next = rnd + 1 < nrnd ? att_item_of(rnd + 1, xmap, xcd, xi) : -1;
        ATT_DECODE(item)
        const int tq = ((128 * bq + q0 + ql) << dsh) + r;
        f32x4 sacc[10];
#pragma unroll
        for (int t = 0; t < 10; ++t) sacc[t] = (f32x4){0.f, 0.f, 0.f, 0.f};
#pragma unroll
        for (int s = 0; s < 5; ++s)
#pragma unroll
            for (int u = 0; u < 2; ++u) { int kk = q0 + 32 * s + (ql >> 2) * 8 + u * 4 + (ql & 3); kk = kk > 255 ? 255 : kk;
                const LAS unsigned short* kp = Ks + kk * AT_KS + quad * 8;
#pragma unroll
                for (int ks = 0; ks < 4; ++ks) sacc[2 * s + u] = mfma16(*(const LAS bf16x8*)(kp + ks * 32), qf[ks], sacc[2 * s + u]); }
        __syncthreads();
        u32x4 kv[8], vv[8]; bf16x8 qn[4];
        if (next >= 0) { att_load_kv(U, next, tid, C_KA, kv); att_load_q(U, next, wave, lane, qn); }
        const float scale2 = 0.08838834764831845f * 1.4426950408889634f;
        float mx = -1e30f;
        int ql2 = ql, quad2 = quad; asm volatile("" : "+v"(ql2), "+v"(quad2));
        const LAS float* bp = biasS + (ql2 - 8 * quad2 + 32 + 128);
#pragma unroll
        for (int s = 0; s < 5; ++s)
#pragma unroll
            for (int u = 0; u < 2; ++u)
#pragma unroll
                for (int j = 0; j < 4; ++j) sacc[2 * s + u][j] = sacc[2 * s + u][j] * scale2 + bp[-(32 * s + 4 * u + j)];
        if (bq == 0) {
            const int t1 = 128 - q0 - 8 * quad2;
#pragma unroll
            for (int s = 0; s < 5; ++s)
#pragma unroll
                for (int u = 0; u < 2; ++u)
#pragma unroll
                    for (int j = 0; j < 4; ++j) sacc[2 * s + u][j] = (32 * s + 4 * u + j >= t1) ? sacc[2 * s + u][j] : -1e30f; }
#pragma unroll
        for (int t = 0; t < 10; ++t)
#pragma unroll
            for (int j = 0; j < 4; ++j) mx = fmaxf(mx, sacc[t][j]);
        mx = quad_max(mx);
        float l = 0.f;
#pragma unroll
        for (int t = 0; t < 10; ++t)
#pragma unroll
            for (int j = 0; j < 4; ++j) { const float e = __builtin_amdgcn_exp2f(sacc[t][j] - mx); sacc[t][j] = e; l += e; }
        l = quad_sum(l);
        if (next >= 0) att_load_kv(U, next, tid, C_VA, vv);
        f32x4 oacc[8];
#pragma unroll
        for (int nt = 0; nt < 8; ++nt) oacc[nt] = (f32x4){0.f, 0.f, 0.f, 0.f};
#pragma unroll
        for (int s = 0; s < 5; ++s) {
            u32x4 pw; pw.x = pk2(sacc[2 * s][0], sacc[2 * s][1]); pw.y = pk2(sacc[2 * s][2], sacc[2 * s][3]); pw.z = pk2(sacc[2 * s + 1][0], sacc[2 * s + 1][1]); pw.w = pk2(sacc[2 * s + 1][2], sacc[2 * s + 1][3]);
            const bf16x8 pf = __builtin_bit_cast(bf16x8, pw);
            int key0 = q0 + 32 * s + quad * 8; key0 = key0 > 248 ? 248 : key0;
            const LAS unsigned short* vp = Vs + key0 * AT_KS;
#pragma unroll
            for (int nt = 0; nt < 8; ++nt) oacc[nt] = mfma16(trfrag(vp + nt * 16, AT_KS, ql), pf, oacc[nt]);
        }
        const float inv = 1.f / l;
        bf16* OP = (bf16*)(p.ws + WS_OP) + (size_t)pat * SEQ * 2048 + (size_t)tq * 2048 + h * 128 + quad * 4;
#pragma unroll
        for (int nt = 0; nt < 8; ++nt) { u32x2 w; w.x = pk2(oacc[nt][0] * inv, oacc[nt][1] * inv); w.y = pk2(oacc[nt][2] * inv, oacc[nt][3] * inv); *(u32x2*)(OP + nt * 16) = w; }
        if (quad == 0) ((float*)(p.ws + WS_LSE))[((size_t)pat * SEQ + tq) * 16 + h] = (mx + __log2f(l)) * 0.6931471805599453f;
        if (next >= 0) att_store(Ks, tid, kv);
        __syncthreads();
        if (next >= 0) { att_store(Vs, tid, vv); att_bias(p, next, tid, biasS);
#pragma unroll
            for (int ks = 0; ks < 4; ++ks) qf[ks] = qn[ks]; }
        __syncthreads();
    }
}
DI void merge_phase(const Params& p, int tid) {
    const bf16* U = (const bf16*)(p.ws + WS_U);
    const bf16* OP = (const bf16*)(p.ws + WS_OP);
    const float* LSE = (const float*)(p.ws + WS_LSE);
    bf16* Y = (bf16*)(p.ws + WS_Y);
    const int gthreads = gridDim.x * NTHR;
    for (int idx0 = blk() * NTHR + tid; idx0 < SEQ * 256; idx0 += 4 * gthreads) {
        float l0[4], l1[4], l2[4]; u32x4 o0[4], o1[4], o2[4], z[4];
#pragma unroll
        for (int u = 0; u < 4; ++u) { int idx = idx0 + u * gthreads; idx = idx < SEQ * 256 ? idx : SEQ * 256 - 1;
            const int t = idx >> 8, c8 = idx & 255, h = c8 >> 4;
            l0[u] = LSE[(size_t)t * 16 + h]; l1[u] = LSE[((size_t)SEQ + t) * 16 + h]; l2[u] = LSE[((size_t)2 * SEQ + t) * 16 + h];
            const size_t o = (size_t)t * 2048 + c8 * 8;
            o0[u] = *(const u32x4*)(OP + o); o1[u] = *(const u32x4*)(OP + (size_t)SEQ * 2048 + o); o2[u] = *(const u32x4*)(OP + (size_t)2 * SEQ * 2048 + o);
            z[u] = *(const u32x4*)(U + (size_t)t * NU + C_ZA + c8 * 8); }
#pragma unroll
        for (int u = 0; u < 4; ++u) { const int idx = idx0 + u * gthreads;
            if (idx < SEQ * 256) { const int t = idx >> 8, c8 = idx & 255;
                const float M = fmaxf(l0[u], fmaxf(l1[u], l2[u]));
                float w0 = __expf(l0[u] - M), w1 = __expf(l1[u] - M), w2 = __expf(l2[u] - M);
                const float inv = 1.f / (w0 + w1 + w2); w0 *= inv; w1 *= inv; w2 *= inv;
                u32x4 y;
#pragma unroll
                for (int e = 0; e < 4; ++e) {
                    const float lo = (w0 * bf_lo(o0[u][e]) + w1 * bf_lo(o1[u][e]) + w2 * bf_lo(o2[u][e])) * silu_f(bf_lo(z[u][e]));
                    const float hi = (w0 * bf_hi(o0[u][e]) + w1 * bf_hi(o1[u][e]) + w2 * bf_hi(o2[u][e])) * silu_f(bf_hi(z[u][e]));
                    y[e] = pk2(lo, hi); }
                *(u32x4*)(Y + (size_t)t * DM + c8 * 8) = y; } }
    }
}

constexpr int M_KS = 264, M_VS3 = 520;
DI void conv8(const bf16* U, const float* cw, int t, int rawcol, int cch, float (&f)[8]) {
#pragma unroll
    for (int e = 0; e < 8; ++e) f[e] = 0.f;
#pragma unroll
    for (int j = 0; j < 4; ++j) { const int tt = t - 3 + j;
        if (tt >= 0) { const u32x4 raw = *(const u32x4*)(U + (size_t)tt * NU + rawcol);
            const f32x4 w0 = *(const f32x4*)(cw + j * 2048 + cch), w1 = *(const f32x4*)(cw + j * 2048 + cch + 4);
            f[0] += w0[0] * bf_lo(raw.x); f[1] += w0[1] * bf_hi(raw.x); f[2] += w0[2] * bf_lo(raw.y); f[3] += w0[3] * bf_hi(raw.y);
            f[4] += w1[0] * bf_lo(raw.z); f[5] += w1[1] * bf_hi(raw.z); f[6] += w1[2] * bf_lo(raw.w); f[7] += w1[3] * bf_hi(raw.w); } }
#pragma unroll
    for (int e = 0; e < 8; ++e) f[e] = silu_f(f[e]);
}
template <int NI, int MODE, int NB>
DI void conv_tile(const bf16* U, const float* cw, int t0, int rawcol0, int cch0, float sc, LAS unsigned short* dst, int tid, float bL, const LAS float* bS, const LAS float* liS, int roff) {
    const int ch = tid & 31, r0 = tid >> 5;
    f32x4 w[4][2];
#pragma unroll
    for (int j = 0; j < 4; ++j) { w[j][0] = *(const f32x4*)(cw + j * 2048 + cch0 + ch * 8); w[j][1] = *(const f32x4*)(cw + j * 2048 + cch0 + ch * 8 + 4); }
    const bf16* src = U + rawcol0 + ch * 8;
#pragma unroll
    for (int ib = 0; ib < NI; ib += NB) {
        u32x4 raw[NB][4];
#pragma unroll
        for (int i = 0; i < NB; ++i)
#pragma unroll
            for (int j = 0; j < 4; ++j) { const int tt = t0 + r0 + 16 * (ib + i) - 3 + j; const int tc = tt < 0 ? 0 : tt;
                raw[i][j] = *(const u32x4*)(src + (size_t)tc * NU); if (tt < 0) raw[i][j] = (u32x4){0u, 0u, 0u, 0u}; }
#pragma unroll
        for (int i = 0; i < NB; ++i) { const int row = r0 + 16 * (ib + i);
            float f[8];
#pragma unroll
            for (int e = 0; e < 8; ++e) f[e] = 0.f;
#pragma unroll
            for (int j = 0; j < 4; ++j) { const u32x4 rw = raw[i][j];
                f[0] += w[j][0][0] * bf_lo(rw.x); f[1] += w[j][0][1] * bf_hi(rw.x); f[2] += w[j][0][2] * bf_lo(rw.y); f[3] += w[j][0][3] * bf_hi(rw.y);
                f[4] += w[j][1][0] * bf_lo(rw.z); f[5] += w[j][1][1] * bf_hi(rw.z); f[6] += w[j][1][2] * bf_lo(rw.w); f[7] += w[j][1][3] * bf_hi(rw.w); }
            float m = sc;
            if (MODE == 1) m *= __expf(bL - bS[roff + row] + liS[roff + row]);
#pragma unroll
            for (int e = 0; e < 8; ++e) f[e] = silu_f(f[e]) * m;
            u32x4 o; o.x = pk2(f[0], f[1]); o.y = pk2(f[2], f[3]); o.z = pk2(f[4], f[5]); o.w = pk2(f[6], f[7]);
            *(LAS u32x4*)(dst + row * M_KS + ch * 8) = o; }
        __builtin_amdgcn_sched_barrier(0);
    }
}
DI void conv_prepass(const Params& p, int l, int tid) {
    const bf16* U = (const bf16*)(p.ws + WS_U);
    const float* cw = p.conv_w + (size_t)l * 4 * 2048;
    bf16* QKC = (bf16*)(p.ws + WS_QKC);
    for (int gid = blk() * NTHR + tid; gid < 256 * 512; gid += gridDim.x * NTHR) {
        const int cidx = gid & 255, t0 = (gid >> 8) * 16;
        f32x4 w[4][2];
#pragma unroll
        for (int j = 0; j < 4; ++j) { w[j][0] = *(const f32x4*)(cw + j * 2048 + cidx * 8); w[j][1] = *(const f32x4*)(cw + j * 2048 + cidx * 8 + 4); }
        const bf16* src = U + C_QM + cidx * 8;
        u32x4 raw[19];
#pragma unroll
        for (int i = 0; i < 19; ++i) { const int tt = t0 - 3 + i; const int tc = tt < 0 ? 0 : tt; raw[i] = *(const u32x4*)(src + (size_t)tc * NU); if (tt < 0) raw[i] = (u32x4){0u, 0u, 0u, 0u}; }
        const float sc = cidx >= 128 ? 0.0625f : 1.f;
#pragma unroll
        for (int i = 0; i < 16; ++i) {
            float f[8];
#pragma unroll
            for (int e = 0; e < 8; ++e) f[e] = 0.f;
#pragma unroll
            for (int j = 0; j < 4; ++j) { const u32x4 rw = raw[i + j];
                f[0] += w[j][0][0] * bf_lo(rw.x); f[1] += w[j][0][1] * bf_hi(rw.x); f[2] += w[j][0][2] * bf_lo(rw.y); f[3] += w[j][0][3] * bf_hi(rw.y);
                f[4] += w[j][1][0] * bf_lo(rw.z); f[5] += w[j][1][1] * bf_hi(rw.z); f[6] += w[j][1][2] * bf_lo(rw.w); f[7] += w[j][1][3] * bf_hi(rw.w); }
#pragma unroll
            for (int e = 0; e < 8; ++e) f[e] = silu_f(f[e]) * sc;
            u32x4 o; o.x = pk2(f[0], f[1]); o.y = pk2(f[2], f[3]); o.z = pk2(f[4], f[5]); o.w = pk2(f[6], f[7]);
            *(u32x4*)(QKC + (size_t)(t0 + i) * 2048 + cidx * 8) = o; }
    }
}
DI void chunk_gates(const float* gates, int c, int hh, LAS float* bS, LAS float* liS, LAS float* wtot, int tid, int wave, int lane) {
    float v = 0.f;
    if (tid < 256) { const float* gp = gates + (size_t)(c * 256 + tid) * 8; const float fgv = gp[4 + hh]; liS[tid] = gp[hh];
        v = fminf(fgv, 0.f) - log1pf(__expf(-fabsf(fgv)));
#pragma unroll
        for (int o = 1; o < 64; o <<= 1) { const float t = __shfl_up(v, o); if (lane >= o) v += t; }
        if (lane == 63) wtot[wave] = v; }
    __syncthreads();
    if (tid < 256) { float pre = 0.f; for (int w = 0; w < wave; ++w) pre += wtot[w]; bS[tid] = v + pre; }
    __syncthreads();
}
DI void m1_item(const Params& p, LAS unsigned char* lds, int l, int item, int tid, int wave, int lane) {
    asm volatile("" : "+v"(tid));
    const bf16* U = (const bf16*)(p.ws + WS_U);
    const bf16* QKC = (const bf16*)(p.ws + WS_QKC);
    LAS unsigned short* Kp = (LAS unsigned short*)lds;
    LAS unsigned short* Vs = Kp + 128 * M_KS;
    LAS float* bS = (LAS float*)(Vs + 128 * AT_KS); LAS float* liS = bS + 256; LAS float* wtot = liS + 256;
    const int hh = item >> 7, c = (item >> 2) & 31, sl = item & 3;
    const int ql = lane & 15, quad = lane >> 4;
    chunk_gates((const float*)(p.ws + WS_GATES), c, hh, bS, liS, wtot, tid, wave, lane);
    const float bL = bS[255];
    f32x4 acc[4][4];
#pragma unroll
    for (int a = 0; a < 4; ++a)
#pragma unroll
        for (int b = 0; b < 4; ++b) acc[a][b] = (f32x4){0.f, 0.f, 0.f, 0.f};
    f32x4 nacc[4];
#pragma unroll
    for (int b = 0; b < 4; ++b) nacc[b] = (f32x4){0.f, 0.f, 0.f, 0.f};
    const bool do_n = (sl == 0) && ((wave & 1) == 0);
    const bf16x8 ones = {0x3F80, 0x3F80, 0x3F80, 0x3F80, 0x3F80, 0x3F80, 0x3F80, 0x3F80};
    const int dvt0 = (wave & 1) * 4, dkt0 = (wave >> 1) * 4;
    for (int half = 0; half < 2; ++half) {
#pragma unroll
        for (int ib = 0; ib < 8; ib += 4) { u32x4 kr[4];
#pragma unroll
            for (int i = 0; i < 4; ++i) { const int cc = tid + NTHR * (ib + i), row = cc >> 5, ch = cc & 31; kr[i] = *(const u32x4*)(QKC + (size_t)(c * 256 + half * 128 + row) * 2048 + 1024 + hh * 256 + ch * 8); }
#pragma unroll
            for (int i = 0; i < 4; ++i) { const int cc = tid + NTHR * (ib + i), row = cc >> 5, ch = cc & 31, sloc = half * 128 + row;
                const float wgt = __expf(bL - bS[sloc] + liS[sloc]);
                u32x4 w; w.x = pk2(bf_lo(kr[i].x) * wgt, bf_hi(kr[i].x) * wgt); w.y = pk2(bf_lo(kr[i].y) * wgt, bf_hi(kr[i].y) * wgt); w.z = pk2(bf_lo(kr[i].z) * wgt, bf_hi(kr[i].z) * wgt); w.w = pk2(bf_lo(kr[i].w) * wgt, bf_hi(kr[i].w) * wgt);
                *(LAS u32x4*)(Kp + row * M_KS + ch * 8) = w; } }
#pragma unroll
        for (int i = 0; i < 4; ++i) { const int cc = tid + NTHR * i, row = cc >> 4, ch = cc & 15;
            *(LAS u32x4*)(Vs + row * AT_KS + ch * 8) = *(const u32x4*)(U + (size_t)(c * 256 + half * 128 + row) * NU + C_VM + hh * 512 + sl * 128 + ch * 8); }
        __syncthreads();
#pragma unroll 1
        for (int ks = 0; ks < 4; ++ks) {
            bf16x8 af[4], bfr[4];
#pragma unroll
            for (int a = 0; a < 4; ++a) af[a] = trfrag(Vs + (ks * 32 + quad * 8) * AT_KS + (dvt0 + a) * 16, AT_KS, ql);
#pragma unroll
            for (int b = 0; b < 4; ++b) bfr[b] = trfrag(Kp + (ks * 32 + quad * 8) * M_KS + (dkt0 + b) * 16, M_KS, ql);
#pragma unroll
            for (int a = 0; a < 4; ++a)
#pragma unroll
                for (int b = 0; b < 4; ++b) acc[a][b] = mfma16(af[a], bfr[b], acc[a][b]);
            if (do_n) {
#pragma unroll
                for (int b = 0; b < 4; ++b) nacc[b] = mfma16(ones, bfr[b], nacc[b]); }
        }
        __syncthreads();
    }
    float* DC = (float*)(p.ws + WS_DC) + ((size_t)(hh * 32 + c) * 512 + sl * 128) * 256;
#pragma unroll
    for (int a = 0; a < 4; ++a)
#pragma unroll
        for (int b = 0; b < 4; ++b)
#pragma unroll
            for (int j = 0; j < 4; ++j) DC[(size_t)((dvt0 + a) * 16 + quad * 4 + j) * 256 + (dkt0 + b) * 16 + ql] = acc[a][b][j];
    if (do_n && quad == 0) {
#pragma unroll
        for (int b = 0; b < 4; ++b) ((float*)(p.ws + WS_DN))[(hh * 32 + c) * 256 + (dkt0 + b) * 16 + ql] = nacc[b][0]; }
    if (sl == 0 && tid == 0) ((float*)(p.ws + WS_BL))[hh * 32 + c] = bL;
}
DI void m2_phase(const Params& p, int tid) {
    const float* DC = (const float*)(p.ws + WS_DC); const float* BL = (const float*)(p.ws + WS_BL);
    bf16* CS = (bf16*)(p.ws + WS_CS);
    const int gthreads = gridDim.x * NTHR, gid = blk() * NTHR + tid;
    for (int e4 = gid; e4 < 4 * 32768; e4 += gthreads) {
        const int hh = e4 >> 15, e = e4 & 32767;
        f32x4 st = {0.f, 0.f, 0.f, 0.f};
#pragma unroll 8
        for (int c = 0; c < 32; ++c) {
            const size_t o = ((size_t)(hh * 32 + c) * 32768 + e) * 4;
            u32x2 w; w.x = pk2(st.x, st.y); w.y = pk2(st.z, st.w); *(u32x2*)(CS + o) = w;
            const f32x4 d = *(const f32x4*)(DC + o);
            st = st * __expf(BL[hh * 32 + c]) + d;
        }
    }
    if (gid < 1024) { const int hh = gid >> 8, dk = gid & 255; const float* DN = (const float*)(p.ws + WS_DN); float* NS = (float*)(p.ws + WS_NS);
        float dn[32], eb[32];
#pragma unroll
        for (int c = 0; c < 32; ++c) { dn[c] = DN[(hh * 32 + c) * 256 + dk]; eb[c] = BL[hh * 32 + c]; }
        float st = 0.f;
#pragma unroll
        for (int c = 0; c < 32; ++c) { NS[(hh * 32 + c) * 256 + dk] = st; st = st * __expf(eb[c]) + dn[c]; } }
}
DI void m3_stage_load(const Params& p, int hh, int c, int st, int tid, u32x4 (&pre)[8]) {
    if (st < 4) { const bf16* CT = (const bf16*)(p.ws + WS_CS) + (size_t)(hh * 32 + c) * 512 * 256;
#pragma unroll
        for (int i = 0; i < 8; ++i) { const int cc = tid + NTHR * i, row = cc >> 5, ch = cc & 31;
            pre[i] = *(const u32x4*)(CT + (size_t)((row >> 6) * 256 + st * 64 + (row & 63)) * 256 + ch * 8); }
    } else { const int kt = (st - 4) >> 1, hb = (st - 4) & 1; const bf16* U = (const bf16*)(p.ws + WS_U); const bf16* QKC = (const bf16*)(p.ws + WS_QKC);
        if (hb == 0) {
#pragma unroll
            for (int i = 0; i < 4; ++i) { const int cc = tid + NTHR * i, row = cc >> 5, ch = cc & 31; pre[i] = *(const u32x4*)(QKC + (size_t)(c * 256 + kt * 64 + row) * 2048 + 1024 + hh * 256 + ch * 8); } }
#pragma unroll
        for (int i = 0; i < 4; ++i) { const int cc = tid + NTHR * i, row = 32 * hb + (cc >> 6), ch = cc & 63; pre[4 + i] = *(const u32x4*)(U + (size_t)(c * 256 + kt * 64 + row) * NU + C_VM + hh * 512 + ch * 8); }
    }
}
DI void m3_stage_store(int st, int tid, const u32x4 (&pre)[8], LAS unsigned short* Ks, LAS unsigned short* Vs) {
    if (st < 4) {
#pragma unroll
        for (int i = 0; i < 8; ++i) { const int cc = tid + NTHR * i, row = cc >> 5, ch = cc & 31; *(LAS u32x4*)(Ks + row * M_KS + ch * 8) = pre[i]; }
    } else { const int hb = (st - 4) & 1;
        if (hb == 0) {
#pragma unroll
            for (int i = 0; i < 4; ++i) { const int cc = tid + NTHR * i, row = cc >> 5, ch = cc & 31; *(LAS u32x4*)(Ks + row * M_KS + ch * 8) = pre[i]; } }
#pragma unroll
        for (int i = 0; i < 4; ++i) { const int cc = tid + NTHR * i, row = 32 * hb + (cc >> 6), ch = cc & 63; *(LAS u32x4*)(Vs + row * M_VS3 + ch * 8) = pre[4 + i]; }
    }
}
DI void m3_item(const Params& p, LAS unsigned char* lds, int l, int hh, int qb, int tid, int wave, int lane) {
    asm volatile("" : "+v"(tid));
    const bf16* U = (const bf16*)(p.ws + WS_U);
    const bf16* QKC = (const bf16*)(p.ws + WS_QKC);
    LAS unsigned short* Qs = (LAS unsigned short*)lds;
    LAS unsigned short* Ks = Qs + 64 * M_KS;
    LAS unsigned short* Vs = Ks + 64 * M_KS;
    LAS float* bS = (LAS float*)(Vs + 64 * M_VS3); LAS float* liS = bS + 256; LAS float* nS = liS + 256; LAS float* wtot = nS + 256; LAS float* ssS = wtot + 8;
    const int c = qb >> 2, jq = qb & 3;
    const int ql = lane & 15, quad = lane >> 4;
    TS_MARK(99);
    u32x4 pre[8];
    u32x4 qv[4];
#pragma unroll
    for (int i = 0; i < 4; ++i) { const int cc = tid + NTHR * i, row = cc >> 5, ch = cc & 31; qv[i] = *(const u32x4*)(QKC + (size_t)(qb * 64 + row) * 2048 + hh * 256 + ch * 8); }
    m3_stage_load(p, hh, c, 0, tid, pre);
    if (tid < 256) nS[tid] = ((const float*)(p.ws + WS_NS))[(hh * 32 + c) * 256 + tid];
    chunk_gates((const float*)(p.ws + WS_GATES), c, hh, bS, liS, wtot, tid, wave, lane);
#pragma unroll
    for (int i = 0; i < 4; ++i) { const int cc = tid + NTHR * i, row = cc >> 5, ch = cc & 31; *(LAS u32x4*)(Qs + row * M_KS + ch * 8) = qv[i]; }
    __syncthreads();
    const int qg = wave & 3, dvh = wave >> 2, q = qg * 16 + ql, iq = jq * 64 + q;
    const LAS unsigned short* qrow = Qs + q * M_KS + quad * 8;
    const float b_ref = bS[jq * 64], e_ref = __expf(b_ref), ebq = __expf(bS[iq] - b_ref);
    f32x4 acc[16];
#pragma unroll
    for (int nt = 0; nt < 16; ++nt) acc[nt] = (f32x4){0.f, 0.f, 0.f, 0.f};
    float nq;
    { float nqp = 0.f;
#pragma unroll
      for (int ks = 0; ks < 8; ++ks) { const bf16x8 qk = *(const LAS bf16x8*)(qrow + ks * 32);
#pragma unroll
          for (int j = 0; j < 8; ++j) nqp += bf2f((unsigned short)qk[j]) * nS[ks * 32 + quad * 8 + j]; }
      nq = quad_sum(nqp) * e_ref; }
    float nqi = 0.f;
    TS_MARK(10);
    const int nst = 4 + 2 * (jq + 1);
    bf16x8 pf1 = {0, 0, 0, 0, 0, 0, 0, 0};
#pragma unroll 1
    for (int st = 0; st < nst; ++st) {
        __syncthreads();
        int tid2 = tid; asm volatile("" : "+v"(tid2));
        m3_stage_store(st, tid2, pre, Ks, Vs);
        __syncthreads();
        if (st + 1 < nst) m3_stage_load(p, hh, c, st + 1, tid2, pre);
        if (st < 4) {
            bf16x8 qf[8];
#pragma unroll
            for (int ks = 0; ks < 8; ++ks) qf[ks] = *(const LAS bf16x8*)(qrow + ks * 32);
#pragma unroll
            for (int n4 = 0; n4 < 4; ++n4) { const LAS unsigned short* cp = Ks + (dvh * 64 + n4 * 16 + ql) * M_KS + quad * 8;
#pragma unroll
                for (int ks = 0; ks < 8; ++ks) acc[n4] = mfma16(*(const LAS bf16x8*)(cp + ks * 32), qf[ks], acc[n4]);
                __builtin_amdgcn_sched_barrier(0); }
            { const f32x4 t0 = acc[0], t1 = acc[1], t2 = acc[2], t3 = acc[3];
#pragma unroll
              for (int i = 0; i < 12; ++i) acc[i] = acc[i + 4];
              acc[12] = t0; acc[13] = t1; acc[14] = t2; acc[15] = t3; }
            if (st == 3) {
#pragma unroll
                for (int nt = 0; nt < 16; ++nt) acc[nt] = acc[nt] * e_ref;
                TS_MARK(11); }
        } else {
            const int kt = (st - 4) >> 1, hb = (st - 4) & 1;
            bf16x8 pf;
            if (hb == 0) {
                bf16x8 qf[8];
#pragma unroll
                for (int ks = 0; ks < 8; ++ks) qf[ks] = *(const LAS bf16x8*)(qrow + ks * 32);
                f32x4 sacc[4];
#pragma unroll
                for (int t = 0; t < 4; ++t) sacc[t] = (f32x4){0.f, 0.f, 0.f, 0.f};
#pragma unroll
                for (int s2 = 0; s2 < 2; ++s2)
#pragma unroll
                    for (int u = 0; u < 2; ++u) { const int krow = 32 * s2 + (ql >> 2) * 8 + u * 4 + (ql & 3);
                        const LAS unsigned short* kp = Ks + krow * M_KS + quad * 8;
#pragma unroll
                        for (int ks = 0; ks < 8; ++ks) sacc[2 * s2 + u] = mfma16(*(const LAS bf16x8*)(kp + ks * 32), qf[ks], sacc[2 * s2 + u]); }
#pragma unroll
                for (int s2 = 0; s2 < 2; ++s2)
#pragma unroll
                    for (int u = 0; u < 2; ++u)
#pragma unroll
                        for (int j = 0; j < 4; ++j) { const int sk = kt * 64 + 32 * s2 + quad * 8 + u * 4 + j;
                            const float w = (sk <= iq) ? __expf(b_ref - bS[sk] + liS[sk]) : 0.f;
                            const float pv = sacc[2 * s2 + u][j] * w; sacc[2 * s2 + u][j] = pv; nqi += pv; }
                u32x4 pw; pw.x = pk2(sacc[0][0], sacc[0][1]); pw.y = pk2(sacc[0][2], sacc[0][3]); pw.z = pk2(sacc[1][0], sacc[1][1]); pw.w = pk2(sacc[1][2], sacc[1][3]);
                pf = __builtin_bit_cast(bf16x8, pw);
                u32x4 pw1; pw1.x = pk2(sacc[2][0], sacc[2][1]); pw1.y = pk2(sacc[2][2], sacc[2][3]); pw1.z = pk2(sacc[3][0], sacc[3][1]); pw1.w = pk2(sacc[3][2], sacc[3][3]);
                pf1 = __builtin_bit_cast(bf16x8, pw1);
            } else pf = pf1;
            const LAS unsigned short* vp = Vs + (32 * hb + quad * 8) * M_VS3 + dvh * 256;
#pragma unroll
            for (int nt = 0; nt < 16; ++nt) { acc[nt] = mfma16(trfrag(vp + nt * 16, M_VS3, ql), pf, acc[nt]); if ((nt & 3) == 3) __builtin_amdgcn_sched_barrier(0); }
        }
    }
    TS_MARK(12);
    nq = (nq + quad_sum(nqi)) * ebq;
#pragma unroll
    for (int nt = 0; nt < 16; ++nt) acc[nt] = acc[nt] * ebq;
    const float inv = 1.f / fmaxf(fabsf(nq), 1.f);
    float ss = 0.f;
#pragma unroll
    for (int nt = 0; nt < 16; ++nt) { acc[nt] = acc[nt] * inv; ss += (acc[nt][0] * acc[nt][0] + acc[nt][1] * acc[nt][1]) + (acc[nt][2] * acc[nt][2] + acc[nt][3] * acc[nt][3]); }
    ss = quad_sum(ss);
    if (quad == 0) ssS[dvh * 64 + q] = ss;
    __syncthreads();
    const float rstd = rsqrtf((ssS[q] + ssS[64 + q]) * (1.f / 512.f) + NORM_EPS);
    LAS unsigned short* Hs = Vs;
#pragma unroll
    for (int nt = 0; nt < 16; ++nt) { u32x2 w; w.x = pk2(acc[nt][0] * rstd, acc[nt][1] * rstd); w.y = pk2(acc[nt][2] * rstd, acc[nt][3] * rstd);
        *(LAS u32x2*)(Hs + q * M_VS3 + dvh * 256 + nt * 16 + quad * 4) = w; }
    __syncthreads();
    const float* ng = p.mnorm_g + l * 2048 + hh * 512;
    bf16* Y = (bf16*)(p.ws + WS_Y);
#pragma unroll
    for (int ib = 0; ib < 8; ib += 2) {
        u32x4 omv[2], zmv[2]; f32x4 g0[2], g1[2];
#pragma unroll
        for (int i = 0; i < 2; ++i) { const int cc = tid + NTHR * (ib + i), row = cc >> 6, ch = cc & 63; const bf16* up = U + (size_t)(qb * 64 + row) * NU + hh * 512 + ch * 8;
            omv[i] = *(const u32x4*)(up + C_OM); zmv[i] = *(const u32x4*)(up + C_ZM); g0[i] = *(const f32x4*)(ng + ch * 8); g1[i] = *(const f32x4*)(ng + ch * 8 + 4); }
#pragma unroll
        for (int i = 0; i < 2; ++i) { const int cc = tid + NTHR * (ib + i), row = cc >> 6, ch = cc & 63;
            const u32x4 hv = *(const LAS u32x4*)(Hs + row * M_VS3 + ch * 8);
            u32x4 y;
            y.x = pk2(bf_lo(hv.x) * g0[i][0] * sigm_f(bf_lo(omv[i].x)) * silu_f(bf_lo(zmv[i].x)), bf_hi(hv.x) * g0[i][1] * sigm_f(bf_hi(omv[i].x)) * silu_f(bf_hi(zmv[i].x)));
            y.y = pk2(bf_lo(hv.y) * g0[i][2] * sigm_f(bf_lo(omv[i].y)) * silu_f(bf_lo(zmv[i].y)), bf_hi(hv.y) * g0[i][3] * sigm_f(bf_hi(omv[i].y)) * silu_f(bf_hi(zmv[i].y)));
            y.z = pk2(bf_lo(hv.z) * g1[i][0] * sigm_f(bf_lo(omv[i].z)) * silu_f(bf_lo(zmv[i].z)), bf_hi(hv.z) * g1[i][1] * sigm_f(bf_hi(omv[i].z)) * silu_f(bf_hi(zmv[i].z)));
            y.w = pk2(bf_lo(hv.w) * g1[i][2] * sigm_f(bf_lo(omv[i].w)) * silu_f(bf_lo(zmv[i].w)), bf_hi(hv.w) * g1[i][3] * sigm_f(bf_hi(omv[i].w)) * silu_f(bf_hi(zmv[i].w)));
            *(u32x4*)(Y + (size_t)(qb * 64 + row) * DM + 2048 + hh * 512 + ch * 8) = y; }
        __builtin_amdgcn_sched_barrier(0);
    }
    __syncthreads();
    TS_MARK(13);
}

#define RLX_AGENT __ATOMIC_RELAXED, __HIP_MEMORY_SCOPE_AGENT
#define XB_TMO      128
#define XB_XCNT(j)  (256  + 64 * (j))
#define XB_XSUB(j)  (1280 + 64 * (j))
#define XB_XGEN(j)  (2304 + 64 * (j))
#define XB_TOP      3328
#define XB_TOPGEN   3392
#define XCD_BAR_WORDS 3456
#define XB_SPIN_CAP (1u << 18)

__device__ __forceinline__ unsigned xb_ld(unsigned* p)              { return __hip_atomic_load(p, __ATOMIC_RELAXED, __HIP_MEMORY_SCOPE_AGENT); }
__device__ __forceinline__ unsigned xb_add(unsigned* p, unsigned v) { return __hip_atomic_fetch_add(p, v, __ATOMIC_RELAXED, __HIP_MEMORY_SCOPE_AGENT); }
__device__ __forceinline__ unsigned xb_xcc_id() { return (unsigned)__builtin_amdgcn_s_getreg((3 << 11) | 20) & 0xFu; }
#define XB_SPIN(cond, bar) do { unsigned _sp = 0; while (cond) { __builtin_amdgcn_s_sleep(1); \
    if ((++_sp & 255u) == 0u) { if (xb_ld(&(bar)[XB_TMO])) break; if (_sp > XB_SPIN_CAP) { atomicAdd(&(bar)[XB_TMO], 1u); break; } } } } while (0)

struct XcdBarrier {
    unsigned* bar; unsigned x;
    volatile LAS unsigned* st;
};

__device__ __forceinline__ XcdBarrier xcd_barrier_post(unsigned* bar, volatile LAS unsigned* st) {
    XcdBarrier b; b.bar = bar; b.x = xb_xcc_id(); b.st = st;
    if (threadIdx.x == 0) (void)xb_add(&bar[XB_XCNT(b.x)], 1u);
    return b;
}
__device__ __forceinline__ void xcd_barrier_complete(unsigned* bar, unsigned x, unsigned& nloc, unsigned& nx) {
    const unsigned G = gridDim.x * gridDim.y * gridDim.z;
    unsigned sum, cnt, mine, sp = 0u;
    for (;;) {
        sum = 0u; cnt = 0u; mine = 0u;
#pragma unroll
        for (unsigned j = 0; j < 16; ++j) { const unsigned c = xb_ld(&bar[XB_XCNT(j)]); sum += c; cnt += (c > 0u) ? 1u : 0u; mine = (j == x) ? c : mine; }
        if (sum == G) break;
        __builtin_amdgcn_s_sleep(1);
        if ((++sp & 255u) == 0u) { if (xb_ld(&bar[XB_TMO])) break; if (sp > XB_SPIN_CAP) { atomicAdd(&bar[XB_TMO], 1u); break; } }
    }
    nloc = mine > 0u ? mine : 1u; nx = cnt > 0u ? cnt : 1u;
}

__device__ __forceinline__ void xcd_barrier(const XcdBarrier& b) {
    asm volatile("s_waitcnt vmcnt(0)" ::: "memory");
    __syncthreads();
    if (threadIdx.x == 0) {
        unsigned* bar = b.bar;
        __builtin_amdgcn_s_waitcnt(0);
        unsigned nloc = b.st[0], nx = b.st[1];
        if (nloc == 0u) { xcd_barrier_complete(bar, b.x, nloc, nx); b.st[0] = nloc; b.st[1] = nx; }
        const unsigned old = xb_add(&bar[XB_XSUB(b.x)], 1u);
        const unsigned gen = old / nloc;
        if (old + 1u == (gen + 1u) * nloc) {
            __builtin_amdgcn_fence(__ATOMIC_RELEASE, "agent");
            asm volatile("s_waitcnt vmcnt(0)" ::: "memory");
            const unsigned og = xb_add(&bar[XB_TOP], 1u);
            const unsigned tg = og / nx;
            if (og + 1u == (tg + 1u) * nx) xb_add(&bar[XB_TOPGEN], 1u);
            else XB_SPIN(xb_ld(&bar[XB_TOPGEN]) == tg, bar);
            __builtin_amdgcn_fence(__ATOMIC_ACQUIRE, "agent");
            xb_add(&bar[XB_XGEN(b.x)], 1u);
            asm volatile("s_waitcnt vmcnt(0)" ::: "memory");
        } else {
            XB_SPIN(xb_ld(&bar[XB_XGEN(b.x)]) == gen, bar);
            __builtin_amdgcn_fence(__ATOMIC_ACQUIRE, "agent");
            asm volatile("s_waitcnt vmcnt(0)" ::: "memory");
        }
    }
    __syncthreads();
}

#if TSEL >= 7
#define TSUB_BEGIN(k) unsigned long long tsub_b = 0; if ((TSEL) == (k) && threadIdx.x == 0) tsub_b = __builtin_amdgcn_s_memrealtime();
#define TSUB_END(k) if ((TSEL) == (k) && threadIdx.x == 0) { volatile LAS unsigned long long* TWs = (volatile LAS unsigned long long*)((LAS unsigned char*)lds_raw + LDS_BARST + 16); TWs[2] += __builtin_amdgcn_s_memrealtime() - tsub_b; }
#else
#define TSUB_BEGIN(k)
#define TSUB_END(k)
#endif
constexpr int NPH = 15;
__global__ void __launch_bounds__(NTHR, 2) hymba_fwd(Params p0) {
    extern __shared__ __attribute__((aligned(16))) unsigned char lds_raw[];
    cg::grid_group grid = cg::this_grid();
    if (threadIdx.x < 16) ((LAS unsigned*)((LAS unsigned char*)lds_raw + LDS_BARST))[threadIdx.x] = 0u;
    __syncthreads();
    XcdBarrier bar = xcd_barrier_post((unsigned*)(p0.ws + WS_CTL), (volatile LAS unsigned*)((LAS unsigned char*)lds_raw + LDS_BARST));
#if TSEL >= 0
    volatile LAS unsigned long long* TW = (volatile LAS unsigned long long*)((LAS unsigned char*)lds_raw + LDS_BARST + 16);
    if (threadIdx.x == 0) { const unsigned long long t = __builtin_amdgcn_s_memrealtime(); TW[0] = t; TW[1] = t; TW[2] = 0; }
#endif
    for (int ph = p0.ph_lo; ph < p0.ph_hi; ++ph) {
        const int ptype = ph == 0 ? 0 : 1 + (ph - 1) % 7;
        const int nrep = (REPEAT_MASK) == 0 ? 1 : ((((REPEAT_MASK) >> ptype) & 1) ? 2 : 1);
        for (int rep = 0; rep < nrep; ++rep) {
        int tid = threadIdx.x; asm volatile("" : "+v"(tid));
        int G = gridDim.x; asm volatile("" : "+s"(G));
        const int lane = tid & 63, wave = __builtin_amdgcn_readfirstlane(tid >> 6);
        LAS unsigned char* lds = (LAS unsigned char*)lds_raw; asm volatile("" : "+s"(lds));
        Params p = p0;
        asm volatile("" : "+s"(p.ws)); asm volatile("" : "+s"(p.x)); asm volatile("" : "+s"(p.out)); asm volatile("" : "+s"(p.w_in)); asm volatile("" : "+s"(p.w_out));
        asm volatile("" : "+s"(p.conv_w)); asm volatile("" : "+s"(p.norm_g)); asm volatile("" : "+s"(p.mnorm_g)); asm volatile("" : "+s"(p.b_gate)); asm volatile("" : "+s"(p.rel_bias)); asm volatile("" : "+s"(p.final_g));
        if (ph == 0) {
            prologue_transposes(p, lds, wave, lane);
            build_wgt(p, tid);
            norm_phase(p, p.x, 0, wave, lane);
        } else {
            const int l = (ph - 1) / 7, k = (ph - 1) % 7;
            if (k == 0) {
                pg8::Gemm g{(const pg8::bf16_t*)(p.ws + WS_XN), (const pg8::bf16_t*)(p.ws + WS_WIN + (size_t)l * 128 * MiB), SEQ, NU, DM};
                pg8::StaticOrder S; S.init(SEQ, NU, G, blk());
                pg8::EpiBf16Plain E{(pg8::bf16_t*)(p.ws + WS_U), NU};
                pg8::gemm_phase<pg8::EpiBf16Plain, pg8::StaticOrder, true, true>(lds, g, S, E);
            } else if (k == 1) {
                gate_items(p, lds, l, tid, wave, lane);
                conv_prepass(p, l, tid);
                attn_phase(p, lds, tid, wave, lane);
            } else if (k == 2) {
                const bool xmap = (G == 256); const int xcd = blk() & 7, xi = blk() >> 3;
                int tid3 = tid; asm volatile("" : "+v"(tid3));
                { TSUB_BEGIN(8)
                for (int rr = 0; rr < 1 + (REP_M1); ++rr)
                for (int it = blk(), rnd = 0; it < 512; it += G, ++rnd) {
                    int item = it;
                    if (xmap) item = (xcd * 16 + rnd * 8 + (xi >> 2)) * 4 + (xi & 3);
                    m1_item(p, lds, l, item, tid3, __builtin_amdgcn_readfirstlane(tid3 >> 6), tid3 & 63); __syncthreads(); }
                TSUB_END(8) }
                merge_phase(p, tid);
            } else if (k == 3) {
                m2_phase(p, tid);
            } else if (k == 4) {
                const bool xmap = (G == 256); const int xcd = blk() & 7, xi = blk() >> 3;
                TSUB_BEGIN(9)
                for (int it = blk(), rnd = 0; it < 512; it += G, ++rnd) {
                    int hh = it >> 7, qb = it & 127; if ((it >> 8) & 1) qb ^= 3;
                    if (xmap) { const int pair = xcd * 16 + rnd * 8 + (xi >> 2); hh = pair >> 5; qb = (pair & 31) * 4 + (rnd ? 3 - (xi & 3) : (xi & 3)); }
                    m3_item(p, lds, l, hh, qb, tid, wave, lane); }
                TSUB_END(9)
            } else if (k == 5) {
                pg8::Gemm g{(const pg8::bf16_t*)(p.ws + WS_Y), (const pg8::bf16_t*)(p.ws + WS_WOUT + (size_t)l * 32 * MiB), SEQ, DM, DM};
                pg8::StaticOrder S; S.init(SEQ, DM, G, blk());
                pg8::EpiResF32 E{l == 0 ? p.x : (const float*)(p.ws + WS_X1), l == 0 ? (float*)(p.ws + WS_X1) : p.out, DM};
                pg8::gemm_phase<pg8::EpiResF32, pg8::StaticOrder, true, true>(lds, g, S, E);
            } else {
                if (l == 0) norm_phase(p, (const float*)(p.ws + WS_X1), 1, wave, lane);
                else final_norm_phase(p, (LAS unsigned char*)lds_raw, wave, lane);
            }
        }
        __syncthreads();
        }
        if (ph + 1 < p0.ph_hi) { if (p0.ph_hi > NPH) grid.sync(); else xcd_barrier(bar); }
#if TSEL >= 0
        if (threadIdx.x == 0) { const unsigned long long now = __builtin_amdgcn_s_memrealtime(); if (ptype == (TSEL)) TW[2] += now - TW[1]; TW[1] = now;
          if (ph + 2 == p0.ph_hi) ((volatile LAS int*)TW)[8] = (int)((float)TW[2] / (float)(now - TW[0]) * 131072.f); }
        if (ph + 2 == p0.ph_hi) __syncthreads();
#endif
    }
}

extern "C" void kernel_launch(void* const* d_in, const int* in_sizes, int n_in, void* d_out, int out_size, void* d_ws, size_t ws_size, hipStream_t stream) {
    static int grid = 0;
    if (grid == 0) {
        if (n_in != 9 || in_sizes[0] != SEQ * DM || out_size != SEQ * DM || ws_size < WS_END) {
            fprintf(stderr, "kernel_launch: unexpected problem: n_in %d in0 %d out %d ws %zu (need %zu)\n", n_in, n_in > 0 ? in_sizes[0] : -1, out_size, ws_size, (size_t)WS_END); grid = -1; return; }
        int dev = 0, cus = 0, per_cu = 0;
        hipGetDevice(&dev);
        hipDeviceGetAttribute(&cus, hipDeviceAttributeMultiprocessorCount, dev);
        if (hipFuncSetAttribute((const void*)hymba_fwd, hipFuncAttributeMaxDynamicSharedMemorySize, LDS_BYTES) != hipSuccess) { fprintf(stderr, "kernel_launch: hipFuncSetAttribute failed\n"); grid = -1; return; }
        if (hipOccupancyMaxActiveBlocksPerMultiprocessor(&per_cu, (const void*)hymba_fwd, NTHR, LDS_BYTES) != hipSuccess || per_cu < 1) { fprintf(stderr, "kernel_launch: occupancy query gave %d\n", per_cu); per_cu = 1; }
        (void)hipGetLastError();
        grid = cus * per_cu;
        fprintf(stderr, "kernel_launch: %d CUs x %d = grid %d\n", cus, per_cu, grid);
    }
    if (grid < 0) return;
    if (hipMemsetAsync((char*)d_ws + WS_CTL, 0, 16384, stream) != hipSuccess) { fprintf(stderr, "kernel_launch: hipMemsetAsync failed\n"); return; }
    Params p{};
    p.x = (const float*)d_in[0]; p.norm_g = (const float*)d_in[1]; p.w_in = (const float*)d_in[2]; p.b_gate = (const float*)d_in[3]; p.conv_w = (const float*)d_in[4];
    p.mnorm_g = (const float*)d_in[5]; p.w_out = (const float*)d_in[6]; p.rel_bias = (const float*)d_in[7]; p.final_g = (const float*)d_in[8];
    p.out = (float*)d_out; p.ws = (unsigned char*)d_ws;
#if MULTI_LAUNCH
    for (int ph = 0; ph < NPH; ++ph) { p.ph_lo = ph; p.ph_hi = ph + 1; hipLaunchKernelGGL(hymba_fwd, dim3(grid), dim3(NTHR), LDS_BYTES, stream, p); }
#else
    p.ph_lo = 0; p.ph_hi = NPH;
    void* args[] = {&p};
    hipError_t e = hipLaunchCooperativeKernel((const void*)hymba_fwd, dim3(grid), dim3(NTHR), args, LDS_BYTES, stream);
    if (e != hipSuccess) fprintf(stderr, "kernel_launch: cooperative launch failed: %s (grid %d)\n", hipGetErrorString(e), grid);
#endif
}
```

```cpp
#include <hip/hip_runtime.h>
#include <hip/hip_cooperative_groups.h>
#include <cstdio>
#include <cstdint>
namespace cg = cooperative_groups;
namespace pg8 {
#define PG8_LAS __attribute__((address_space(3)))
typedef unsigned short bf16_t;
typedef short bf16x8 __attribute__((ext_vector_type(8)));
typedef float f32x4 __attribute__((ext_vector_type(4)));
typedef unsigned u32x4 __attribute__((ext_vector_type(4)));
constexpr int BM = 256, BK = 64, HALF = 128, HTB = HALF * BK * 2  , STAGE_BYTES = 8 * HTB, NXCD = 8, WGM = 8;

__host__ __device__ __forceinline__ int lds_byte(int r, int c) { const int st = (r >> 4) * 2 + (c >> 5), rr = r & 15, cc = c & 31, ob = rr * 64 + cc * 2; return st * 1024 + (ob ^ (((ob >> 9) & 1) << 5)); }
__host__ __device__ __forceinline__ void stage_rc(int b, int& R, int& C) { const int st = b / 1024, sb = b % 1024, swz = sb ^ (((sb >> 9) & 1) << 5); R = (st >> 1) * 16 + swz / 64; C = (st & 1) * 32 + (swz % 64) / 2; }
__host__ __device__ __forceinline__ int perm32(int rho) { const int n = rho >> 4, i = rho & 15; return 8 * (i >> 2) + 4 * n + (i & 3); }

struct Unit { int pm, pn; };
struct Gemm { const bf16_t* A; const bf16_t* Bt; int M, N, K; };

struct StaticOrder {
    int nM, nN, nwg, G, c;
    __host__ __device__ void init(int M, int N, int G_, int c_) { nM = M / BM; nN = N / BM; nwg = nM * nN; G = G_; c = c_; }
    __host__ __device__ bool next(int i, Unit& u) const {
        const long L = (long)i * G + c; if (L >= nwg) return false;
        int wgid = (int)L; { const int q = nwg / NXCD, r = nwg % NXCD, xcd = wgid % NXCD, off = wgid / NXCD; wgid = (xcd < r ? xcd * (q + 1) : r * (q + 1) + (xcd - r) * q) + off; }
        const int nig = WGM * nN, gid = wgid / nig, fm = gid * WGM, gsz = (nM - fm) < WGM ? (nM - fm) : WGM;
        u.pm = fm + ((wgid % nig) % gsz); u.pn = (wgid % nig) / gsz; return true;
    }
    __device__ __forceinline__ void a_ready(const Unit&) const {}
    __device__ __forceinline__ void done(const Unit&) const {}
};

__device__ __forceinline__ unsigned cvt_pk_bf16(float lo, float hi) { unsigned r; asm volatile("v_cvt_pk_bf16_f32 %0, %1, %2" : "=v"(r) : "v"(lo), "v"(hi)); return r; }
struct EpiBf16Plain {
    static constexpr bool PERM = true, AFTER_DRAIN = false;
    bf16_t* O; int ldc;
    __device__ __forceinline__ void operator()(const f32x4 (&acc)[2][2][4][2], const Unit& u, int wr, int wc, int fr, int fq) const {
        const int row0 = u.pm * BM + wr * 64 + fr; const int col0 = u.pn * BM + wc * 32 + 8 * fq;
#pragma unroll
        for (int ai = 0; ai < 2; ++ai)
#pragma unroll
            for (int m = 0; m < 4; ++m) { bf16_t* rowp = O + (size_t)(row0 + ai * HALF + m * 16) * ldc + col0;
#pragma unroll
                for (int bj = 0; bj < 2; ++bj) { const f32x4 v0 = acc[ai][bj][m][0], v1 = acc[ai][bj][m][1];
                    u32x4 w; w.x = cvt_pk_bf16(v0[0], v0[1]); w.y = cvt_pk_bf16(v0[2], v0[3]); w.z = cvt_pk_bf16(v1[0], v1[1]); w.w = cvt_pk_bf16(v1[2], v1[3]);
                    *(u32x4*)(rowp + bj * HALF) = w; } }
    }
};
struct EpiResF32 {
    static constexpr bool PERM = true, AFTER_DRAIN = false;
    const float* base; float* out; int ld;
    __device__ __forceinline__ void operator()(const f32x4 (&acc)[2][2][4][2], const Unit& u, int wr, int wc, int fr, int fq) const {
        const int row0 = u.pm * BM + wr * 64 + fr; const int col0 = u.pn * BM + wc * 32 + 8 * fq;
#pragma unroll
        for (int ai = 0; ai < 2; ++ai)
#pragma unroll
            for (int m = 0; m < 4; ++m) { const size_t ro = (size_t)(row0 + ai * HALF + m * 16) * ld + col0;
#pragma unroll
                for (int bj = 0; bj < 2; ++bj) {
                    const f32x4 b0 = *(const f32x4*)(base + ro + bj * HALF), b1 = *(const f32x4*)(base + ro + bj * HALF + 4);
                    *(f32x4*)(out + ro + bj * HALF) = acc[ai][bj][m][0] + b0;
                    *(f32x4*)(out + ro + bj * HALF + 4) = acc[ai][bj][m][1] + b1; } }
    }
};
template <class Epi, class Sched, bool ALIGN_EPI = false, bool SP2 = false>
__device__ __forceinline__ void gemm_phase(PG8_LAS unsigned char* lds, const Gemm g, const Sched& S, const Epi& E) {
    int tid = threadIdx.x; asm volatile("" : "+v"(tid));
    const int wid = __builtin_amdgcn_readfirstlane(tid >> 6), lane = tid & 63, wr = wid >> 2, wc = wid & 3, fr = lane & 15, fq = lane >> 4;
    const int K = g.K, nt = K / BK;
    unsigned voffA[2], voffB[2];
#pragma unroll
    for (int i = 0; i < 2; ++i) { int R, C; stage_rc(tid * 16 + i * 8192, R, C); const int Rb = Epi::PERM ? ((R & ~31) + perm32(R & 31)) : R;
        voffA[i] = (unsigned)(R * K + C) * 2u; voffB[i] = (unsigned)(Rb * K + C) * 2u; }
    const size_t kstep = (size_t)(BK * 2);
    const size_t hstep = (size_t)HALF * K * 2;
    const size_t tstep = 2 * hstep;
    const unsigned ldsw = (unsigned)wid * 1024u;
    const int aoff = lds_byte(wr * 64 + fr, fq * 8), boff = lds_byte(wc * 32 + fr, fq * 8);
#define PG8_SA(b, h) (((b) * 2 + (h)) * HTB)
#define PG8_SB(b, h) ((4 + (b) * 2 + (h)) * HTB)
#define PG8_STAGE(bufoff, gbase, voff) do { _Pragma("unroll") for (int _i = 0; _i < 2; ++_i) \
        __builtin_amdgcn_global_load_lds((const unsigned*)((const char*)(gbase) + (voff)[_i]), (PG8_LAS unsigned*)(lds + (bufoff) + ldsw + _i * 8192), 16, 0, 0); } while (0)
#define PG8_LDA(dst, b, h) do { _Pragma("unroll") for (int m = 0; m < 4; ++m) _Pragma("unroll") for (int k = 0; k < 2; ++k) dst[m][k] = *(const PG8_LAS bf16x8*)(lds + PG8_SA(b, h) + aoff + m * 2048 + k * 1024); } while (0)
#define PG8_LDB(dst, b, h) do { _Pragma("unroll") for (int n = 0; n < 2; ++n) _Pragma("unroll") for (int k = 0; k < 2; ++k) dst[n][k] = *(const PG8_LAS bf16x8*)(lds + PG8_SB(b, h) + boff + n * 2048 + k * 1024); } while (0)
#define PG8_MMA(ai, bj, At, Bt) do { __builtin_amdgcn_s_setprio(1); _Pragma("unroll") for (int m = 0; m < 4; ++m) _Pragma("unroll") for (int n = 0; n < 2; ++n) _Pragma("unroll") for (int k = 0; k < 2; ++k) \
        acc[ai][bj][m][n] = __builtin_amdgcn_mfma_f32_16x16x32_bf16(Bt[n][k], At[m][k], acc[ai][bj][m][n], 0, 0, 0); __builtin_amdgcn_s_setprio(0); } while (0)
#define PG8_WAIT_V(n) asm volatile("s_waitcnt vmcnt(" #n ")" ::: "memory")
#define PG8_WAIT_L(n) asm volatile("s_waitcnt lgkmcnt(" #n ")" ::: "memory")
#define PG8_BAR __builtin_amdgcn_s_barrier()
#define PG8_SCHED __builtin_amdgcn_sched_barrier(0)
    Unit cur, nxt; int ui = 0;
    if (!S.next(0, cur)) return;
    f32x4 acc[2][2][4][2];
#pragma unroll
    for (int a = 0; a < 2; ++a)
#pragma unroll
        for (int b = 0; b < 2; ++b)
#pragma unroll
            for (int m = 0; m < 4; ++m)
#pragma unroll
                for (int n = 0; n < 2; ++n) acc[a][b][m][n] = (f32x4){0.f, 0.f, 0.f, 0.f};
    bf16x8 At[4][2], B0[2][2], B1[2][2];
    const char* cA = (const char*)g.A + (size_t)cur.pm * tstep; const char* cB = (const char*)g.Bt + (size_t)cur.pn * tstep;
    S.a_ready(cur);
    if constexpr (SP2) {
        PG8_STAGE(PG8_SB(0, 0), cB, voffB); PG8_STAGE(PG8_SB(0, 1), cB + hstep, voffB); PG8_STAGE(PG8_SA(0, 0), cA, voffA); PG8_STAGE(PG8_SA(0, 1), cA + hstep, voffA);
        if (wr == 1) PG8_BAR;
        PG8_WAIT_V(2); PG8_BAR;
        PG8_STAGE(PG8_SB(1, 0), cB + kstep, voffB); PG8_STAGE(PG8_SA(1, 0), cA + kstep, voffA); PG8_STAGE(PG8_SB(1, 1), cB + hstep + kstep, voffB);
        PG8_WAIT_V(6); PG8_BAR;
    } else {
        PG8_STAGE(PG8_SB(0, 0), cB, voffB); PG8_STAGE(PG8_SA(0, 0), cA, voffA); PG8_STAGE(PG8_SB(0, 1), cB + hstep, voffB); PG8_STAGE(PG8_SA(0, 1), cA + hstep, voffA);
        if (wr == 1) PG8_BAR;
        PG8_WAIT_V(4); PG8_BAR;
        PG8_STAGE(PG8_SB(1, 0), cB + kstep, voffB); PG8_STAGE(PG8_SA(1, 0), cA + kstep, voffA); PG8_STAGE(PG8_SB(1, 1), cB + hstep + kstep, voffB);
        PG8_WAIT_V(6); PG8_BAR;
    }
    for (;;) {
        const bool has_next = S.next(ui + 1, nxt);
        const char* nA = has_next ? (const char*)g.A + (size_t)nxt.pm * tstep : cA; const char* nB = has_next ? (const char*)g.Bt + (size_t)nxt.pn * tstep : cB;
        for (int t = 0; t < nt; t += 2) {
            const bool last = (t == nt - 2);
            const char* a1 = cA + (size_t)(t + 1) * kstep;
            const char* a2 = last ? nA : cA + (size_t)(t + 2) * kstep; const char* b2 = last ? nB : cB + (size_t)(t + 2) * kstep;
            const char* a3 = a2 + kstep; const char* b3 = b2 + kstep;
            if (last && has_next) S.a_ready(nxt);
            if constexpr (SP2) {
            PG8_LDB(B0, 0, 0); PG8_LDB(B1, 0, 1); PG8_SCHED; PG8_LDA(At, 0, 0); PG8_STAGE(PG8_SA(1, 1), a1 + hstep, voffA);
            PG8_WAIT_V(8); PG8_WAIT_L(0); PG8_BAR; PG8_MMA(0, 0, At, B0); PG8_MMA(0, 1, At, B1); PG8_BAR; PG8_SCHED;
            PG8_LDA(At, 0, 1); PG8_STAGE(PG8_SB(0, 0), b2, voffB); PG8_STAGE(PG8_SB(0, 1), b2 + hstep, voffB); PG8_STAGE(PG8_SA(0, 0), a2, voffA);
            PG8_WAIT_V(8); PG8_WAIT_L(0); PG8_BAR; PG8_MMA(1, 0, At, B0); PG8_MMA(1, 1, At, B1); PG8_BAR; PG8_SCHED;
            PG8_LDB(B0, 1, 0); PG8_LDB(B1, 1, 1); PG8_SCHED; PG8_LDA(At, 1, 0); PG8_STAGE(PG8_SA(0, 1), a2 + hstep, voffA);
            PG8_WAIT_V(8); PG8_WAIT_L(0); PG8_BAR; PG8_MMA(0, 0, At, B0); PG8_MMA(0, 1, At, B1); PG8_BAR; PG8_SCHED;
            PG8_LDA(At, 1, 1); PG8_STAGE(PG8_SB(1, 0), b3, voffB); PG8_STAGE(PG8_SB(1, 1), b3 + hstep, voffB); PG8_STAGE(PG8_SA(1, 0), a3, voffA);
            PG8_WAIT_V(8); PG8_WAIT_L(0); PG8_BAR; PG8_MMA(1, 0, At, B0); PG8_MMA(1, 1, At, B1); PG8_BAR; PG8_SCHED;
            } else {
            PG8_LDB(B0, 0, 0); PG8_SCHED; PG8_LDA(At, 0, 0); PG8_STAGE(PG8_SA(1, 1), a1 + hstep, voffA);
            PG8_WAIT_L(8); PG8_BAR; PG8_WAIT_L(0); PG8_MMA(0, 0, At, B0); PG8_BAR; PG8_SCHED;
            PG8_LDB(B1, 0, 1); PG8_STAGE(PG8_SB(0, 0), b2, voffB);
            PG8_BAR; PG8_WAIT_L(0); PG8_MMA(0, 1, At, B1); PG8_BAR;
            PG8_LDA(At, 0, 1); PG8_STAGE(PG8_SA(0, 0), a2, voffA);
            PG8_BAR; PG8_WAIT_L(0); PG8_MMA(1, 0, At, B0); PG8_BAR; PG8_SCHED;
            PG8_STAGE(PG8_SB(0, 1), b2 + hstep, voffB);
            PG8_WAIT_V(6); PG8_BAR; PG8_MMA(1, 1, At, B1); PG8_BAR;
            PG8_LDB(B0, 1, 0); PG8_SCHED; PG8_LDA(At, 1, 0); PG8_STAGE(PG8_SA(0, 1), a2 + hstep, voffA);
            PG8_WAIT_L(8); PG8_BAR; PG8_WAIT_L(0); PG8_MMA(0, 0, At, B0); PG8_BAR; PG8_SCHED;
            PG8_LDB(B1, 1, 1); PG8_STAGE(PG8_SB(1, 0), b3, voffB);
            PG8_BAR; PG8_WAIT_L(0); PG8_MMA(0, 1, At, B1); PG8_BAR;
            PG8_LDA(At, 1, 1); PG8_STAGE(PG8_SA(1, 0), a3, voffA);
            PG8_BAR; PG8_WAIT_L(0); PG8_MMA(1, 0, At, B0); PG8_BAR; PG8_SCHED;
            PG8_STAGE(PG8_SB(1, 1), b3 + hstep, voffB);
            PG8_WAIT_V(6); PG8_BAR; PG8_MMA(1, 1, At, B1); PG8_BAR;
            }
        }
        if constexpr (ALIGN_EPI) { if (wr == 0) PG8_BAR; }
        if constexpr (!Epi::AFTER_DRAIN) { E(acc, cur, wr, wc, fr, fq); S.done(cur); }
        if (!has_next) break;
#pragma unroll
        for (int a = 0; a < 2; ++a)
#pragma unroll
            for (int b = 0; b < 2; ++b)
#pragma unroll
                for (int m = 0; m < 4; ++m)
#pragma unroll
                    for (int n = 0; n < 2; ++n) acc[a][b][m][n] = (f32x4){0.f, 0.f, 0.f, 0.f};
        cur = nxt; cA = nA; cB = nB; ++ui;
        if constexpr (ALIGN_EPI) { if (wr == 1) PG8_BAR; }
    }
    PG8_WAIT_V(0);
    if constexpr (!ALIGN_EPI) { if (wr == 0) PG8_BAR; }
    PG8_BAR;
    if constexpr (Epi::AFTER_DRAIN) { E.fused(acc, cur, wr, wc, fr, fq, lds, wid, lane); S.done(cur); }
#undef PG8_SA
#undef PG8_SB
#undef PG8_STAGE
#undef PG8_LDA
#undef PG8_LDB
#undef PG8_MMA
#undef PG8_WAIT_V
#undef PG8_WAIT_L
#undef PG8_BAR
#undef PG8_SCHED
}
}

#ifndef MULTI_LAUNCH
#define MULTI_LAUNCH 0
#endif
#ifndef USE_TR
#define USE_TR 1
#endif
#ifndef TSEL
#define TSEL (-1)
#endif
#if TSEL >= 10
#define TS_MARK(k0) do { if (threadIdx.x == 0) { volatile LAS unsigned long long* TWs = (volatile LAS unsigned long long*)(lds + LDS_BARST + 16); const unsigned long long nowt = __builtin_amdgcn_s_memrealtime(); if ((TSEL) == (k0)) TWs[2] += nowt - TWs[3]; TWs[3] = nowt; } } while (0)
#else
#define TS_MARK(k0) do {} while (0)
#endif
#ifndef REP_ATTN
#define REP_ATTN 0
#endif
#ifndef REP_M1
#define REP_M1 0
#endif
#ifndef REPEAT_MASK
#define REPEAT_MASK 0
#endif
#define LAS __attribute__((address_space(3)))
#define DI __device__ __forceinline__
typedef unsigned short bf16;
typedef short bf16x8 __attribute__((ext_vector_type(8)));
typedef float f32x4 __attribute__((ext_vector_type(4)));
typedef unsigned u32x4 __attribute__((ext_vector_type(4)));
typedef unsigned u32x2 __attribute__((ext_vector_type(2)));

constexpr int SEQ = 8192, DM = 4096, INW = 16392, NU = 16384;
constexpr int C_QA = 0, C_KA = 2048, C_VA = 4096, C_ZA = 6144, C_QM = 8192, C_KM = 9216, C_VM = 10240, C_OM = 12288, C_ZM = 14336;
constexpr float NORM_EPS = 1e-6f;
constexpr int NTHR = 512, NWAVE = 8;
constexpr int LDS_BYTES = 147456;

constexpr size_t MiB = (size_t)1 << 20;
constexpr size_t WS_WIN = 0, WS_WOUT = 256 * MiB, WS_XN = 320 * MiB, WS_U = 384 * MiB, WS_OP = 640 * MiB, WS_Y = 736 * MiB, WS_X1 = 800 * MiB,
                 WS_DC = 928 * MiB, WS_CS = 992 * MiB, WS_LSE = 1024 * MiB, WS_GATES = 1026 * MiB, WS_DN = 1027 * MiB, WS_NS = 1028 * MiB, WS_BL = 1029 * MiB,
                 WS_CTL = 1030 * MiB, WS_QKC = 1032 * MiB, WS_WGT = 1064 * MiB, WS_END = 1065 * MiB;
constexpr int LDS_BARST = LDS_BYTES - 64;

struct Params { const float *x, *norm_g, *w_in, *b_gate, *conv_w, *mnorm_g, *w_out, *rel_bias, *final_g; float* out; unsigned char* ws; int ph_lo, ph_hi; };

DI int blk() { int b = blockIdx.x; asm volatile("" : "+s"(b)); return b; }
DI float bf_lo(unsigned u) { return __uint_as_float(u << 16); }
DI float bf_hi(unsigned u) { return __uint_as_float(u & 0xffff0000u); }
DI float bf2f(unsigned short u) { return __uint_as_float((unsigned)u << 16); }
DI unsigned pk2(float lo, float hi) { return pg8::cvt_pk_bf16(lo, hi); }
DI float wave_sum(float v) {
#pragma unroll
    for (int o = 1; o < 64; o <<= 1) v += __shfl_xor(v, o);
    return v;
}
DI float quad_sum(float v) { v += __shfl_xor(v, 16); v += __shfl_xor(v, 32); return v; }
DI float quad_max(float v) { v = fmaxf(v, __shfl_xor(v, 16)); v = fmaxf(v, __shfl_xor(v, 32)); return v; }
DI float silu_f(float x) { return x * __builtin_amdgcn_rcpf(1.f + __expf(-x)); }
DI float sigm_f(float x) { return __builtin_amdgcn_rcpf(1.f + __expf(-x)); }
DI bf16x8 gatherT(const LAS unsigned short* p, int stride) {
    bf16x8 r;
#pragma unroll
    for (int j = 0; j < 8; ++j) r[j] = (short)p[j * stride];
    return r;
}
typedef short s16x4 __attribute__((ext_vector_type(4)));
DI bf16x8 trfrag(const LAS unsigned short* blk, int stride, int ql) {
#if USE_TR
    const LAS unsigned short* a = blk + (ql >> 2) * stride + 4 * (ql & 3);
    const s16x4 lo = __builtin_amdgcn_ds_read_tr16_b64_v4i16((LAS s16x4*)a);
    const s16x4 hi = __builtin_amdgcn_ds_read_tr16_b64_v4i16((LAS s16x4*)(a + 4 * stride));
    return (bf16x8){lo[0], lo[1], lo[2], lo[3], hi[0], hi[1], hi[2], hi[3]};
#else
    return gatherT(blk + ql, stride);
#endif
}
DI f32x4 mfma16(bf16x8 a, bf16x8 b, f32x4 c) { return __builtin_amdgcn_mfma_f32_16x16x32_bf16(a, b, c, 0, 0, 0); }
#define LDS_WAIT() asm volatile("s_waitcnt lgkmcnt(0)" ::: "memory")

struct TrTile { const float* src; bf16* dst; };
DI TrTile tr_tile_addr(const Params& p, int it, int lane) {
    constexpr int T_IN = 64 * 256, T_OUT = 64 * 64;
    const float* W; bf16* WT; int ldw, nb, kb;
    int r = it;
    if (r < T_IN) { W = p.w_in; WT = (bf16*)(p.ws + WS_WIN); ldw = INW; kb = r >> 8; nb = r & 255; }
    else if ((r -= T_IN) < T_OUT) { W = p.w_out; WT = (bf16*)(p.ws + WS_WOUT); ldw = DM; kb = r >> 6; nb = r & 63; }
    else if ((r -= T_OUT) < T_IN) { W = p.w_in + (size_t)DM * INW; WT = (bf16*)(p.ws + WS_WIN + 128 * MiB); ldw = INW; kb = r >> 8; nb = r & 255; }
    else { r -= T_IN; W = p.w_out + (size_t)DM * DM; WT = (bf16*)(p.ws + WS_WOUT + 32 * MiB); ldw = DM; kb = r >> 6; nb = r & 63; }
    TrTile t;
    t.src = W + (size_t)(kb * 64 + 16 * (lane >> 4)) * ldw + nb * 64 + 4 * (lane & 15);
    t.dst = WT + (size_t)(nb * 64 + (lane >> 3)) * DM + kb * 64 + 8 * (lane & 7);
    return t;
}
DI int tr_ldw(int it) { constexpr int T_IN = 64 * 256, T_OUT = 64 * 64; const int r = it % (T_IN + T_OUT); return r < T_IN ? INW : DM; }
DI void tr_load(const float* src, int ldw, f32x4 (&v)[16]) {
#pragma unroll
    for (int i = 0; i < 16; ++i) v[i] = *(const f32x4*)(src + (size_t)i * ldw);
}
DI void tr_store(const f32x4 (&v)[16], bf16* dst, LAS unsigned short* T, int lane) {
    const int kr = lane >> 4, nc = 4 * (lane & 15);
#pragma unroll
    for (int e = 0; e < 4; ++e)
#pragma unroll
        for (int hf = 0; hf < 2; ++hf) { u32x4 w;
            w.x = pk2(v[8 * hf + 0][e], v[8 * hf + 1][e]); w.y = pk2(v[8 * hf + 2][e], v[8 * hf + 3][e]); w.z = pk2(v[8 * hf + 4][e], v[8 * hf + 5][e]); w.w = pk2(v[8 * hf + 6][e], v[8 * hf + 7][e]);
            *(LAS u32x4*)(T + (nc + e) * 72 + 16 * kr + 8 * hf) = w; }
    LDS_WAIT(); asm volatile("" ::: "memory");
#pragma unroll
    for (int j = 0; j < 8; ++j) { const u32x4 w = *(const LAS u32x4*)(T + ((lane >> 3) + 8 * j) * 72 + 8 * (lane & 7)); *(u32x4*)(dst + (size_t)(8 * j) * DM) = w; }
    LDS_WAIT(); asm volatile("" ::: "memory");
}
DI void prologue_transposes(const Params& p, LAS unsigned char* lds, int wave, int lane) {
    LAS unsigned short* T = (LAS unsigned short*)(lds + wave * 16384);
    const int gw = blk() * NWAVE + wave, ngw = gridDim.x * NWAVE;
    constexpr int NIT = 2 * (64 * 256 + 64 * 64);
    f32x4 va[16], vb[16];
    int it = gw;
    if (it >= NIT) return;
    TrTile ta = tr_tile_addr(p, it, lane), tb;
    tr_load(ta.src, tr_ldw(it), va);
    for (;;) {
        const int it1 = it + ngw; const bool h1 = it1 < NIT;
        if (h1) { tb = tr_tile_addr(p, it1, lane); tr_load(tb.src, tr_ldw(it1), vb); }
        tr_store(va, ta.dst, T, lane);
        if (!h1) break;
        const int it2 = it1 + ngw; const bool h2 = it2 < NIT;
        if (h2) { ta = tr_tile_addr(p, it2, lane); tr_load(ta.src, tr_ldw(it2), va); }
        tr_store(vb, tb.dst, T, lane);
        if (!h2) break;
        it = it2;
    }
}

DI void norm_phase(const Params& p, const float* X, int l, int wave, int lane) {
    const float* g = p.norm_g + l * DM;
    bf16* XN = (bf16*)(p.ws + WS_XN);
    for (int row = blk() * NWAVE + wave; row < SEQ; row += gridDim.x * NWAVE) {
        const f32x4* xr = (const f32x4*)(X + (size_t)row * DM) + lane;
        f32x4 v[16]; float ss = 0.f;
#pragma unroll
        for (int j = 0; j < 16; ++j) { v[j] = xr[64 * j]; ss += (v[j].x * v[j].x + v[j].y * v[j].y) + (v[j].z * v[j].z + v[j].w * v[j].w); }
        const float rstd = rsqrtf(wave_sum(ss) * (1.f / DM) + NORM_EPS);
        u32x2* o8 = (u32x2*)(XN + (size_t)row * DM) + lane;
#pragma unroll
        for (int j = 0; j < 16; ++j) { const f32x4 h = v[j] * rstd * ((const f32x4*)g)[lane + 64 * j]; u32x2 w; w.x = pk2(h.x, h.y); w.y = pk2(h.z, h.w); o8[64 * j] = w; }
    }
}
DI void build_wgt(const Params& p, int tid) {
    bf16* WgT = (bf16*)(p.ws + WS_WGT);
    for (int gid = blk() * NTHR + tid; gid < 2 * 16 * DM; gid += gridDim.x * NTHR) {
        if (gid < 2 * 8 * DM) { const int l = gid >> 15, k = (gid >> 3) & (DM - 1), j = gid & 7;
            WgT[((size_t)l * 16 + j) * DM + k] = (bf16)(pk2(p.w_in[(size_t)l * DM * INW + (size_t)k * INW + NU + j], 0.f) & 0xffffu); }
        else { const int r = gid - 2 * 8 * DM, l = r >> 15, j = 8 + ((r >> 12) & 7), k = r & (DM - 1); WgT[((size_t)l * 16 + j) * DM + k] = 0; }
    }
}
DI void gate_items(const Params& p, LAS unsigned char* lds, int l, int tid, int wave, int lane) {
    const bf16* XN = (const bf16*)(p.ws + WS_XN);
    const bf16* WgT = (const bf16*)(p.ws + WS_WGT) + (size_t)l * 16 * DM;
    float* gates = (float*)(p.ws + WS_GATES);
    LAS float* red = (LAS float*)lds;
    const int ql = lane & 15, quad = lane >> 4;
    for (int t = blk(); t < SEQ / 16; t += gridDim.x) {
        const bf16* a = WgT + (size_t)ql * DM + wave * 512 + quad * 8; const bf16* b = XN + (size_t)(t * 16 + ql) * DM + wave * 512 + quad * 8;
        f32x4 acc0 = {0.f, 0.f, 0.f, 0.f}, acc1 = {0.f, 0.f, 0.f, 0.f};
#pragma unroll
        for (int i = 0; i < 16; i += 2) { acc0 = mfma16(*(const bf16x8*)(a + i * 32), *(const bf16x8*)(b + i * 32), acc0); acc1 = mfma16(*(const bf16x8*)(a + i * 32 + 32), *(const bf16x8*)(b + i * 32 + 32), acc1); }
        const f32x4 r = acc0 + acc1;
        if (quad < 2) *(LAS f32x4*)(red + (wave * 16 + ql) * 8 + quad * 4) = r;
        __syncthreads();
        if (tid < 128) { float sum = p.b_gate[l * 8 + (tid & 7)];
#pragma unroll
            for (int w = 0; w < 8; ++w) sum += red[w * 128 + tid];
            gates[(size_t)t * 128 + tid] = sum; }
        __syncthreads();
    }
}
DI void final_norm_phase(const Params& p, LAS unsigned char* lds0, int wave, int lane) {
#if TSEL >= 0
    const int n2 = ((volatile LAS int*)(lds0 + LDS_BARST + 16))[8];
#endif
    for (int row = blk() * NWAVE + wave; row < SEQ; row += gridDim.x * NWAVE) {
        f32x4* xr = (f32x4*)(p.out + (size_t)row * DM) + lane;
        f32x4 v[16]; float ss = 0.f;
#pragma unroll
        for (int j = 0; j < 16; ++j) { v[j] = xr[64 * j]; ss += (v[j].x * v[j].x + v[j].y * v[j].y) + (v[j].z * v[j].z + v[j].w * v[j].w); }
        const float rstd = rsqrtf(wave_sum(ss) * (1.f / DM) + NORM_EPS);
#pragma unroll
        for (int j = 0; j < 16; ++j) { f32x4 o = v[j] * rstd * ((const f32x4*)p.final_g)[lane + 64 * j];
#if TSEL >= 0
            if (blk() == 0) { const int e0 = ((row >> 11) * 8 + (row & 7)) * 4096 + 4 * (lane + 64 * j);
                o.x += (e0 + 0 < n2) ? 0.02f : 0.f; o.y += (e0 + 1 < n2) ? 0.02f : 0.f; o.z += (e0 + 2 < n2) ? 0.02f : 0.f; o.w += (e0 + 3 < n2) ? 0.02f : 0.f; }
#endif
            xr[64 * j] = o; }
    }
}

constexpr int AT_KS = 136;
#define ATT_DECODE(item) const int pat = (item) >> 10, h = ((item) & 1023) >> 6, rb_ = (item) & 63, dsh = pat * 2, r = rb_ >> (6 - dsh), bq = rb_ & ((64 >> dsh) - 1), sub0 = 128 * bq - 128; (void)sub0; (void)r; (void)h;
DI void att_load_kv(const bf16* U, int item, int tid, int coff, u32x4 (&v)[8]) {
    ATT_DECODE(item)
#pragma unroll
    for (int i = 0; i < 8; ++i) { const int c = tid + NTHR * i, row = c >> 4, ch = c & 15; int sub = sub0 + row; sub = sub < 0 ? 0 : sub;
        v[i] = *(const u32x4*)(U + (size_t)((sub << dsh) + r) * NU + coff + h * 128 + ch * 8); }
}
DI void att_store(LAS unsigned short* dst, int tid, const u32x4 (&v)[8]) {
#pragma unroll
    for (int i = 0; i < 8; ++i) { const int c = tid + NTHR * i, row = c >> 4, ch = c & 15; *(LAS u32x4*)(dst + row * AT_KS + ch * 8) = v[i]; }
}
DI void att_load_q(const bf16* U, int item, int wave, int lane, bf16x8 (&qf)[4]) {
    ATT_DECODE(item)
    const int tq = ((128 * bq + wave * 16 + (lane & 15)) << dsh) + r;
#pragma unroll
    for (int ks = 0; ks < 4; ++ks) qf[ks] = *(const bf16x8*)(U + (size_t)tq * NU + C_QA + h * 128 + ks * 32 + (lane >> 4) * 8);
}
DI void att_bias(const Params& p, int item, int tid, LAS float* biasS) {
    ATT_DECODE(item)
    if (tid < 177) { const int i = tid - 32; float v = -1e30f;
        if (i >= 0 && i <= 128) { const int n = i << dsh; int b = n;
            if (n >= 16) { b = 16 + (int)floorf(log2f((float)n * 0.0625f) * (16.f / 7.f)); b = b > 31 ? 31 : b; }
            v = p.rel_bias[b * 16 + h] * 1.4426950408889634f; }
        biasS[tid] = v; }
}
DI int att_item_of(int rnd, bool xmap, int xcd, int xi) {
    if (!xmap) return blk() + rnd * gridDim.x;
    const int h = 2 * xcd + rnd / 6, j = (rnd % 6) * 32 + xi; return (j >> 6) * 1024 + h * 64 + (j & 63);
}
DI void attn_phase(const Params& p, LAS unsigned char* lds, int tid, int wave, int lane) {
    const bf16* U = (const bf16*)(p.ws + WS_U);
    LAS unsigned short* Ks = (LAS unsigned short*)lds;
    LAS unsigned short* Vs = Ks + 256 * AT_KS;
    LAS float* biasS = (LAS float*)(Vs + 256 * AT_KS);
    const int G = gridDim.x; const bool xmap = (G == 256); const int xcd = blk() & 7, xi = blk() >> 3;
    const int nrnd = (blk() < 3072) ? (3072 - blk() + G - 1) / G : 0;
    if (nrnd <= 0) return;
    const int ql = lane & 15, quad = lane >> 4, q0 = wave * 16;
    bf16x8 qf[4];
    { const int item0 = att_item_of(0, xmap, xcd, xi); u32x4 kv[8], vv[8];
      att_load_kv(U, item0, tid, C_KA, kv); att_load_kv(U, item0, tid, C_VA, vv); att_load_q(U, item0, wave, lane, qf); att_bias(p, item0, tid, biasS);
      att_store(Ks, tid, kv); att_store(Vs, tid, vv); }
    __syncthreads();
    for (int rnd = 0; rnd < nrnd; ++rnd) {
        const int item = att_item_of(rnd, xmap, xcd, xi), next = rnd + 1 < nrnd ? att_item_of(rnd + 1, xmap, xcd, xi) : -1;
        ATT_DECODE(item)
        const int tq = ((128 * bq + q0 + ql) << dsh) + r;
        f32x4 sacc[10];
#pragma unroll
        for (int t = 0; t < 10; ++t) sacc[t] = (f32x4){0.f, 0.f, 0.f, 0.f};
#pragma unroll
        for (int s = 0; s < 5; ++s)
#pragma unroll
            for (int u = 0; u < 2; ++u) { int kk = q0 + 32 * s + (ql >> 2) * 8 + u * 4 + (ql & 3); kk = kk > 255 ? 255 : kk;
                const LAS unsigned short* kp = Ks + kk * AT_KS + quad * 8;
#pragma unroll
                for (int ks = 0; ks < 4; ++ks) sacc[2 * s + u] = mfma16(*(const LAS bf16x8*)(kp + ks * 32), qf[ks], sacc[2 * s + u]); }
        __syncthreads();
        u32x4 kv[8], vv[8]; bf16x8 qn[4];
        if (next >= 0) { att_load_kv(U, next, tid, C_KA, kv); att_load_q(U, next, wave, lane, qn); }
        const float scale2 = 0.08838834764831845f * 1.4426950408889634f;
        float mx = -1e30f;
        int ql2 = ql, quad2 = quad; asm volatile("" : "+v"(ql2), "+v"(quad2));
        const LAS float* bp = biasS + (ql2 - 8 * quad2 + 32 + 128);
#pragma unroll
        for (int s = 0; s < 5; ++s)
#pragma unroll
            for (int u = 0; u < 2; ++u)
#pragma unroll
                for (int j = 0; j < 4; ++j) sacc[2 * s + u][j] = sacc[2 * s + u][j] * scale2 + bp[-(32 * s + 4 * u + j)];
        if (bq == 0) {
            const int t1 = 128 - q0 - 8 * quad2;
#pragma unroll
            for (int s = 0; s < 5; ++s)
#pragma unroll
                for (int u = 0; u < 2; ++u)
#pragma unroll
                    for (int j = 0; j < 4; ++j) sacc[2 * s + u][j] = (32 * s + 4 * u + j >= t1) ? sacc[2 * s + u][j] : -1e30f; }
#pragma unroll
        for (int t = 0; t < 10; ++t)
#pragma unroll
            for (int j = 0; j < 4; ++j) mx = fmaxf(mx, sacc[t][j]);
        mx = quad_max(mx);
        float l = 0.f;
#pragma unroll
        for (int t = 0; t < 10; ++t)
#pragma unroll
            for (int j = 0; j < 4; ++j) { const float e = __builtin_amdgcn_exp2f(sacc[t][j] - mx); sacc[t][j] = e; l += e; }
        l = quad_sum(l);
        if (next >= 0) att_load_kv(U, next, tid, C_VA, vv);
        f32x4 oacc[8];
#pragma unroll
        for (int nt = 0; nt < 8; ++nt) oacc[nt] = (f32x4){0.f, 0.f, 0.f, 0.f};
#pragma unroll
        for (int s = 0; s < 5; ++s) {
            u32x4 pw; pw.x = pk2(sacc[2 * s][0], sacc[2 * s][1]); pw.y = pk2(sacc[2 * s][2], sacc[2 * s][3]); pw.z = pk2(sacc[2 * s + 1][0], sacc[2 * s + 1][1]); pw.w = pk2(sacc[2 * s + 1][2], sacc[2 * s + 1][3]);
            const bf16x8 pf = __builtin_bit_cast(bf16x8, pw);
            int key0 = q0 + 32 * s + quad * 8; key0 = key0 > 248 ? 248 : key0;
            const LAS unsigned short* vp = Vs + key0 * AT_KS;
#pragma unroll
            for (int nt = 0; nt < 8; ++nt) oacc[nt] = mfma16(trfrag(vp + nt * 16, AT_KS, ql), pf, oacc[nt]);
        }
        const float inv = 1.f / l;
        bf16* OP = (bf16*)(p.ws + WS_OP) + (size_t)pat * SEQ * 2048 + (size_t)tq * 2048 + h * 128 + quad * 4;
#pragma unroll
        for (int nt = 0; nt < 8; ++nt) { u32x2 w; w.x = pk2(oacc[nt][0] * inv, oacc[nt][1] * inv); w.y = pk2(oacc[nt][2] * inv, oacc[nt][3] * inv); *(u32x2*)(OP + nt * 16) = w; }
        if (quad == 0) ((float*)(p.ws + WS_LSE))[((size_t)pat * SEQ + tq) * 16 + h] = (mx + __log2f(l)) * 0.6931471805599453f;
        if (next >= 0) att_store(Ks, tid, kv);
        __syncthreads();
        if (next >= 0) { att_store(Vs, tid, vv); att_bias(p, next, tid, biasS);
#pragma unroll
            for (int ks = 0; ks < 4; ++ks) qf[ks] = qn[ks]; }
        __syncthreads();
    }
}
DI void merge_phase(const Params& p, int tid) {
    const bf16* U = (const bf16*)(p.ws + WS_U);
    const bf16* OP = (const bf16*)(p.ws + WS_OP);
    const float* LSE = (const float*)(p.ws + WS_LSE);
    bf16* Y = (bf16*)(p.ws + WS_Y);
    const int gthreads = gridDim.x * NTHR;
    for (int idx0 = blk() * NTHR + tid; idx0 < SEQ * 256; idx0 += 4 * gthreads) {
        float l0[4], l1[4], l2[4]; u32x4 o0[4], o1[4], o2[4], z[4];
#pragma unroll
        for (int u = 0; u < 4; ++u) { int idx = idx0 + u * gthreads; idx = idx < SEQ * 256 ? idx : SEQ * 256 - 1;
            const int t = idx >> 8, c8 = idx & 255, h = c8 >> 4;
            l0[u] = LSE[(size_t)t * 16 + h]; l1[u] = LSE[((size_t)SEQ + t) * 16 + h]; l2[u] = LSE[((size_t)2 * SEQ + t) * 16 + h];
            const size_t o = (size_t)t * 2048 + c8 * 8;
            o0[u] = *(const u32x4*)(OP + o); o1[u] = *(const u32x4*)(OP + (size_t)SEQ * 2048 + o); o2[u] = *(const u32x4*)(OP + (size_t)2 * SEQ * 2048 + o);
            z[u] = *(const u32x4*)(U + (size_t)t * NU + C_ZA + c8 * 8); }
#pragma unroll
        for (int u = 0; u < 4; ++u) { const int idx = idx0 + u * gthreads;
            if (idx < SEQ * 256) { const int t = idx >> 8, c8 = idx & 255;
                const float M = fmaxf(l0[u], fmaxf(l1[u], l2[u]));
                float w0 = __expf(l0[u] - M), w1 = __expf(l1[u] - M), w2 = __expf(l2[u] - M);
                const float inv = 1.f / (w0 + w1 + w2); w0 *= inv; w1 *= inv; w2 *= inv;
                u32x4 y;
#pragma unroll
                for (int e = 0; e < 4; ++e) {
                    const float lo = (w0 * bf_lo(o0[u][e]) + w1 * bf_lo(o1[u][e]) + w2 * bf_lo(o2[u][e])) * silu_f(bf_lo(z[u][e]));
                    const float hi = (w0 * bf_hi(o0[u][e]) + w1 * bf_hi(o1[u][e]) + w2 * bf_hi(o2[u][e])) * silu_f(bf_hi(z[u][e]));
                    y[e] = pk2(lo, hi); }
                *(u32x4*)(Y + (size_t)t * DM + c8 * 8) = y; } }
    }
}

constexpr int M_KS = 264, M_VS3 = 520;
DI void conv8(const bf16* U, const float* cw, int t, int rawcol, int cch, float (&f)[8]) {
#pragma unroll
    for (int e = 0; e < 8; ++e) f[e] = 0.f;
#pragma unroll
    for (int j = 0; j < 4; ++j) { const int tt = t - 3 + j;
        if (tt >= 0) { const u32x4 raw = *(const u32x4*)(U + (size_t)tt * NU + rawcol);
            const f32x4 w0 = *(const f32x4*)(cw + j * 2048 + cch), w1 = *(const f32x4*)(cw + j * 2048 + cch + 4);
            f[0] += w0[0] * bf_lo(raw.x); f[1] += w0[1] * bf_hi(raw.x); f[2] += w0[2] * bf_lo(raw.y); f[3] += w0[3] * bf_hi(raw.y);
            f[4] += w1[0] * bf_lo(raw.z); f[5] += w1[1] * bf_hi(raw.z); f[6] += w1[2] * bf_lo(raw.w); f[7] += w1[3] * bf_hi(raw.w); } }
#pragma unroll
    for (int e = 0; e < 8; ++e) f[e] = silu_f(f[e]);
}
template <int NI, int MODE, int NB>
DI void conv_tile(const bf16* U, const float* cw, int t0, int rawcol0, int cch0, float sc, LAS unsigned short* dst, int tid, float bL, const LAS float* bS, const LAS float* liS, int roff) {
    const int ch = tid & 31, r0 = tid >> 5;
    f32x4 w[4][2];
#pragma unroll
    for (int j = 0; j < 4; ++j) { w[j][0] = *(const f32x4*)(cw + j * 2048 + cch0 + ch * 8); w[j][1] = *(const f32x4*)(cw + j * 2048 + cch0 + ch * 8 + 4); }
    const bf16* src = U + rawcol0 + ch * 8;
#pragma unroll
    for (int ib = 0; ib < NI; ib += NB) {
        u32x4 raw[NB][4];
#pragma unroll
        for (int i = 0; i < NB; ++i)
#pragma unroll
            for (int j = 0; j < 4; ++j) { const int tt = t0 + r0 + 16 * (ib + i) - 3 + j; const int tc = tt < 0 ? 0 : tt;
                raw[i][j] = *(const u32x4*)(src + (size_t)tc * NU); if (tt < 0) raw[i][j] = (u32x4){0u, 0u, 0u, 0u}; }
#pragma unroll
        for (int i = 0; i < NB; ++i) { const int row = r0 + 16 * (ib + i);
            float f[8];
#pragma unroll
            for (int e = 0; e < 8; ++e) f[e] = 0.f;
#pragma unroll
            for (int j = 0; j < 4; ++j) { const u32x4 rw = raw[i][j];
                f[0] += w[j][0][0] * bf_lo(rw.x); f[1] += w[j][0][1] * bf_hi(rw.x); f[2] += w[j][0][2] * bf_lo(rw.y); f[3] += w[j][0][3] * bf_hi(rw.y);
                f[4] += w[j][1][0] * bf_lo(rw.z); f[5] += w[j][1][1] * bf_hi(rw.z); f[6] += w[j][1][2] * bf_lo(rw.w); f[7] += w[j][1][3] * bf_hi(rw.w); }
            float m = sc;
            if (MODE == 1) m *= __expf(bL - bS[roff + row] + liS[roff + row]);
#pragma unroll
            for (int e = 0; e < 8; ++e) f[e] = silu_f(f[e]) * m;
            u32x4 o; o.x = pk2(f[0], f[1]); o.y = pk2(f[2], f[3]); o.z = pk2(f[4], f[5]); o.w = pk2(f[6], f[7]);
            *(LAS u32x4*)(dst + row * M_KS + ch * 8) = o; }
        __builtin_amdgcn_sched_barrier(0);
    }
}
DI void conv_prepass(const Params& p, int l, int tid) {
    const bf16* U = (const bf16*)(p.ws + WS_U);
    const float* cw = p.conv_w + (size_t)l * 4 * 2048;
    bf16* QKC = (bf16*)(p.ws + WS_QKC);
    for (int gid = blk() * NTHR + tid; gid < 256 * 512; gid += gridDim.x * NTHR) {
        const int cidx = gid & 255, t0 = (gid >> 8) * 16;
        f32x4 w[4][2];
#pragma unroll
        for (int j = 0; j < 4; ++j) { w[j][0] = *(const f32x4*)(cw + j * 2048 + cidx * 8); w[j][1] = *(const f32x4*)(cw + j * 2048 + cidx * 8 + 4); }
        const bf16* src = U + C_QM + cidx * 8;
        u32x4 raw[19];
#pragma unroll
        for (int i = 0; i < 19; ++i) { const int tt = t0 - 3 + i; const int tc = tt < 0 ? 0 : tt; raw[i] = *(const u32x4*)(src + (size_t)tc * NU); if (tt < 0) raw[i] = (u32x4){0u, 0u, 0u, 0u}; }
        const float sc = cidx >= 128 ? 0.0625f : 1.f;
#pragma unroll
        for (int i = 0; i < 16; ++i) {
            float f[8];
#pragma unroll
            for (int e = 0; e < 8; ++e) f[e] = 0.f;
#pragma unroll
            for (int j = 0; j < 4; ++j) { const u32x4 rw = raw[i + j];
                f[0] += w[j][0][0] * bf_lo(rw.x); f[1] += w[j][0][1] * bf_hi(rw.x); f[2] += w[j][0][2] * bf_lo(rw.y); f[3] += w[j][0][3] * bf_hi(rw.y);
                f[4] += w[j][1][0] * bf_lo(rw.z); f[5] += w[j][1][1] * bf_hi(rw.z); f[6] += w[j][1][2] * bf_lo(rw.w); f[7] += w[j][1][3] * bf_hi(rw.w); }
#pragma unroll
            for (int e = 0; e < 8; ++e) f[e] = silu_f(f[e]) * sc;
            u32x4 o; o.x = pk2(f[0], f[1]); o.y = pk2(f[2], f[3]); o.z = pk2(f[4], f[5]); o.w = pk2(f[6], f[7]);
            *(u32x4*)(QKC + (size_t)(t0 + i) * 2048 + cidx * 8) = o; }
    }
}
DI void chunk_gates(const float* gates, int c, int hh, LAS float* bS, LAS float* liS, LAS float* wtot, int tid, int wave, int lane) {
    float v = 0.f;
    if (tid < 256) { const float* gp = gates + (size_t)(c * 256 + tid) * 8; const float fgv = gp[4 + hh]; liS[tid] = gp[hh];
        v = fminf(fgv, 0.f) - log1pf(__expf(-fabsf(fgv)));
#pragma unroll
        for (int o = 1; o < 64; o <<= 1) { const float t = __shfl_up(v, o); if (lane >= o) v += t; }
        if (lane == 63) wtot[wave] = v; }
    __syncthreads();
    if (tid < 256) { float pre = 0.f; for (int w = 0; w < wave; ++w) pre += wtot[w]; bS[tid] = v + pre; }
    __syncthreads();
}
DI void m1_item(const Params& p, LAS unsigned char* lds, int l, int item, int tid, int wave, int lane) {
    asm volatile("" : "+v"(tid));
    const bf16* U = (const bf16*)(p.ws + WS_U);
    const bf16* QKC = (const bf16*)(p.ws + WS_QKC);
    LAS unsigned short* Kp = (LAS unsigned short*)lds;
    LAS unsigned short* Vs = Kp + 128 * M_KS;
    LAS float* bS = (LAS float*)(Vs + 128 * AT_KS); LAS float* liS = bS + 256; LAS float* wtot = liS + 256;
    const int hh = item >> 7, c = (item >> 2) & 31, sl = item & 3;
    const int ql = lane & 15, quad = lane >> 4;
    u32x4 kr[8], vr[4];
#define M1_LOAD(half) do { _Pragma("unroll") for (int i = 0; i < 8; ++i) { const int cc = tid + NTHR * i, row = cc >> 5, ch = cc & 31; kr[i] = *(const u32x4*)(QKC + (size_t)(c * 256 + (half) * 128 + row) * 2048 + 1024 + hh * 256 + ch * 8); } \
        _Pragma("unroll") for (int i = 0; i < 4; ++i) { const int cc = tid + NTHR * i, row = cc >> 4, ch = cc & 15; vr[i] = *(const u32x4*)(U + (size_t)(c * 256 + (half) * 128 + row) * NU + C_VM + hh * 512 + sl * 128 + ch * 8); } } while (0)
#define M1_STORE(half) do { _Pragma("unroll") for (int i = 0; i < 8; ++i) { const int cc = tid + NTHR * i, row = cc >> 5, ch = cc & 31, sloc = (half) * 128 + row; \
            const float wgt = __expf(bL - bS[sloc] + liS[sloc]); \
            u32x4 w; w.x = pk2(bf_lo(kr[i].x) * wgt, bf_hi(kr[i].x) * wgt); w.y = pk2(bf_lo(kr[i].y) * wgt, bf_hi(kr[i].y) * wgt); w.z = pk2(bf_lo(kr[i].z) * wgt, bf_hi(kr[i].z) * wgt); w.w = pk2(bf_lo(kr[i].w) * wgt, bf_hi(kr[i].w) * wgt); \
            *(LAS u32x4*)(Kp + row * M_KS + ch * 8) = w; } \
        _Pragma("unroll") for (int i = 0; i < 4; ++i) { const int cc = tid + NTHR * i, row = cc >> 4, ch = cc & 15; *(LAS u32x4*)(Vs + row * AT_KS + ch * 8) = vr[i]; } } while (0)
    M1_LOAD(0);
    chunk_gates((const float*)(p.ws + WS_GATES), c, hh, bS, liS, wtot, tid, wave, lane);
    const float bL = bS[255];
    f32x4 acc[4][4];
#pragma unroll
    for (int a = 0; a < 4; ++a)
#pragma unroll
        for (int b = 0; b < 4; ++b) acc[a][b] = (f32x4){0.f, 0.f, 0.f, 0.f};
    f32x4 nacc[4];
#pragma unroll
    for (int b = 0; b < 4; ++b) nacc[b] = (f32x4){0.f, 0.f, 0.f, 0.f};
    const bool do_n = (sl == 0) && ((wave & 1) == 0);
    const bf16x8 ones = {0x3F80, 0x3F80, 0x3F80, 0x3F80, 0x3F80, 0x3F80, 0x3F80, 0x3F80};
    const int dvt0 = (wave & 1) * 4, dkt0 = (wave >> 1) * 4;
    M1_STORE(0);
    __syncthreads();
    M1_LOAD(1);
#pragma unroll 1
    for (int half = 0; half < 2; ++half) {
#pragma unroll 1
        for (int ks = 0; ks < 4; ++ks) {
            bf16x8 af[4], bfr[4];
#pragma unroll
            for (int a = 0; a < 4; ++a) af[a] = trfrag(Vs + (ks * 32 + quad * 8) * AT_KS + (dvt0 + a) * 16, AT_KS, ql);
#pragma unroll
            for (int b = 0; b < 4; ++b) bfr[b] = trfrag(Kp + (ks * 32 + quad * 8) * M_KS + (dkt0 + b) * 16, M_KS, ql);
#pragma unroll
            for (int a = 0; a < 4; ++a)
#pragma unroll
                for (int b = 0; b < 4; ++b) acc[a][b] = mfma16(af[a], bfr[b], acc[a][b]);
            if (do_n) {
#pragma unroll
                for (int b = 0; b < 4; ++b) nacc[b] = mfma16(ones, bfr[b], nacc[b]); }
        }
        __syncthreads();
        if (half == 0) { M1_STORE(1); __syncthreads(); }
    }
#undef M1_LOAD
#undef M1_STORE
    float* DC = (float*)(p.ws + WS_DC) + ((size_t)(hh * 32 + c) * 512 + sl * 128) * 256;
#pragma unroll
    for (int a = 0; a < 4; ++a)
#pragma unroll
        for (int b = 0; b < 4; ++b)
#pragma unroll
            for (int j = 0; j < 4; ++j) DC[(size_t)((dvt0 + a) * 16 + quad * 4 + j) * 256 + (dkt0 + b) * 16 + ql] = acc[a][b][j];
    if (do_n && quad == 0) {
#pragma unroll
        for (int b = 0; b < 4; ++b) ((float*)(p.ws + WS_DN))[(hh * 32 + c) * 256 + (dkt0 + b) * 16 + ql] = nacc[b][0]; }
    if (sl == 0 && tid == 0) ((float*)(p.ws + WS_BL))[hh * 32 + c] = bL;
}
DI void m2_phase(const Params& p, int tid) {
    const float* DC = (const float*)(p.ws + WS_DC); const float* BL = (const float*)(p.ws + WS_BL);
    bf16* CS = (bf16*)(p.ws + WS_CS);
    const int gthreads = gridDim.x * NTHR, gid = blk() * NTHR + tid;
    for (int e4 = gid; e4 < 4 * 32768; e4 += gthreads) {
        const int hh = e4 >> 15, e = e4 & 32767;
        const int hu = __builtin_amdgcn_readfirstlane(hh);
        f32x4 st = {0.f, 0.f, 0.f, 0.f};
#pragma unroll
        for (int cb = 0; cb < 32; cb += 16) {
            f32x4 d[16];
#pragma unroll
            for (int c = 0; c < 16; ++c) d[c] = *(const f32x4*)(DC + ((size_t)(hh * 32 + cb + c) * 32768 + e) * 4);
#pragma unroll
            for (int c = 0; c < 16; ++c) {
                u32x2 w; w.x = pk2(st.x, st.y); w.y = pk2(st.z, st.w); *(u32x2*)(CS + ((size_t)(hh * 32 + cb + c) * 32768 + e) * 4) = w;
                st = st * __expf(BL[hu * 32 + cb + c]) + d[c];
            }
        }
    }
    if (gid < 1024) { const int hh = gid >> 8, dk = gid & 255; const float* DN = (const float*)(p.ws + WS_DN); float* NS = (float*)(p.ws + WS_NS);
        float dn[32], eb[32];
#pragma unroll
        for (int c = 0; c < 32; ++c) { dn[c] = DN[(hh * 32 + c) * 256 + dk]; eb[c] = BL[hh * 32 + c]; }
        float st = 0.f;
#pragma unroll
        for (int c = 0; c < 32; ++c) { NS[(hh * 32 + c) * 256 + dk] = st; st = st * __expf(eb[c]) + dn[c]; } }
}
DI void m3_stage_load(const Params& p, int hh, int c, int st, int tid, u32x4 (&pre)[8]) {
    if (st < 4) { const bf16* CT = (const bf16*)(p.ws + WS_CS) + (size_t)(hh * 32 + c) * 512 * 256;
#pragma unroll
        for (int i = 0; i < 8; ++i) { const int cc = tid + NTHR * i, row = cc >> 5, ch = cc & 31;
            pre[i] = *(const u32x4*)(CT + (size_t)((row >> 6) * 256 + st * 64 + (row & 63)) * 256 + ch * 8); }
    } else { const int kt = (st - 4) >> 1, hb = (st - 4) & 1; const bf16* U = (const bf16*)(p.ws + WS_U); const bf16* QKC = (const bf16*)(p.ws + WS_QKC);
        if (hb == 0) {
#pragma unroll
            for (int i = 0; i < 4; ++i) { const int cc = tid + NTHR * i, row = cc >> 5, ch = cc & 31; pre[i] = *(const u32x4*)(QKC + (size_t)(c * 256 + kt * 64 + row) * 2048 + 1024 + hh * 256 + ch * 8); } }
#pragma unroll
        for (int i = 0; i < 4; ++i) { const int cc = tid + NTHR * i, row = 32 * hb + (cc >> 6), ch = cc & 63; pre[4 + i] = *(const u32x4*)(U + (size_t)(c * 256 + kt * 64 + row) * NU + C_VM + hh * 512 + ch * 8); }
    }
}
DI void m3_stage_store(int st, int tid, const u32x4 (&pre)[8], LAS unsigned short* Ks, LAS unsigned short* Vs) {
    if (st < 4) {
#pragma unroll
        for (int i = 0; i < 8; ++i) { const int cc = tid + NTHR * i, row = cc >> 5, ch = cc & 31; *(LAS u32x4*)(Ks + row * M_KS + ch * 8) = pre[i]; }
    } else { const int hb = (st - 4) & 1;
        if (hb == 0) {
#pragma unroll
            for (int i = 0; i < 4; ++i) { const int cc = tid + NTHR * i, row = cc >> 5, ch = cc & 31; *(LAS u32x4*)(Ks + row * M_KS + ch * 8) = pre[i]; } }
#pragma unroll
        for (int i = 0; i < 4; ++i) { const int cc = tid + NTHR * i, row = 32 * hb + (cc >> 6), ch = cc & 63; *(LAS u32x4*)(Vs + row * M_VS3 + ch * 8) = pre[4 + i]; }
    }
}
DI void m3_item(const Params& p, LAS unsigned char* lds, int l, int hh, int qb, int tid, int wave, int lane) {
    asm volatile("" : "+v"(tid));
    const bf16* U = (const bf16*)(p.ws + WS_U);
    const bf16* QKC = (const bf16*)(p.ws + WS_QKC);
    LAS unsigned short* Qs = (LAS unsigned short*)lds;
    LAS unsigned short* Ks = Qs + 64 * M_KS;
    LAS unsigned short* Vs = Ks + 64 * M_KS;
    LAS float* bS = (LAS float*)(Vs + 64 * M_VS3); LAS float* liS = bS + 256; LAS float* nS = liS + 256; LAS float* wtot = nS + 256; LAS float* ssS = wtot + 8;
    const int c = qb >> 2, jq = qb & 3;
    const int ql = lane & 15, quad = lane >> 4;
    TS_MARK(99);
    u32x4 pre[8];
    u32x4 qv[4];
#pragma unroll
    for (int i = 0; i < 4; ++i) { const int cc = tid + NTHR * i, row = cc >> 5, ch = cc & 31; qv[i] = *(const u32x4*)(QKC + (size_t)(qb * 64 + row) * 2048 + hh * 256 + ch * 8); }
    m3_stage_load(p, hh, c, 0, tid, pre);
    if (tid < 256) nS[tid] = ((const float*)(p.ws + WS_NS))[(hh * 32 + c) * 256 + tid];
    chunk_gates((const float*)(p.ws + WS_GATES), c, hh, bS, liS, wtot, tid, wave, lane);
#pragma unroll
    for (int i = 0; i < 4; ++i) { const int cc = tid + NTHR * i, row = cc >> 5, ch = cc & 31; *(LAS u32x4*)(Qs + row * M_KS + ch * 8) = qv[i]; }
    __syncthreads();
    const int qg = wave & 3, dvh = wave >> 2, q = qg * 16 + ql, iq = jq * 64 + q;
    const LAS unsigned short* qrow = Qs + q * M_KS + quad * 8;
    const float b_ref = bS[jq * 64], e_ref = __expf(b_ref), ebq = __expf(bS[iq] - b_ref);
    f32x4 acc[16];
#pragma unroll
    for (int nt = 0; nt < 16; ++nt) acc[nt] = (f32x4){0.f, 0.f, 0.f, 0.f};
    float nq;
    { float nqp = 0.f;
#pragma unroll
      for (int ks = 0; ks < 8; ++ks) { const bf16x8 qk = *(const LAS bf16x8*)(qrow + ks * 32);
#pragma unroll
          for (int j = 0; j < 8; ++j) nqp += bf2f((unsigned short)qk[j]) * nS[ks * 32 + quad * 8 + j]; }
      nq = quad_sum(nqp) * e_ref; }
    float nqi = 0.f;
    TS_MARK(10);
    const int nst = 4 + 2 * (jq + 1);
    bf16x8 pf1 = {0, 0, 0, 0, 0, 0, 0, 0};
#pragma unroll 1
    for (int st = 0; st < nst; ++st) {
        __syncthreads();
        int tid2 = tid; asm volatile("" : "+v"(tid2));
        m3_stage_store(st, tid2, pre, Ks, Vs);
        __syncthreads();
        if (st + 1 < nst) m3_stage_load(p, hh, c, st + 1, tid2, pre);
        if (st < 4) {
            bf16x8 qf[8];
#pragma unroll
            for (int ks = 0; ks < 8; ++ks) qf[ks] = *(const LAS bf16x8*)(qrow + ks * 32);
#pragma unroll
            for (int n4 = 0; n4 < 4; ++n4) { const LAS unsigned short* cp = Ks + (dvh * 64 + n4 * 16 + ql) * M_KS + quad * 8;
#pragma unroll
                for (int ks = 0; ks < 8; ++ks) acc[n4] = mfma16(*(const LAS bf16x8*)(cp + ks * 32), qf[ks], acc[n4]);
                __builtin_amdgcn_sched_barrier(0); }
            { const f32x4 t0 = acc[0], t1 = acc[1], t2 = acc[2], t3 = acc[3];
#pragma unroll
              for (int i = 0; i < 12; ++i) acc[i] = acc[i + 4];
              acc[12] = t0; acc[13] = t1; acc[14] = t2; acc[15] = t3; }
            if (st == 3) {
#pragma unroll
                for (int nt = 0; nt < 16; ++nt) acc[nt] = acc[nt] * e_ref;
                TS_MARK(11); }
        } else {
            const int kt = (st - 4) >> 1, hb = (st - 4) & 1;
            bf16x8 pf;
            if (hb == 0) {
                bf16x8 qf[8];
#pragma unroll
                for (int ks = 0; ks < 8; ++ks) qf[ks] = *(const LAS bf16x8*)(qrow + ks * 32);
                f32x4 sacc[4];
#pragma unroll
                for (int t = 0; t < 4; ++t) sacc[t] = (f32x4){0.f, 0.f, 0.f, 0.f};
#pragma unroll
                for (int s2 = 0; s2 < 2; ++s2)
#pragma unroll
                    for (int u = 0; u < 2; ++u) { const int krow = 32 * s2 + (ql >> 2) * 8 + u * 4 + (ql & 3);
                        const LAS unsigned short* kp = Ks + krow * M_KS + quad * 8;
#pragma unroll
                        for (int ks = 0; ks < 8; ++ks) sacc[2 * s2 + u] = mfma16(*(const LAS bf16x8*)(kp + ks * 32), qf[ks], sacc[2 * s2 + u]); }
#pragma unroll
                for (int s2 = 0; s2 < 2; ++s2)
#pragma unroll
                    for (int u = 0; u < 2; ++u)
#pragma unroll
                        for (int j = 0; j < 4; ++j) { const int sk = kt * 64 + 32 * s2 + quad * 8 + u * 4 + j;
                            const float w = (sk <= iq) ? __expf(b_ref - bS[sk] + liS[sk]) : 0.f;
                            const float pv = sacc[2 * s2 + u][j] * w; sacc[2 * s2 + u][j] = pv; nqi += pv; }
                u32x4 pw; pw.x = pk2(sacc[0][0], sacc[0][1]); pw.y = pk2(sacc[0][2], sacc[0][3]); pw.z = pk2(sacc[1][0], sacc[1][1]); pw.w = pk2(sacc[1][2], sacc[1][3]);
                pf = __builtin_bit_cast(bf16x8, pw);
                u32x4 pw1; pw1.x = pk2(sacc[2][0], sacc[2][1]); pw1.y = pk2(sacc[2][2], sacc[2][3]); pw1.z = pk2(sacc[3][0], sacc[3][1]); pw1.w = pk2(sacc[3][2], sacc[3][3]);
                pf1 = __builtin_bit_cast(bf16x8, pw1);
            } else pf = pf1;
            const LAS unsigned short* vp = Vs + (32 * hb + quad * 8) * M_VS3 + dvh * 256;
#pragma unroll
            for (int nt = 0; nt < 16; ++nt) { acc[nt] = mfma16(trfrag(vp + nt * 16, M_VS3, ql), pf, acc[nt]); if ((nt & 3) == 3) __builtin_amdgcn_sched_barrier(0); }
        }
    }
    TS_MARK(12);
    nq = (nq + quad_sum(nqi)) * ebq;
#pragma unroll
    for (int nt = 0; nt < 16; ++nt) acc[nt] = acc[nt] * ebq;
    const float inv = 1.f / fmaxf(fabsf(nq), 1.f);
    float ss = 0.f;
#pragma unroll
    for (int nt = 0; nt < 16; ++nt) { acc[nt] = acc[nt] * inv; ss += (acc[nt][0] * acc[nt][0] + acc[nt][1] * acc[nt][1]) + (acc[nt][2] * acc[nt][2] + acc[nt][3] * acc[nt][3]); }
    ss = quad_sum(ss);
    if (quad == 0) ssS[dvh * 64 + q] = ss;
    __syncthreads();
    const float rstd = rsqrtf((ssS[q] + ssS[64 + q]) * (1.f / 512.f) + NORM_EPS);
    LAS unsigned short* Hs = Vs;
#pragma unroll
    for (int nt = 0; nt < 16; ++nt) { u32x2 w; w.x = pk2(acc[nt][0] * rstd, acc[nt][1] * rstd); w.y = pk2(acc[nt][2] * rstd, acc[nt][3] * rstd);
        *(LAS u32x2*)(Hs + q * M_VS3 + dvh * 256 + nt * 16 + quad * 4) = w; }
    __syncthreads();
    const float* ng = p.mnorm_g + l * 2048 + hh * 512;
    bf16* Y = (bf16*)(p.ws + WS_Y);
#pragma unroll
    for (int ib = 0; ib < 8; ib += 2) {
        u32x4 omv[2], zmv[2]; f32x4 g0[2], g1[2];
#pragma unroll
        for (int i = 0; i < 2; ++i) { const int cc = tid + NTHR * (ib + i), row = cc >> 6, ch = cc & 63; const bf16* up = U + (size_t)(qb * 64 + row) * NU + hh * 512 + ch * 8;
            omv[i] = *(const u32x4*)(up + C_OM); zmv[i] = *(const u32x4*)(up + C_ZM); g0[i] = *(const f32x4*)(ng + ch * 8); g1[i] = *(const f32x4*)(ng + ch * 8 + 4); }
#pragma unroll
        for (int i = 0; i < 2; ++i) { const int cc = tid + NTHR * (ib + i), row = cc >> 6, ch = cc & 63;
            const u32x4 hv = *(const LAS u32x4*)(Hs + row * M_VS3 + ch * 8);
            u32x4 y;
            y.x = pk2(bf_lo(hv.x) * g0[i][0] * sigm_f(bf_lo(omv[i].x)) * silu_f(bf_lo(zmv[i].x)), bf_hi(hv.x) * g0[i][1] * sigm_f(bf_hi(omv[i].x)) * silu_f(bf_hi(zmv[i].x)));
            y.y = pk2(bf_lo(hv.y) * g0[i][2] * sigm_f(bf_lo(omv[i].y)) * silu_f(bf_lo(zmv[i].y)), bf_hi(hv.y) * g0[i][3] * sigm_f(bf_hi(omv[i].y)) * silu_f(bf_hi(zmv[i].y)));
            y.z = pk2(bf_lo(hv.z) * g1[i][0] * sigm_f(bf_lo(omv[i].z)) * silu_f(bf_lo(zmv[i].z)), bf_hi(hv.z) * g1[i][1] * sigm_f(bf_hi(omv[i].z)) * silu_f(bf_hi(zmv[i].z)));
            y.w = pk2(bf_lo(hv.w) * g1[i][2] * sigm_f(bf_lo(omv[i].w)) * silu_f(bf_lo(zmv[i].w)), bf_hi(hv.w) * g1[i][3] * sigm_f(bf_hi(omv[i].w)) * silu_f(bf_hi(zmv[i].w)));
            *(u32x4*)(Y + (size_t)(qb * 64 + row) * DM + 2048 + hh * 512 + ch * 8) = y; }
        __builtin_amdgcn_sched_barrier(0);
    }
    __syncthreads();
    TS_MARK(13);
}

#define RLX_AGENT __ATOMIC_RELAXED, __HIP_MEMORY_SCOPE_AGENT
#define XB_TMO      128
#define XB_XCNT(j)  (256  + 64 * (j))
#define XB_XSUB(j)  (1280 + 64 * (j))
#define XB_XGEN(j)  (2304 + 64 * (j))
#define XB_TOP      3328
#define XB_TOPGEN   3392
#define XCD_BAR_WORDS 3456
#define XB_SPIN_CAP (1u << 18)

__device__ __forceinline__ unsigned xb_ld(unsigned* p)              { return __hip_atomic_load(p, __ATOMIC_RELAXED, __HIP_MEMORY_SCOPE_AGENT); }
__device__ __forceinline__ unsigned xb_add(unsigned* p, unsigned v) { return __hip_atomic_fetch_add(p, v, __ATOMIC_RELAXED, __HIP_MEMORY_SCOPE_AGENT); }
__device__ __forceinline__ unsigned xb_xcc_id() { return (unsigned)__builtin_amdgcn_s_getreg((3 << 11) | 20) & 0xFu; }
#define XB_SPIN(cond, bar) do { unsigned _sp = 0; while (cond) { __builtin_amdgcn_s_sleep(1); \
    if ((++_sp & 255u) == 0u) { if (xb_ld(&(bar)[XB_TMO])) break; if (_sp > XB_SPIN_CAP) { atomicAdd(&(bar)[XB_TMO], 1u); break; } } } } while (0)

struct XcdBarrier {
    unsigned* bar; unsigned x;
    volatile LAS unsigned* st;
};

__device__ __forceinline__ XcdBarrier xcd_barrier_post(unsigned* bar, volatile LAS unsigned* st) {
    XcdBarrier b; b.bar = bar; b.x = xb_xcc_id(); b.st = st;
    if (threadIdx.x == 0) (void)xb_add(&bar[XB_XCNT(b.x)], 1u);
    return b;
}
__device__ __forceinline__ void xcd_barrier_complete(unsigned* bar, unsigned x, unsigned& nloc, unsigned& nx) {
    const unsigned G = gridDim.x * gridDim.y * gridDim.z;
    unsigned sum, cnt, mine, sp = 0u;
    for (;;) {
        sum = 0u; cnt = 0u; mine = 0u;
#pragma unroll
        for (unsigned j = 0; j < 16; ++j) { const unsigned c = xb_ld(&bar[XB_XCNT(j)]); sum += c; cnt += (c > 0u) ? 1u : 0u; mine = (j == x) ? c : mine; }
        if (sum == G) break;
        __builtin_amdgcn_s_sleep(1);
        if ((++sp & 255u) == 0u) { if (xb_ld(&bar[XB_TMO])) break; if (sp > XB_SPIN_CAP) { atomicAdd(&bar[XB_TMO], 1u); break; } }
    }
    nloc = mine > 0u ? mine : 1u; nx = cnt > 0u ? cnt : 1u;
}

__device__ __forceinline__ void xcd_barrier(const XcdBarrier& b) {
    asm volatile("s_waitcnt vmcnt(0)" ::: "memory");
    __syncthreads();
    if (threadIdx.x == 0) {
        unsigned* bar = b.bar;
        __builtin_amdgcn_s_waitcnt(0);
        unsigned nloc = b.st[0], nx = b.st[1];
        if (nloc == 0u) { xcd_barrier_complete(bar, b.x, nloc, nx); b.st[0] = nloc; b.st[1] = nx; }
        const unsigned old = xb_add(&bar[XB_XSUB(b.x)], 1u);
        const unsigned gen = old / nloc;
        if (old + 1u == (gen + 1u) * nloc) {
            __builtin_amdgcn_fence(__ATOMIC_RELEASE, "agent");
            asm volatile("s_waitcnt vmcnt(0)" ::: "memory");
            const unsigned og = xb_add(&bar[XB_TOP], 1u);
            const unsigned tg = og / nx;
            if (og + 1u == (tg + 1u) * nx) xb_add(&bar[XB_TOPGEN], 1u);
            else XB_SPIN(xb_ld(&bar[XB_TOPGEN]) == tg, bar);
            __builtin_amdgcn_fence(__ATOMIC_ACQUIRE, "agent");
            xb_add(&bar[XB_XGEN(b.x)], 1u);
            asm volatile("s_waitcnt vmcnt(0)" ::: "memory");
        } else {
            XB_SPIN(xb_ld(&bar[XB_XGEN(b.x)]) == gen, bar);
            __builtin_amdgcn_fence(__ATOMIC_ACQUIRE, "agent");
            asm volatile("s_waitcnt vmcnt(0)" ::: "memory");
        }
    }
    __syncthreads();
}

#if TSEL >= 7
#define TSUB_BEGIN(k) unsigned long long tsub_b = 0; if ((TSEL) == (k) && threadIdx.x == 0) tsub_b = __builtin_amdgcn_s_memrealtime();
#define TSUB_END(k) if ((TSEL) == (k) && threadIdx.x == 0) { volatile LAS unsigned long long* TWs = (volatile LAS unsigned long long*)((LAS unsigned char*)lds_raw + LDS_BARST + 16); TWs[2] += __builtin_amdgcn_s_memrealtime() - tsub_b; }
#else
#define TSUB_BEGIN(k)
#define TSUB_END(k)
#endif
constexpr int NPH = 15;
__global__ void __launch_bounds__(NTHR, 2) hymba_fwd(Params p0) {
    extern __shared__ __attribute__((aligned(16))) unsigned char lds_raw[];
    cg::grid_group grid = cg::this_grid();
    if (threadIdx.x < 16) ((LAS unsigned*)((LAS unsigned char*)lds_raw + LDS_BARST))[threadIdx.x] = 0u;
    __syncthreads();
    XcdBarrier bar = xcd_barrier_post((unsigned*)(p0.ws + WS_CTL), (volatile LAS unsigned*)((LAS unsigned char*)lds_raw + LDS_BARST));
#if TSEL >= 0
    volatile LAS unsigned long long* TW = (volatile LAS unsigned long long*)((LAS unsigned char*)lds_raw + LDS_BARST + 16);
    if (threadIdx.x == 0) { const unsigned long long t = __builtin_amdgcn_s_memrealtime(); TW[0] = t; TW[1] = t; TW[2] = 0; }
#endif
    for (int ph = p0.ph_lo; ph < p0.ph_hi; ++ph) {
        const int ptype = ph == 0 ? 0 : 1 + (ph - 1) % 7;
        const int nrep = (REPEAT_MASK) == 0 ? 1 : ((((REPEAT_MASK) >> ptype) & 1) ? 2 : 1);
        for (int rep = 0; rep < nrep; ++rep) {
        int tid = threadIdx.x; asm volatile("" : "+v"(tid));
        int G = gridDim.x; asm volatile("" : "+s"(G));
        const int lane = tid & 63, wave = __builtin_amdgcn_readfirstlane(tid >> 6);
        LAS unsigned char* lds = (LAS unsigned char*)lds_raw; asm volatile("" : "+s"(lds));
        Params p = p0;
        asm volatile("" : "+s"(p.ws)); asm volatile("" : "+s"(p.x)); asm volatile("" : "+s"(p.out)); asm volatile("" : "+s"(p.w_in)); asm volatile("" : "+s"(p.w_out));
        asm volatile("" : "+s"(p.conv_w)); asm volatile("" : "+s"(p.norm_g)); asm volatile("" : "+s"(p.mnorm_g)); asm volatile("" : "+s"(p.b_gate)); asm volatile("" : "+s"(p.rel_bias)); asm volatile("" : "+s"(p.final_g));
        if (ph == 0) {
            prologue_transposes(p, lds, wave, lane);
            build_wgt(p, tid);
            norm_phase(p, p.x, 0, wave, lane);
        } else {
            const int l = (ph - 1) / 7, k = (ph - 1) % 7;
            if (k == 0) {
                pg8::Gemm g{(const pg8::bf16_t*)(p.ws + WS_XN), (const pg8::bf16_t*)(p.ws + WS_WIN + (size_t)l * 128 * MiB), SEQ, NU, DM};
                pg8::StaticOrder S; S.init(SEQ, NU, G, blk());
                pg8::EpiBf16Plain E{(pg8::bf16_t*)(p.ws + WS_U), NU};
                pg8::gemm_phase<pg8::EpiBf16Plain, pg8::StaticOrder, true, true>(lds, g, S, E);
            } else if (k == 1) {
                gate_items(p, lds, l, tid, wave, lane);
                conv_prepass(p, l, tid);
                attn_phase(p, lds, tid, wave, lane);
            } else if (k == 2) {
                const bool xmap = (G == 256); const int xcd = blk() & 7, xi = blk() >> 3;
                int tid3 = tid; asm volatile("" : "+v"(tid3));
                { TSUB_BEGIN(8)
                for (int rr = 0; rr < 1 + (REP_M1); ++rr)
                for (int it = blk(), rnd = 0; it < 512; it += G, ++rnd) {
                    int item = it;
                    if (xmap) item = (xcd * 16 + rnd * 8 + (xi >> 2)) * 4 + (xi & 3);
                    m1_item(p, lds, l, item, tid3, __builtin_amdgcn_readfirstlane(tid3 >> 6), tid3 & 63); __syncthreads(); }
                TSUB_END(8) }
                merge_phase(p, tid);
            } else if (k == 3) {
                m2_phase(p, tid);
            } else if (k == 4) {
                const bool xmap = (G == 256); const int xcd = blk() & 7, xi = blk() >> 3;
                TSUB_BEGIN(9)
                for (int it = blk(), rnd = 0; it < 512; it += G, ++rnd) {
                    int hh = it >> 7, qb = it & 127; if ((it >> 8) & 1) qb ^= 3;
                    if (xmap) { const int pair = xcd * 16 + rnd * 8 + (xi >> 2); hh = pair >> 5; qb = (pair & 31) * 4 + (rnd ? 3 - (xi & 3) : (xi & 3)); }
                    m3_item(p, lds, l, hh, qb, tid, wave, lane); }
                TSUB_END(9)
            } else if (k == 5) {
                pg8::Gemm g{(const pg8::bf16_t*)(p.ws + WS_Y), (const pg8::bf16_t*)(p.ws + WS_WOUT + (size_t)l * 32 * MiB), SEQ, DM, DM};
                pg8::StaticOrder S; S.init(SEQ, DM, G, blk());
                pg8::EpiResF32 E{l == 0 ? p.x : (const float*)(p.ws + WS_X1), l == 0 ? (float*)(p.ws + WS_X1) : p.out, DM};
                pg8::gemm_phase<pg8::EpiResF32, pg8::StaticOrder, true, true>(lds, g, S, E);
            } else {
                if (l == 0) norm_phase(p, (const float*)(p.ws + WS_X1), 1, wave, lane);
                else final_norm_phase(p, (LAS unsigned char*)lds_raw, wave, lane);
            }
        }
        __syncthreads();
        }
        if (ph + 1 < p0.ph_hi) { if (p0.ph_hi > NPH) grid.sync(); else xcd_barrier(bar); }
#if TSEL >= 0
        if (threadIdx.x == 0) { const unsigned long long now = __builtin_amdgcn_s_memrealtime(); if (ptype == (TSEL)) TW[2] += now - TW[1]; TW[1] = now;
          if (ph + 2 == p0.ph_hi) ((volatile LAS int*)TW)[8] = (int)((float)TW[2] / (float)(now - TW[0]) * 131072.f); }
        if (ph + 2 == p0.ph_hi) __syncthreads();
#endif
    }
}

extern "C" void kernel_launch(void* const* d_in, const int* in_sizes, int n_in, void* d_out, int out_size, void* d_ws, size_t ws_size, hipStream_t stream) {
    static int grid = 0;
    if (grid == 0) {
        if (n_in != 9 || in_sizes[0] != SEQ * DM || out_size != SEQ * DM || ws_size < WS_END) {
            fprintf(stderr, "kernel_launch: unexpected problem: n_in %d in0 %d out %d ws %zu (need %zu)\n", n_in, n_in > 0 ? in_sizes[0] : -1, out_size, ws_size, (size_t)WS_END); grid = -1; return; }
        int dev = 0, cus = 0, per_cu = 0;
        hipGetDevice(&dev);
        hipDeviceGetAttribute(&cus, hipDeviceAttributeMultiprocessorCount, dev);
        if (hipFuncSetAttribute((const void*)hymba_fwd, hipFuncAttributeMaxDynamicSharedMemorySize, LDS_BYTES) != hipSuccess) { fprintf(stderr, "kernel_launch: hipFuncSetAttribute failed\n"); grid = -1; return; }
        if (hipOccupancyMaxActiveBlocksPerMultiprocessor(&per_cu, (const void*)hymba_fwd, NTHR, LDS_BYTES) != hipSuccess || per_cu < 1) { fprintf(stderr, "kernel_launch: occupancy query gave %d\n", per_cu); per_cu = 1; }
        (void)hipGetLastError();
        grid = cus * per_cu;
        fprintf(stderr, "kernel_launch: %d CUs x %d = grid %d\n", cus, per_cu, grid);
    }
    if (grid < 0) return;
    if (hipMemsetAsync((char*)d_ws + WS_CTL, 0, 16384, stream) != hipSuccess) { fprintf(stderr, "kernel_launch: hipMemsetAsync failed\n"); return; }
    Params p{};
    p.x = (const float*)d_in[0]; p.norm_g = (const float*)d_in[1]; p.w_in = (const float*)d_in[2]; p.b_gate = (const float*)d_in[3]; p.conv_w = (const float*)d_in[4];
    p.mnorm_g = (const float*)d_in[5]; p.w_out = (const float*)d_in[6]; p.rel_bias = (const float*)d_in[7]; p.final_g = (const float*)d_in[8];
    p.out = (float*)d_out; p.ws = (unsigned char*)d_ws;
#if MULTI_LAUNCH
    for (int ph = 0; ph < NPH; ++ph) { p.ph_lo = ph; p.ph_hi = ph + 1; hipLaunchKernelGGL(hymba_fwd, dim3(grid), dim3(NTHR), LDS_BYTES, stream, p); }
#else
    p.ph_lo = 0; p.ph_hi = NPH;
    void* args[] = {&p};
    hipError_t e = hipLaunchCooperativeKernel((const void*)hymba_fwd, dim3(grid), dim3(NTHR), args, LDS_BYTES, stream);
    if (e != hipSuccess) fprintf(stderr, "kernel_launch: cooperative launch failed: %s (grid %d)\n", hipGetErrorString(e), grid);
#endif
}
```

```cpp
#include <hip/hip_runtime.h>
#include <hip/hip_cooperative_groups.h>
#include <cstdio>
#include <cstdint>
namespace cg = cooperative_groups;
namespace pg8 {
#define PG8_LAS __attribute__((address_space(3)))
typedef unsigned short bf16_t;
typedef short bf16x8 __attribute__((ext_vector_type(8)));
typedef float f32x4 __attribute__((ext_vector_type(4)));
typedef unsigned u32x4 __attribute__((ext_vector_type(4)));
constexpr int BM = 256, BK = 64, HALF = 128, HTB = HALF * BK * 2  , STAGE_BYTES = 8 * HTB, NXCD = 8, WGM = 8;

__host__ __device__ __forceinline__ int lds_byte(int r, int c) { const int st = (r >> 4) * 2 + (c >> 5), rr = r & 15, cc = c & 31, ob = rr * 64 + cc * 2; return st * 1024 + (ob ^ (((ob >> 9) & 1) << 5)); }
__host__ __device__ __forceinline__ void stage_rc(int b, int& R, int& C) { const int st = b / 1024, sb = b % 1024, swz = sb ^ (((sb >> 9) & 1) << 5); R = (st >> 1) * 16 + swz / 64; C = (st & 1) * 32 + (swz % 64) / 2; }
__host__ __device__ __forceinline__ int perm32(int rho) { const int n = rho >> 4, i = rho & 15; return 8 * (i >> 2) + 4 * n + (i & 3); }

struct Unit { int pm, pn; };
struct Gemm { const bf16_t* A; const bf16_t* Bt; int M, N, K; };

struct StaticOrder {
    int nM, nN, nwg, G, c;
    __host__ __device__ void init(int M, int N, int G_, int c_) { nM = M / BM; nN = N / BM; nwg = nM * nN; G = G_; c = c_; }
    __host__ __device__ bool next(int i, Unit& u) const {
        const long L = (long)i * G + c; if (L >= nwg) return false;
        int wgid = (int)L; { const int q = nwg / NXCD, r = nwg % NXCD, xcd = wgid % NXCD, off = wgid / NXCD; wgid = (xcd < r ? xcd * (q + 1) : r * (q + 1) + (xcd - r) * q) + off; }
        const int nig = WGM * nN, gid = wgid / nig, fm = gid * WGM, gsz = (nM - fm) < WGM ? (nM - fm) : WGM;
        u.pm = fm + ((wgid % nig) % gsz); u.pn = (wgid % nig) / gsz; return true;
    }
    __device__ __forceinline__ void a_ready(const Unit&) const {}
    __device__ __forceinline__ void done(const Unit&) const {}
};

__device__ __forceinline__ unsigned cvt_pk_bf16(float lo, float hi) { unsigned r; asm volatile("v_cvt_pk_bf16_f32 %0, %1, %2" : "=v"(r) : "v"(lo), "v"(hi)); return r; }
struct EpiBf16Plain {
    static constexpr bool PERM = true, AFTER_DRAIN = false;
    bf16_t* O; int ldc;
    __device__ __forceinline__ void operator()(const f32x4 (&acc)[2][2][4][2], const Unit& u, int wr, int wc, int fr, int fq) const {
        const int row0 = u.pm * BM + wr * 64 + fr; const int col0 = u.pn * BM + wc * 32 + 8 * fq;
#pragma unroll
        for (int ai = 0; ai < 2; ++ai)
#pragma unroll
            for (int m = 0; m < 4; ++m) { bf16_t* rowp = O + (size_t)(row0 + ai * HALF + m * 16) * ldc + col0;
#pragma unroll
                for (int bj = 0; bj < 2; ++bj) { const f32x4 v0 = acc[ai][bj][m][0], v1 = acc[ai][bj][m][1];
                    u32x4 w; w.x = cvt_pk_bf16(v0[0], v0[1]); w.y = cvt_pk_bf16(v0[2], v0[3]); w.z = cvt_pk_bf16(v1[0], v1[1]); w.w = cvt_pk_bf16(v1[2], v1[3]);
                    *(u32x4*)(rowp + bj * HALF) = w; } }
    }
};
struct EpiResF32 {
    static constexpr bool PERM = true, AFTER_DRAIN = false;
    const float* base; float* out; int ld;
    __device__ __forceinline__ void operator()(const f32x4 (&acc)[2][2][4][2], const Unit& u, int wr, int wc, int fr, int fq) const {
        const int row0 = u.pm * BM + wr * 64 + fr; const int col0 = u.pn * BM + wc * 32 + 8 * fq;
#pragma unroll
        for (int ai = 0; ai < 2; ++ai)
#pragma unroll
            for (int m = 0; m < 4; ++m) { const size_t ro = (size_t)(row0 + ai * HALF + m * 16) * ld + col0;
#pragma unroll
                for (int bj = 0; bj < 2; ++bj) {
                    const f32x4 b0 = *(const f32x4*)(base + ro + bj * HALF), b1 = *(const f32x4*)(base + ro + bj * HALF + 4);
                    *(f32x4*)(out + ro + bj * HALF) = acc[ai][bj][m][0] + b0;
                    *(f32x4*)(out + ro + bj * HALF + 4) = acc[ai][bj][m][1] + b1; } }
    }
};
template <class Epi, class Sched, bool ALIGN_EPI = false, bool SP2 = false>
__device__ __forceinline__ void gemm_phase(PG8_LAS unsigned char* lds, const Gemm g, const Sched& S, const Epi& E) {
    int tid = threadIdx.x; asm volatile("" : "+v"(tid));
    const int wid = __builtin_amdgcn_readfirstlane(tid >> 6), lane = tid & 63, wr = wid >> 2, wc = wid & 3, fr = lane & 15, fq = lane >> 4;
    const int K = g.K, nt = K / BK;
    unsigned voffA[2], voffB[2];
#pragma unroll
    for (int i = 0; i < 2; ++i) { int R, C; stage_rc(tid * 16 + i * 8192, R, C); const int Rb = Epi::PERM ? ((R & ~31) + perm32(R & 31)) : R;
        voffA[i] = (unsigned)(R * K + C) * 2u; voffB[i] = (unsigned)(Rb * K + C) * 2u; }
    const size_t kstep = (size_t)(BK * 2);
    const size_t hstep = (size_t)HALF * K * 2;
    const size_t tstep = 2 * hstep;
    const unsigned ldsw = (unsigned)wid * 1024u;
    const int aoff = lds_byte(wr * 64 + fr, fq * 8), boff = lds_byte(wc * 32 + fr, fq * 8);
#define PG8_SA(b, h) (((b) * 2 + (h)) * HTB)
#define PG8_SB(b, h) ((4 + (b) * 2 + (h)) * HTB)
#define PG8_STAGE(bufoff, gbase, voff) do { _Pragma("unroll") for (int _i = 0; _i < 2; ++_i) \
        __builtin_amdgcn_global_load_lds((const unsigned*)((const char*)(gbase) + (voff)[_i]), (PG8_LAS unsigned*)(lds + (bufoff) + ldsw + _i * 8192), 16, 0, 0); } while (0)
#define PG8_LDA(dst, b, h) do { _Pragma("unroll") for (int m = 0; m < 4; ++m) _Pragma("unroll") for (int k = 0; k < 2; ++k) dst[m][k] = *(const PG8_LAS bf16x8*)(lds + PG8_SA(b, h) + aoff + m * 2048 + k * 1024); } while (0)
#define PG8_LDB(dst, b, h) do { _Pragma("unroll") for (int n = 0; n < 2; ++n) _Pragma("unroll") for (int k = 0; k < 2; ++k) dst[n][k] = *(const PG8_LAS bf16x8*)(lds + PG8_SB(b, h) + boff + n * 2048 + k * 1024); } while (0)
#define PG8_MMA(ai, bj, At, Bt) do { __builtin_amdgcn_s_setprio(1); _Pragma("unroll") for (int m = 0; m < 4; ++m) _Pragma("unroll") for (int n = 0; n < 2; ++n) _Pragma("unroll") for (int k = 0; k < 2; ++k) \
        acc[ai][bj][m][n] = __builtin_amdgcn_mfma_f32_16x16x32_bf16(Bt[n][k], At[m][k], acc[ai][bj][m][n], 0, 0, 0); __builtin_amdgcn_s_setprio(0); } while (0)
#define PG8_WAIT_V(n) asm volatile("s_waitcnt vmcnt(" #n ")" ::: "memory")
#define PG8_WAIT_L(n) asm volatile("s_waitcnt lgkmcnt(" #n ")" ::: "memory")
#define PG8_BAR __builtin_amdgcn_s_barrier()
#define PG8_SCHED __builtin_amdgcn_sched_barrier(0)
    Unit cur, nxt; int ui = 0;
    if (!S.next(0, cur)) return;
    f32x4 acc[2][2][4][2];
#pragma unroll
    for (int a = 0; a < 2; ++a)
#pragma unroll
        for (int b = 0; b < 2; ++b)
#pragma unroll
            for (int m = 0; m < 4; ++m)
#pragma unroll
                for (int n = 0; n < 2; ++n) acc[a][b][m][n] = (f32x4){0.f, 0.f, 0.f, 0.f};
    bf16x8 At[4][2], B0[2][2], B1[2][2];
    const char* cA = (const char*)g.A + (size_t)cur.pm * tstep; const char* cB = (const char*)g.Bt + (size_t)cur.pn * tstep;
    S.a_ready(cur);
    if constexpr (SP2) {
        PG8_STAGE(PG8_SB(0, 0), cB, voffB); PG8_STAGE(PG8_SB(0, 1), cB + hstep, voffB); PG8_STAGE(PG8_SA(0, 0), cA, voffA); PG8_STAGE(PG8_SA(0, 1), cA + hstep, voffA);
        if (wr == 1) PG8_BAR;
        PG8_WAIT_V(2); PG8_BAR;
        PG8_STAGE(PG8_SB(1, 0), cB + kstep, voffB); PG8_STAGE(PG8_SA(1, 0), cA + kstep, voffA); PG8_STAGE(PG8_SB(1, 1), cB + hstep + kstep, voffB);
        PG8_WAIT_V(6); PG8_BAR;
    } else {
        PG8_STAGE(PG8_SB(0, 0), cB, voffB); PG8_STAGE(PG8_SA(0, 0), cA, voffA); PG8_STAGE(PG8_SB(0, 1), cB + hstep, voffB); PG8_STAGE(PG8_SA(0, 1), cA + hstep, voffA);
        if (wr == 1) PG8_BAR;
        PG8_WAIT_V(4); PG8_BAR;
        PG8_STAGE(PG8_SB(1, 0), cB + kstep, voffB); PG8_STAGE(PG8_SA(1, 0), cA + kstep, voffA); PG8_STAGE(PG8_SB(1, 1), cB + hstep + kstep, voffB);
        PG8_WAIT_V(6); PG8_BAR;
    }
    for (;;) {
        const bool has_next = S.next(ui + 1, nxt);
        const char* nA = has_next ? (const char*)g.A + (size_t)nxt.pm * tstep : cA; const char* nB = has_next ? (const char*)g.Bt + (size_t)nxt.pn * tstep : cB;
        for (int t = 0; t < nt; t += 2) {
            const bool last = (t == nt - 2);
            const char* a1 = cA + (size_t)(t + 1) * kstep;
            const char* a2 = last ? nA : cA + (size_t)(t + 2) * kstep; const char* b2 = last ? nB : cB + (size_t)(t + 2) * kstep;
            const char* a3 = a2 + kstep; const char* b3 = b2 + kstep;
            if (last && has_next) S.a_ready(nxt);
            if constexpr (SP2) {
            PG8_LDB(B0, 0, 0); PG8_LDB(B1, 0, 1); PG8_SCHED; PG8_LDA(At, 0, 0); PG8_STAGE(PG8_SA(1, 1), a1 + hstep, voffA);
            PG8_WAIT_V(8); PG8_WAIT_L(0); PG8_BAR; PG8_MMA(0, 0, At, B0); PG8_MMA(0, 1, At, B1); PG8_BAR; PG8_SCHED;
            PG8_LDA(At, 0, 1); PG8_STAGE(PG8_SB(0, 0), b2, voffB); PG8_STAGE(PG8_SB(0, 1), b2 + hstep, voffB); PG8_STAGE(PG8_SA(0, 0), a2, voffA);
            PG8_WAIT_V(8); PG8_WAIT_L(0); PG8_BAR; PG8_MMA(1, 0, At, B0); PG8_MMA(1, 1, At, B1); PG8_BAR; PG8_SCHED;
            PG8_LDB(B0, 1, 0); PG8_LDB(B1, 1, 1); PG8_SCHED; PG8_LDA(At, 1, 0); PG8_STAGE(PG8_SA(0, 1), a2 + hstep, voffA);
            PG8_WAIT_V(8); PG8_WAIT_L(0); PG8_BAR; PG8_MMA(0, 0, At, B0); PG8_MMA(0, 1, At, B1); PG8_BAR; PG8_SCHED;
            PG8_LDA(At, 1, 1); PG8_STAGE(PG8_SB(1, 0), b3, voffB); PG8_STAGE(PG8_SB(1, 1), b3 + hstep, voffB); PG8_STAGE(PG8_SA(1, 0), a3, voffA);
            PG8_WAIT_V(8); PG8_WAIT_L(0); PG8_BAR; PG8_MMA(1, 0, At, B0); PG8_MMA(1, 1, At, B1); PG8_BAR; PG8_SCHED;
            } else {
            PG8_LDB(B0, 0, 0); PG8_SCHED; PG8_LDA(At, 0, 0); PG8_STAGE(PG8_SA(1, 1), a1 + hstep, voffA);
            PG8_WAIT_L(8); PG8_BAR; PG8_WAIT_L(0); PG8_MMA(0, 0, At, B0); PG8_BAR; PG8_SCHED;
            PG8_LDB(B1, 0, 1); PG8_STAGE(PG8_SB(0, 0), b2, voffB);
            PG8_BAR; PG8_WAIT_L(0); PG8_MMA(0, 1, At, B1); PG8_BAR;
            PG8_LDA(At, 0, 1); PG8_STAGE(PG8_SA(0, 0), a2, voffA);
            PG8_BAR; PG8_WAIT_L(0); PG8_MMA(1, 0, At, B0); PG8_BAR; PG8_SCHED;
            PG8_STAGE(PG8_SB(0, 1), b2 + hstep, voffB);
            PG8_WAIT_V(6); PG8_BAR; PG8_MMA(1, 1, At, B1); PG8_BAR;
            PG8_LDB(B0, 1, 0); PG8_SCHED; PG8_LDA(At, 1, 0); PG8_STAGE(PG8_SA(0, 1), a2 + hstep, voffA);
            PG8_WAIT_L(8); PG8_BAR; PG8_WAIT_L(0); PG8_MMA(0, 0, At, B0); PG8_BAR; PG8_SCHED;
            PG8_LDB(B1, 1, 1); PG8_STAGE(PG8_SB(1, 0), b3, voffB);
            PG8_BAR; PG8_WAIT_L(0); PG8_MMA(0, 1, At, B1); PG8_BAR;
            PG8_LDA(At, 1, 1); PG8_STAGE(PG8_SA(1, 0), a3, voffA);
            PG8_BAR; PG8_WAIT_L(0); PG8_MMA(1, 0, At, B0); PG8_BAR; PG8_SCHED;
            PG8_STAGE(PG8_SB(1, 1), b3 + hstep, voffB);
            PG8_WAIT_V(6); PG8_BAR; PG8_MMA(1, 1, At, B1); PG8_BAR;
            }
        }
        if constexpr (ALIGN_EPI) { if (wr == 0) PG8_BAR; }
        if constexpr (!Epi::AFTER_DRAIN) { E(acc, cur, wr, wc, fr, fq); S.done(cur); }
        if (!has_next) break;
#pragma unroll
        for (int a = 0; a < 2; ++a)
#pragma unroll
            for (int b = 0; b < 2; ++b)
#pragma unroll
                for (int m = 0; m < 4; ++m)
#pragma unroll
                    for (int n = 0; n < 2; ++n) acc[a][b][m][n] = (f32x4){0.f, 0.f, 0.f, 0.f};
        cur = nxt; cA = nA; cB = nB; ++ui;
        if constexpr (ALIGN_EPI) { if (wr == 1) PG8_BAR; }
    }
    PG8_WAIT_V(0);
    if constexpr (!ALIGN_EPI) { if (wr == 0) PG8_BAR; }
    PG8_BAR;
    if constexpr (Epi::AFTER_DRAIN) { E.fused(acc, cur, wr, wc, fr, fq, lds, wid, lane); S.done(cur); }
#undef PG8_SA
#undef PG8_SB
#undef PG8_STAGE
#undef PG8_LDA
#undef PG8_LDB
#undef PG8_MMA
#undef PG8_WAIT_V
#undef PG8_WAIT_L
#undef PG8_BAR
#undef PG8_SCHED
}
}

#ifndef MULTI_LAUNCH
#define MULTI_LAUNCH 0
#endif
#ifndef USE_TR
#define USE_TR 1
#endif
#ifndef TSEL
#define TSEL (-1)
#endif
#if TSEL >= 10
#define TS_MARK(k0) do { if (threadIdx.x == 0) { volatile LAS unsigned long long* TWs = (volatile LAS unsigned long long*)(lds + LDS_BARST + 16); const unsigned long long nowt = __builtin_amdgcn_s_memrealtime(); if ((TSEL) == (k0)) TWs[2] += nowt - TWs[3]; TWs[3] = nowt; } } while (0)
#else
#define TS_MARK(k0) do {} while (0)
#endif
#ifndef REP_ATTN
#define REP_ATTN 0
#endif
#ifndef REP_M1
#define REP_M1 0
#endif
#ifndef REPEAT_MASK
#define REPEAT_MASK 0
#endif
#define LAS __attribute__((address_space(3)))
#define DI __device__ __forceinline__
typedef unsigned short bf16;
typedef short bf16x8 __attribute__((ext_vector_type(8)));
typedef float f32x4 __attribute__((ext_vector_type(4)));
typedef unsigned u32x4 __attribute__((ext_vector_type(4)));
typedef unsigned u32x2 __attribute__((ext_vector_type(2)));

constexpr int SEQ = 8192, DM = 4096, INW = 16392, NU = 16384;
constexpr int C_QA = 0, C_KA = 2048, C_VA = 4096, C_ZA = 6144, C_QM = 8192, C_KM = 9216, C_VM = 10240, C_OM = 12288, C_ZM = 14336;
constexpr float NORM_EPS = 1e-6f;
constexpr int NTHR = 512, NWAVE = 8;
constexpr int LDS_BYTES = 147456;

constexpr size_t MiB = (size_t)1 << 20;
constexpr size_t WS_WIN = 0, WS_WOUT = 256 * MiB, WS_XN = 320 * MiB, WS_U = 384 * MiB, WS_OP = 640 * MiB, WS_Y = 736 * MiB, WS_X1 = 800 * MiB,
                 WS_DC = 928 * MiB, WS_CS = 992 * MiB, WS_LSE = 1024 * MiB, WS_GATES = 1026 * MiB, WS_DN = 1027 * MiB, WS_NS = 1028 * MiB, WS_BL = 1029 * MiB,
                 WS_CTL = 1030 * MiB, WS_QKC = 1032 * MiB, WS_WGT = 1064 * MiB, WS_END = 1065 * MiB;
constexpr int LDS_BARST = LDS_BYTES - 64;

struct Params { const float *x, *norm_g, *w_in, *b_gate, *conv_w, *mnorm_g, *w_out, *rel_bias, *final_g; float* out; unsigned char* ws; int ph_lo, ph_hi; };

DI int blk() { int b = blockIdx.x; asm volatile("" : "+s"(b)); return b; }
DI float bf_lo(unsigned u) { return __uint_as_float(u << 16); }
DI float bf_hi(unsigned u) { return __uint_as_float(u & 0xffff0000u); }
DI float bf2f(unsigned short u) { return __uint_as_float((unsigned)u << 16); }
DI unsigned pk2(float lo, float hi) { return pg8::cvt_pk_bf16(lo, hi); }
DI float wave_sum(float v) {
#pragma unroll
    for (int o = 1; o < 64; o <<= 1) v += __shfl_xor(v, o);
    return v;
}
DI float quad_sum(float v) { v += __shfl_xor(v, 16); v += __shfl_xor(v, 32); return v; }
DI float quad_max(float v) { v = fmaxf(v, __shfl_xor(v, 16)); v = fmaxf(v, __shfl_xor(v, 32)); return v; }
DI float silu_f(float x) { return x * __builtin_amdgcn_rcpf(1.f + __expf(-x)); }
DI float sigm_f(float x) { return __builtin_amdgcn_rcpf(1.f + __expf(-x)); }
DI bf16x8 gatherT(const LAS unsigned short* p, int stride) {
    bf16x8 r;
#pragma unroll
    for (int j = 0; j < 8; ++j) r[j] = (short)p[j * stride];
    return r;
}
typedef short s16x4 __attribute__((ext_vector_type(4)));
DI bf16x8 trfrag(const LAS unsigned short* blk, int stride, int ql) {
#if USE_TR
    const LAS unsigned short* a = blk + (ql >> 2) * stride + 4 * (ql & 3);
    const s16x4 lo = __builtin_amdgcn_ds_read_tr16_b64_v4i16((LAS s16x4*)a);
    const s16x4 hi = __builtin_amdgcn_ds_read_tr16_b64_v4i16((LAS s16x4*)(a + 4 * stride));
    return (bf16x8){lo[0], lo[1], lo[2], lo[3], hi[0], hi[1], hi[2], hi[3]};
#else
    return gatherT(blk + ql, stride);
#endif
}
DI f32x4 mfma16(bf16x8 a, bf16x8 b, f32x4 c) { return __builtin_amdgcn_mfma_f32_16x16x32_bf16(a, b, c, 0, 0, 0); }
#define LDS_WAIT() asm volatile("s_waitcnt lgkmcnt(0)" ::: "memory")

DI void bt_addr(const Params& p, int it, int wave, int lane, const float*& src, bf16*& dst, int& ldw) {
    constexpr int B_IN = 32 * 64, B_OUT = 32 * 16;
    const float* W; bf16* WT; int sh; int r = it;
    if (r < B_IN) { W = p.w_in; WT = (bf16*)(p.ws + WS_WIN); ldw = INW; sh = 6; }
    else if ((r -= B_IN) < B_OUT) { W = p.w_out; WT = (bf16*)(p.ws + WS_WOUT); ldw = DM; sh = 4; }
    else if ((r -= B_OUT) < B_IN) { W = p.w_in + (size_t)DM * INW; WT = (bf16*)(p.ws + WS_WIN + 128 * MiB); ldw = INW; sh = 6; }
    else { r -= B_IN; W = p.w_out + (size_t)DM * DM; WT = (bf16*)(p.ws + WS_WOUT + 32 * MiB); ldw = DM; sh = 4; }
    const int kb = r >> sh, nb = r & ((1 << sh) - 1);
    src = W + (size_t)(kb * 128 + 16 * wave) * ldw + nb * 256 + 4 * lane;
    dst = WT + (size_t)(nb * 256 + wave * 32 + (lane >> 4)) * DM + kb * 128 + 8 * (lane & 15);
}
DI void bt_load(const float* src, int ldw, f32x4 (&v)[16]) {
#pragma unroll
    for (int i = 0; i < 16; ++i) v[i] = *(const f32x4*)(src + (size_t)i * ldw);
}
DI void bt_store(const f32x4 (&v)[16], bf16* dst, LAS unsigned short* T, int wave, int lane) {
#pragma unroll
    for (int e = 0; e < 4; ++e)
#pragma unroll
        for (int hf = 0; hf < 2; ++hf) { u32x4 w;
            w.x = pk2(v[8 * hf + 0][e], v[8 * hf + 1][e]); w.y = pk2(v[8 * hf + 2][e], v[8 * hf + 3][e]); w.z = pk2(v[8 * hf + 4][e], v[8 * hf + 5][e]); w.w = pk2(v[8 * hf + 6][e], v[8 * hf + 7][e]);
            *(LAS u32x4*)(T + (4 * lane + e) * 136 + 16 * wave + 8 * hf) = w; }
    __syncthreads();
#pragma unroll
    for (int i = 0; i < 8; ++i) { const u32x4 w = *(const LAS u32x4*)(T + (wave * 32 + 4 * i + (lane >> 4)) * 136 + 8 * (lane & 15)); *(u32x4*)(dst + (size_t)(4 * i) * DM) = w; }
}
DI void prologue_transposes(const Params& p, LAS unsigned char* lds, int wave, int lane) {
    LAS unsigned short* T0 = (LAS unsigned short*)lds; LAS unsigned short* T1 = T0 + 256 * 136;
    constexpr int NIT = 2 * (32 * 64 + 32 * 16);
    const int G = gridDim.x;
    f32x4 va[16], vb[16];
    int it = blk();
    if (it >= NIT) return;
    const float* sa; bf16* da; int la; const float* sb; bf16* db; int lb;
    bt_addr(p, it, wave, lane, sa, da, la); bt_load(sa, la, va);
    for (;;) {
        const int it1 = it + G; const bool h1 = it1 < NIT;
        if (h1) { bt_addr(p, it1, wave, lane, sb, db, lb); bt_load(sb, lb, vb); }
        bt_store(va, da, T0, wave, lane);
        if (!h1) break;
        const int it2 = it1 + G; const bool h2 = it2 < NIT;
        if (h2) { bt_addr(p, it2, wave, lane, sa, da, la); bt_load(sa, la, va); }
        bt_store(vb, db, T1, wave, lane);
        if (!h2) break;
        it = it2;
    }
    __syncthreads();
}

DI void norm_phase(const Params& p, const float* X, int l, int wave, int lane) {
    const float* g = p.norm_g + l * DM;
    bf16* XN = (bf16*)(p.ws + WS_XN);
    const int rstep = gridDim.x * NWAVE;
    for (int row = blk() * NWAVE + wave; row < SEQ; row += 2 * rstep) {
        const int row1 = row + rstep; const bool h1 = row1 < SEQ;
        const f32x4* xr0 = (const f32x4*)(X + (size_t)row * DM) + lane; const f32x4* xr1 = (const f32x4*)(X + (size_t)(h1 ? row1 : row) * DM) + lane;
        f32x4 v0[16], v1[16]; float s0 = 0.f, s1 = 0.f;
#pragma unroll
        for (int j = 0; j < 16; ++j) { v0[j] = xr0[64 * j]; v1[j] = xr1[64 * j]; }
#pragma unroll
        for (int j = 0; j < 16; ++j) { s0 += (v0[j].x * v0[j].x + v0[j].y * v0[j].y) + (v0[j].z * v0[j].z + v0[j].w * v0[j].w); s1 += (v1[j].x * v1[j].x + v1[j].y * v1[j].y) + (v1[j].z * v1[j].z + v1[j].w * v1[j].w); }
        const float r0 = rsqrtf(wave_sum(s0) * (1.f / DM) + NORM_EPS), r1 = rsqrtf(wave_sum(s1) * (1.f / DM) + NORM_EPS);
        u32x2* o0 = (u32x2*)(XN + (size_t)row * DM) + lane; u32x2* o1 = (u32x2*)(XN + (size_t)row1 * DM) + lane;
#pragma unroll
        for (int j = 0; j < 16; ++j) { const f32x4 gv = ((const f32x4*)g)[lane + 64 * j];
            const f32x4 h0 = v0[j] * r0 * gv; u32x2 w0; w0.x = pk2(h0.x, h0.y); w0.y = pk2(h0.z, h0.w); o0[64 * j] = w0;
            if (h1) { const f32x4 hb = v1[j] * r1 * gv; u32x2 w1; w1.x = pk2(hb.x, hb.y); w1.y = pk2(hb.z, hb.w); o1[64 * j] = w1; } }
    }
}
DI void build_wgt(const Params& p, int tid) {
    bf16* WgT = (bf16*)(p.ws + WS_WGT);
    for (int gid = blk() * NTHR + tid; gid < 2 * 16 * DM; gid += gridDim.x * NTHR) {
        if (gid < 2 * 8 * DM) { const int l = gid >> 15, k = (gid >> 3) & (DM - 1), j = gid & 7;
            WgT[((size_t)l * 16 + j) * DM + k] = (bf16)(pk2(p.w_in[(size_t)l * DM * INW + (size_t)k * INW + NU + j], 0.f) & 0xffffu); }
        else { const int r = gid - 2 * 8 * DM, l = r >> 15, j = 8 + ((r >> 12) & 7), k = r & (DM - 1); WgT[((size_t)l * 16 + j) * DM + k] = 0; }
    }
}
DI void gate_items(const Params& p, LAS unsigned char* lds, int l, int tid, int wave, int lane) {
    const bf16* XN = (const bf16*)(p.ws + WS_XN);
    const bf16* WgT = (const bf16*)(p.ws + WS_WGT) + (size_t)l * 16 * DM;
    float* gates = (float*)(p.ws + WS_GATES);
    LAS float* red = (LAS float*)lds;
    const int ql = lane & 15, quad = lane >> 4;
    for (int t = blk(); t < SEQ / 16; t += gridDim.x) {
        const bf16* a = WgT + (size_t)ql * DM + wave * 512 + quad * 8; const bf16* b = XN + (size_t)(t * 16 + ql) * DM + wave * 512 + quad * 8;
        f32x4 acc0 = {0.f, 0.f, 0.f, 0.f}, acc1 = {0.f, 0.f, 0.f, 0.f};
#pragma unroll
        for (int i = 0; i < 16; i += 2) { acc0 = mfma16(*(const bf16x8*)(a + i * 32), *(const bf16x8*)(b + i * 32), acc0); acc1 = mfma16(*(const bf16x8*)(a + i * 32 + 32), *(const bf16x8*)(b + i * 32 + 32), acc1); }
        const f32x4 r = acc0 + acc1;
        if (quad < 2) *(LAS f32x4*)(red + (wave * 16 + ql) * 8 + quad * 4) = r;
        __syncthreads();
        if (tid < 128) { float sum = p.b_gate[l * 8 + (tid & 7)];
#pragma unroll
            for (int w = 0; w < 8; ++w) sum += red[w * 128 + tid];
            gates[(size_t)t * 128 + tid] = sum; }
        __syncthreads();
    }
}
DI void final_norm_phase(const Params& p, LAS unsigned char* lds0, int wave, int lane) {
#if TSEL >= 0
    const int n2 = ((volatile LAS int*)(lds0 + LDS_BARST + 16))[8];
#endif
    const int rstep = gridDim.x * NWAVE;
    for (int rowa = blk() * NWAVE + wave; rowa < SEQ; rowa += 2 * rstep) {
        const int rowb = rowa + rstep; const bool hb = rowb < SEQ;
        f32x4* xa = (f32x4*)(p.out + (size_t)rowa * DM) + lane; f32x4* xb = (f32x4*)(p.out + (size_t)(hb ? rowb : rowa) * DM) + lane;
        f32x4 va[16], vb[16]; float sa = 0.f, sb = 0.f;
#pragma unroll
        for (int j = 0; j < 16; ++j) { va[j] = xa[64 * j]; vb[j] = xb[64 * j]; }
#pragma unroll
        for (int j = 0; j < 16; ++j) { sa += (va[j].x * va[j].x + va[j].y * va[j].y) + (va[j].z * va[j].z + va[j].w * va[j].w); sb += (vb[j].x * vb[j].x + vb[j].y * vb[j].y) + (vb[j].z * vb[j].z + vb[j].w * vb[j].w); }
        const float ra = rsqrtf(wave_sum(sa) * (1.f / DM) + NORM_EPS), rb = rsqrtf(wave_sum(sb) * (1.f / DM) + NORM_EPS);
#pragma unroll
        for (int rr = 0; rr < 2; ++rr) {
            if (rr == 1 && !hb) break;
            const int row = rr ? rowb : rowa; f32x4* xr = rr ? xb : xa; const float rstd = rr ? rb : ra;
#pragma unroll
            for (int j = 0; j < 16; ++j) { f32x4 o = (rr ? vb[j] : va[j]) * rstd * ((const f32x4*)p.final_g)[lane + 64 * j];
#if TSEL >= 0
                if (blk() == 0) { const int e0 = ((row >> 11) * 8 + (row & 7)) * 4096 + 4 * (lane + 64 * j);
                    o.x += (e0 + 0 < n2) ? 0.02f : 0.f; o.y += (e0 + 1 < n2) ? 0.02f : 0.f; o.z += (e0 + 2 < n2) ? 0.02f : 0.f; o.w += (e0 + 3 < n2) ? 0.02f : 0.f; }
#endif
                xr[64 * j] = o; }
            (void)row;
        }
    }
}

constexpr int AT_KS = 136;
#define ATT_DECODE(item) const int pat = (item) >> 10, h = ((item) & 1023) >> 6, rb_ = (item) & 63, dsh = pat * 2, r = rb_ >> (6 - dsh), bq = rb_ & ((64 >> dsh) - 1), sub0 = 128 * bq - 128; (void)sub0; (void)r; (void)h;
DI void att_load_kv(const bf16* U, int item, int tid, int coff, u32x4 (&v)[8]) {
    ATT_DECODE(item)
#pragma unroll
    for (int i = 0; i < 8; ++i) { const int c = tid + NTHR * i, row = c >> 4, ch = c & 15; int sub = sub0 + row; sub = sub < 0 ? 0 : sub;
        v[i] = *(const u32x4*)(U + (size_t)((sub << dsh) + r) * NU + coff + h * 128 + ch * 8); }
}
DI void att_store(LAS unsigned short* dst, int tid, const u32x4 (&v)[8]) {
#pragma unroll
    for (int i = 0; i < 8; ++i) { const int c = tid + NTHR * i, row = c >> 4, ch = c & 15; *(LAS u32x4*)(dst + row * AT_KS + ch * 8) = v[i]; }
}
DI void att_load_q(const bf16* U, int item, int wave, int lane, bf16x8 (&qf)[4]) {
    ATT_DECODE(item)
    const int tq = ((128 * bq + wave * 16 + (lane & 15)) << dsh) + r;
#pragma unroll
    for (int ks = 0; ks < 4; ++ks) qf[ks] = *(const bf16x8*)(U + (size_t)tq * NU + C_QA + h * 128 + ks * 32 + (lane >> 4) * 8);
}
DI void att_bias(const Params& p, int item, int tid, LAS float* biasS) {
    ATT_DECODE(item)
    if (tid < 177) { const int i = tid - 32; float v = -1e30f;
        if (i >= 0 && i <= 128) { const int n = i << dsh; int b = n;
            if (n >= 16) { b = 16 + (int)floorf(log2f((float)n * 0.0625f) * (16.f / 7.f)); b = b > 31 ? 31 : b; }
            v = p.rel_bias[b * 16 + h] * 1.4426950408889634f; }
        biasS[tid] = v; }
}
DI int att_item_of(int rnd, bool xmap, int xcd, int xi) {
    if (!xmap) return blk() + rnd * gridDim.x;
    const int h = 2 * xcd + rnd / 6, j = (rnd % 6) * 32 + xi; return (j >> 6) * 1024 + h * 64 + (j & 63);
}
DI void attn_phase(const Params& p, LAS unsigned char* lds, int tid, int wave, int lane) {
    const bf16* U = (const bf16*)(p.ws + WS_U);
    LAS unsigned short* Ks = (LAS unsigned short*)lds;
    LAS unsigned short* Vs = Ks + 256 * AT_KS;
    LAS float* biasS = (LAS float*)(Vs + 256 * AT_KS);
    const int G = gridDim.x; const bool xmap = (G == 256); const int xcd = blk() & 7, xi = blk() >> 3;
    const int nrnd = (blk() < 3072) ? (3072 - blk() + G - 1) / G : 0;
    if (nrnd <= 0) return;
    const int ql = lane & 15, quad = lane >> 4, q0 = wave * 16;
    bf16x8 qf[4];
    { const int item0 = att_item_of(0, xmap, xcd, xi); u32x4 kv[8], vv[8];
      att_load_kv(U, item0, tid, C_KA, kv); att_load_kv(U, item0, tid, C_VA, vv); att_load_q(U, item0, wave, lane, qf); att_bias(p, item0, tid, biasS);
      att_store(Ks, tid, kv); att_store(Vs, tid, vv); }
    __syncthreads();
    for (int rnd = 0; rnd < nrnd; ++rnd) {
        const int item = att_item_of(rnd, xmap, xcd, xi), next = rnd + 1 < nrnd ? att_item_of(rnd + 1, xmap, xcd, xi) : -1;
        ATT_DECODE(item)
        const int tq = ((128 * bq + q0 + ql) << dsh) + r;
        f32x4 sacc[10];
#pragma unroll
        for (int t = 0; t < 10; ++t) sacc[t] = (f32x4){0.f, 0.f, 0.f, 0.f};
#pragma unroll
        for (int s = 0; s < 5; ++s)
#pragma unroll
            for (int u = 0; u < 2; ++u) { int kk = q0 + 32 * s + (ql >> 2) * 8 + u * 4 + (ql & 3); kk = kk > 255 ? 255 : kk;
                const LAS unsigned short* kp = Ks + kk * AT_KS + quad * 8;
#pragma unroll
                for (int ks = 0; ks < 4; ++ks) sacc[2 * s + u] = mfma16(*(const LAS bf16x8*)(kp + ks * 32), qf[ks], sacc[2 * s + u]); }
        __syncthreads();
        u32x4 kv[8], vv[8]; bf16x8 qn[4];
        if (next >= 0) { att_load_kv(U, next, tid, C_KA, kv); att_load_q(U, next, wave, lane, qn); }
        const float scale2 = 0.08838834764831845f * 1.4426950408889634f;
        float mx = -1e30f;
        int ql2 = ql, quad2 = quad; asm volatile("" : "+v"(ql2), "+v"(quad2));
        const LAS float* bp = biasS + (ql2 - 8 * quad2 + 32 + 128);
#pragma unroll
        for (int s = 0; s < 5; ++s)
#pragma unroll
            for (int u = 0; u < 2; ++u)
#pragma unroll
                for (int j = 0; j < 4; ++j) sacc[2 * s + u][j] = sacc[2 * s + u][j] * scale2 + bp[-(32 * s + 4 * u + j)];
        if (bq == 0) {
            const int t1 = 128 - q0 - 8 * quad2;
#pragma unroll
            for (int s = 0; s < 5; ++s)
#pragma unroll
                for (int u = 0; u < 2; ++u)
#pragma unroll
                    for (int j = 0; j < 4; ++j) sacc[2 * s + u][j] = (32 * s + 4 * u + j >= t1) ? sacc[2 * s + u][j] : -1e30f; }
#pragma unroll
        for (int t = 0; t < 10; ++t)
#pragma unroll
            for (int j = 0; j < 4; ++j) mx = fmaxf(mx, sacc[t][j]);
        mx = quad_max(mx);
        float l = 0.f;
#pragma unroll
        for (int t = 0; t < 10; ++t)
#pragma unroll
            for (int j = 0; j < 4; ++j) { const float e = __builtin_amdgcn_exp2f(sacc[t][j] - mx); sacc[t][j] = e; l += e; }
        l = quad_sum(l);
        if (next >= 0) att_load_kv(U, next, tid, C_VA, vv);
        f32x4 oacc[8];
#pragma unroll
        for (int nt = 0; nt < 8; ++nt) oacc[nt] = (f32x4){0.f, 0.f, 0.f, 0.f};
#pragma unroll
        for (int s = 0; s < 5; ++s) {
            u32x4 pw; pw.x = pk2(sacc[2 * s][0], sacc[2 * s][1]); pw.y = pk2(sacc[2 * s][2], sacc[2 * s][3]); pw.z = pk2(sacc[2 * s + 1][0], sacc[2 * s + 1][1]); pw.w = pk2(sacc[2 * s + 1][2], sacc[2 * s + 1][3]);
            const bf16x8 pf = __builtin_bit_cast(bf16x8, pw);
            int key0 = q0 + 32 * s + quad * 8; key0 = key0 > 248 ? 248 : key0;
            const LAS unsigned short* vp = Vs + key0 * AT_KS;
#pragma unroll
            for (int nt = 0; nt < 8; ++nt) oacc[nt] = mfma16(trfrag(vp + nt * 16, AT_KS, ql), pf, oacc[nt]);
        }
        const float inv = 1.f / l;
        bf16* OP = (bf16*)(p.ws + WS_OP) + (size_t)pat * SEQ * 2048 + (size_t)tq * 2048 + h * 128 + quad * 4;
#pragma unroll
        for (int nt = 0; nt < 8; ++nt) { u32x2 w; w.x = pk2(oacc[nt][0] * inv, oacc[nt][1] * inv); w.y = pk2(oacc[nt][2] * inv, oacc[nt][3] * inv); *(u32x2*)(OP + nt * 16) = w; }
        if (quad == 0) ((float*)(p.ws + WS_LSE))[((size_t)pat * SEQ + tq) * 16 + h] = (mx + __log2f(l)) * 0.6931471805599453f;
        if (next >= 0) att_store(Ks, tid, kv);
        __syncthreads();
        if (next >= 0) { att_store(Vs, tid, vv); att_bias(p, next, tid, biasS);
#pragma unroll
            for (int ks = 0; ks < 4; ++ks) qf[ks] = qn[ks]; }
        __syncthreads();
    }
}
DI void merge_phase(const Params& p, int tid) {
    const bf16* U = (const bf16*)(p.ws + WS_U);
    const bf16* OP = (const bf16*)(p.ws + WS_OP);
    const float* LSE = (const float*)(p.ws + WS_LSE);
    bf16* Y = (bf16*)(p.ws + WS_Y);
    const int gthreads = gridDim.x * NTHR;
    for (int idx0 = blk() * NTHR + tid; idx0 < SEQ * 256; idx0 += 4 * gthreads) {
        float l0[4], l1[4], l2[4]; u32x4 o0[4], o1[4], o2[4], z[4];
#pragma unroll
        for (int u = 0; u < 4; ++u) { int idx = idx0 + u * gthreads; idx = idx < SEQ * 256 ? idx : SEQ * 256 - 1;
            const int t = idx >> 8, c8 = idx & 255, h = c8 >> 4;
            l0[u] = LSE[(size_t)t * 16 + h]; l1[u] = LSE[((size_t)SEQ + t) * 16 + h]; l2[u] = LSE[((size_t)2 * SEQ + t) * 16 + h];
            const size_t o = (size_t)t * 2048 + c8 * 8;
            o0[u] = *(const u32x4*)(OP + o); o1[u] = *(const u32x4*)(OP + (size_t)SEQ * 2048 + o); o2[u] = *(const u32x4*)(OP + (size_t)2 * SEQ * 2048 + o);
            z[u] = *(const u32x4*)(U + (size_t)t * NU + C_ZA + c8 * 8); }
#pragma unroll
        for (int u = 0; u < 4; ++u) { const int idx = idx0 + u * gthreads;
            if (idx < SEQ * 256) { const int t = idx >> 8, c8 = idx & 255;
                const float M = fmaxf(l0[u], fmaxf(l1[u], l2[u]));
                float w0 = __expf(l0[u] - M), w1 = __expf(l1[u] - M), w2 = __expf(l2[u] - M);
                const float inv = 1.f / (w0 + w1 + w2); w0 *= inv; w1 *= inv; w2 *= inv;
                u32x4 y;
#pragma unroll
                for (int e = 0; e < 4; ++e) {
                    const float lo = (w0 * bf_lo(o0[u][e]) + w1 * bf_lo(o1[u][e]) + w2 * bf_lo(o2[u][e])) * silu_f(bf_lo(z[u][e]));
                    const float hi = (w0 * bf_hi(o0[u][e]) + w1 * bf_hi(o1[u][e]) + w2 * bf_hi(o2[u][e])) * silu_f(bf_hi(z[u][e]));
                    y[e] = pk2(lo, hi); }
                *(u32x4*)(Y + (size_t)t * DM + c8 * 8) = y; } }
    }
}

constexpr int M_KS = 264, M_VS3 = 520;
DI void conv8(const bf16* U, const float* cw, int t, int rawcol, int cch, float (&f)[8]) {
#pragma unroll
    for (int e = 0; e < 8; ++e) f[e] = 0.f;
#pragma unroll
    for (int j = 0; j < 4; ++j) { const int tt = t - 3 + j;
        if (tt >= 0) { const u32x4 raw = *(const u32x4*)(U + (size_t)tt * NU + rawcol);
            const f32x4 w0 = *(const f32x4*)(cw + j * 2048 + cch), w1 = *(const f32x4*)(cw + j * 2048 + cch + 4);
            f[0] += w0[0] * bf_lo(raw.x); f[1] += w0[1] * bf_hi(raw.x); f[2] += w0[2] * bf_lo(raw.y); f[3] += w0[3] * bf_hi(raw.y);
            f[4] += w1[0] * bf_lo(raw.z); f[5] += w1[1] * bf_hi(raw.z); f[6] += w1[2] * bf_lo(raw.w); f[7] += w1[3] * bf_hi(raw.w); } }
#pragma unroll
    for (int e = 0; e < 8; ++e) f[e] = silu_f(f[e]);
}
template <int NI, int MODE, int NB>
DI void conv_tile(const bf16* U, const float* cw, int t0, int rawcol0, int cch0, float sc, LAS unsigned short* dst, int tid, float bL, const LAS float* bS, const LAS float* liS, int roff) {
    const int ch = tid & 31, r0 = tid >> 5;
    f32x4 w[4][2];
#pragma unroll
    for (int j = 0; j < 4; ++j) { w[j][0] = *(const f32x4*)(cw + j * 2048 + cch0 + ch * 8); w[j][1] = *(const f32x4*)(cw + j * 2048 + cch0 + ch * 8 + 4); }
    const bf16* src = U + rawcol0 + ch * 8;
#pragma unroll
    for (int ib = 0; ib < NI; ib += NB) {
        u32x4 raw[NB][4];
#pragma unroll
        for (int i = 0; i < NB; ++i)
#pragma unroll
            for (int j = 0; j < 4; ++j) { const int tt = t0 + r0 + 16 * (ib + i) - 3 + j; const int tc = tt < 0 ? 0 : tt;
                raw[i][j] = *(const u32x4*)(src + (size_t)tc * NU); if (tt < 0) raw[i][j] = (u32x4){0u, 0u, 0u, 0u}; }
#pragma unroll
        for (int i = 0; i < NB; ++i) { const int row = r0 + 16 * (ib + i);
            float f[8];
#pragma unroll
            for (int e = 0; e < 8; ++e) f[e] = 0.f;
#pragma unroll
            for (int j = 0; j < 4; ++j) { const u32x4 rw = raw[i][j];
                f[0] += w[j][0][0] * bf_lo(rw.x); f[1] += w[j][0][1] * bf_hi(rw.x); f[2] += w[j][0][2] * bf_lo(rw.y); f[3] += w[j][0][3] * bf_hi(rw.y);
                f[4] += w[j][1][0] * bf_lo(rw.z); f[5] += w[j][1][1] * bf_hi(rw.z); f[6] += w[j][1][2] * bf_lo(rw.w); f[7] += w[j][1][3] * bf_hi(rw.w); }
            float m = sc;
            if (MODE == 1) m *= __expf(bL - bS[roff + row] + liS[roff + row]);
#pragma unroll
            for (int e = 0; e < 8; ++e) f[e] = silu_f(f[e]) * m;
            u32x4 o; o.x = pk2(f[0], f[1]); o.y = pk2(f[2], f[3]); o.z = pk2(f[4], f[5]); o.w = pk2(f[6], f[7]);
            *(LAS u32x4*)(dst + row * M_KS + ch * 8) = o; }
        __builtin_amdgcn_sched_barrier(0);
    }
}
DI void conv_prepass(const Params& p, int l, int tid) {
    const bf16* U = (const bf16*)(p.ws + WS_U);
    const float* cw = p.conv_w + (size_t)l * 4 * 2048;
    bf16* QKC = (bf16*)(p.ws + WS_QKC);
    for (int gid = blk() * NTHR + tid; gid < 256 * 512; gid += gridDim.x * NTHR) {
        const int cidx = gid & 255, t0 = (gid >> 8) * 16;
        f32x4 w[4][2];
#pragma unroll
        for (int j = 0; j < 4; ++j) { w[j][0] = *(const f32x4*)(cw + j * 2048 + cidx * 8); w[j][1] = *(const f32x4*)(cw + j * 2048 + cidx * 8 + 4); }
        const bf16* src = U + C_QM + cidx * 8;
        u32x4 raw[19];
#pragma unroll
        for (int i = 0; i < 19; ++i) { const int tt = t0 - 3 + i; const int tc = tt < 0 ? 0 : tt; raw[i] = *(const u32x4*)(src + (size_t)tc * NU); if (tt < 0) raw[i] = (u32x4){0u, 0u, 0u, 0u}; }
        const float sc = cidx >= 128 ? 0.0625f : 1.f;
#pragma unroll
        for (int i = 0; i < 16; ++i) {
            float f[8];
#pragma unroll
            for (int e = 0; e < 8; ++e) f[e] = 0.f;
#pragma unroll
            for (int j = 0; j < 4; ++j) { const u32x4 rw = raw[i + j];
                f[0] += w[j][0][0] * bf_lo(rw.x); f[1] += w[j][0][1] * bf_hi(rw.x); f[2] += w[j][0][2] * bf_lo(rw.y); f[3] += w[j][0][3] * bf_hi(rw.y);
                f[4] += w[j][1][0] * bf_lo(rw.z); f[5] += w[j][1][1] * bf_hi(rw.z); f[6] += w[j][1][2] * bf_lo(rw.w); f[7] += w[j][1][3] * bf_hi(rw.w); }
#pragma unroll
            for (int e = 0; e < 8; ++e) f[e] = silu_f(f[e]) * sc;
            u32x4 o; o.x = pk2(f[0], f[1]); o.y = pk2(f[2], f[3]); o.z = pk2(f[4], f[5]); o.w = pk2(f[6], f[7]);
            *(u32x4*)(QKC + (size_t)(t0 + i) * 2048 + cidx * 8) = o; }
    }
}
DI void chunk_gates(const float* gates, int c, int hh, LAS float* bS, LAS float* liS, LAS float* wtot, int tid, int wave, int lane) {
    float v = 0.f;
    if (tid < 256) { const float* gp = gates + (size_t)(c * 256 + tid) * 8; const float fgv = gp[4 + hh]; liS[tid] = gp[hh];
        v = fminf(fgv, 0.f) - log1pf(__expf(-fabsf(fgv)));
#pragma unroll
        for (int o = 1; o < 64; o <<= 1) { const float t = __shfl_up(v, o); if (lane >= o) v += t; }
        if (lane == 63) wtot[wave] = v; }
    __syncthreads();
    if (tid < 256) { float pre = 0.f; for (int w = 0; w < wave; ++w) pre += wtot[w]; bS[tid] = v + pre; }
    __syncthreads();
}
DI void m1_item(const Params& p, LAS unsigned char* lds, int l, int item, int tid, int wave, int lane) {
    asm volatile("" : "+v"(tid));
    const bf16* U = (const bf16*)(p.ws + WS_U);
    const bf16* QKC = (const bf16*)(p.ws + WS_QKC);
    LAS unsigned short* Kp = (LAS unsigned short*)lds;
    LAS unsigned short* Vs = Kp + 128 * M_KS;
    LAS float* bS = (LAS float*)(Vs + 128 * AT_KS); LAS float* liS = bS + 256; LAS float* wtot = liS + 256;
    const int hh = item >> 7, c = (item >> 2) & 31, sl = item & 3;
    const int ql = lane & 15, quad = lane >> 4;
    u32x4 kr[8], vr[4];
#define M1_LOAD(half) do { _Pragma("unroll") for (int i = 0; i < 8; ++i) { const int cc = tid + NTHR * i, row = cc >> 5, ch = cc & 31; kr[i] = *(const u32x4*)(QKC + (size_t)(c * 256 + (half) * 128 + row) * 2048 + 1024 + hh * 256 + ch * 8); } \
        _Pragma("unroll") for (int i = 0; i < 4; ++i) { const int cc = tid + NTHR * i, row = cc >> 4, ch = cc & 15; vr[i] = *(const u32x4*)(U + (size_t)(c * 256 + (half) * 128 + row) * NU + C_VM + hh * 512 + sl * 128 + ch * 8); } } while (0)
#define M1_STORE(half) do { _Pragma("unroll") for (int i = 0; i < 8; ++i) { const int cc = tid + NTHR * i, row = cc >> 5, ch = cc & 31, sloc = (half) * 128 + row; \
            const float wgt = __expf(bL - bS[sloc] + liS[sloc]); \
            u32x4 w; w.x = pk2(bf_lo(kr[i].x) * wgt, bf_hi(kr[i].x) * wgt); w.y = pk2(bf_lo(kr[i].y) * wgt, bf_hi(kr[i].y) * wgt); w.z = pk2(bf_lo(kr[i].z) * wgt, bf_hi(kr[i].z) * wgt); w.w = pk2(bf_lo(kr[i].w) * wgt, bf_hi(kr[i].w) * wgt); \
            *(LAS u32x4*)(Kp + row * M_KS + ch * 8) = w; } \
        _Pragma("unroll") for (int i = 0; i < 4; ++i) { const int cc = tid + NTHR * i, row = cc >> 4, ch = cc & 15; *(LAS u32x4*)(Vs + row * AT_KS + ch * 8) = vr[i]; } } while (0)
    M1_LOAD(0);
    chunk_gates((const float*)(p.ws + WS_GATES), c, hh, bS, liS, wtot, tid, wave, lane);
    const float bL = bS[255];
    f32x4 acc[4][4];
#pragma unroll
    for (int a = 0; a < 4; ++a)
#pragma unroll
        for (int b = 0; b < 4; ++b) acc[a][b] = (f32x4){0.f, 0.f, 0.f, 0.f};
    f32x4 nacc[4];
#pragma unroll
    for (int b = 0; b < 4; ++b) nacc[b] = (f32x4){0.f, 0.f, 0.f, 0.f};
    const bool do_n = (sl == 0) && ((wave & 1) == 0);
    const bf16x8 ones = {0x3F80, 0x3F80, 0x3F80, 0x3F80, 0x3F80, 0x3F80, 0x3F80, 0x3F80};
    const int dvt0 = (wave & 1) * 4, dkt0 = (wave >> 1) * 4;
    M1_STORE(0);
    __syncthreads();
    M1_LOAD(1);
#pragma unroll 1
    for (int half = 0; half < 2; ++half) {
#pragma unroll 1
        for (int ks = 0; ks < 4; ++ks) {
            bf16x8 af[4], bfr[4];
#pragma unroll
            for (int a = 0; a < 4; ++a) af[a] = trfrag(Vs + (ks * 32 + quad * 8) * AT_KS + (dvt0 + a) * 16, AT_KS, ql);
#pragma unroll
            for (int b = 0; b < 4; ++b) bfr[b] = trfrag(Kp + (ks * 32 + quad * 8) * M_KS + (dkt0 + b) * 16, M_KS, ql);
#pragma unroll
            for (int a = 0; a < 4; ++a)
#pragma unroll
                for (int b = 0; b < 4; ++b) acc[a][b] = mfma16(af[a], bfr[b], acc[a][b]);
            if (do_n) {
#pragma unroll
                for (int b = 0; b < 4; ++b) nacc[b] = mfma16(ones, bfr[b], nacc[b]); }
        }
        __syncthreads();
        if (half == 0) { M1_STORE(1); __syncthreads(); }
    }
#undef M1_LOAD
#undef M1_STORE
    float* DC = (float*)(p.ws + WS_DC) + ((size_t)(hh * 32 + c) * 512 + sl * 128) * 256;
#pragma unroll
    for (int a = 0; a < 4; ++a)
#pragma unroll
        for (int b = 0; b < 4; ++b)
#pragma unroll
            for (int j = 0; j < 4; ++j) DC[(size_t)((dvt0 + a) * 16 + quad * 4 + j) * 256 + (dkt0 + b) * 16 + ql] = acc[a][b][j];
    if (do_n && quad == 0) {
#pragma unroll
        for (int b = 0; b < 4; ++b) ((float*)(p.ws + WS_DN))[(hh * 32 + c) * 256 + (dkt0 + b) * 16 + ql] = nacc[b][0]; }
    if (sl == 0 && tid == 0) ((float*)(p.ws + WS_BL))[hh * 32 + c] = bL;
}
DI void m2_phase(const Params& p, int tid) {
    const float* DC = (const float*)(p.ws + WS_DC); const float* BL = (const float*)(p.ws + WS_BL);
    bf16* CS = (bf16*)(p.ws + WS_CS);
    const int gthreads = gridDim.x * NTHR, gid = blk() * NTHR + tid;
    for (int e4 = gid; e4 < 4 * 32768; e4 += gthreads) {
        const int hh = e4 >> 15, e = e4 & 32767;
        const int hu = __builtin_amdgcn_readfirstlane(hh);
        f32x4 st = {0.f, 0.f, 0.f, 0.f};
#pragma unroll
        for (int cb = 0; cb < 32; cb += 16) {
            f32x4 d[16];
#pragma unroll
            for (int c = 0; c < 16; ++c) d[c] = *(const f32x4*)(DC + ((size_t)(hh * 32 + cb + c) * 32768 + e) * 4);
#pragma unroll
            for (int c = 0; c < 16; ++c) {
                u32x2 w; w.x = pk2(st.x, st.y); w.y = pk2(st.z, st.w); *(u32x2*)(CS + ((size_t)(hh * 32 + cb + c) * 32768 + e) * 4) = w;
                st = st * __expf(BL[hu * 32 + cb + c]) + d[c];
            }
        }
    }
    if (gid < 1024) { const int hh = gid >> 8, dk = gid & 255; const float* DN = (const float*)(p.ws + WS_DN); float* NS = (float*)(p.ws + WS_NS);
        float dn[32], eb[32];
#pragma unroll
        for (int c = 0; c < 32; ++c) { dn[c] = DN[(hh * 32 + c) * 256 + dk]; eb[c] = BL[hh * 32 + c]; }
        float st = 0.f;
#pragma unroll
        for (int c = 0; c < 32; ++c) { NS[(hh * 32 + c) * 256 + dk] = st; st = st * __expf(eb[c]) + dn[c]; } }
}
DI void m3_stage_load(const Params& p, int hh, int c, int st, int tid, u32x4 (&pre)[8]) {
    if (st < 4) { const bf16* CT = (const bf16*)(p.ws + WS_CS) + (size_t)(hh * 32 + c) * 512 * 256;
#pragma unroll
        for (int i = 0; i < 8; ++i) { const int cc = tid + NTHR * i, row = cc >> 5, ch = cc & 31;
            pre[i] = *(const u32x4*)(CT + (size_t)((row >> 6) * 256 + st * 64 + (row & 63)) * 256 + ch * 8); }
    } else { const int kt = (st - 4) >> 1, hb = (st - 4) & 1; const bf16* U = (const bf16*)(p.ws + WS_U); const bf16* QKC = (const bf16*)(p.ws + WS_QKC);
        if (hb == 0) {
#pragma unroll
            for (int i = 0; i < 4; ++i) { const int cc = tid + NTHR * i, row = cc >> 5, ch = cc & 31; pre[i] = *(const u32x4*)(QKC + (size_t)(c * 256 + kt * 64 + row) * 2048 + 1024 + hh * 256 + ch * 8); } }
#pragma unroll
        for (int i = 0; i < 4; ++i) { const int cc = tid + NTHR * i, row = 32 * hb + (cc >> 6), ch = cc & 63; pre[4 + i] = *(const u32x4*)(U + (size_t)(c * 256 + kt * 64 + row) * NU + C_VM + hh * 512 + ch * 8); }
    }
}
DI void m3_stage_store(int st, int tid, const u32x4 (&pre)[8], LAS unsigned short* Ks, LAS unsigned short* Vs) {
    if (st < 4) {
#pragma unroll
        for (int i = 0; i < 8; ++i) { const int cc = tid + NTHR * i, row = cc >> 5, ch = cc & 31; *(LAS u32x4*)(Ks + row * M_KS + ch * 8) = pre[i]; }
    } else { const int hb = (st - 4) & 1;
        if (hb == 0) {
#pragma unroll
            for (int i = 0; i < 4; ++i) { const int cc = tid + NTHR * i, row = cc >> 5, ch = cc & 31; *(LAS u32x4*)(Ks + row * M_KS + ch * 8) = pre[i]; } }
#pragma unroll
        for (int i = 0; i < 4; ++i) { const int cc = tid + NTHR * i, row = 32 * hb + (cc >> 6), ch = cc & 63; *(LAS u32x4*)(Vs + row * M_VS3 + ch * 8) = pre[4 + i]; }
    }
}
DI void m3_item(const Params& p, LAS unsigned char* lds, int l, int hh, int qb, int tid, int wave, int lane) {
    asm volatile("" : "+v"(tid));
    const bf16* U = (const bf16*)(p.ws + WS_U);
    const bf16* QKC = (const bf16*)(p.ws + WS_QKC);
    LAS unsigned short* Qs = (LAS unsigned short*)lds;
    LAS unsigned short* Ks = Qs + 64 * M_KS;
    LAS unsigned short* Vs = Ks + 64 * M_KS;
    LAS float* bS = (LAS float*)(Vs + 64 * M_VS3); LAS float* liS = bS + 256; LAS float* nS = liS + 256; LAS float* wtot = nS + 256; LAS float* ssS = wtot + 8;
    const int c = qb >> 2, jq = qb & 3;
    const int ql = lane & 15, quad = lane >> 4;
    TS_MARK(99);
    u32x4 pre[8];
    u32x4 qv[4];
#pragma unroll
    for (int i = 0; i < 4; ++i) { const int cc = tid + NTHR * i, row = cc >> 5, ch = cc & 31; qv[i] = *(const u32x4*)(QKC + (size_t)(qb * 64 + row) * 2048 + hh * 256 + ch * 8); }
    m3_stage_load(p, hh, c, 0, tid, pre);
    if (tid < 256) nS[tid] = ((const float*)(p.ws + WS_NS))[(hh * 32 + c) * 256 + tid];
    chunk_gates((const float*)(p.ws + WS_GATES), c, hh, bS, liS, wtot, tid, wave, lane);
#pragma unroll
    for (int i = 0; i < 4; ++i) { const int cc = tid + NTHR * i, row = cc >> 5, ch = cc & 31; *(LAS u32x4*)(Qs + row * M_KS + ch * 8) = qv[i]; }
    __syncthreads();
    const int qg = wave & 3, dvh = wave >> 2, q = qg * 16 + ql, iq = jq * 64 + q;
    const LAS unsigned short* qrow = Qs + q * M_KS + quad * 8;
    const float b_ref = bS[jq * 64], e_ref = __expf(b_ref), ebq = __expf(bS[iq] - b_ref);
    f32x4 acc[16];
#pragma unroll
    for (int nt = 0; nt < 16; ++nt) acc[nt] = (f32x4){0.f, 0.f, 0.f, 0.f};
    float nq;
    { float nqp = 0.f;
#pragma unroll
      for (int ks = 0; ks < 8; ++ks) { const bf16x8 qk = *(const LAS bf16x8*)(qrow + ks * 32);
#pragma unroll
          for (int j = 0; j < 8; ++j) nqp += bf2f((unsigned short)qk[j]) * nS[ks * 32 + quad * 8 + j]; }
      nq = quad_sum(nqp) * e_ref; }
    float nqi = 0.f;
    TS_MARK(10);
    const int nst = 4 + 2 * (jq + 1);
    bf16x8 pf1 = {0, 0, 0, 0, 0, 0, 0, 0};
#pragma unroll 1
    for (int st = 0; st < nst; ++st) {
        __syncthreads();
        int tid2 = tid; asm volatile("" : "+v"(tid2));
        m3_stage_store(st, tid2, pre, Ks, Vs);
        __syncthreads();
        if (st + 1 < nst) m3_stage_load(p, hh, c, st + 1, tid2, pre);
        if (st < 4) {
            bf16x8 qf[8];
#pragma unroll
            for (int ks = 0; ks < 8; ++ks) qf[ks] = *(const LAS bf16x8*)(qrow + ks * 32);
#pragma unroll
            for (int n4 = 0; n4 < 4; ++n4) { const LAS unsigned short* cp = Ks + (dvh * 64 + n4 * 16 + ql) * M_KS + quad * 8;
#pragma unroll
                for (int ks = 0; ks < 8; ++ks) acc[n4] = mfma16(*(const LAS bf16x8*)(cp + ks * 32), qf[ks], acc[n4]);
                __builtin_amdgcn_sched_barrier(0); }
            { const f32x4 t0 = acc[0], t1 = acc[1], t2 = acc[2], t3 = acc[3];
#pragma unroll
              for (int i = 0; i < 12; ++i) acc[i] = acc[i + 4];
              acc[12] = t0; acc[13] = t1; acc[14] = t2; acc[15] = t3; }
            if (st == 3) {
#pragma unroll
                for (int nt = 0; nt < 16; ++nt) acc[nt] = acc[nt] * e_ref;
                TS_MARK(11); }
        } else {
            const int kt = (st - 4) >> 1, hb = (st - 4) & 1;
            bf16x8 pf;
            if (hb == 0) {
                bf16x8 qf[8];
#pragma unroll
                for (int ks = 0; ks < 8; ++ks) qf[ks] = *(const LAS bf16x8*)(qrow + ks * 32);
                f32x4 sacc[4];
#pragma unroll
                for (int t = 0; t < 4; ++t) sacc[t] = (f32x4){0.f, 0.f, 0.f, 0.f};
#pragma unroll
                for (int s2 = 0; s2 < 2; ++s2)
#pragma unroll
                    for (int u = 0; u < 2; ++u) { const int krow = 32 * s2 + (ql >> 2) * 8 + u * 4 + (ql & 3);
                        const LAS unsigned short* kp = Ks + krow * M_KS + quad * 8;
#pragma unroll
                        for (int ks = 0; ks < 8; ++ks) sacc[2 * s2 + u] = mfma16(*(const LAS bf16x8*)(kp + ks * 32), qf[ks], sacc[2 * s2 + u]); }
#pragma unroll
                for (int s2 = 0; s2 < 2; ++s2)
#pragma unroll
                    for (int u = 0; u < 2; ++u)
#pragma unroll
                        for (int j = 0; j < 4; ++j) { const int sk = kt * 64 + 32 * s2 + quad * 8 + u * 4 + j;
                            const float w = (sk <= iq) ? __expf(b_ref - bS[sk] + liS[sk]) : 0.f;
                            const float pv = sacc[2 * s2 + u][j] * w; sacc[2 * s2 + u][j] = pv; nqi += pv; }
                u32x4 pw; pw.x = pk2(sacc[0][0], sacc[0][1]); pw.y = pk2(sacc[0][2], sacc[0][3]); pw.z = pk2(sacc[1][0], sacc[1][1]); pw.w = pk2(sacc[1][2], sacc[1][3]);
                pf = __builtin_bit_cast(bf16x8, pw);
                u32x4 pw1; pw1.x = pk2(sacc[2][0], sacc[2][1]); pw1.y = pk2(sacc[2][2], sacc[2][3]); pw1.z = pk2(sacc[3][0], sacc[3][1]); pw1.w = pk2(sacc[3][2], sacc[3][3]);
                pf1 = __builtin_bit_cast(bf16x8, pw1);
            } else pf = pf1;
            const LAS unsigned short* vp = Vs + (32 * hb + quad * 8) * M_VS3 + dvh * 256;
#pragma unroll
            for (int nt = 0; nt < 16; ++nt) { acc[nt] = mfma16(trfrag(vp + nt * 16, M_VS3, ql), pf, acc[nt]); if ((nt & 3) == 3) __builtin_amdgcn_sched_barrier(0); }
        }
    }
    TS_MARK(12);
    nq = (nq + quad_sum(nqi)) * ebq;
#pragma unroll
    for (int nt = 0; nt < 16; ++nt) acc[nt] = acc[nt] * ebq;
    const float inv = 1.f / fmaxf(fabsf(nq), 1.f);
    float ss = 0.f;
#pragma unroll
    for (int nt = 0; nt < 16; ++nt) { acc[nt] = acc[nt] * inv; ss += (acc[nt][0] * acc[nt][0] + acc[nt][1] * acc[nt][1]) + (acc[nt][2] * acc[nt][2] + acc[nt][3] * acc[nt][3]); }
    ss = quad_sum(ss);
    if (quad == 0) ssS[dvh * 64 + q] = ss;
    __syncthreads();
    const float rstd = rsqrtf((ssS[q] + ssS[64 + q]) * (1.f / 512.f) + NORM_EPS);
    LAS unsigned short* Hs = Vs;
#pragma unroll
    for (int nt = 0; nt < 16; ++nt) { u32x2 w; w.x = pk2(acc[nt][0] * rstd, acc[nt][1] * rstd); w.y = pk2(acc[nt][2] * rstd, acc[nt][3] * rstd);
        *(LAS u32x2*)(Hs + q * M_VS3 + dvh * 256 + nt * 16 + quad * 4) = w; }
    __syncthreads();
    const float* ng = p.mnorm_g + l * 2048 + hh * 512;
    bf16* Y = (bf16*)(p.ws + WS_Y);
#pragma unroll
    for (int ib = 0; ib < 8; ib += 2) {
        u32x4 omv[2], zmv[2]; f32x4 g0[2], g1[2];
#pragma unroll
        for (int i = 0; i < 2; ++i) { const int cc = tid + NTHR * (ib + i), row = cc >> 6, ch = cc & 63; const bf16* up = U + (size_t)(qb * 64 + row) * NU + hh * 512 + ch * 8;
            omv[i] = *(const u32x4*)(up + C_OM); zmv[i] = *(const u32x4*)(up + C_ZM); g0[i] = *(const f32x4*)(ng + ch * 8); g1[i] = *(const f32x4*)(ng + ch * 8 + 4); }
#pragma unroll
        for (int i = 0; i < 2; ++i) { const int cc = tid + NTHR * (ib + i), row = cc >> 6, ch = cc & 63;
            const u32x4 hv = *(const LAS u32x4*)(Hs + row * M_VS3 + ch * 8);
            u32x4 y;
            y.x = pk2(bf_lo(hv.x) * g0[i][0] * sigm_f(bf_lo(omv[i].x)) * silu_f(bf_lo(zmv[i].x)), bf_hi(hv.x) * g0[i][1] * sigm_f(bf_hi(omv[i].x)) * silu_f(bf_hi(zmv[i].x)));
            y.y = pk2(bf_lo(hv.y) * g0[i][2] * sigm_f(bf_lo(omv[i].y)) * silu_f(bf_lo(zmv[i].y)), bf_hi(hv.y) * g0[i][3] * sigm_f(bf_hi(omv[i].y)) * silu_f(bf_hi(zmv[i].y)));
            y.z = pk2(bf_lo(hv.z) * g1[i][0] * sigm_f(bf_lo(omv[i].z)) * silu_f(bf_lo(zmv[i].z)), bf_hi(hv.z) * g1[i][1] * sigm_f(bf_hi(omv[i].z)) * silu_f(bf_hi(zmv[i].z)));
            y.w = pk2(bf_lo(hv.w) * g1[i][2] * sigm_f(bf_lo(omv[i].w)) * silu_f(bf_lo(zmv[i].w)), bf_hi(hv.w) * g1[i][3] * sigm_f(bf_hi(omv[i].w)) * silu_f(bf_hi(zmv[i].w)));
            *(u32x4*)(Y + (size_t)(qb * 64 + row) * DM + 2048 + hh * 512 + ch * 8) = y; }
        __builtin_amdgcn_sched_barrier(0);
    }
    __syncthreads();
    TS_MARK(13);
}

#define RLX_AGENT __ATOMIC_RELAXED, __HIP_MEMORY_SCOPE_AGENT
#define XB_TMO      128
#define XB_XCNT(j)  (256  + 64 * (j))
#define XB_XSUB(j)  (1280 + 64 * (j))
#define XB_XGEN(j)  (2304 + 64 * (j))
#define XB_TOP      3328
#define XB_TOPGEN   3392
#define XCD_BAR_WORDS 3456
#define XB_SPIN_CAP (1u << 18)

__device__ __forceinline__ unsigned xb_ld(unsigned* p)              { return __hip_atomic_load(p, __ATOMIC_RELAXED, __HIP_MEMORY_SCOPE_AGENT); }
__device__ __forceinline__ unsigned xb_add(unsigned* p, unsigned v) { return __hip_atomic_fetch_add(p, v, __ATOMIC_RELAXED, __HIP_MEMORY_SCOPE_AGENT); }
__device__ __forceinline__ unsigned xb_xcc_id() { return (unsigned)__builtin_amdgcn_s_getreg((3 << 11) | 20) & 0xFu; }
#define XB_SPIN(cond, bar) do { unsigned _sp = 0; while (cond) { __builtin_amdgcn_s_sleep(1); \
    if ((++_sp & 255u) == 0u) { if (xb_ld(&(bar)[XB_TMO])) break; if (_sp > XB_SPIN_CAP) { atomicAdd(&(bar)[XB_TMO], 1u); break; } } } } while (0)

struct XcdBarrier {
    unsigned* bar; unsigned x;
    volatile LAS unsigned* st;
};

__device__ __forceinline__ XcdBarrier xcd_barrier_post(unsigned* bar, volatile LAS unsigned* st) {
    XcdBarrier b; b.bar = bar; b.x = xb_xcc_id(); b.st = st;
    if (threadIdx.x == 0) (void)xb_add(&bar[XB_XCNT(b.x)], 1u);
    return b;
}
__device__ __forceinline__ void xcd_barrier_complete(unsigned* bar, unsigned x, unsigned& nloc, unsigned& nx) {
    const unsigned G = gridDim.x * gridDim.y * gridDim.z;
    unsigned sum, cnt, mine, sp = 0u;
    for (;;) {
        sum = 0u; cnt = 0u; mine = 0u;
#pragma unroll
        for (unsigned j = 0; j < 16; ++j) { const unsigned c = xb_ld(&bar[XB_XCNT(j)]); sum += c; cnt += (c > 0u) ? 1u : 0u; mine = (j == x) ? c : mine; }
        if (sum == G) break;
        __builtin_amdgcn_s_sleep(1);
        if ((++sp & 255u) == 0u) { if (xb_ld(&bar[XB_TMO])) break; if (sp > XB_SPIN_CAP) { atomicAdd(&bar[XB_TMO], 1u); break; } }
    }
    nloc = mine > 0u ? mine : 1u; nx = cnt > 0u ? cnt : 1u;
}

__device__ __forceinline__ void xcd_barrier(const XcdBarrier& b) {
    asm volatile("s_waitcnt vmcnt(0)" ::: "memory");
    __syncthreads();
    if (threadIdx.x == 0) {
        unsigned* bar = b.bar;
        __builtin_amdgcn_s_waitcnt(0);
        unsigned nloc = b.st[0], nx = b.st[1];
        if (nloc == 0u) { xcd_barrier_complete(bar, b.x, nloc, nx); b.st[0] = nloc; b.st[1] = nx; }
        const unsigned old = xb_add(&bar[XB_XSUB(b.x)], 1u);
        const unsigned gen = old / nloc;
        if (old + 1u == (gen + 1u) * nloc) {
            __builtin_amdgcn_fence(__ATOMIC_RELEASE, "agent");
            asm volatile("s_waitcnt vmcnt(0)" ::: "memory");
            const unsigned og = xb_add(&bar[XB_TOP], 1u);
            const unsigned tg = og / nx;
            if (og + 1u == (tg + 1u) * nx) xb_add(&bar[XB_TOPGEN], 1u);
            else XB_SPIN(xb_ld(&bar[XB_TOPGEN]) == tg, bar);
            __builtin_amdgcn_fence(__ATOMIC_ACQUIRE, "agent");
            xb_add(&bar[XB_XGEN(b.x)], 1u);
            asm volatile("s_waitcnt vmcnt(0)" ::: "memory");
        } else {
            XB_SPIN(xb_ld(&bar[XB_XGEN(b.x)]) == gen, bar);
            __builtin_amdgcn_fence(__ATOMIC_ACQUIRE, "agent");
            asm volatile("s_waitcnt vmcnt(0)" ::: "memory");
        }
    }
    __syncthreads();
}

#if TSEL >= 7
#define TSUB_BEGIN(k) unsigned long long tsub_b = 0; if ((TSEL) == (k) && threadIdx.x == 0) tsub_b = __builtin_amdgcn_s_memrealtime();
#define TSUB_END(k) if ((TSEL) == (k) && threadIdx.x == 0) { volatile LAS unsigned long long* TWs = (volatile LAS unsigned long long*)((LAS unsigned char*)lds_raw + LDS_BARST + 16); TWs[2] += __builtin_amdgcn_s_memrealtime() - tsub_b; }
#else
#define TSUB_BEGIN(k)
#define TSUB_END(k)
#endif
constexpr int NPH = 15;
__global__ void __launch_bounds__(NTHR, 2) hymba_fwd(Params p0) {
    extern __shared__ __attribute__((aligned(16))) unsigned char lds_raw[];
    cg::grid_group grid = cg::this_grid();
    if (threadIdx.x < 16) ((LAS unsigned*)((LAS unsigned char*)lds_raw + LDS_BARST))[threadIdx.x] = 0u;
    __syncthreads();
    XcdBarrier bar = xcd_barrier_post((unsigned*)(p0.ws + WS_CTL), (volatile LAS unsigned*)((LAS unsigned char*)lds_raw + LDS_BARST));
#if TSEL >= 0
    volatile LAS unsigned long long* TW = (volatile LAS unsigned long long*)((LAS unsigned char*)lds_raw + LDS_BARST + 16);
    if (threadIdx.x == 0) { const unsigned long long t = __builtin_amdgcn_s_memrealtime(); TW[0] = t; TW[1] = t; TW[2] = 0; }
#endif
    for (int ph = p0.ph_lo; ph < p0.ph_hi; ++ph) {
        const int ptype = ph == 0 ? 0 : 1 + (ph - 1) % 7;
        const int nrep = (REPEAT_MASK) == 0 ? 1 : ((((REPEAT_MASK) >> ptype) & 1) ? 2 : 1);
        for (int rep = 0; rep < nrep; ++rep) {
        int tid = threadIdx.x; asm volatile("" : "+v"(tid));
        int G = gridDim.x; asm volatile("" : "+s"(G));
        const int lane = tid & 63, wave = __builtin_amdgcn_readfirstlane(tid >> 6);
        LAS unsigned char* lds = (LAS unsigned char*)lds_raw; asm volatile("" : "+s"(lds));
        Params p = p0;
        asm volatile("" : "+s"(p.ws)); asm volatile("" : "+s"(p.x)); asm volatile("" : "+s"(p.out)); asm volatile("" : "+s"(p.w_in)); asm volatile("" : "+s"(p.w_out));
        asm volatile("" : "+s"(p.conv_w)); asm volatile("" : "+s"(p.norm_g)); asm volatile("" : "+s"(p.mnorm_g)); asm volatile("" : "+s"(p.b_gate)); asm volatile("" : "+s"(p.rel_bias)); asm volatile("" : "+s"(p.final_g));
        if (ph == 0) {
            prologue_transposes(p, lds, wave, lane);
            build_wgt(p, tid);
            norm_phase(p, p.x, 0, wave, lane);
        } else {
            const int l = (ph - 1) / 7, k = (ph - 1) % 7;
            if (k == 0) {
                pg8::Gemm g{(const pg8::bf16_t*)(p.ws + WS_XN), (const pg8::bf16_t*)(p.ws + WS_WIN + (size_t)l * 128 * MiB), SEQ, NU, DM};
                pg8::StaticOrder S; S.init(SEQ, NU, G, blk());
                pg8::EpiBf16Plain E{(pg8::bf16_t*)(p.ws + WS_U), NU};
                pg8::gemm_phase<pg8::EpiBf16Plain, pg8::StaticOrder, true, true>(lds, g, S, E);
            } else if (k == 1) {
                gate_items(p, lds, l, tid, wave, lane);
                conv_prepass(p, l, tid);
                attn_phase(p, lds, tid, wave, lane);
            } else if (k == 2) {
                const bool xmap = (G == 256); const int xcd = blk() & 7, xi = blk() >> 3;
                int tid3 = tid; asm volatile("" : "+v"(tid3));
                { TSUB_BEGIN(8)
                for (int rr = 0; rr < 1 + (REP_M1); ++rr)
                for (int it = blk(), rnd = 0; it < 512; it += G, ++rnd) {
                    int item = it;
                    if (xmap) item = (xcd * 16 + rnd * 8 + (xi >> 2)) * 4 + (xi & 3);
                    m1_item(p, lds, l, item, tid3, __builtin_amdgcn_readfirstlane(tid3 >> 6), tid3 & 63); __syncthreads(); }
                TSUB_END(8) }
                merge_phase(p, tid);
            } else if (k == 3) {
                m2_phase(p, tid);
            } else if (k == 4) {
                const bool xmap = (G == 256); const int xcd = blk() & 7, xi = blk() >> 3;
                TSUB_BEGIN(9)
                for (int it = blk(), rnd = 0; it < 512; it += G, ++rnd) {
                    int hh = it >> 7, qb = it & 127; if ((it >> 8) & 1) qb ^= 3;
                    if (xmap) { const int pair = xcd * 16 + rnd * 8 + (xi >> 2); hh = pair >> 5; qb = (pair & 31) * 4 + (rnd ? 3 - (xi & 3) : (xi & 3)); }
                    m3_item(p, lds, l, hh, qb, tid, wave, lane); }
                TSUB_END(9)
            } else if (k == 5) {
                pg8::Gemm g{(const pg8::bf16_t*)(p.ws + WS_Y), (const pg8::bf16_t*)(p.ws + WS_WOUT + (size_t)l * 32 * MiB), SEQ, DM, DM};
                pg8::StaticOrder S; S.init(SEQ, DM, G, blk());
                pg8::EpiResF32 E{l == 0 ? p.x : (const float*)(p.ws + WS_X1), l == 0 ? (float*)(p.ws + WS_X1) : p.out, DM};
                pg8::gemm_phase<pg8::EpiResF32, pg8::StaticOrder, true, true>(lds, g, S, E);
            } else {
                if (l == 0) norm_phase(p, (const float*)(p.ws + WS_X1), 1, wave, lane);
                else final_norm_phase(p, (LAS unsigned char*)lds_raw, wave, lane);
            }
        }
        __syncthreads();
        }
        if (ph + 1 < p0.ph_hi) { if (p0.ph_hi > NPH) grid.sync(); else xcd_barrier(bar); }
#if TSEL >= 0
        if (threadIdx.x == 0) { const unsigned long long now = __builtin_amdgcn_s_memrealtime(); if (ptype == (TSEL)) TW[2] += now - TW[1]; TW[1] = now;
          if (ph + 2 == p0.ph_hi) ((volatile LAS int*)TW)[8] = (int)((float)TW[2] / (float)(now - TW[0]) * 131072.f); }
        if (ph + 2 == p0.ph_hi) __syncthreads();
#endif
    }
}

extern "C" void kernel_launch(void* const* d_in, const int* in_sizes, int n_in, void* d_out, int out_size, void* d_ws, size_t ws_size, hipStream_t stream) {
    static int grid = 0;
    if (grid == 0) {
        if (n_in != 9 || in_sizes[0] != SEQ * DM || out_size != SEQ * DM || ws_size < WS_END) {
            fprintf(stderr, "kernel_launch: unexpected problem: n_in %d in0 %d out %d ws %zu (need %zu)\n", n_in, n_in > 0 ? in_sizes[0] : -1, out_size, ws_size, (size_t)WS_END); grid = -1; return; }
        int dev = 0, cus = 0, per_cu = 0;
        hipGetDevice(&dev);
        hipDeviceGetAttribute(&cus, hipDeviceAttributeMultiprocessorCount, dev);
        if (hipFuncSetAttribute((const void*)hymba_fwd, hipFuncAttributeMaxDynamicSharedMemorySize, LDS_BYTES) != hipSuccess) { fprintf(stderr, "kernel_launch: hipFuncSetAttribute failed\n"); grid = -1; return; }
        if (hipOccupancyMaxActiveBlocksPerMultiprocessor(&per_cu, (const void*)hymba_fwd, NTHR, LDS_BYTES) != hipSuccess || per_cu < 1) { fprintf(stderr, "kernel_launch: occupancy query gave %d\n", per_cu); per_cu = 1; }
        (void)hipGetLastError();
        grid = cus * per_cu;
        fprintf(stderr, "kernel_launch: %d CUs x %d = grid %d\n", cus, per_cu, grid);
    }
    if (grid < 0) return;
    if (hipMemsetAsync((char*)d_ws + WS_CTL, 0, 16384, stream) != hipSuccess) { fprintf(stderr, "kernel_launch: hipMemsetAsync failed\n"); return; }
    Params p{};
    p.x = (const float*)d_in[0]; p.norm_g = (const float*)d_in[1]; p.w_in = (const float*)d_in[2]; p.b_gate = (const float*)d_in[3]; p.conv_w = (const float*)d_in[4];
    p.mnorm_g = (const float*)d_in[5]; p.w_out = (const float*)d_in[6]; p.rel_bias = (const float*)d_in[7]; p.final_g = (const float*)d_in[8];
    p.out = (float*)d_out; p.ws = (unsigned char*)d_ws;
#if MULTI_LAUNCH
    for (int ph = 0; ph < NPH; ++ph) { p.ph_lo = ph; p.ph_hi = ph + 1; hipLaunchKernelGGL(hymba_fwd, dim3(grid), dim3(NTHR), LDS_BYTES, stream, p); }
#else
    p.ph_lo = 0; p.ph_hi = NPH;
    void* args[] = {&p};
    hipError_t e = hipLaunchCooperativeKernel((const void*)hymba_fwd, dim3(grid), dim3(NTHR), args, LDS_BYTES, stream);
    if (e != hipSuccess) fprintf(stderr, "kernel_launch: cooperative launch failed: %s (grid %d)\n", hipGetErrorString(e), grid);
#endif
}
```
